# Optimizing an MI355X kernel written in HIP

```python
import jax, jax.numpy as jnp
from jax import lax
import numpy as np


D_MODEL = 2048
BATCH = 2
SEQ = 8192
DEPTH = 1

CHUNK = 64
HG_HEADS = 8
HG_DK = 128
HG_DV = 128
HG_WIDTH = HG_HEADS * HG_DK
SA_HEADS = 8
SA_HEAD_DIM = 128
SA_WIDTH = SA_HEADS * SA_HEAD_DIM
IDX_HEADS = 8
IDX_DIM = 64
MAX_TOPK = 256
N_BRANCH = 2
N_GROUPS = 4
EXPERTS_PER_GROUP = 8
N_EXPERTS = N_GROUPS * EXPERTS_PER_GROUP
TOPK_IN_GROUP = 2
D_FF_EXPERT = 1024
MOE_BLOCK = 128
DN_ALPHA = (2.0 * DEPTH) ** 0.25
DN_BETA = (8.0 * DEPTH) ** -0.25
LN_EPS = 1e-5
RMS_EPS = 1e-6
PROJ_SIZES = (HG_WIDTH, HG_WIDTH, HG_WIDTH, HG_WIDTH,
              SA_WIDTH, SA_WIDTH, SA_WIDTH,
              IDX_HEADS * IDX_DIM, IDX_DIM, IDX_HEADS,
              N_BRANCH * D_MODEL)
PROJ_TOTAL = sum(PROJ_SIZES)

kernel_name = 'hybrid_hgrn2_dsa_hmoe_block'


def _layer_norm(x, g, b):
    xf = x.astype(jnp.float32)
    mu = jnp.mean(xf, -1, keepdims=True)
    var = jnp.mean(jnp.square(xf - mu), -1, keepdims=True)
    y = (xf - mu) * lax.rsqrt(var + LN_EPS) * g.astype(jnp.float32) + b.astype(jnp.float32)
    return y.astype(x.dtype)


def _hgrn2(q, f_logit, i, g, lb, norm_g):
    bsz, seq, _ = q.shape
    n_chunks = seq // CHUNK
    f32 = jnp.float32
    shp_k = (bsz, n_chunks, CHUNK, HG_HEADS, HG_DK)
    shp_v = (bsz, n_chunks, CHUNK, HG_HEADS, HG_DV)
    f = lb + (1.0 - lb) * jax.nn.sigmoid(f_logit.astype(f32))
    qh = jax.nn.silu(q.astype(f32)).reshape(shp_k)
    kh = (1.0 - f).reshape(shp_k)
    vh = i.astype(f32).reshape(shp_v)
    cum = jnp.cumsum(jnp.log(f).reshape(shp_k), axis=2)
    cum_last = cum[:, :, -1:]
    q_dec = qh * jnp.exp(cum)
    k_dec = kh * jnp.exp(-cum)
    k_end = kh * jnp.exp(cum_last - cum)
    causal = jnp.tril(jnp.ones((CHUNK, CHUNK), dtype=bool))
    att = jnp.einsum('bnthd,bnshd->bnhts', q_dec, k_dec)
    att = jnp.where(causal, att, 0.0)
    o = jnp.einsum('bnhts,bnshv->bnthv', att, vh)
    chunk_kv = jnp.einsum('bnshd,bnshv->bnhdv', k_end, vh)
    chunk_decay = jnp.exp(cum_last[:, :, 0])

    def step(state, inp):
        dec, kv = inp
        return dec[..., None] * state + kv, state

    s0 = jnp.zeros((bsz, HG_HEADS, HG_DK, HG_DV), f32)
    _, s_prev = lax.scan(step, s0, (jnp.moveaxis(chunk_decay, 1, 0), jnp.moveaxis(chunk_kv, 1, 0)))
    s_prev = jnp.moveaxis(s_prev, 0, 1)
    o = o + jnp.einsum('bnthd,bnhdv->bnthv', q_dec, s_prev)
    o = o * lax.rsqrt(jnp.mean(jnp.square(o), -1, keepdims=True) + RMS_EPS)
    o = o.reshape(bsz, seq, HG_HEADS * HG_DV) * norm_g.astype(f32) * jax.nn.silu(g.astype(f32))
    return o.astype(q.dtype)


def _dsa(q, k, v, q_idx, k_idx, w_idx):
    bsz, seq, _ = q.shape
    n_chunks = seq // CHUNK
    topk = min(MAX_TOPK, seq // 4)
    f32 = jnp.float32
    q = q.reshape(bsz, seq, SA_HEADS, SA_HEAD_DIM)
    k = k.reshape(bsz, seq, SA_HEADS, SA_HEAD_DIM)
    v = v.reshape(bsz, seq, SA_HEADS, SA_HEAD_DIM)
    q_idx = q_idx.reshape(bsz, seq, IDX_HEADS, IDX_DIM)
    w_idx = w_idx * (IDX_HEADS ** -0.5 * IDX_DIM ** -0.5)
    scale = SA_HEAD_DIM ** -0.5
    slopes = 2.0 ** (-8.0 * jnp.arange(1, SA_HEADS + 1, dtype=f32) / SA_HEADS)
    key_chunk = jnp.arange(seq) // CHUNK
    gather = jax.vmap(lambda arr, idx: arr[idx])

    def one_chunk(c):
        start = c * CHUNK
        qc = lax.dynamic_slice_in_dim(q, start, CHUNK, axis=1)
        qic = lax.dynamic_slice_in_dim(q_idx, start, CHUNK, axis=1)
        wc = lax.dynamic_slice_in_dim(w_idx, start, CHUNK, axis=1)
        rel = jax.nn.relu(jnp.einsum('bqhd,bsd->bqhs', qic, k_idx))
        score = jnp.einsum('bqh,bqhs->bqs', wc, rel).astype(f32)
        score = jnp.where(key_chunk <= c, score, -jnp.inf)
        top_val, top_idx = lax.top_k(score, topk)
        valid = top_val > -jnp.inf
        ks = gather(k, top_idx)
        vs = gather(v, top_idx)
        qpos = start + jnp.arange(CHUNK)
        dist = jnp.abs(qpos[None, :, None] - top_idx).astype(f32)
        logits = jnp.einsum('bqhd,bqkhd->bqhk', qc, ks).astype(f32) * scale
        logits = logits - slopes[None, None, :, None] * dist[:, :, None, :]
        logits = jnp.where(valid[:, :, None, :], logits, -jnp.inf)
        p = jax.nn.softmax(logits, axis=-1)
        return jnp.einsum('bqhk,bqkhd->bqhd', p.astype(v.dtype), vs)

    out = lax.map(one_chunk, jnp.arange(n_chunks))
    return jnp.transpose(out, (1, 0, 2, 3, 4)).reshape(bsz, seq, SA_WIDTH)


def _token_mixer(x, w_in, b_in, lb, hg_norm_g, w_branch_a, w_branch_b, w_out):
    proj = x @ w_in + b_in
    points = [int(p) for p in np.cumsum(PROJ_SIZES)[:-1]]
    aq, af, ai, ag, bq, bk, bv, iq, ik, iw, gates = jnp.split(proj, points, axis=-1)
    branch_a = _hgrn2(aq, af, ai, ag, lb, hg_norm_g)
    branch_b = _dsa(bq, bk, bv, iq, ik, iw)
    gate = jax.nn.sigmoid(gates.astype(jnp.float32)).astype(x.dtype)
    gate_a, gate_b = jnp.split(gate, N_BRANCH, axis=-1)
    merged = gate_a * (branch_a @ w_branch_a) + gate_b * (branch_b @ w_branch_b)
    return merged @ w_out


def _routed_experts(xf, e_ids, wts, w_gate, w_up, w_down):
    n_tok, d = xf.shape
    n_assign = n_tok * TOPK_IN_GROUP
    e = e_ids.reshape(-1)
    tok = jnp.repeat(jnp.arange(n_tok, dtype=jnp.int32), TOPK_IN_GROUP)
    w = wts.reshape(-1)
    order = jnp.argsort(e)
    e_s, tok_s, w_s = e[order], tok[order], w[order]
    counts = jnp.zeros((N_EXPERTS,), jnp.int32).at[e].add(1)
    padded = ((counts + MOE_BLOCK - 1) // MOE_BLOCK) * MOE_BLOCK
    start = jnp.cumsum(counts) - counts
    pend = jnp.cumsum(padded)
    pstart = pend - padded
    dest = pstart[e_s] + (jnp.arange(n_assign, dtype=jnp.int32) - start[e_s])
    n_blocks = -(-(n_assign + N_EXPERTS * (MOE_BLOCK - 1)) // MOE_BLOCK)
    n_rows = n_blocks * MOE_BLOCK
    row_tok = jnp.zeros((n_rows,), jnp.int32).at[dest].set(tok_s)
    row_w = jnp.zeros((n_rows,), xf.dtype).at[dest].set(w_s)
    block_pos = jnp.arange(n_blocks, dtype=jnp.int32) * MOE_BLOCK
    block_e = jnp.minimum(jnp.searchsorted(pend, block_pos, side='right'), N_EXPERTS - 1)

    def one_block(args):
        rows, ex = args
        xb = xf[rows]
        hb = jax.nn.silu(xb @ w_gate[ex]) * (xb @ w_up[ex])
        return hb @ w_down[ex]

    ys = lax.map(one_block, (row_tok.reshape(n_blocks, MOE_BLOCK), block_e))
    ys = ys.reshape(n_rows, d) * row_w[:, None]
    return jnp.zeros_like(xf).at[row_tok].add(ys)


def _hier_moe(x, w_group, b_group, w_router, b_router, w_gate, w_up, w_down):
    bsz, seq, d = x.shape
    xf = x.reshape(-1, d)
    n_tok = xf.shape[0]
    g_prob = jax.nn.softmax((xf @ w_group + b_group).astype(jnp.float32), axis=-1)
    g_top_p, g_top = lax.top_k(g_prob, 1)
    e_logits = (xf @ w_router + b_router).astype(jnp.float32).reshape(n_tok, N_GROUPS, EXPERTS_PER_GROUP)
    e_in_group = jnp.take_along_axis(e_logits, g_top[:, :, None], axis=1)[:, 0]
    e_val, e_idx = lax.top_k(e_in_group, TOPK_IN_GROUP)
    wts = jax.nn.softmax(e_val, axis=-1) * g_top_p
    e_ids = g_top * EXPERTS_PER_GROUP + e_idx
    y = _routed_experts(xf, e_ids, wts.astype(x.dtype), w_gate, w_up, w_down)
    return y.reshape(bsz, seq, d)


def setup_inputs(seed: int = 0) -> dict:
    key = jax.random.key(seed)
    ks = jax.random.split(key, 20)
    f32 = jnp.float32
    d = D_MODEL
    nrm = lambda k, shp, s: jax.random.normal(k, shp, f32) * s
    x = nrm(ks[0], (BATCH, SEQ, d), 1.0)
    w_in = nrm(ks[1], (DEPTH, d, PROJ_TOTAL), d ** -0.5)
    v_lo = 4 * HG_WIDTH + 2 * SA_WIDTH
    w_in = w_in.at[:, :, v_lo:v_lo + SA_WIDTH].multiply(DN_BETA)
    b_in = nrm(ks[2], (DEPTH, PROJ_TOTAL), 0.02)
    hg_lb_logits = nrm(ks[3], (DEPTH + 1, HG_WIDTH), 0.1)
    hg_norm_g = 1.0 + nrm(ks[4], (DEPTH, HG_WIDTH), 0.02)
    w_branch_a = nrm(ks[5], (DEPTH, HG_WIDTH, d), HG_WIDTH ** -0.5)
    w_branch_b = nrm(ks[6], (DEPTH, SA_WIDTH, d), SA_WIDTH ** -0.5)
    w_out = nrm(ks[7], (DEPTH, d, d), d ** -0.5 * DN_BETA)
    ln1_g = 1.0 + nrm(ks[8], (DEPTH, d), 0.02)
    ln1_b = nrm(ks[9], (DEPTH, d), 0.02)
    w_group = nrm(ks[10], (DEPTH, d, N_GROUPS), d ** -0.5)
    b_group = nrm(ks[11], (DEPTH, N_GROUPS), 0.01)
    w_router = nrm(ks[12], (DEPTH, d, N_EXPERTS), d ** -0.5)
    b_router = nrm(ks[13], (DEPTH, N_EXPERTS), 0.01)
    w_gate = nrm(ks[14], (DEPTH, N_EXPERTS, d, D_FF_EXPERT), d ** -0.5)
    w_up = nrm(ks[15], (DEPTH, N_EXPERTS, d, D_FF_EXPERT), d ** -0.5)
    w_down = nrm(ks[16], (DEPTH, N_EXPERTS, D_FF_EXPERT, d), D_FF_EXPERT ** -0.5 * DN_BETA)
    ln2_g = 1.0 + nrm(ks[17], (DEPTH, d), 0.02)
    ln2_b = nrm(ks[18], (DEPTH, d), 0.02)
    return {'x': x, 'w_in': w_in, 'b_in': b_in, 'hg_lb_logits': hg_lb_logits, 'hg_norm_g': hg_norm_g,
            'w_branch_a': w_branch_a, 'w_branch_b': w_branch_b, 'w_out': w_out,
            'ln1_g': ln1_g, 'ln1_b': ln1_b, 'w_group': w_group, 'b_group': b_group,
            'w_router': w_router, 'b_router': b_router, 'w_gate': w_gate, 'w_up': w_up,
            'w_down': w_down, 'ln2_g': ln2_g, 'ln2_b': ln2_b}


def reference(x, w_in, b_in, hg_lb_logits, hg_norm_g, w_branch_a, w_branch_b, w_out,
              ln1_g, ln1_b, w_group, b_group, w_router, b_router, w_gate, w_up,
              w_down, ln2_g, ln2_b):
    lower_bounds = jnp.cumsum(jax.nn.softmax(hg_lb_logits.astype(jnp.float32), axis=0), axis=0)
    h = x
    for l in range(DEPTH):
        mix = _token_mixer(h, w_in[l], b_in[l], lower_bounds[l], hg_norm_g[l],
                           w_branch_a[l], w_branch_b[l], w_out[l])
        h = _layer_norm(DN_ALPHA * h + mix, ln1_g[l], ln1_b[l])
        ffn = _hier_moe(h, w_group[l], b_group[l], w_router[l], b_router[l],
                        w_gate[l], w_up[l], w_down[l])
        h = _layer_norm(DN_ALPHA * h + ffn, ln2_g[l], ln2_b[l])
    return h
```

```cpp
#include <hip/hip_runtime.h>
#include <hip/hip_cooperative_groups.h>
#include <cstdio>
#include <cstdint>
namespace cg = cooperative_groups;

#define LAS __attribute__((address_space(3)))
typedef unsigned short bf16_t;
typedef short bf16x8 __attribute__((ext_vector_type(8)));
typedef float f32x4 __attribute__((ext_vector_type(4)));
typedef float f32x2 __attribute__((ext_vector_type(2)));
typedef float f32x16 __attribute__((ext_vector_type(16)));
typedef unsigned u32x4 __attribute__((ext_vector_type(4)));
typedef unsigned u32x2 __attribute__((ext_vector_type(2)));

constexpr int MT = 16384, SEQ = 8192, DM = 2048, NHEAD = 8, HD = 128, NPROJ = 11848, NPROJ_PAD = 12032;
constexpr int NEXP = 32, DFF = 1024, MAXROWS = 40960;
constexpr float DN_ALPHA = 1.189207115002721f;
constexpr float LN_EPS = 1e-5f, RMS_EPS = 1e-6f;
constexpr int NWAVES = 8, NTHR = 512;
constexpr int LDS_BYTES = 163840;

constexpr size_t MiB = 1u << 20;
constexpr size_t WS_CTL = 0;
constexpr size_t WS_WIN = 1 * MiB;
constexpr size_t WS_WA = 48 * MiB, WS_WB = 52 * MiB, WS_WOUT = 56 * MiB;
constexpr size_t WS_XB = 64 * MiB;
constexpr size_t WS_MERGED = 64 * MiB;
constexpr size_t WS_AQ = 128 * MiB, WS_AI = 160 * MiB, WS_AG = 192 * MiB, WS_BQ = 224 * MiB, WS_BK = 256 * MiB, WS_BV = 288 * MiB;
constexpr size_t WS_AF = 320 * MiB;
constexpr size_t WS_IQ = 384 * MiB;
constexpr size_t WS_IKW = 400 * MiB;
constexpr size_t WS_GATES = 408 * MiB;
constexpr size_t WS_WGU = 128 * MiB;
constexpr size_t WS_WD = 384 * MiB;
constexpr size_t WS_MASK = 536 * MiB;
constexpr size_t WS_KV = 552 * MiB;
constexpr size_t WS_PRE1 = 552 * MiB;
constexpr size_t WS_ST = 680 * MiB;
constexpr size_t WS_H1B = 680 * MiB;
constexpr size_t WS_DECAY = 744 * MiB;
constexpr size_t WS_ROWS = 745 * MiB;
constexpr size_t WS_SLOT = 747 * MiB;
constexpr size_t WS_BRA = 750 * MiB, WS_BRB = 782 * MiB;
constexpr size_t WS_IK2 = 814 * MiB;
constexpr size_t WS_HH = 750 * MiB;
constexpr size_t WS_XG = 830 * MiB;
constexpr size_t WS_Y = 830 * MiB;
constexpr size_t WS_END = 990 * MiB;
constexpr int CW_CNT = 1024;
constexpr int CW_NT = 4096;
constexpr int CW_TILEE = 4160;
constexpr int CW_TBASE = 4400;
constexpr int CW_BAR = 8192;
constexpr int LDS_BIAS = 131072;
constexpr int LDS_MOE_TB = 131072, LDS_MOE_TE = 131072 + 256, LDS_MOE_TOK = 131072 + 1024;
constexpr int LDS_BARST = LDS_BYTES - 64;

__device__ __forceinline__ float bf2f(unsigned h) { return __uint_as_float(h << 16); }
__device__ __forceinline__ unsigned cvt_pk(float lo, float hi) { unsigned r; asm volatile("v_cvt_pk_bf16_f32 %0, %1, %2" : "=v"(r) : "v"(lo), "v"(hi)); return r; }
__device__ __forceinline__ unsigned cvt_pk_mfma(float lo, float hi) { unsigned r; asm volatile("s_nop 15\n\ts_nop 3\n\tv_cvt_pk_bf16_f32 %0, %1, %2" : "=v"(r) : "v"(lo), "v"(hi)); return r; }
__device__ __forceinline__ unsigned cvt_pk_to_mfma(float lo, float hi) { unsigned r; asm volatile("v_cvt_pk_bf16_f32 %0, %1, %2\n\ts_nop 1" : "=v"(r) : "v"(lo), "v"(hi)); return r; }
__device__ __forceinline__ float wave_sum(float v) {
#pragma unroll
    for (int o = 1; o < 64; o <<= 1) v += __shfl_xor(v, o);
    return v;
}
__device__ __forceinline__ float fast_exp(float x) { return __builtin_amdgcn_exp2f(x * 1.4426950408889634f); }
__device__ __forceinline__ float sigmoidf_(float x) { return __builtin_amdgcn_rcpf(1.0f + __expf(-x)); }
#define LDS_WAIT() asm volatile("s_waitcnt lgkmcnt(0)" ::: "memory")
template <typename T> __device__ __forceinline__ T* uni_ptr(T* p) { const unsigned long long v = (unsigned long long)p; const unsigned lo = __builtin_amdgcn_readfirstlane((unsigned)v), hi = __builtin_amdgcn_readfirstlane((unsigned)(v >> 32)); return (T*)(((unsigned long long)hi << 32) | lo); }
__device__ __forceinline__ float uni_f(float x) { return __uint_as_float(__builtin_amdgcn_readfirstlane(__float_as_uint(x))); }

namespace pg8 {
#define PG8_LAS __attribute__((address_space(3)))
typedef unsigned short bf16_t;
typedef short bf16x8 __attribute__((ext_vector_type(8)));
typedef float f32x4 __attribute__((ext_vector_type(4)));
typedef unsigned u32x4 __attribute__((ext_vector_type(4)));
constexpr int BM = 256, BK = 64, HALF = 128, HTB = HALF * BK * 2  , STAGE_BYTES = 8 * HTB, NXCD = 8, WGM = 8;

__host__ __device__ __forceinline__ int lds_byte(int r, int c) { const int st = (r >> 4) * 2 + (c >> 5), rr = r & 15, cc = c & 31, ob = rr * 64 + cc * 2; return st * 1024 + (ob ^ (((ob >> 9) & 1) << 5)); }
__host__ __device__ __forceinline__ void stage_rc(int b, int& R, int& C) { const int st = b / 1024, sb = b % 1024, swz = sb ^ (((sb >> 9) & 1) << 5); R = (st >> 1) * 16 + swz / 64; C = (st & 1) * 32 + (swz % 64) / 2; }
__host__ __device__ __forceinline__ int perm32(int rho) { const int n = rho >> 4, i = rho & 15; return 8 * (i >> 2) + 4 * n + (i & 3); }

struct Unit { int pm, pn, pb; };
struct Gemm { const bf16_t* A; const bf16_t* Bt; int M, N, K; };

struct StaticOrder {
    static constexpr bool GATHER = false; __device__ __forceinline__ unsigned row_off(int, int) const { return 0u; }
    int nM, nN, nwg, G, c;
    __host__ __device__ void init(int M, int N, int G_, int c_) { nM = M / BM; nN = N / BM; nwg = nM * nN; G = G_; c = c_; }
    __host__ __device__ bool next(int i, Unit& u) const {
        const long L = (long)i * G + c; if (L >= nwg) return false;
        int wgid = (int)L; { const int q = nwg / NXCD, r = nwg % NXCD, xcd = wgid % NXCD, off = wgid / NXCD; wgid = (xcd < r ? xcd * (q + 1) : r * (q + 1) + (xcd - r) * q) + off; }
        const int nig = WGM * nN, gid = wgid / nig, fm = gid * WGM, gsz = (nM - fm) < WGM ? (nM - fm) : WGM;
        u.pm = fm + ((wgid % nig) % gsz); u.pn = (wgid % nig) / gsz; u.pb = u.pn; return true;
    }
    __device__ __forceinline__ void a_ready(const Unit&) const {}
    __device__ __forceinline__ void done(const Unit&) const {}
};


__device__ __forceinline__ unsigned cvt_pk_bf16(float lo, float hi) { unsigned r; asm volatile("v_cvt_pk_bf16_f32 %0, %1, %2" : "=v"(r) : "v"(lo), "v"(hi)); return r; }
__device__ __forceinline__ float sigm(float x) { return __builtin_amdgcn_rcpf(1.0f + __expf(-x)); }

struct EpiProj {
    static constexpr bool PERM = true, AFTER_DRAIN = false;
    unsigned char* ws; const PG8_LAS unsigned char* lbias;
    __device__ __forceinline__ void operator()(const f32x4 (&acc)[2][2][4][2], const Unit& u, int wr, int wc, int fr, int fq) const {
        const int pn = u.pn, row0 = u.pm * BM + wr * 64 + fr, lc0 = wc * 32 + 8 * fq;
        f32x4 bv[2][2];
#pragma unroll
        for (int bj = 0; bj < 2; ++bj) { const u32x4 bw = *(const PG8_LAS u32x4*)(lbias + (size_t)(pn * 256 + lc0 + bj * HALF) * 2);
            bv[bj][0] = (f32x4){__uint_as_float(bw.x << 16), __uint_as_float(bw.x & 0xffff0000u), __uint_as_float(bw.y << 16), __uint_as_float(bw.y & 0xffff0000u)};
            bv[bj][1] = (f32x4){__uint_as_float(bw.z << 16), __uint_as_float(bw.z & 0xffff0000u), __uint_as_float(bw.w << 16), __uint_as_float(bw.w & 0xffff0000u)}; }
        if (pn >= 4 && pn < 8) {
            float* base = (float*)(ws + WS_AF);
#pragma unroll
            for (int ai = 0; ai < 2; ++ai)
#pragma unroll
                for (int m = 0; m < 4; ++m) { float* rowp = base + (size_t)(row0 + ai * HALF + m * 16) * 1024 + (pn - 4) * 256 + lc0;
#pragma unroll
                    for (int bj = 0; bj < 2; ++bj) { *(f32x4*)(rowp + bj * HALF) = acc[ai][bj][m][0] + bv[bj][0]; *(f32x4*)(rowp + bj * HALF + 4) = acc[ai][bj][m][1] + bv[bj][1]; } }
            return;
        }
        bf16_t* base; int ldc, colt; bool sg = false;
        if (pn < 28) { const int s = pn >> 2, idx = (s == 0) ? 0 : s - 1; base = (bf16_t*)(ws + WS_AQ + (size_t)idx * (32 * MiB)); ldc = 1024; colt = (pn & 3) * 256; }
        else if (pn < 30) { base = (bf16_t*)(ws + WS_IQ); ldc = 512; colt = (pn - 28) * 256; }
        else if (pn == 30) { base = (bf16_t*)(ws + WS_IKW); ldc = 256; colt = 0; }
        else { base = (bf16_t*)(ws + WS_GATES); ldc = 4096; colt = (pn - 31) * 256; sg = true; }
#pragma unroll
        for (int ai = 0; ai < 2; ++ai)
#pragma unroll
            for (int m = 0; m < 4; ++m) { bf16_t* rowp = base + (size_t)(row0 + ai * HALF + m * 16) * ldc + colt + lc0;
#pragma unroll
                for (int bj = 0; bj < 2; ++bj) { f32x4 v0 = acc[ai][bj][m][0] + bv[bj][0], v1 = acc[ai][bj][m][1] + bv[bj][1];
                    if (sg) { v0 = (f32x4){sigm(v0[0]), sigm(v0[1]), sigm(v0[2]), sigm(v0[3])}; v1 = (f32x4){sigm(v1[0]), sigm(v1[1]), sigm(v1[2]), sigm(v1[3])}; }
                    u32x4 w; w.x = cvt_pk_bf16(v0[0], v0[1]); w.y = cvt_pk_bf16(v0[2], v0[3]); w.z = cvt_pk_bf16(v1[0], v1[1]); w.w = cvt_pk_bf16(v1[2], v1[3]);
                    *(u32x4*)(rowp + bj * HALF) = w;
                    if (pn == 30 && bj == 0 && lc0 < 64) {
                        const int tok = row0 + ai * HALF + m * 16;
                        *(u32x4*)((bf16_t*)(ws + WS_IK2) + ((size_t)((tok >> 5) * 4 + (lc0 >> 4)) * 64 + ((lc0 >> 3) & 1) * 32 + (tok & 31)) * 8) = w; } } }
    }
};

__device__ __forceinline__ f32x4 bf4lo(u32x4 w) { return (f32x4){__uint_as_float(w.x << 16), __uint_as_float(w.x & 0xffff0000u), __uint_as_float(w.y << 16), __uint_as_float(w.y & 0xffff0000u)}; }
__device__ __forceinline__ f32x4 bf4hi(u32x4 w) { return (f32x4){__uint_as_float(w.z << 16), __uint_as_float(w.z & 0xffff0000u), __uint_as_float(w.w << 16), __uint_as_float(w.w & 0xffff0000u)}; }

template <int MODE> struct EpiBranch {
    static constexpr bool PERM = true, AFTER_DRAIN = false;
    bf16_t* merged; const bf16_t* gates;
    __device__ __forceinline__ void operator()(const f32x4 (&acc)[2][2][4][2], const Unit& u, int wr, int wc, int fr, int fq) const {
        const int row0 = u.pm * BM + wr * 64 + fr, col0 = u.pn * BM + wc * 32 + 8 * fq;
#pragma unroll
        for (int ai = 0; ai < 2; ++ai)
#pragma unroll
            for (int m = 0; m < 4; ++m) { const size_t r = (size_t)(row0 + ai * HALF + m * 16);
#pragma unroll
                for (int bj = 0; bj < 2; ++bj) { const int c = col0 + bj * HALF;
                    const u32x4 gw = *(const u32x4*)(gates + r * 4096 + MODE * 2048 + c);
                    f32x4 v0 = acc[ai][bj][m][0] * bf4lo(gw), v1 = acc[ai][bj][m][1] * bf4hi(gw);
                    if (MODE == 1) { const u32x4 pw = *(const u32x4*)(merged + r * 2048 + c); v0 = v0 + bf4lo(pw); v1 = v1 + bf4hi(pw); }
                    u32x4 w; w.x = cvt_pk_bf16(v0[0], v0[1]); w.y = cvt_pk_bf16(v0[2], v0[3]); w.z = cvt_pk_bf16(v1[0], v1[1]); w.w = cvt_pk_bf16(v1[2], v1[3]);
                    *(u32x4*)(merged + r * 2048 + c) = w; } }
    }
};

struct EpiResBf16 {
    static constexpr bool PERM = true, AFTER_DRAIN = false;
    bf16_t* C; const float* x; float alpha;
    __device__ __forceinline__ void operator()(const f32x4 (&acc)[2][2][4][2], const Unit& u, int wr, int wc, int fr, int fq) const {
        const int row0 = u.pm * BM + wr * 64 + fr, col0 = u.pn * BM + wc * 32 + 8 * fq;
#pragma unroll
        for (int ai = 0; ai < 2; ++ai)
#pragma unroll
            for (int m = 0; m < 4; ++m) { const size_t off = (size_t)(row0 + ai * HALF + m * 16) * 2048 + col0;
#pragma unroll
                for (int bj = 0; bj < 2; ++bj) { const f32x4 x0 = *(const f32x4*)(x + off + bj * HALF), x1 = *(const f32x4*)(x + off + bj * HALF + 4);
                    const f32x4 v0 = x0 * alpha + acc[ai][bj][m][0], v1 = x1 * alpha + acc[ai][bj][m][1];
                    u32x4 w; w.x = cvt_pk_bf16(v0[0], v0[1]); w.y = cvt_pk_bf16(v0[2], v0[3]); w.z = cvt_pk_bf16(v1[0], v1[1]); w.w = cvt_pk_bf16(v1[2], v1[3]);
                    *(u32x4*)(C + off + bj * HALF) = w; } }
    }
};

struct EpiGateUp {
    static constexpr bool PERM = true, AFTER_DRAIN = false;
    bf16_t* H;
    __device__ __forceinline__ void operator()(const f32x4 (&acc)[2][2][4][2], const Unit& u, int wr, int wc, int fr, int fq) const {
        const int row0 = u.pm * BM + wr * 64 + fr, hc0 = u.pn * 128 + wc * 16 + 4 * fq;
#pragma unroll
        for (int ai = 0; ai < 2; ++ai)
#pragma unroll
            for (int m = 0; m < 4; ++m) { bf16_t* rowp = H + (size_t)(row0 + ai * HALF + m * 16) * 1024 + hc0;
#pragma unroll
                for (int bj = 0; bj < 2; ++bj) { const f32x4 g = acc[ai][bj][m][0], up = acc[ai][bj][m][1];
                    f32x4 h;
#pragma unroll
                    for (int j = 0; j < 4; ++j) h[j] = g[j] * sigm(g[j]) * up[j];
                    u32x2 w; w.x = cvt_pk_bf16(h[0], h[1]); w.y = cvt_pk_bf16(h[2], h[3]);
                    *(u32x2*)(rowp + bj * 64) = w; } }
    }
};

struct EpiStoreBf16 {
    static constexpr bool PERM = true, AFTER_DRAIN = false;
    bf16_t* O; int ldc; float one;
    __device__ __forceinline__ void operator()(const f32x4 (&acc)[2][2][4][2], const Unit& u, int wr, int wc, int fr, int fq) const {
        const int row0 = u.pm * BM + wr * 64 + fr, col0 = u.pn * BM + wc * 32 + 8 * fq;
#pragma unroll
        for (int ai = 0; ai < 2; ++ai)
#pragma unroll
            for (int m = 0; m < 4; ++m) { bf16_t* rowp = O + (size_t)(row0 + ai * HALF + m * 16) * ldc + col0;
#pragma unroll
                for (int bj = 0; bj < 2; ++bj) { const f32x4 v0 = acc[ai][bj][m][0] * one, v1 = acc[ai][bj][m][1] * one;
                    u32x4 w; w.x = cvt_pk_bf16(v0[0], v0[1]); w.y = cvt_pk_bf16(v0[2], v0[3]); w.z = cvt_pk_bf16(v1[0], v1[1]); w.w = cvt_pk_bf16(v1[2], v1[3]);
                    *(u32x4*)(rowp + bj * HALF) = w; } }
    }
};

template <bool GATH> struct GroupedOrder {
    static constexpr bool GATHER = GATH;
    int nM, nN, nwg, G, c; const PG8_LAS unsigned* tile_e; const PG8_LAS unsigned* tokoff;
    __device__ __forceinline__ void init(int nT, int nN_, int G_, int c_, const PG8_LAS unsigned* te, const PG8_LAS unsigned* to) { nM = nT; nN = nN_; nwg = nM * nN; G = G_; c = c_; tile_e = te; tokoff = to; }
    __device__ __forceinline__ bool next(int i, Unit& u) const {
        const long L = (long)i * G + c; if (L >= nwg) return false;
        int wgid = (int)L; { const int q = nwg / NXCD, r = nwg % NXCD, xcd = wgid % NXCD, off = wgid / NXCD; wgid = (xcd < r ? xcd * (q + 1) : r * (q + 1) + (xcd - r) * q) + off; }
        const int nig = WGM * nN, gid = wgid / nig, fm = gid * WGM, gsz = (nM - fm) < WGM ? (nM - fm) : WGM;
        u.pm = fm + ((wgid % nig) % gsz); u.pn = (wgid % nig) / gsz; u.pb = (int)tile_e[u.pm] * nN + u.pn; return true;
    }
    __device__ __forceinline__ unsigned row_off(int ui, int r) const { return tokoff[ui * 256 + r]; }
    __device__ __forceinline__ void a_ready(const Unit&) const {}
    __device__ __forceinline__ void done(const Unit&) const {}
};

template <class Epi, class Sched, bool ALIGN_EPI = false, bool SP2 = false>
__device__ __forceinline__ void gemm_phase(PG8_LAS unsigned char* lds, const Gemm g, const Sched& S, const Epi& E) {
    int tid_ = threadIdx.x; asm volatile("" : "+v"(tid_));
    const int tid = tid_, wid = __builtin_amdgcn_readfirstlane(tid >> 6), lane = tid & 63, wr = wid >> 2, wc = wid & 3, fr = lane & 15, fq = lane >> 4;
    const int K = g.K, nt = K / BK;
    constexpr bool GATHER = Sched::GATHER;
    unsigned voffA[2], voffB[2], cAoff[2]; int rA[2];
#pragma unroll
    for (int i = 0; i < 2; ++i) { int R, C; stage_rc(tid * 16 + i * 8192, R, C); const int Rb = Epi::PERM ? ((R & ~31) + perm32(R & 31)) : R;
        voffA[i] = (unsigned)(R * K + C) * 2u; voffB[i] = (unsigned)(Rb * K + C) * 2u; cAoff[i] = (unsigned)C * 2u; rA[i] = R; }
    const size_t kstep = (size_t)(BK * 2);
    const size_t hstep = (size_t)HALF * K * 2;
    const size_t tstep = 2 * hstep;
    const unsigned ldsw = (unsigned)wid * 1024u;
    const int aoff = lds_byte(wr * 64 + fr, fq * 8), boff = lds_byte(wc * 32 + fr, fq * 8);
#define PG8_SA(b, h) (((b) * 2 + (h)) * HTB)
#define PG8_SB(b, h) ((4 + (b) * 2 + (h)) * HTB)
#define PG8_STAGE(bufoff, gbase, voff) do { _Pragma("unroll") for (int _i = 0; _i < 2; ++_i) \
        __builtin_amdgcn_global_load_lds((const unsigned*)((const char*)(gbase) + (voff)[_i]), (PG8_LAS unsigned*)(lds + (bufoff) + ldsw + _i * 8192), 16, 0, 0); } while (0)
#define PG8_STAGE_A(bufoff, gbase, h, nx) do { _Pragma("unroll") for (int _i = 0; _i < 2; ++_i) { const unsigned vo_ = GATHER ? ((nx) ? vAn[h][_i] : vAc[h][_i]) : voffA[_i]; \
        __builtin_amdgcn_global_load_lds((const unsigned*)((const char*)(gbase) + vo_), (PG8_LAS unsigned*)(lds + (bufoff) + ldsw + _i * 8192), 16, 0, 0); } } while (0)
#define PG8_LDA(dst, b, h) do { _Pragma("unroll") for (int m = 0; m < 4; ++m) _Pragma("unroll") for (int k = 0; k < 2; ++k) dst[m][k] = *(const PG8_LAS bf16x8*)(lds + PG8_SA(b, h) + aoff + m * 2048 + k * 1024); } while (0)
#define PG8_LDB(dst, b, h) do { _Pragma("unroll") for (int n = 0; n < 2; ++n) _Pragma("unroll") for (int k = 0; k < 2; ++k) dst[n][k] = *(const PG8_LAS bf16x8*)(lds + PG8_SB(b, h) + boff + n * 2048 + k * 1024); } while (0)
#define PG8_MMA(ai, bj, At, Bt) do { __builtin_amdgcn_s_setprio(1); _Pragma("unroll") for (int m = 0; m < 4; ++m) _Pragma("unroll") for (int n = 0; n < 2; ++n) _Pragma("unroll") for (int k = 0; k < 2; ++k) \
        acc[ai][bj][m][n] = __builtin_amdgcn_mfma_f32_16x16x32_bf16(Bt[n][k], At[m][k], acc[ai][bj][m][n], 0, 0, 0); __builtin_amdgcn_s_setprio(0); } while (0)
#define PG8_WAIT_V(n) asm volatile("s_waitcnt vmcnt(" #n ")" ::: "memory")
#define PG8_WAIT_L(n) asm volatile("s_waitcnt lgkmcnt(" #n ")" ::: "memory")
#define PG8_BAR __builtin_amdgcn_s_barrier()
#define PG8_SCHED __builtin_amdgcn_sched_barrier(0)
    Unit cur, nxt; int ui = 0;
    if (!S.next(0, cur)) return;
    f32x4 acc[2][2][4][2];
#pragma unroll
    for (int a = 0; a < 2; ++a)
#pragma unroll
        for (int b = 0; b < 2; ++b)
#pragma unroll
            for (int m = 0; m < 4; ++m)
#pragma unroll
                for (int n = 0; n < 2; ++n) acc[a][b][m][n] = (f32x4){0.f, 0.f, 0.f, 0.f};
    bf16x8 At[4][2], B0[2][2], B1[2][2];
    const size_t hstepA = GATHER ? 0 : hstep;
    unsigned vAc[2][2], vAn[2][2];
#pragma unroll
    for (int h = 0; h < 2; ++h)
#pragma unroll
        for (int i = 0; i < 2; ++i) { vAc[h][i] = GATHER ? S.row_off(0, h * HALF + rA[i]) + cAoff[i] : 0u; vAn[h][i] = vAc[h][i]; }
    const char* cA = (const char*)g.A + (GATHER ? (size_t)0 : (size_t)cur.pm * tstep); const char* cB = (const char*)g.Bt + (size_t)cur.pb * tstep;
    S.a_ready(cur);
    if constexpr (SP2) {
        PG8_STAGE(PG8_SB(0, 0), cB, voffB); PG8_STAGE(PG8_SB(0, 1), cB + hstep, voffB); PG8_STAGE_A(PG8_SA(0, 0), cA, 0, false); PG8_STAGE_A(PG8_SA(0, 1), cA + hstepA, 1, false);
        if (wr == 1) PG8_BAR;
        PG8_WAIT_V(2); PG8_BAR;
        PG8_STAGE(PG8_SB(1, 0), cB + kstep, voffB); PG8_STAGE_A(PG8_SA(1, 0), cA + kstep, 0, false); PG8_STAGE(PG8_SB(1, 1), cB + hstep + kstep, voffB);
        PG8_WAIT_V(6); PG8_BAR;
    } else {
        PG8_STAGE(PG8_SB(0, 0), cB, voffB); PG8_STAGE_A(PG8_SA(0, 0), cA, 0, false); PG8_STAGE(PG8_SB(0, 1), cB + hstep, voffB); PG8_STAGE_A(PG8_SA(0, 1), cA + hstepA, 1, false);
        if (wr == 1) PG8_BAR;
        PG8_WAIT_V(4); PG8_BAR;
        PG8_STAGE(PG8_SB(1, 0), cB + kstep, voffB); PG8_STAGE_A(PG8_SA(1, 0), cA + kstep, 0, false); PG8_STAGE(PG8_SB(1, 1), cB + hstep + kstep, voffB);
        PG8_WAIT_V(6); PG8_BAR;
    }
    for (;;) {
        const bool has_next = S.next(ui + 1, nxt);
        const char* nA = has_next ? (const char*)g.A + (GATHER ? (size_t)0 : (size_t)nxt.pm * tstep) : cA; const char* nB = has_next ? (const char*)g.Bt + (size_t)nxt.pb * tstep : cB;
        if (GATHER) {
#pragma unroll
            for (int h = 0; h < 2; ++h)
#pragma unroll
                for (int i = 0; i < 2; ++i) vAn[h][i] = has_next ? S.row_off(ui + 1, h * HALF + rA[i]) + cAoff[i] : vAc[h][i]; }
        for (int t = 0; t < nt; t += 2) {
            const bool last = (t == nt - 2);
            const char* a1 = cA + (size_t)(t + 1) * kstep;
            const char* a2 = last ? nA : cA + (size_t)(t + 2) * kstep; const char* b2 = last ? nB : cB + (size_t)(t + 2) * kstep;
            const char* a3 = a2 + kstep; const char* b3 = b2 + kstep;
            if (last && has_next) S.a_ready(nxt);
            if constexpr (SP2) {
            PG8_LDB(B0, 0, 0); PG8_LDB(B1, 0, 1); PG8_SCHED; PG8_LDA(At, 0, 0); PG8_STAGE_A(PG8_SA(1, 1), a1 + hstepA, 1, false);
            PG8_WAIT_V(8); PG8_WAIT_L(0); PG8_BAR; PG8_MMA(0, 0, At, B0); PG8_MMA(0, 1, At, B1); PG8_BAR; PG8_SCHED;
            PG8_LDA(At, 0, 1); PG8_STAGE(PG8_SB(0, 0), b2, voffB); PG8_STAGE(PG8_SB(0, 1), b2 + hstep, voffB); PG8_STAGE_A(PG8_SA(0, 0), a2, 0, last);
            PG8_WAIT_V(8); PG8_WAIT_L(0); PG8_BAR; PG8_MMA(1, 0, At, B0); PG8_MMA(1, 1, At, B1); PG8_BAR; PG8_SCHED;
            PG8_LDB(B0, 1, 0); PG8_LDB(B1, 1, 1); PG8_SCHED; PG8_LDA(At, 1, 0); PG8_STAGE_A(PG8_SA(0, 1), a2 + hstepA, 1, last);
            PG8_WAIT_V(8); PG8_WAIT_L(0); PG8_BAR; PG8_MMA(0, 0, At, B0); PG8_MMA(0, 1, At, B1); PG8_BAR; PG8_SCHED;
            PG8_LDA(At, 1, 1); PG8_STAGE(PG8_SB(1, 0), b3, voffB); PG8_STAGE(PG8_SB(1, 1), b3 + hstep, voffB); PG8_STAGE_A(PG8_SA(1, 0), a3, 0, last);
            PG8_WAIT_V(8); PG8_WAIT_L(0); PG8_BAR; PG8_MMA(1, 0, At, B0); PG8_MMA(1, 1, At, B1); PG8_BAR; PG8_SCHED;
            } else {
            PG8_LDB(B0, 0, 0); PG8_SCHED; PG8_LDA(At, 0, 0); PG8_STAGE_A(PG8_SA(1, 1), a1 + hstepA, 1, false);
            PG8_WAIT_L(8); PG8_BAR; PG8_WAIT_L(0); PG8_MMA(0, 0, At, B0); PG8_BAR; PG8_SCHED;
            PG8_LDB(B1, 0, 1); PG8_STAGE(PG8_SB(0, 0), b2, voffB);
            PG8_BAR; PG8_WAIT_L(0); PG8_MMA(0, 1, At, B1); PG8_BAR;
            PG8_LDA(At, 0, 1); PG8_STAGE_A(PG8_SA(0, 0), a2, 0, last);
            PG8_BAR; PG8_WAIT_L(0); PG8_MMA(1, 0, At, B0); PG8_BAR; PG8_SCHED;
            PG8_STAGE(PG8_SB(0, 1), b2 + hstep, voffB);
            PG8_WAIT_V(6); PG8_BAR; PG8_MMA(1, 1, At, B1); PG8_BAR;
            PG8_LDB(B0, 1, 0); PG8_SCHED; PG8_LDA(At, 1, 0); PG8_STAGE_A(PG8_SA(0, 1), a2 + hstepA, 1, last);
            PG8_WAIT_L(8); PG8_BAR; PG8_WAIT_L(0); PG8_MMA(0, 0, At, B0); PG8_BAR; PG8_SCHED;
            PG8_LDB(B1, 1, 1); PG8_STAGE(PG8_SB(1, 0), b3, voffB);
            PG8_BAR; PG8_WAIT_L(0); PG8_MMA(0, 1, At, B1); PG8_BAR;
            PG8_LDA(At, 1, 1); PG8_STAGE_A(PG8_SA(1, 0), a3, 0, last);
            PG8_BAR; PG8_WAIT_L(0); PG8_MMA(1, 0, At, B0); PG8_BAR; PG8_SCHED;
            PG8_STAGE(PG8_SB(1, 1), b3 + hstep, voffB);
            PG8_WAIT_V(6); PG8_BAR; PG8_MMA(1, 1, At, B1); PG8_BAR;
            }
        }
        if constexpr (ALIGN_EPI) { if (wr == 0) PG8_BAR; }
        if constexpr (!Epi::AFTER_DRAIN) { E(acc, cur, wr, wc, fr, fq); S.done(cur); }
        if (!has_next) break;
#pragma unroll
        for (int a = 0; a < 2; ++a)
#pragma unroll
            for (int b = 0; b < 2; ++b)
#pragma unroll
                for (int m = 0; m < 4; ++m)
#pragma unroll
                    for (int n = 0; n < 2; ++n) acc[a][b][m][n] = (f32x4){0.f, 0.f, 0.f, 0.f};
        cur = nxt; cA = nA; cB = nB; ++ui;
#pragma unroll
        for (int h = 0; h < 2; ++h)
#pragma unroll
            for (int i = 0; i < 2; ++i) vAc[h][i] = vAn[h][i];
        if constexpr (ALIGN_EPI) { if (wr == 1) PG8_BAR; }
    }
    PG8_WAIT_V(0);
    if constexpr (!ALIGN_EPI) { if (wr == 0) PG8_BAR; }
    PG8_BAR;
    if constexpr (Epi::AFTER_DRAIN) { E.fused(acc, cur, wr, wc, fr, fq, lds, wid, lane); S.done(cur); }
#undef PG8_SA
#undef PG8_SB
#undef PG8_STAGE
#undef PG8_STAGE_A
#undef PG8_LDA
#undef PG8_LDB
#undef PG8_MMA
#undef PG8_WAIT_V
#undef PG8_WAIT_L
#undef PG8_BAR
#undef PG8_SCHED
}
}
#define XB_TMO      128
#define XB_XCNT(j)  (256  + 64 * (j))
#define XB_XSUB(j)  (1280 + 64 * (j))
#define XB_XGEN(j)  (2304 + 64 * (j))
#define XB_TOP      3328
#define XB_TOPGEN   3392
#define XCD_BAR_WORDS 3456
#define XB_SPIN_CAP (1u << 18)

__device__ __forceinline__ unsigned xb_ld(unsigned* p)              { return __hip_atomic_load(p, __ATOMIC_RELAXED, __HIP_MEMORY_SCOPE_AGENT); }
__device__ __forceinline__ unsigned xb_add(unsigned* p, unsigned v) { return __hip_atomic_fetch_add(p, v, __ATOMIC_RELAXED, __HIP_MEMORY_SCOPE_AGENT); }
__device__ __forceinline__ unsigned xb_xcc_id() { return (unsigned)__builtin_amdgcn_s_getreg((3 << 11) | 20) & 0xFu; }
#define XB_SPIN(cond, bar) do { unsigned _sp = 0; while (cond) { __builtin_amdgcn_s_sleep(1); \
    if ((++_sp & 255u) == 0u) { if (xb_ld(&(bar)[XB_TMO])) break; if (_sp > XB_SPIN_CAP) { atomicAdd(&(bar)[XB_TMO], 1u); break; } } } } while (0)

struct XcdBarrier {
    unsigned* bar; unsigned x;
    volatile LAS unsigned* st;
};

__device__ __forceinline__ XcdBarrier xcd_barrier_post(unsigned* bar, volatile LAS unsigned* st) {
    XcdBarrier b; b.bar = bar; b.x = xb_xcc_id(); b.st = st;
    if (threadIdx.x == 0) (void)xb_add(&bar[XB_XCNT(b.x)], 1u);
    return b;
}
__device__ __forceinline__ void xcd_barrier_complete(unsigned* bar, unsigned x, unsigned& nloc, unsigned& nx) {
    const unsigned G = gridDim.x * gridDim.y * gridDim.z;
    unsigned sum, cnt, mine, sp = 0u;
    for (;;) {
        sum = 0u; cnt = 0u; mine = 0u;
#pragma unroll
        for (unsigned j = 0; j < 16; ++j) { const unsigned c = xb_ld(&bar[XB_XCNT(j)]); sum += c; cnt += (c > 0u) ? 1u : 0u; mine = (j == x) ? c : mine; }
        if (sum == G) break;
        __builtin_amdgcn_s_sleep(1);
        if ((++sp & 255u) == 0u) { if (xb_ld(&bar[XB_TMO])) break; if (sp > XB_SPIN_CAP) { atomicAdd(&bar[XB_TMO], 1u); break; } }
    }
    nloc = mine > 0u ? mine : 1u; nx = cnt > 0u ? cnt : 1u;
}

__device__ __forceinline__ void xcd_barrier(const XcdBarrier& b) {
    asm volatile("s_waitcnt vmcnt(0)" ::: "memory");
    __syncthreads();
    if (threadIdx.x == 0) {
        unsigned* bar = b.bar;
        __builtin_amdgcn_s_waitcnt(0);
        unsigned nloc = b.st[0], nx = b.st[1];
        if (nloc == 0u) { xcd_barrier_complete(bar, b.x, nloc, nx); b.st[0] = nloc; b.st[1] = nx; }
        const unsigned old = xb_add(&bar[XB_XSUB(b.x)], 1u);
        const unsigned gen = old / nloc;
        if (old + 1u == (gen + 1u) * nloc) {
            __builtin_amdgcn_fence(__ATOMIC_RELEASE, "agent");
            asm volatile("s_waitcnt vmcnt(0)" ::: "memory");
            const unsigned og = xb_add(&bar[XB_TOP], 1u);
            const unsigned tg = og / nx;
            if (og + 1u == (tg + 1u) * nx) xb_add(&bar[XB_TOPGEN], 1u);
            else XB_SPIN(xb_ld(&bar[XB_TOPGEN]) == tg, bar);
            __builtin_amdgcn_fence(__ATOMIC_ACQUIRE, "agent");
            xb_add(&bar[XB_XGEN(b.x)], 1u);
            asm volatile("s_waitcnt vmcnt(0)" ::: "memory");
        } else {
            XB_SPIN(xb_ld(&bar[XB_XGEN(b.x)]) == gen, bar);
            __builtin_amdgcn_fence(__ATOMIC_ACQUIRE, "agent");
            asm volatile("s_waitcnt vmcnt(0)" ::: "memory");
        }
    }
    __syncthreads();
}

struct Args { const float* in[19]; float* out; unsigned char* ws; int ph_lo, ph_hi; };
enum { I_X = 0, I_WIN, I_BIN, I_LB, I_HGNG, I_WA, I_WB, I_WOUT, I_LN1G, I_LN1B, I_WGRP, I_BGRP, I_WRT, I_BRT, I_WGATE, I_WUP, I_WDOWN, I_LN2G, I_LN2B };

__device__ __forceinline__ void transpose_item(const float* src4, size_t ldw, bf16_t* WT, size_t K, int dest_row0, int k0, LAS float* scr, int lane) {
    f32x4 v[8];
#pragma unroll
    for (int i = 0; i < 8; ++i) v[i] = src4 ? __builtin_nontemporal_load((const f32x4*)(src4 + (size_t)(8 * i) * ldw)) : (f32x4){0.f, 0.f, 0.f, 0.f};
#pragma unroll
    for (int i = 0; i < 8; ++i) { const int k = 8 * i + (lane >> 3), n4 = (lane & 7) * 4;
        scr[k * 33 + n4 + 0] = v[i][0]; scr[k * 33 + n4 + 1] = v[i][1]; scr[k * 33 + n4 + 2] = v[i][2]; scr[k * 33 + n4 + 3] = v[i][3]; }
    LDS_WAIT(); asm volatile("" ::: "memory");
    const int c = lane & 7;
#pragma unroll
    for (int j = 0; j < 4; ++j) { const int n = (lane >> 3) + 8 * j; const LAS float* s = scr + (8 * c) * 33 + n;
        u32x4 o; o.x = cvt_pk(s[0 * 33], s[1 * 33]); o.y = cvt_pk(s[2 * 33], s[3 * 33]); o.z = cvt_pk(s[4 * 33], s[5 * 33]); o.w = cvt_pk(s[6 * 33], s[7 * 33]);
        *(u32x4*)(WT + (size_t)(dest_row0 + n) * K + k0 + 8 * c) = o; }
    LDS_WAIT(); asm volatile("" ::: "memory");
}

__device__ __forceinline__ void phase_prologue(const Args& a, LAS unsigned char* lds, int tid, int G) {
    const int lane = tid & 63, wave = tid >> 6;
    unsigned char* ws = a.ws;
    { const float* x = a.in[I_X]; bf16_t* xb = (bf16_t*)(ws + WS_XB); const size_t n8 = (size_t)MT * DM / 8;
      for (size_t i = (size_t)blockIdx.x * NTHR + tid; i < n8; i += (size_t)G * NTHR) {
          const f32x4 p = __builtin_nontemporal_load((const f32x4*)(x + i * 8)), q = __builtin_nontemporal_load((const f32x4*)(x + i * 8 + 4));
          u32x4 o; o.x = cvt_pk(p[0], p[1]); o.y = cvt_pk(p[2], p[3]); o.z = cvt_pk(q[0], q[1]); o.w = cvt_pk(q[2], q[3]);
          *(u32x4*)(xb + i * 8) = o; } }
    LAS float* scr = (LAS float*)(lds + wave * 8704);
    const int gw = blockIdx.x * NWAVES + wave, NGW = G * NWAVES;
    constexpr int IT_IN = (NPROJ_PAD / 32) * (DM / 64);
    constexpr int IT_A = (DM / 32) * (1024 / 64);
    constexpr int IT_OUT = (DM / 32) * (DM / 64);
    constexpr int NIT = IT_IN + 2 * IT_A + IT_OUT;
    for (int it = gw; it < NIT; it += NGW) {
        int r = it;
        if (r < IT_IN) { const int kb = r / (NPROJ_PAD / 32), rb = r % (NPROJ_PAD / 32); const int n = rb * 32 + (lane & 7) * 4;
            int src = -1; if (n < 7752) src = n; else if (n >= 7936) src = n - 184;
            const float* p = (src >= 0) ? a.in[I_WIN] + (size_t)(kb * 64 + (lane >> 3)) * NPROJ + src : nullptr;
            transpose_item(p, NPROJ, (bf16_t*)(ws + WS_WIN), DM, rb * 32, kb * 64, scr, lane); continue; }
        r -= IT_IN;
        if (r < 2 * IT_A) { const int which = r / IT_A; r %= IT_A; const int kb = r / 64, rb = r % 64; const int n = rb * 32 + (lane & 7) * 4;
            const float* p = a.in[which ? I_WB : I_WA] + (size_t)(kb * 64 + (lane >> 3)) * DM + n;
            transpose_item(p, DM, (bf16_t*)(ws + (which ? WS_WB : WS_WA)), 1024, rb * 32, kb * 64, scr, lane); continue; }
        r -= 2 * IT_A;
        { const int kb = r / 64, rb = r % 64; const int n = rb * 32 + (lane & 7) * 4;
          const float* p = a.in[I_WOUT] + (size_t)(kb * 64 + (lane >> 3)) * DM + n;
          transpose_item(p, DM, (bf16_t*)(ws + WS_WOUT), DM, rb * 32, kb * 64, scr, lane); }
    }
}

constexpr int EW_GU = 64 * 32, EW_D = 64 * 16, EW_E = EW_GU + EW_D;
__device__ __forceinline__ const float* ew_src(const Args& a, int it, int lane, size_t& ldw) {
    const int e = it / EW_E; int r = it % EW_E;
    if (r < EW_GU) { const int kb = r / 64, rb = r % 64; const int n = rb * 32 + (lane & 7) * 4; const int j = n >> 3, up = (n >> 2) & 1; ldw = DFF;
        return a.in[up ? I_WUP : I_WGATE] + (size_t)e * DM * DFF + (size_t)(kb * 64 + (lane >> 3)) * DFF + 4 * j; }
    r -= EW_GU; const int kb = r / 64, rb = r % 64; const int n = rb * 32 + (lane & 7) * 4; ldw = DM;
    return a.in[I_WDOWN] + (size_t)e * DFF * DM + (size_t)(kb * 64 + (lane >> 3)) * DM + n;
}
__device__ __forceinline__ void ew_store(const Args& a, int it, const f32x4 (&v)[8], LAS float* scr, int lane) {
    const int e = it / EW_E; int r = it % EW_E; bf16_t* WT; size_t K; int rb, kb;
    if (r < EW_GU) { kb = r / 64; rb = r % 64; WT = (bf16_t*)(a.ws + WS_WGU) + (size_t)e * 2048 * 2048; K = 2048; }
    else { r -= EW_GU; kb = r / 64; rb = r % 64; WT = (bf16_t*)(a.ws + WS_WD) + (size_t)e * 2048 * 1024; K = 1024; }
#pragma unroll
    for (int i = 0; i < 8; ++i) { const int k = 8 * i + (lane >> 3), n4 = (lane & 7) * 4;
        scr[k * 33 + n4 + 0] = v[i][0]; scr[k * 33 + n4 + 1] = v[i][1]; scr[k * 33 + n4 + 2] = v[i][2]; scr[k * 33 + n4 + 3] = v[i][3]; }
    LDS_WAIT(); asm volatile("" ::: "memory");
    const int c = lane & 7;
#pragma unroll
    for (int j = 0; j < 4; ++j) { const int n = (lane >> 3) + 8 * j; const LAS float* s = scr + (8 * c) * 33 + n;
        u32x4 o; o.x = cvt_pk(s[0 * 33], s[1 * 33]); o.y = cvt_pk(s[2 * 33], s[3 * 33]); o.z = cvt_pk(s[4 * 33], s[5 * 33]); o.w = cvt_pk(s[6 * 33], s[7 * 33]);
        *(u32x4*)(WT + (size_t)(rb * 32 + n) * K + kb * 64 + 8 * c) = o; }
    LDS_WAIT(); asm volatile("" ::: "memory");
}
__device__ __forceinline__ void phase_expert_weights(const Args& a, LAS unsigned char* lds, int tid, int G) {
    const int lane = tid & 63, wave = tid >> 6;
    LAS float* scr = (LAS float*)(lds + wave * 8704);
    const int gw = blockIdx.x * NWAVES + wave, NGW = G * NWAVES, NIT = NEXP * EW_E;
    int it = gw; if (it >= NIT) return;
    f32x4 v[8]; { size_t ldw; const float* p = ew_src(a, it, lane, ldw);
#pragma unroll
        for (int i = 0; i < 8; ++i) v[i] = *(const f32x4*)(p + (size_t)(8 * i) * ldw); }
    for (;;) {
        const int nx = it + NGW; const bool has = nx < NIT;
        f32x4 vn[8];
        if (has) { size_t ldw; const float* p = ew_src(a, nx, lane, ldw);
#pragma unroll
            for (int i = 0; i < 8; ++i) vn[i] = *(const f32x4*)(p + (size_t)(8 * i) * ldw); }
        ew_store(a, it, v, scr, lane);
        if (!has) break;
#pragma unroll
        for (int i = 0; i < 8; ++i) v[i] = vn[i];
        it = nx;
    }
}

constexpr int HG_QD = 0, HG_KD = 17408, HG_P = 34816, HG_VT = 44032, HG_SEG = 62464, HG_RED = 64512;
constexpr int HG_LBT = 66560;
constexpr int HG_LD128 = 136, HG_LD64 = 72;

struct HgPrep { float cum[16]; float kh[16]; float tot; };
__device__ __forceinline__ void hg_fill_lb(const Args& a, LAS unsigned char* lds, int tid) {
    for (int i = tid; i < 1024; i += NTHR) { const float l0 = a.in[I_LB][i], l1 = a.in[I_LB][1024 + i]; *(LAS float*)(lds + HG_LBT + i * 4) = 1.0f / (1.0f + __expf(l1 - l0)); }
    __syncthreads();
}
__device__ __forceinline__ void hg_prep(HgPrep& P, const float (&z)[16], float lb, int d, int seg, LAS unsigned char* lds) {
    float run = 0.f;
#pragma unroll
    for (int j = 0; j < 16; ++j) { const float sg = sigmoidf_(z[j]); const float f = lb + (1.0f - lb) * sg; run += __logf(f); P.cum[j] = run; P.kh[j] = (1.0f - lb) * (1.0f - sg); }
    LAS float* segs = (LAS float*)(lds + HG_SEG);
    segs[seg * 128 + d] = run;
    __syncthreads();
    float off = 0.f, tot = 0.f;
#pragma unroll
    for (int s = 0; s < 4; ++s) { const float v = segs[s * 128 + d]; tot += v; if (s < seg) off += v; }
#pragma unroll
    for (int j = 0; j < 16; ++j) P.cum[j] += off;
    P.tot = tot;
}
__device__ __forceinline__ void hg_write_vt(const unsigned (&vv)[16], int d, int seg, LAS unsigned char* lds) {
    u32x4 w0, w1;
    w0.x = vv[0] | (vv[1] << 16); w0.y = vv[2] | (vv[3] << 16); w0.z = vv[4] | (vv[5] << 16); w0.w = vv[6] | (vv[7] << 16);
    w1.x = vv[8] | (vv[9] << 16); w1.y = vv[10] | (vv[11] << 16); w1.z = vv[12] | (vv[13] << 16); w1.w = vv[14] | (vv[15] << 16);
    LAS unsigned char* p = lds + HG_VT + d * (HG_LD64 * 2) + seg * 32;
    *(LAS u32x4*)p = w0; *(LAS u32x4*)(p + 16) = w1;
}

__device__ __forceinline__ void hgrn1_unit(const Args& a, int unit, LAS unsigned char* lds, int tid) {
    unsigned char* ws = a.ws;
    const int lane = tid & 63, wave = tid >> 6, d = tid & 127, seg = tid >> 7;
    const int b = unit >> 10, h = (unit >> 7) & 7, n = unit & 127, tok0 = b * SEQ + n * 64;
    float z[16]; unsigned vv[16];
    { const float* AF = (const float*)(ws + WS_AF); const bf16_t* AI = (const bf16_t*)(ws + WS_AI);
#pragma unroll
      for (int j = 0; j < 16; ++j) z[j] = AF[(size_t)(tok0 + seg * 16 + j) * 1024 + h * 128 + d];
#pragma unroll
      for (int j = 0; j < 16; ++j) vv[j] = AI[(size_t)(tok0 + seg * 16 + j) * 1024 + h * 128 + d]; }
    const float lbv = *(const LAS float*)(lds + HG_LBT + (h * 128 + d) * 4);
    HgPrep P;
    hg_prep(P, z, lbv, d, seg, lds);
    { unsigned pk[8];
#pragma unroll
      for (int j = 0; j < 8; ++j) pk[j] = cvt_pk(P.kh[2 * j] * __expf(P.tot - P.cum[2 * j]), P.kh[2 * j + 1] * __expf(P.tot - P.cum[2 * j + 1]));
      LAS unsigned char* p = lds + HG_KD + d * (HG_LD64 * 2) + seg * 32;
      *(LAS u32x4*)p = (u32x4){pk[0], pk[1], pk[2], pk[3]}; *(LAS u32x4*)(p + 16) = (u32x4){pk[4], pk[5], pk[6], pk[7]}; }
    if (seg == 0) ((float*)(ws + WS_DECAY))[(size_t)unit * 128 + d] = __expf(P.tot);
    hg_write_vt(vv, d, seg, lds);
    __syncthreads();
    const int fr = lane & 15, fq = lane >> 4;
    bf16x8 af[2];
#pragma unroll
    for (int ks = 0; ks < 2; ++ks) af[ks] = *(const LAS bf16x8*)(lds + HG_KD + (16 * wave + fr) * (HG_LD64 * 2) + (32 * ks + 8 * fq) * 2);
    float* kvo = (float*)(ws + WS_KV) + (size_t)unit * 16384;
#pragma unroll
    for (int vb = 0; vb < 8; ++vb) {
        f32x4 acc = {0.f, 0.f, 0.f, 0.f};
#pragma unroll
        for (int ks = 0; ks < 2; ++ks) { const bf16x8 bfr = *(const LAS bf16x8*)(lds + HG_VT + (16 * vb + fr) * (HG_LD64 * 2) + (32 * ks + 8 * fq) * 2);
            acc = __builtin_amdgcn_mfma_f32_16x16x32_bf16(af[ks], bfr, acc, 0, 0, 0); }
        *(f32x4*)(kvo + (size_t)(16 * vb + fr) * 128 + 16 * wave + 4 * fq) = acc;
    }
    __syncthreads();
}

__device__ __forceinline__ void hgrn_scan(const Args& a, int tid, int G) {
    unsigned char* ws = a.ws;
    const float* KV = (const float*)(ws + WS_KV); const float* DEC = (const float*)(ws + WS_DECAY); unsigned* ST = (unsigned*)(ws + WS_ST);
    for (int g = blockIdx.x * NTHR + tid; g < 16 * 8192; g += G * NTHR) {
        const int bh = g >> 13, rem = g & 8191, v = rem >> 6, d2 = (rem & 63) * 2;
        float s0 = 0.f, s1 = 0.f;
        for (int n0 = 0; n0 < 128; n0 += 8) {
            f32x2 kv[8], dc[8];
#pragma unroll
            for (int j = 0; j < 8; ++j) { const size_t unit = (size_t)bh * 128 + n0 + j; kv[j] = *(const f32x2*)(KV + unit * 16384 + v * 128 + d2); dc[j] = *(const f32x2*)(DEC + unit * 128 + d2); }
#pragma unroll
            for (int j = 0; j < 8; ++j) { const size_t unit = (size_t)bh * 128 + n0 + j; ST[(unit * 16384 + v * 128 + d2) >> 1] = cvt_pk(s0, s1);
                s0 = dc[j][0] * s0 + kv[j][0]; s1 = dc[j][1] * s1 + kv[j][1]; }
        }
    }
}

__device__ __forceinline__ void hg3_load(const Args& a, int unit, int tid, float (&z)[16], unsigned (&qq)[16], unsigned (&vv)[16]) {
    unsigned char* ws = a.ws; const int d = tid & 127, seg = tid >> 7;
    const int b = unit >> 10, h = (unit >> 7) & 7, n = unit & 127, tok0 = b * SEQ + n * 64;
    const float* AF = (const float*)(ws + WS_AF); const bf16_t* AI = (const bf16_t*)(ws + WS_AI); const bf16_t* AQ = (const bf16_t*)(ws + WS_AQ);
#pragma unroll
    for (int j = 0; j < 16; ++j) z[j] = AF[(size_t)(tok0 + seg * 16 + j) * 1024 + h * 128 + d];
#pragma unroll
    for (int j = 0; j < 16; ++j) qq[j] = AQ[(size_t)(tok0 + seg * 16 + j) * 1024 + h * 128 + d];
#pragma unroll
    for (int j = 0; j < 16; ++j) vv[j] = AI[(size_t)(tok0 + seg * 16 + j) * 1024 + h * 128 + d];
}
__device__ __forceinline__ void hgrn3_unit(const Args& a, int unit, int next_unit, LAS unsigned char* lds, int tid, float (&z)[16], unsigned (&qq)[16], unsigned (&vv)[16]) {
    unsigned char* ws = a.ws;
    const int lane = tid & 63, wave = tid >> 6, d = tid & 127, seg = tid >> 7;
    const int b = unit >> 10, h = (unit >> 7) & 7, n = unit & 127, tok0 = b * SEQ + n * 64;
    const float lbv = *(const LAS float*)(lds + HG_LBT + (h * 128 + d) * 4);
    bf16x8 as[4][4]; u32x2 gwv[4]; f32x4 gnv[4];
    { const int fr_ = lane & 15, fq_ = lane >> 4, tb_ = wave & 3, t_ = 16 * tb_ + fr_;
      const bf16_t* ST = (const bf16_t*)(ws + WS_ST) + (size_t)unit * 16384; const bf16_t* AG = (const bf16_t*)(ws + WS_AG); const float* ng = a.in[I_HGNG];
#pragma unroll
      for (int vi = 0; vi < 4; ++vi) { const int vb = 4 * (wave >> 2) + vi;
#pragma unroll
          for (int ks = 0; ks < 4; ++ks) as[vi][ks] = *(const bf16x8*)(ST + (size_t)(16 * vb + fr_) * 128 + 32 * ks + 8 * fq_);
          const int v0 = 16 * vb + 4 * fq_;
          gwv[vi] = *(const u32x2*)(AG + (size_t)(tok0 + t_) * 1024 + h * 128 + v0); gnv[vi] = *(const f32x4*)(ng + h * 128 + v0); } }
#ifndef HG3_RA
#define HG3_RA 1
#define HG3_RB 1
#define HG3_RC 1
#endif
    for (int ra = 0; ra < HG3_RA; ++ra) {
    HgPrep P;
    hg_prep(P, z, lbv, d, seg, lds);
    {
#pragma unroll
      for (int j = 0; j < 16; ++j) { const float q = bf2f(qq[j]); const float qs = q * sigmoidf_(q);
          const float qd = qs * __expf(P.cum[j]), kd = P.kh[j] * __expf(-P.cum[j]);
          const int t = seg * 16 + j;
          *(LAS bf16_t*)(lds + HG_QD + (t * HG_LD128 + d) * 2) = (bf16_t)(cvt_pk(qd, 0.f) & 0xffffu);
          *(LAS bf16_t*)(lds + HG_KD + (t * HG_LD128 + d) * 2) = (bf16_t)(cvt_pk(kd, 0.f) & 0xffffu); } }
    hg_write_vt(vv, d, seg, lds);
    __syncthreads();
    }
    if (next_unit >= 0) hg3_load(a, next_unit, tid, z, qq, vv);
    const int fr = lane & 15, fq = lane >> 4;
    for (int rb = 0; rb < HG3_RB; ++rb) {
    { const int tb = wave & 3;
      bf16x8 bq[4];
#pragma unroll
      for (int ks = 0; ks < 4; ++ks) bq[ks] = *(const LAS bf16x8*)(lds + HG_QD + ((16 * tb + fr) * HG_LD128 + 32 * ks + 8 * fq) * 2);
#pragma unroll
      for (int si = 0; si < 2; ++si) { const int sb = 2 * (wave >> 2) + si;
          f32x4 acc = {0.f, 0.f, 0.f, 0.f};
#pragma unroll
          for (int ks = 0; ks < 4; ++ks) { const bf16x8 ak = *(const LAS bf16x8*)(lds + HG_KD + ((16 * sb + fr) * HG_LD128 + 32 * ks + 8 * fq) * 2);
              acc = __builtin_amdgcn_mfma_f32_16x16x32_bf16(ak, bq[ks], acc, 0, 0, 0); }
          const int t = 16 * tb + fr, s0 = 16 * sb + 4 * fq;
          float p[4];
#pragma unroll
          for (int r = 0; r < 4; ++r) p[r] = (s0 + r <= t) ? acc[r] : 0.f;
          *(LAS u32x2*)(lds + HG_P + (t * HG_LD64 + s0) * 2) = (u32x2){cvt_pk(p[0], p[1]), cvt_pk(p[2], p[3])}; } }
    __syncthreads();
    }
    for (int rc = 0; rc < HG3_RC; ++rc) {
    const int tb = wave & 3, t = 16 * tb + fr;
    f32x4 o[4];
    { bf16x8 bp[2], bq[4];
#pragma unroll
      for (int ks = 0; ks < 2; ++ks) bp[ks] = *(const LAS bf16x8*)(lds + HG_P + ((16 * tb + fr) * HG_LD64 + 32 * ks + 8 * fq) * 2);
#pragma unroll
      for (int ks = 0; ks < 4; ++ks) bq[ks] = *(const LAS bf16x8*)(lds + HG_QD + ((16 * tb + fr) * HG_LD128 + 32 * ks + 8 * fq) * 2);
#pragma unroll
      for (int vi = 0; vi < 4; ++vi) { const int vb = 4 * (wave >> 2) + vi;
          f32x4 acc = {0.f, 0.f, 0.f, 0.f};
#pragma unroll
          for (int ks = 0; ks < 2; ++ks) { const bf16x8 av = *(const LAS bf16x8*)(lds + HG_VT + ((16 * vb + fr) * HG_LD64 + 32 * ks + 8 * fq) * 2);
              acc = __builtin_amdgcn_mfma_f32_16x16x32_bf16(av, bp[ks], acc, 0, 0, 0); }
#pragma unroll
          for (int ks = 0; ks < 4; ++ks) acc = __builtin_amdgcn_mfma_f32_16x16x32_bf16(as[vi][ks], bq[ks], acc, 0, 0, 0);
          o[vi] = acc; } }
    float ss = 0.f;
#pragma unroll
    for (int vi = 0; vi < 4; ++vi) ss += (o[vi][0] * o[vi][0] + o[vi][1] * o[vi][1]) + (o[vi][2] * o[vi][2] + o[vi][3] * o[vi][3]);
    ss += __shfl_xor(ss, 16); ss += __shfl_xor(ss, 32);
    LAS float* red = (LAS float*)(lds + HG_RED);
    if (fq == 0) red[(wave >> 2) * 64 + t] = ss;
    __syncthreads();
    const float tot = red[t] + red[64 + t];
    const float rinv = 1.0f / sqrtf(tot * (1.0f / 128.0f) + RMS_EPS);
    bf16_t* BRA = (bf16_t*)(ws + WS_BRA);
#pragma unroll
    for (int vi = 0; vi < 4; ++vi) { const int v0 = 16 * (4 * (wave >> 2) + vi) + 4 * fq; const size_t off = (size_t)(tok0 + t) * 1024 + h * 128 + v0;
        const u32x2 gw = gwv[vi]; const f32x4 gn = gnv[vi];
        const float g0 = __uint_as_float(gw.x << 16), g1 = __uint_as_float(gw.x & 0xffff0000u), g2 = __uint_as_float(gw.y << 16), g3 = __uint_as_float(gw.y & 0xffff0000u);
        const float r0 = o[vi][0] * rinv * gn[0] * (g0 * sigmoidf_(g0)), r1 = o[vi][1] * rinv * gn[1] * (g1 * sigmoidf_(g1));
        const float r2 = o[vi][2] * rinv * gn[2] * (g2 * sigmoidf_(g2)), r3 = o[vi][3] * rinv * gn[3] * (g3 * sigmoidf_(g3));
        *(u32x2*)(BRA + off) = (u32x2){cvt_pk(r0, r1), cvt_pk(r2, r3)}; }
    __syncthreads();
    }
}


constexpr int IX_S = 0, IX_H = 131072, IX_L = 147456, IX_M = 155648, IX_C = 159744;
constexpr int IX_CAP = 512;
__device__ __forceinline__ unsigned ix_sortable(unsigned u) { return (u & 0x80000000u) ? ~u : (u | 0x80000000u); }

__device__ __forceinline__ void ix_radix_fallback(LAS unsigned* S, LAS unsigned* H, unsigned* MASK, int t0, int L, int tid) {
    const int lane = tid & 63, wave = __builtin_amdgcn_readfirstlane(tid >> 6);
    for (int q = 0; q < 4; ++q) for (int i = tid; i < L; i += NTHR) S[q * 8192 + i] = ix_sortable(S[q * 8192 + i]);
    for (int i = tid; i < 2048; i += NTHR) H[i] = 0u;
    __syncthreads();
    const int qs = wave >> 1, half = wave & 1;
    unsigned prefix = 0u; int kth = 256;
    for (int p = 0; p < 4; ++p) {
        const int shift = 24 - 8 * p;
        LAS unsigned* hist = H + (p & 1) * 1024 + qs * 256;
        for (int i = half * 64 + lane; i < L; i += 128) { const unsigned k = S[qs * 8192 + i];
            const bool in = (p == 0) || ((k >> (shift + 8)) == prefix);
            if (in) atomicAdd((unsigned*)(hist + ((k >> shift) & 255u)), 1u); }
        __syncthreads();
        const unsigned c0 = hist[255 - 4 * lane], c1 = hist[254 - 4 * lane], c2 = hist[253 - 4 * lane], c3 = hist[252 - 4 * lane];
        const int tot = (int)(c0 + c1 + c2 + c3);
        int incl = tot;
#pragma unroll
        for (int o = 1; o < 64; o <<= 1) { const int v = __shfl_up(incl, o); if (lane >= o) incl += v; }
        const unsigned long long bal = __ballot(incl >= kth);
        const int fl = __ffsll((long long)bal) - 1;
        const int rem = kth - (incl - tot);
        int dig, nk;
        if (rem <= (int)c0) { dig = 255 - 4 * lane; nk = rem; }
        else if (rem <= (int)(c0 + c1)) { dig = 254 - 4 * lane; nk = rem - (int)c0; }
        else if (rem <= (int)(c0 + c1 + c2)) { dig = 253 - 4 * lane; nk = rem - (int)(c0 + c1); }
        else { dig = 252 - 4 * lane; nk = rem - (int)(c0 + c1 + c2); }
        dig = __shfl(dig, fl); nk = __shfl(nk, fl);
        prefix = (prefix << 8) | (unsigned)dig; kth = nk;
        __syncthreads();
        if (p < 2) for (int i = tid; i < 1024; i += NTHR) H[(p & 1) * 1024 + i] = 0u;
    }
    const unsigned T = prefix;
    const int NG = L / 64;
    int tie_before = 0;
    if (half == 1) for (int g = 0; g < 64 && g < NG; ++g) { const unsigned k = S[qs * 8192 + 64 * g + lane]; tie_before += __popcll(__ballot(k == T)); }
    unsigned mlo = 0u, mhi = 0u;
    const unsigned long long lt = (1ull << lane) - 1ull;
    for (int g = 64 * half; g < NG && g < 64 * half + 64; ++g) {
        const unsigned k = S[qs * 8192 + 64 * g + lane];
        const bool eq = (k == T);
        const unsigned long long eqm = __ballot(eq);
        const int rank = tie_before + __popcll(eqm & lt);
        const bool sel = (k > T) || (eq && rank < kth);
        const unsigned long long m = __ballot(sel);
        if (lane == g - 64 * half) { mlo = (unsigned)m; mhi = (unsigned)(m >> 32); }
        tie_before += __popcll(eqm);
    }
    *(u32x2*)(MASK + (size_t)(t0 + qs) * 256 + 2 * (64 * half + lane)) = (u32x2){mlo, mhi};
    __syncthreads();
}

__device__ __forceinline__ void indexer_unit(const Args& a, int unit, LAS unsigned char* lds, int tid) {
    unsigned char* ws = a.ws;
    const int lane = tid & 63, wave = __builtin_amdgcn_readfirstlane(tid >> 6);
    const int t0 = unit * 4, b = t0 >> 13, qpos0 = t0 & (SEQ - 1), c = qpos0 >> 6, L = 64 * (c + 1);
    unsigned* MASK = (unsigned*)(ws + WS_MASK);
    if (c < 4) {
        const int qi = tid >> 7, w2 = (tid & 127) * 2;
        const unsigned m0 = (w2 * 32 < L) ? 0xffffffffu : 0u, m1 = ((w2 + 1) * 32 < L) ? 0xffffffffu : 0u;
        *(u32x2*)(MASK + (size_t)(t0 + qi) * 256 + w2) = (u32x2){m0, m1};
        return;
    }
    const bf16_t* IQ = (const bf16_t*)(ws + WS_IQ); const bf16_t* IKW = (const bf16_t*)(ws + WS_IKW);
    LAS unsigned* S = (LAS unsigned*)(lds + IX_S); LAS unsigned* H = (LAS unsigned*)(lds + IX_H); LAS unsigned* LST = (LAS unsigned*)(lds + IX_L);
    LAS unsigned* MB = (LAS unsigned*)(lds + IX_M); LAS float* MM = (LAS float*)(lds + IX_C); LAS unsigned* CC = (LAS unsigned*)(lds + IX_C + 256);
    const int r32 = lane & 31, hh = lane >> 5;
    for (int i = tid; i < 4096; i += NTHR) H[i] = 0u;
    for (int i = tid; i < 1024; i += NTHR) MB[i] = 0u;
    if (tid < 8) CC[tid] = 0u;
    bf16x8 af[4];
#pragma unroll
    for (int ks = 0; ks < 4; ++ks) af[ks] = *(const bf16x8*)(IQ + (size_t)(t0 + (r32 >> 3)) * 512 + (r32 & 7) * 64 + 16 * ks + 8 * hh);
    bf16x8 a2[2];
#pragma unroll
    for (int sI = 0; sI < 2; ++sI)
#pragma unroll
        for (int j = 0; j < 8; ++j) { const int qm = 2 * sI + (j >> 2), hm = 4 * hh + (j & 3);
            a2[sI][j] = (r32 == qm) ? (short)IKW[(size_t)(t0 + qm) * 256 + 64 + hm] : (short)0; }
    float mn[4], mx[4];
#pragma unroll
    for (int qi = 0; qi < 4; ++qi) { mn[qi] = 3.0e38f; mx[qi] = -3.0e38f; }
    const int NT32 = L / 32;
    const bf16_t* kbase = (const bf16_t*)(ws + WS_IK2) + (size_t)b * (SEQ / 32) * 2048 + lane * 8;
#define IX_LOADT(dst, kt_) do { const bf16_t* kp_ = kbase + (size_t)(kt_) * 2048; _Pragma("unroll") for (int ks = 0; ks < 4; ++ks) dst[ks] = *(const bf16x8*)(kp_ + 512 * ks); } while (0)
#define IX_MM(acc, bt) do { acc = f32x16{}; _Pragma("unroll") for (int ks = 0; ks < 4; ++ks) acc = __builtin_amdgcn_mfma_f32_32x32x16_bf16(af[ks], bt[ks], acc, 0, 0, 0); } while (0)
#define IX_HS(y_, acc) do { unsigned pk_[8]; _Pragma("unroll") for (int i = 0; i < 8; ++i) { const float x0_ = __builtin_amdgcn_fmed3f(acc[2 * i], 0.0f, 3.0e38f), x1_ = __builtin_amdgcn_fmed3f(acc[2 * i + 1], 0.0f, 3.0e38f); pk_[i] = cvt_pk_to_mfma(x0_, x1_); } \
        const u32x4 f0_ = {pk_[0], pk_[1], pk_[2], pk_[3]}, f1_ = {pk_[4], pk_[5], pk_[6], pk_[7]}; \
        y_ = f32x16{}; y_ = __builtin_amdgcn_mfma_f32_32x32x16_bf16(a2[0], *(const bf16x8*)&f0_, y_, 0, 0, 0); y_ = __builtin_amdgcn_mfma_f32_32x32x16_bf16(a2[1], *(const bf16x8*)&f1_, y_, 0, 0, 0); } while (0)
#define IX_ST(y_, kt_) do { const int key = (kt_) * 32 + r32; \
        if (hh == 0) { _Pragma("unroll") for (int qi = 0; qi < 4; ++qi) { const float s = y_[qi] + 0.0f; mn[qi] = fminf(mn[qi], s); mx[qi] = fmaxf(mx[qi], s); S[qi * 8192 + key] = __float_as_uint(s); } } } while (0)
#ifndef IX_REP_S1
#define IX_REP_S1 1
#endif
    for (int rp1 = 0; rp1 < IX_REP_S1; ++rp1) {
    bf16x8 bA[4], bB[4], bC[4];
    { const int kt = wave; if (kt < NT32) IX_LOADT(bA, kt); if (kt + 8 < NT32) IX_LOADT(bB, kt + 8); if (kt + 16 < NT32) IX_LOADT(bC, kt + 16); }
    for (int kt = wave; kt < NT32; kt += 3 * NWAVES) {
        const int kn = kt + 3 * NWAVES;
        bf16x8 nA[4], nB[4], nC[4];
        if (kn < NT32) IX_LOADT(nA, kn); if (kn + 8 < NT32) IX_LOADT(nB, kn + 8); if (kn + 16 < NT32) IX_LOADT(nC, kn + 16);
        const bool hB = kt + 8 < NT32, hC = kt + 16 < NT32;
#ifndef IX_REP_C
#define IX_REP_C 1
#endif
        for (int rc_ = 0; rc_ < IX_REP_C; ++rc_) {
        f32x16 xA, xB, xC;
        IX_MM(xA, bA); if (hB) IX_MM(xB, bB); if (hC) IX_MM(xC, bC);
        { f32x16 yy; IX_HS(yy, xA); IX_ST(yy, kt); }
        if (hB) { f32x16 yy; IX_HS(yy, xB); IX_ST(yy, kt + 8); }
        if (hC) { f32x16 yy; IX_HS(yy, xC); IX_ST(yy, kt + 16); }
        }
#pragma unroll
        for (int ks = 0; ks < 4; ++ks) { bA[ks] = nA[ks]; bB[ks] = nB[ks]; bC[ks] = nC[ks]; }
    }
    }
#undef IX_LOADT
#undef IX_MM
#undef IX_HS
#undef IX_ST
#pragma unroll
    for (int qi = 0; qi < 4; ++qi) {
#pragma unroll
        for (int o = 1; o < 32; o <<= 1) { mn[qi] = fminf(mn[qi], __shfl_xor(mn[qi], o)); mx[qi] = fmaxf(mx[qi], __shfl_xor(mx[qi], o)); }
        if (lane == 0) { MM[(wave * 4 + qi) * 2] = mn[qi]; MM[(wave * 4 + qi) * 2 + 1] = mx[qi]; } }
    __syncthreads();
    const int qs = wave >> 1, half = wave & 1;
    float mnq = 3.0e38f, mxq = -3.0e38f;
#pragma unroll
    for (int w = 0; w < NWAVES; ++w) { mnq = fminf(mnq, MM[(w * 4 + qs) * 2]); mxq = fmaxf(mxq, MM[(w * 4 + qs) * 2 + 1]); }
    const float scl = (mxq > mnq) ? 1023.0f / (mxq - mnq) : 0.0f;
#define IX_BIN(sbits) min((int)((__uint_as_float(sbits) - mnq) * scl), 1023)
    { LAS unsigned* hist = H + qs * 1024;
      int i = half * 64 + lane;
      for (; i + 384 < L; i += 512) { const unsigned s0 = S[qs * 8192 + i], s1 = S[qs * 8192 + i + 128], s2 = S[qs * 8192 + i + 256], s3 = S[qs * 8192 + i + 384];
          const int b0 = IX_BIN(s0), b1 = IX_BIN(s1), b2 = IX_BIN(s2), b3 = IX_BIN(s3);
          atomicAdd((unsigned*)(hist + b0), 1u); atomicAdd((unsigned*)(hist + b1), 1u); atomicAdd((unsigned*)(hist + b2), 1u); atomicAdd((unsigned*)(hist + b3), 1u); }
      for (; i < L; i += 128) { const int bin = IX_BIN(S[qs * 8192 + i]); atomicAdd((unsigned*)(hist + bin), 1u); } }
    __syncthreads();
    int bstar, rtake, cntb;
    { const LAS u32x4* hp = (const LAS u32x4*)(H + qs * 1024 + 1008 - 16 * lane);
      const u32x4 h0 = hp[0], h1 = hp[1], h2 = hp[2], h3 = hp[3];
      const unsigned cb[16] = {h0.x, h0.y, h0.z, h0.w, h1.x, h1.y, h1.z, h1.w, h2.x, h2.y, h2.z, h2.w, h3.x, h3.y, h3.z, h3.w};
      int tot = 0;
#pragma unroll
      for (int j = 0; j < 16; ++j) tot += (int)cb[j];
      int incl = tot;
#pragma unroll
      for (int o = 1; o < 64; o <<= 1) { const int v = __shfl_up(incl, o); if (lane >= o) incl += v; }
      const unsigned long long bal = __ballot(incl >= 256);
      const int fl = __ffsll((long long)bal) - 1;
      const int rem = 256 - (incl - tot);
      int cum = 0, bs = 0, rt = 0, cn = 0; bool found = false;
#pragma unroll
      for (int j = 15; j >= 0; --j) { const int cj = (int)cb[j]; if (!found && cum + cj >= rem) { bs = 1008 - 16 * lane + j; rt = rem - cum; cn = cj; found = true; } cum += cj; }
      bstar = __shfl(bs, fl); rtake = __shfl(rt, fl); cntb = __shfl(cn, fl); }
    const int NG = L / 64;
    const bool all_eq = (cntb == rtake);
    const unsigned long long lt = (1ull << lane) - 1ull;
    { unsigned mlo = 0u, mhi = 0u;
      const int gh = (NG + 1) >> 1, gbeg = half ? gh : 0, gend = half ? NG : gh;
      const float tge = (float)bstar, tgt = (bstar >= 1023) ? 3.0e38f : (float)(bstar + 1);
      unsigned sv[4] = {0u, 0u, 0u, 0u};
      for (int g = gbeg; g < gend; ++g) {
          const int gi = (g - gbeg) & 3;
          if (gi == 0) {
#pragma unroll
              for (int j = 0; j < 4; ++j) if (g + j < gend) sv[j] = S[qs * 8192 + 64 * (g + j) + lane]; }
          const unsigned sb = (gi == 0) ? sv[0] : (gi == 1) ? sv[1] : (gi == 2) ? sv[2] : sv[3];
          const float tq = (__uint_as_float(sb) - mnq) * scl;
          unsigned long long m = __ballot(tq >= tgt);
          const unsigned long long eqm = __ballot(tq >= tge) & ~m;
          if (all_eq) m |= eqm;
          else if (eqm != 0ull) {
              unsigned base = 0u;
              if (lane == 0) base = atomicAdd((unsigned*)(CC + qs), (unsigned)__popcll(eqm));
              base = __builtin_amdgcn_readfirstlane(base);
              const unsigned pos = base + (unsigned)__popcll(eqm & lt);
              if (((eqm >> lane) & 1ull) && pos < (unsigned)IX_CAP) LST[qs * IX_CAP + pos] = (unsigned)(64 * g + lane); }
          if (lane == g - gbeg) { mlo = (unsigned)m; mhi = (unsigned)(m >> 32); }
      }
      if (lane < gend - gbeg) *(LAS u32x2*)(MB + qs * 256 + 2 * (gbeg + lane)) = (u32x2){mlo, mhi}; }
    __syncthreads();
    if (half == 0 && !all_eq) {
        const int nc = cntb;
        if (nc > IX_CAP) { if (lane == 0) CC[4] = 1u; }
        else {
            unsigned myk[8], myi[8]; int rk[8];
#pragma unroll
            for (int sI = 0; sI < 8; ++sI) { const int j = sI * 64 + lane; rk[sI] = 0; myi[sI] = 0u; myk[sI] = 0u;
                if (sI * 64 < nc && j < nc) { myi[sI] = LST[qs * IX_CAP + j]; myk[sI] = ix_sortable(S[qs * 8192 + myi[sI]]); } }
            for (int t = 0; t < nc; ++t) { const unsigned it = LST[qs * IX_CAP + t]; const unsigned kt_ = ix_sortable(S[qs * 8192 + it]);
#pragma unroll
                for (int sI = 0; sI < 8; ++sI) if (sI * 64 < nc) rk[sI] += (kt_ > myk[sI] || (kt_ == myk[sI] && it < myi[sI])) ? 1 : 0; }
#pragma unroll
            for (int sI = 0; sI < 8; ++sI) { const int j = sI * 64 + lane;
                if (sI * 64 < nc && j < nc && rk[sI] < rtake) atomicOr((unsigned*)(MB + qs * 256 + (myi[sI] >> 5)), 1u << (myi[sI] & 31u)); }
        }
    }
#undef IX_BIN
    __syncthreads();
    if (CC[4] != 0u) { __syncthreads(); ix_radix_fallback(S, H, MASK, t0, L, tid); return; }
    { const int qi = tid >> 7, w2 = (tid & 127) * 2;
      *(u32x2*)(MASK + (size_t)(t0 + qi) * 256 + w2) = *(const LAS u32x2*)(MB + qi * 256 + w2); }
    __syncthreads();
}

constexpr int NA_IDX = 0, NA_LG = 1024, NA_SCAN = 1024 + 8192;
__device__ __forceinline__ void attn_gather_unit(const Args& a, int tok, LAS unsigned char* lds, int tid) {
    unsigned char* ws = a.ws;
    const int lane = tid & 63, wave = __builtin_amdgcn_readfirstlane(tid >> 6);
    const int b = tok >> 13, qpos = tok & (SEQ - 1), c = qpos >> 6, L = 64 * (c + 1), nsel = L < 256 ? L : 256;
    const unsigned* MASK = (const unsigned*)(ws + WS_MASK);
    LAS int* idxs = (LAS int*)(lds + NA_IDX); LAS float* lg = (LAS float*)(lds + NA_LG) + wave * 256; LAS int* wsum = (LAS int*)(lds + NA_SCAN);
    unsigned w = 0u; int cnt = 0;
    if (tid < 256) { w = MASK[(size_t)tok * 256 + tid]; cnt = __popc(w); }
    int incl = cnt;
#pragma unroll
    for (int o = 1; o < 64; o <<= 1) { const int v = __shfl_up(incl, o); if (lane >= o) incl += v; }
    if (lane == 63) wsum[wave] = incl;
    __syncthreads();
    if (tid < 256) { int off = incl - cnt; for (int ww = 0; ww < wave; ++ww) off += wsum[ww];
        while (w) { const int bit = __ffs(w) - 1; w &= w - 1; if (off < 256) idxs[off] = tid * 32 + bit; ++off; } }
    __syncthreads();
    const int h = wave;
    const bf16_t* BQ = (const bf16_t*)(ws + WS_BQ); const bf16_t* BK = (const bf16_t*)(ws + WS_BK); const bf16_t* BV = (const bf16_t*)(ws + WS_BV);
    const float slope = exp2f(-(float)(h + 1));
    float qv[8];
    { const u32x4 qw = *(const u32x4*)(BQ + (size_t)tok * 1024 + h * 128 + 8 * (lane & 15));
      qv[0] = __uint_as_float(qw.x << 16); qv[1] = __uint_as_float(qw.x & 0xffff0000u); qv[2] = __uint_as_float(qw.y << 16); qv[3] = __uint_as_float(qw.y & 0xffff0000u);
      qv[4] = __uint_as_float(qw.z << 16); qv[5] = __uint_as_float(qw.z & 0xffff0000u); qv[6] = __uint_as_float(qw.w << 16); qv[7] = __uint_as_float(qw.w & 0xffff0000u); }
    for (int it = 0; it < nsel / 4; ++it) {
        const int key = idxs[4 * it + (lane >> 4)];
        const u32x4 kw = *(const u32x4*)(BK + (size_t)(b * SEQ + key) * 1024 + h * 128 + 8 * (lane & 15));
        float s = qv[0] * __uint_as_float(kw.x << 16) + qv[1] * __uint_as_float(kw.x & 0xffff0000u) + qv[2] * __uint_as_float(kw.y << 16) + qv[3] * __uint_as_float(kw.y & 0xffff0000u)
                + qv[4] * __uint_as_float(kw.z << 16) + qv[5] * __uint_as_float(kw.z & 0xffff0000u) + qv[6] * __uint_as_float(kw.w << 16) + qv[7] * __uint_as_float(kw.w & 0xffff0000u);
        s += __shfl_xor(s, 1); s += __shfl_xor(s, 2); s += __shfl_xor(s, 4); s += __shfl_xor(s, 8);
        const float dist = fabsf((float)(qpos - key));
        if ((lane & 15) == 0) lg[4 * it + (lane >> 4)] = s * 0.08838834764831845f - slope * dist;
    }
    LDS_WAIT();
    float mx = -3.0e38f;
    for (int k = lane; k < nsel; k += 64) mx = fmaxf(mx, lg[k]);
#pragma unroll
    for (int o = 1; o < 64; o <<= 1) mx = fmaxf(mx, __shfl_xor(mx, o));
    float sm = 0.f;
    for (int k = lane; k < nsel; k += 64) { const float e = __expf(lg[k] - mx); lg[k] = e; sm += e; }
    sm = wave_sum(sm);
    const float rs = 1.0f / sm;
    LDS_WAIT();
    float o0 = 0.f, o1 = 0.f;
    for (int k = 0; k < nsel; k += 4) {
        unsigned vw[4]; float pp[4];
#pragma unroll
        for (int j = 0; j < 4; ++j) { const int key = idxs[k + j]; pp[j] = lg[k + j]; vw[j] = *(const unsigned*)(BV + (size_t)(b * SEQ + key) * 1024 + h * 128 + 2 * lane); }
#pragma unroll
        for (int j = 0; j < 4; ++j) { o0 += pp[j] * __uint_as_float(vw[j] << 16); o1 += pp[j] * __uint_as_float(vw[j] & 0xffff0000u); }
    }
    *(unsigned*)((bf16_t*)(ws + WS_BRB) + (size_t)tok * 1024 + h * 128 + 2 * lane) = cvt_pk(o0 * rs, o1 * rs);
    __syncthreads();
}

constexpr int RT_BLK = 148, RT_BUF = 64 * RT_BLK * 4;
constexpr int RT_SCR = 2 * RT_BUF;
__device__ __forceinline__ void phase8_router_expw(const Args& a, LAS unsigned char* lds, int tid, int G, bool route, bool do_expw) {
    unsigned char* ws = a.ws; const int wave = __builtin_amdgcn_readfirstlane(tid >> 6);
    const int npass = MT / 8;
    if (wave < 4) {
        __syncthreads();
        int cbuf = 0;
        for (int ps = blockIdx.x; ps < npass; ps += G) {
            int lane = tid & 63; asm volatile("" : "+v"(lane));
            f32x4 v[2][8];
#pragma unroll
            for (int r = 0; r < 2; ++r) { const int row = ps * 8 + wave * 2 + r;
                const bf16_t* pre = (const bf16_t*)(ws + WS_PRE1) + (size_t)row * DM; float s = 0.f;
#pragma unroll
                for (int i = 0; i < 8; ++i) { const u32x2 pw = *(const u32x2*)(pre + 256 * i + 4 * lane);
                    v[r][i] = (f32x4){__uint_as_float(pw.x << 16), __uint_as_float(pw.x & 0xffff0000u), __uint_as_float(pw.y << 16), __uint_as_float(pw.y & 0xffff0000u)};
                    s += (v[r][i][0] + v[r][i][1]) + (v[r][i][2] + v[r][i][3]); }
                const float mean = wave_sum(s) * (1.0f / DM); float s2 = 0.f;
#pragma unroll
                for (int i = 0; i < 8; ++i) { v[r][i] = v[r][i] - mean; s2 += (v[r][i][0] * v[r][i][0] + v[r][i][1] * v[r][i][1]) + (v[r][i][2] * v[r][i][2] + v[r][i][3] * v[r][i][3]); }
                const float rstd = 1.0f / sqrtf(wave_sum(s2) * (1.0f / DM) + LN_EPS);
                bf16_t* H1B = (bf16_t*)(ws + WS_H1B) + (size_t)row * DM;
#pragma unroll
                for (int i = 0; i < 8; ++i) { const f32x4 gg = *(const f32x4*)(a.in[I_LN1G] + 256 * i + 4 * lane), bb = *(const f32x4*)(a.in[I_LN1B] + 256 * i + 4 * lane);
                    v[r][i] = v[r][i] * rstd * gg + bb;
                    *(u32x2*)(H1B + 256 * i + 4 * lane) = (u32x2){cvt_pk(v[r][i][0], v[r][i][1]), cvt_pk(v[r][i][2], v[r][i][3])}; } }
            f32x2 acc2[36];
#pragma unroll
            for (int j = 0; j < 36; ++j) acc2[j] = (f32x2){0.f, 0.f};
#pragma unroll
            for (int i = 0; i < 8; ++i) {
                int lq = lane; asm volatile("" : "+v"(lq));
                const LAS float* blk = (const LAS float*)(lds + cbuf * RT_BUF) + lq * RT_BLK;
#pragma unroll
                for (int kk = 0; kk < 4; ++kk) {
                    __builtin_amdgcn_sched_barrier(0);
                    const f32x2 hv = (f32x2){v[0][i][kk], v[1][i][kk]};
#pragma unroll
                    for (int q = 0; q < 9; ++q) { const f32x4 w4 = *(const LAS f32x4*)(blk + kk * 36 + 4 * q);
                        acc2[4 * q + 0] += hv * (f32x2){w4[0], w4[0]}; acc2[4 * q + 1] += hv * (f32x2){w4[1], w4[1]};
                        acc2[4 * q + 2] += hv * (f32x2){w4[2], w4[2]}; acc2[4 * q + 3] += hv * (f32x2){w4[3], w4[3]}; } }
                __syncthreads();
                cbuf ^= 1;
            }
#pragma unroll
            for (int r = 0; r < 2; ++r) {
                const int row = ps * 8 + wave * 2 + r;
                float lgt[36];
#pragma unroll
                for (int j = 0; j < 36; ++j) lgt[j] = wave_sum(r == 0 ? acc2[j][0] : acc2[j][1]);
                float gl[4]; float gm = -3.0e38f; int gt = 0;
#pragma unroll
                for (int j = 0; j < 4; ++j) { gl[j] = lgt[j] + a.in[I_BGRP][j]; if (gl[j] > gm) { gm = gl[j]; gt = j; } }
                float gs = 0.f;
#pragma unroll
                for (int j = 0; j < 4; ++j) gs += __expf(gl[j] - gm);
                const float gp = 1.0f / gs;
                float e1 = -3.0e38f, e2 = -3.0e38f; int i1 = 0, i2 = 0;
#pragma unroll
                for (int j = 0; j < 8; ++j) { float ev = 0.f;
#pragma unroll
                    for (int gq = 0; gq < 4; ++gq) if (gq == gt) ev = lgt[4 + 8 * gq + j] + a.in[I_BRT][8 * gq + j];
                    if (ev > e1) { e2 = e1; i2 = i1; e1 = ev; i1 = j; } else if (ev > e2) { e2 = ev; i2 = j; } }
                const float x2 = __expf(e2 - e1), w1 = gp / (1.0f + x2), w2 = gp * x2 / (1.0f + x2);
                if (lane == 0 && route) {
                    unsigned* ctl = (unsigned*)(ws + WS_CTL);
                    int* rows = (int*)(ws + WS_ROWS); int* slot_e = (int*)(ws + WS_SLOT); int* slot_p = slot_e + 2 * MT; float* slot_w = (float*)(slot_p + 2 * MT);
                    const int ea = gt * 8 + i1, eb = gt * 8 + i2;
                    const int pa = (int)atomicAdd(ctl + CW_CNT + 64 * ea, 1u), pb = (int)atomicAdd(ctl + CW_CNT + 64 * eb, 1u);
                    rows[ea * MT + pa] = row; rows[eb * MT + pb] = row;
                    slot_e[2 * row] = ea; slot_e[2 * row + 1] = eb; slot_p[2 * row] = pa; slot_p[2 * row + 1] = pb; slot_w[2 * row] = w1; slot_w[2 * row + 1] = w2;
                }
            }
        }
    } else {
        const int lane = tid & 63, te = tid - 256;
        const float* wg = a.in[I_WGRP]; const float* wr = a.in[I_WRT];
        LAS float* scr = (LAS float*)(lds + RT_SCR + (wave - 4) * 8704);
        f32x4 sa[9], sb[9];
#define RT_LOADW(dst, chunk) do { const int k_ = (chunk) * 256 + te; dst[0] = *(const f32x4*)(wg + (size_t)k_ * 4); _Pragma("unroll") for (int j_ = 0; j_ < 8; ++j_) dst[1 + j_] = *(const f32x4*)(wr + (size_t)k_ * 32 + 4 * j_); } while (0)
#define RT_WRITEW(src, buf) do { LAS float* p_ = (LAS float*)(buf) + (te >> 2) * RT_BLK + (te & 3) * 36; _Pragma("unroll") for (int j_ = 0; j_ < 9; ++j_) *(LAS f32x4*)(p_ + 4 * j_) = src[j_]; } while (0)
        RT_LOADW(sa, 0); RT_WRITEW(sa, lds); RT_LOADW(sb, 1);
        const int ge = blockIdx.x * 4 + (wave - 4), NGE = G * 4, NIT = do_expw ? NEXP * EW_E : 0;
        int it = ge; f32x4 e0[8], e1[8], e2[8];
#define EW_LOAD(dst, item) do { if ((item) < NIT) { size_t ldw_; const float* p_ = ew_src(a, (item), lane, ldw_); _Pragma("unroll") for (int i_ = 0; i_ < 8; ++i_) dst[i_] = __builtin_nontemporal_load((const f32x4*)(p_ + (size_t)(8 * i_) * ldw_)); } } while (0)
#define EW_STEPX(cur, fre) do { if (it < NIT) { EW_LOAD(fre, it + 2 * NGE); ew_store(a, it, cur, scr, lane); it += NGE; } } while (0)
        EW_LOAD(e0, it); EW_LOAD(e1, it + NGE);
        __syncthreads();
        int cbuf = 0;
        for (int ps = blockIdx.x; ps < npass; ps += G) {
#pragma unroll
            for (int i = 0; i < 8; ++i) {
                if (i & 1) { RT_LOADW(sb, (i + 2) & 7); RT_WRITEW(sa, lds + (cbuf ^ 1) * RT_BUF); }
                else { RT_LOADW(sa, (i + 2) & 7); RT_WRITEW(sb, lds + (cbuf ^ 1) * RT_BUF); }
                if (i == 0) { EW_STEPX(e0, e2); EW_STEPX(e1, e0); } else if (i == 1) { EW_STEPX(e2, e1); } else if (i == 2) { EW_STEPX(e0, e2); EW_STEPX(e1, e0); } else if (i == 3) { EW_STEPX(e2, e1); }
                else if (i == 4) { EW_STEPX(e0, e2); EW_STEPX(e1, e0); } else if (i == 5) { EW_STEPX(e2, e1); } else if (i == 6) { EW_STEPX(e0, e2); EW_STEPX(e1, e0); } else { EW_STEPX(e2, e1); }
                __syncthreads();
                cbuf ^= 1;
            }
        }
        while (it < NIT) { EW_STEPX(e0, e2); EW_STEPX(e1, e0); EW_STEPX(e2, e1); }
#undef RT_LOADW
#undef RT_WRITEW
#undef EW_STEPX
#undef EW_LOAD
    }
    __syncthreads();
}

__device__ __forceinline__ void load_tile_base(const Args& a, LAS int* tb, int tid) {
    const unsigned* ctl = (const unsigned*)(a.ws + WS_CTL);
    if (tid == 0) { int acc = 0; for (int e = 0; e < NEXP; ++e) { tb[e] = acc; acc += ((int)ctl[CW_CNT + 64 * e] + 255) >> 8; } tb[NEXP] = acc; }
    __syncthreads();
}

__device__ __forceinline__ void phase_gather(const Args& a, LAS unsigned char* lds, int tid, int G) {
    unsigned char* ws = a.ws; const int lane = tid & 63, wave = tid >> 6;
    LAS int* tb = (LAS int*)lds;
    load_tile_base(a, tb, tid);
    unsigned* ctl = (unsigned*)(ws + WS_CTL);
    const int NT = tb[NEXP];
    if (blockIdx.x == 0) { if (tid == 0) ctl[CW_NT] = (unsigned)NT;
        if (tid < NEXP) for (int t = tb[tid]; t < tb[tid + 1]; ++t) ctl[CW_TILEE + t] = (unsigned)tid;
        if (tid <= NEXP) ctl[CW_TBASE + tid] = (unsigned)tb[tid]; }
    const int* rows = (const int*)(ws + WS_ROWS); const bf16_t* H1B = (const bf16_t*)(ws + WS_H1B); bf16_t* XG = (bf16_t*)(ws + WS_XG);
    for (int r = blockIdx.x * NWAVES + wave; r < NT * 256; r += G * NWAVES) {
        const int tile = r >> 8; int e = 0;
        for (int j = 1; j < NEXP; ++j) if (tb[j] <= tile) e = j;
        const int pos = r - tb[e] * 256; const int cnt = (int)ctl[CW_CNT + 64 * e];
        u32x4 v[4];
        if (pos < cnt) { const int tok = rows[e * MT + pos];
#pragma unroll
            for (int i = 0; i < 4; ++i) v[i] = *(const u32x4*)(H1B + (size_t)tok * DM + 512 * i + 8 * lane); }
        else {
#pragma unroll
            for (int i = 0; i < 4; ++i) v[i] = (u32x4){0u, 0u, 0u, 0u}; }
#pragma unroll
        for (int i = 0; i < 4; ++i) *(u32x4*)(XG + (size_t)r * DM + 512 * i + 8 * lane) = v[i];
    }
}

__device__ __forceinline__ void final_row(const Args& a, int row, int lane, const LAS int* tb) {
    unsigned char* ws = a.ws;
    const int* slot_e = (const int*)(ws + WS_SLOT); const int* slot_p = slot_e + 2 * MT; const float* slot_w = (const float*)(slot_p + 2 * MT);
    const int e0 = slot_e[2 * row], e1 = slot_e[2 * row + 1];
    const size_t r0 = (size_t)tb[e0] * 256 + slot_p[2 * row], r1 = (size_t)tb[e1] * 256 + slot_p[2 * row + 1];
    const float w0 = slot_w[2 * row], w1 = slot_w[2 * row + 1];
    const bf16_t* H1B = (const bf16_t*)(ws + WS_H1B) + (size_t)row * DM; const bf16_t* Y = (const bf16_t*)(ws + WS_Y);
    f32x4 v[8]; float s = 0.f;
#pragma unroll
    for (int i = 0; i < 8; ++i) { const u32x2 hw = *(const u32x2*)(H1B + 256 * i + 4 * lane);
        const f32x4 hv = {__uint_as_float(hw.x << 16), __uint_as_float(hw.x & 0xffff0000u), __uint_as_float(hw.y << 16), __uint_as_float(hw.y & 0xffff0000u)};
        const u32x2 ya = *(const u32x2*)(Y + r0 * DM + 256 * i + 4 * lane), yb = *(const u32x2*)(Y + r1 * DM + 256 * i + 4 * lane);
        const f32x4 fa = {__uint_as_float(ya.x << 16), __uint_as_float(ya.x & 0xffff0000u), __uint_as_float(ya.y << 16), __uint_as_float(ya.y & 0xffff0000u)};
        const f32x4 fb = {__uint_as_float(yb.x << 16), __uint_as_float(yb.x & 0xffff0000u), __uint_as_float(yb.y << 16), __uint_as_float(yb.y & 0xffff0000u)};
        v[i] = hv * DN_ALPHA + fa * w0 + fb * w1; s += (v[i][0] + v[i][1]) + (v[i][2] + v[i][3]); }
    const float mean = wave_sum(s) * (1.0f / DM); float s2 = 0.f;
#pragma unroll
    for (int i = 0; i < 8; ++i) { v[i] = v[i] - mean; s2 += (v[i][0] * v[i][0] + v[i][1] * v[i][1]) + (v[i][2] * v[i][2] + v[i][3] * v[i][3]); }
    const float rstd = 1.0f / sqrtf(wave_sum(s2) * (1.0f / DM) + LN_EPS);
    float* O = a.out + (size_t)row * DM;
#pragma unroll
    for (int i = 0; i < 8; ++i) { const f32x4 g = *(const f32x4*)(a.in[I_LN2G] + 256 * i + 4 * lane), bb = *(const f32x4*)(a.in[I_LN2B] + 256 * i + 4 * lane);
        *(f32x4*)(O + 256 * i + 4 * lane) = v[i] * rstd * g + bb; }
}


namespace fa {
constexpr int D = 128, NW = 8, QBLK = 32, KVBLK = 64, LDX = 1024;
constexpr float SCALE = 0.088388347648318440f, THR = 8.f;
constexpr size_t SHM_V = KVBLK * D * 2, SHM_K = KVBLK * D * 2, SHM_ATTN = 2 * SHM_V + 2 * SHM_K + NW * 64 * 4;
using s16x4 = __attribute__((ext_vector_type(4))) short;
#define KSWZ(row, colB) ((row) * 256 + ((colB) ^ (((row) & 7) << 4)))
#define SBAR() __builtin_amdgcn_sched_barrier(0)
__device__ __forceinline__ int crow(int r, int hi) { return (r & 3) + 8 * (r >> 2) + 4 * hi; }

__device__ __forceinline__ void partialSM(f32x16& p0, f32x16& p1, float& m_reg, float& mn, float& alpha) {
  constexpr float C = SCALE * 1.4426950408889634f;
  float pmax = p0[0];
#pragma unroll
  for (int r = 1; r < 16; ++r) pmax = fmaxf(pmax, p0[r]);
#pragma unroll
  for (int r = 0; r < 16; ++r) pmax = fmaxf(pmax, p1[r]);
  { auto rr = __builtin_amdgcn_permlane32_swap(__float_as_uint(pmax), __float_as_uint(pmax), false, false);
    pmax = fmaxf(__uint_as_float(rr[0]), __uint_as_float(rr[1])); }
  if (__builtin_expect(__all(pmax - m_reg <= THR / SCALE), 1)) { mn = m_reg; alpha = 1.f; }
  else { mn = fmaxf(m_reg, pmax); alpha = __builtin_amdgcn_exp2f((m_reg - mn) * C); m_reg = mn; }
  float mnC = -mn * C;
#pragma unroll
  for (int r = 0; r < 16; ++r) p0[r] = fmaf(p0[r], C, mnC);
#pragma unroll
  for (int r = 0; r < 16; ++r) p1[r] = fmaf(p1[r], C, mnC);
#pragma unroll
  for (int r = 0; r < 16; ++r) p0[r] = __builtin_amdgcn_exp2f(p0[r]);
}
__device__ __forceinline__ void finishSM(f32x16& p0, f32x16& p1, float alpha, float& l_reg, bf16x8& pa0, bf16x8& pa1, bf16x8& pa2, bf16x8& pa3) {
#pragma unroll
  for (int r = 0; r < 16; ++r) p1[r] = __builtin_amdgcn_exp2f(p1[r]);
  float ps = 0;
#pragma unroll
  for (int r = 0; r < 16; ++r) ps += p0[r];
#pragma unroll
  for (int r = 0; r < 16; ++r) ps += p1[r];
  { auto rr = __builtin_amdgcn_permlane32_swap(__float_as_uint(ps), __float_as_uint(ps), false, false);
    ps = __uint_as_float(rr[0]) + __uint_as_float(rr[1]); }
  l_reg = l_reg * alpha + ps;
#define PK4(P, BASE, OUT) do { unsigned a0 = cvt_pk(P[BASE + 0], P[BASE + 1]), a1 = cvt_pk(P[BASE + 2], P[BASE + 3]);   \
    unsigned b0 = cvt_pk(P[BASE + 4], P[BASE + 5]), b1 = cvt_pk(P[BASE + 6], P[BASE + 7]);                              \
    auto r0 = __builtin_amdgcn_permlane32_swap(a0, b0, false, false); auto r1 = __builtin_amdgcn_permlane32_swap(a1, b1, false, false); \
    u32x4 w = {r0[0], r1[0], r0[1], r1[1]}; OUT = *reinterpret_cast<bf16x8*>(&w); } while (0)
  PK4(p0, 0, pa0); PK4(p0, 8, pa1); PK4(p1, 0, pa2); PK4(p1, 8, pa3);
#undef PK4
}
__device__ __forceinline__ void qkt(f32x16& p0, f32x16& p1, const char* Ks, const bf16x8* qr, int r32, int hi) {
  p0 = f32x16{}; p1 = f32x16{};
#pragma unroll
  for (int d0 = 0; d0 < 8; ++d0) { int cb = (d0 * 16 + hi * 8) * 2;
    bf16x8 b0 = *reinterpret_cast<const bf16x8*>(Ks + KSWZ(r32, cb));
    bf16x8 b1 = *reinterpret_cast<const bf16x8*>(Ks + KSWZ(32 + r32, cb));
    p0 = __builtin_amdgcn_mfma_f32_32x32x16_bf16(b0, qr[d0], p0, 0, 0, 0);
    p1 = __builtin_amdgcn_mfma_f32_32x32x16_bf16(b1, qr[d0], p1, 0, 0, 0); }
}
__device__ __forceinline__ void mask_bias(f32x16& p0, f32x16& p1, u32x2 mw, float dq, float slr, int hi) {
  const unsigned w0 = mw.x >> (4 * hi), w1 = mw.y >> (4 * hi);
  const unsigned NEG = 0xf149f2cau;
#pragma unroll
  for (int r = 0; r < 16; ++r) { const int c = (r & 3) + 8 * (r >> 2);
    const float d0 = dq - (float)c, d1 = dq - (float)(32 + c);
    const float s0 = fmaf(-slr, fabsf(d0), p0[r]), s1 = fmaf(-slr, fabsf(d1), p1[r]);
    const unsigned t0 = (unsigned)(((int)(w0 << (31 - c))) >> 31), t1 = (unsigned)(((int)(w1 << (31 - c))) >> 31);
    p0[r] = __uint_as_float((__float_as_uint(s0) & t0) | (NEG & ~t0));
    p1[r] = __uint_as_float((__float_as_uint(s1) & t1) | (NEG & ~t1)); }
}
__device__ __forceinline__ int v_st(int k, int c) { const int kk = (k & ~0xC) | ((k & 4) << 1) | ((k & 8) >> 1); return ((kk >> 3) * 4 + (c >> 5)) * 512 + ((kk & 7) * 32 + (c & 31)) * 2; }
__device__ __forceinline__ int v_rd_base(int lane) { return ((lane & 3) << 3) | (((lane >> 2) & 3) << 6) | (((lane >> 4) & 1) << 5) | (((lane >> 5) & 1) << 8); }
constexpr int v_rd_off(int d0, int ks, int half) { return d0 * 512 + ks * 4096 + half * 2048; }
template <int OFF> __device__ __forceinline__ s16x4 tr_read(int vb) {
  s16x4 r; asm volatile("ds_read_b64_tr_b16 %0, %1 offset:%2" : "=&v"(r) : "v"(vb), "i"(OFF) : "memory"); return r;
}
template <int D0> __device__ __forceinline__ void pv_one(f32x16& od, int vb, bf16x8 pa0, bf16x8 pa1, bf16x8 pa2, bf16x8 pa3) {
  const s16x4 l0 = tr_read<v_rd_off(D0, 0, 0)>(vb), h0 = tr_read<v_rd_off(D0, 0, 1)>(vb), l1 = tr_read<v_rd_off(D0, 1, 0)>(vb), h1 = tr_read<v_rd_off(D0, 1, 1)>(vb);
  const s16x4 l2 = tr_read<v_rd_off(D0, 2, 0)>(vb), h2 = tr_read<v_rd_off(D0, 2, 1)>(vb), l3 = tr_read<v_rd_off(D0, 3, 0)>(vb), h3 = tr_read<v_rd_off(D0, 3, 1)>(vb);
  asm volatile("s_waitcnt lgkmcnt(0)" ::: "memory"); SBAR();
#define PK(L, H) (bf16x8){L[0], L[1], L[2], L[3], H[0], H[1], H[2], H[3]}
  od = __builtin_amdgcn_mfma_f32_32x32x16_bf16(pa0, PK(l0, h0), od, 0, 0, 0);
  od = __builtin_amdgcn_mfma_f32_32x32x16_bf16(pa1, PK(l1, h1), od, 0, 0, 0);
  od = __builtin_amdgcn_mfma_f32_32x32x16_bf16(pa2, PK(l2, h2), od, 0, 0, 0);
  od = __builtin_amdgcn_mfma_f32_32x32x16_bf16(pa3, PK(l3, h3), od, 0, 0, 0);
#undef PK
}
__device__ __forceinline__ void pv_d0(f32x16* o, int vb, bf16x8 pa0, bf16x8 pa1, bf16x8 pa2, bf16x8 pa3) {
  pv_one<0>(o[0], vb, pa0, pa1, pa2, pa3); pv_one<1>(o[1], vb, pa0, pa1, pa2, pa3); pv_one<2>(o[2], vb, pa0, pa1, pa2, pa3); pv_one<3>(o[3], vb, pa0, pa1, pa2, pa3);
}

#define FA_GAS __attribute__((address_space(1)))
__device__ __forceinline__ void attn_block(const bf16_t* Qb_, const bf16_t* Kh_, const bf16_t* Vh_, const unsigned* maskrow_,
                                           bf16_t* Ob_, int NT, int qpos0, float slr, char* lds) {
  const FA_GAS bf16_t* Qb = (const FA_GAS bf16_t*)Qb_; const FA_GAS bf16_t* Kh = (const FA_GAS bf16_t*)Kh_; const FA_GAS bf16_t* Vh = (const FA_GAS bf16_t*)Vh_;
  const FA_GAS unsigned* maskrow = (const FA_GAS unsigned*)maskrow_; FA_GAS bf16_t* Ob = (FA_GAS bf16_t*)Ob_;
  int tid_ = threadIdx.x; asm volatile("" : "+v"(tid_));
  const int tid = tid_, wid = tid >> 6, lane = tid & 63, r32 = lane & 31, hi = lane >> 5;
  char* V_lds = lds; char* K_lds = lds + 2 * SHM_V;
  float* wsm = (float*)(lds + 2 * SHM_V + 2 * SHM_K) + wid * 64; float* li_l = wsm; float* al_l = wsm + 32;
  float m_reg = -1e30f, l_reg = 0; f32x16 o[4] = {}; bf16x8 qr[8];
  const FA_GAS bf16_t* Qw = Qb + (long)(wid * QBLK + r32) * LDX + hi * 8;
#pragma unroll
  for (int d0 = 0; d0 < 8; ++d0) qr[d0] = *reinterpret_cast<const FA_GAS bf16x8*>(Qw + d0 * 16);
  const unsigned moff = (unsigned)(wid * QBLK + r32) * 256u;
  const float qposf = (float)(qpos0 + wid * QBLK + r32 - 4 * hi);
  const int sr = tid >> 4, sc = (tid & 15) * 8, vst0 = v_st(sr, sc), vst1 = v_st(32 + sr, sc);
  const int vb0 = (int)(uintptr_t)V_lds + v_rd_base(lane);
  constexpr int SDEPTH = 1;
  struct { bf16x8 vs0, vs1, ks0, ks1; } sr_[SDEPTH];
#define KOFF(j) ((NT - 1 - (j)) * KVBLK)
#define SLOAD(i, k0) do { sr_[i].vs0 = *reinterpret_cast<const FA_GAS bf16x8*>(&Vh[(long)((k0) + sr) * LDX + sc]); sr_[i].vs1 = *reinterpret_cast<const FA_GAS bf16x8*>(&Vh[(long)((k0) + 32 + sr) * LDX + sc]); \
    sr_[i].ks0 = *reinterpret_cast<const FA_GAS bf16x8*>(&Kh[(long)((k0) + sr) * LDX + sc]); sr_[i].ks1 = *reinterpret_cast<const FA_GAS bf16x8*>(&Kh[(long)((k0) + 32 + sr) * LDX + sc]); } while (0)
#define SWRITE(b, i) do { *(bf16x8*)(V_lds + (b) * SHM_V + vst0) = sr_[i].vs0;          \
    *(bf16x8*)(V_lds + (b) * SHM_V + vst1) = sr_[i].vs1; int kc = sc * 2;               \
    *(bf16x8*)(K_lds + (b) * SHM_K + KSWZ(sr, kc)) = sr_[i].ks0;                       \
    *(bf16x8*)(K_lds + (b) * SHM_K + KSWZ(32 + sr, kc)) = sr_[i].ks1; } while (0)
#define SWAIT() do { if constexpr (SDEPTH == 2) asm volatile("s_waitcnt vmcnt(4)" ::: "memory"); else asm volatile("s_waitcnt vmcnt(0)" ::: "memory"); } while (0)
#define RESC(a) do { if (__any((a) < 1.f)) { if (hi == 0) al_l[r32] = (a); asm volatile("s_waitcnt lgkmcnt(0)" ::: "memory"); \
    _Pragma("unroll") for (int d = 0; d < 4; ++d) _Pragma("unroll") for (int r = 0; r < 16; ++r) o[d][r] *= al_l[crow(r, hi)]; } } while (0)
#define MASKW(j) (*reinterpret_cast<const FA_GAS u32x2*>(maskrow + (moff + 2u * (unsigned)(NT - 1 - (j)))))
#define MB(P0, P1, j, MW) mask_bias(P0, P1, MW, qposf - (float)KOFF(j), slr, hi)
  f32x16 pA0, pA1, pB0, pB1; float mnA, mnB, alA, alB; bf16x8 pa0, pa1, pa2, pa3;
  constexpr int SE = 0, SO = SDEPTH - 1;
  SLOAD(SE, KOFF(0)); asm volatile("s_waitcnt vmcnt(0)" ::: "memory"); SWRITE(0, SE); __syncthreads();
  u32x2 mA = MASKW(0), mB = MASKW(1);
  { qkt(pA0, pA1, K_lds, qr, r32, hi); MB(pA0, pA1, 0, mA); } partialSM(pA0, pA1, m_reg, mnA, alA);
  SLOAD(SO, KOFF(1)); if constexpr (SDEPTH == 2) { if (2 < NT) SLOAD(SE, KOFF(2)); }
  SWAIT(); SWRITE(1, SO); __syncthreads();
  for (int j = 1; j + 1 < NT; j += 2) {
    SBAR(); mA = MASKW(j + 1); { qkt(pB0, pB1, K_lds + SHM_K, qr, r32, hi); MB(pB0, pB1, j, mB); }
    finishSM(pA0, pA1, alA, l_reg, pa0, pa1, pa2, pa3); SBAR();
    SLOAD(SO, KOFF(j + SDEPTH)); SBAR();
    pv_d0(o, vb0, pa0, pa1, pa2, pa3); partialSM(pB0, pB1, m_reg, mnB, alB);
    __syncthreads(); SWAIT(); SWRITE(0, SE);
    RESC(alB); __syncthreads();
    SBAR(); mB = MASKW(j + 2); { qkt(pA0, pA1, K_lds, qr, r32, hi); MB(pA0, pA1, j + 1, mA); }
    finishSM(pB0, pB1, alB, l_reg, pa0, pa1, pa2, pa3); SBAR();
    if (SDEPTH == 1 || j + 3 < NT) SLOAD(SE, KOFF(j + 1 + SDEPTH)); SBAR();
    pv_d0(o, vb0 + (int)SHM_V, pa0, pa1, pa2, pa3); partialSM(pA0, pA1, m_reg, mnA, alA);
    __syncthreads(); SWAIT(); SWRITE(1, SO);
    RESC(alA); __syncthreads();
  }
  SBAR(); { qkt(pB0, pB1, K_lds + SHM_K, qr, r32, hi); MB(pB0, pB1, NT - 1, mB); }
  finishSM(pA0, pA1, alA, l_reg, pa0, pa1, pa2, pa3); SBAR();
  pv_d0(o, vb0, pa0, pa1, pa2, pa3); partialSM(pB0, pB1, m_reg, mnB, alB);
  __syncthreads(); RESC(alB);
  finishSM(pB0, pB1, alB, l_reg, pa0, pa1, pa2, pa3); SBAR();
  pv_d0(o, vb0 + (int)SHM_V, pa0, pa1, pa2, pa3);
  if (hi == 0) li_l[r32] = l_reg; asm volatile("s_waitcnt lgkmcnt(0)" ::: "memory");
  float rli[16];
#pragma unroll
  for (int r = 0; r < 16; ++r) rli[r] = __builtin_amdgcn_rcpf(li_l[crow(r, hi)]);
  FA_GAS bf16_t* Ow = Ob + (long)(wid * QBLK) * LDX;
#pragma unroll
  for (int r = 0; r < 16; ++r) { int orow = crow(r, hi);
#pragma unroll
    for (int d0 = 0; d0 < 4; ++d0) Ow[(long)orow * LDX + d0 * 32 + r32] = (bf16_t)(cvt_pk(o[d0][r] * rli[r], 0.f) & 0xffffu); }
  __syncthreads();
#undef KOFF
#undef SLOAD
#undef SWRITE
#undef SWAIT
#undef RESC
#undef MASKW
#undef MB
}
#undef KSWZ
#undef SBAR
}

__device__ __forceinline__ void phase_attention(const Args& a, char* lds, int G) {
    unsigned char* ws = uni_ptr(a.ws);
    const bf16_t* BQ = (const bf16_t*)(ws + WS_BQ); const bf16_t* BK = (const bf16_t*)(ws + WS_BK); const bf16_t* BV = (const bf16_t*)(ws + WS_BV);
    const unsigned* MASK = (const unsigned*)(ws + WS_MASK); bf16_t* BRB = (bf16_t*)(ws + WS_BRB);
    const int bx = blockIdx.x; const int vcu = (G % 8 == 0) ? (bx % 8) * (G / 8) + bx / 8 : bx;
    for (int p0 = vcu; p0 < 256; p0 += G) { const int p = __builtin_amdgcn_readfirstlane(p0);
        const int b = p >> 7, h = (p >> 4) & 7, x = p & 15;
        const float slr = uni_f((1.0f / fa::SCALE) / (float)(2 << h));
#pragma unroll 1
        for (int half = 0; half < 2; ++half) { const int qb = half ? 31 - x : x; const size_t row0 = (size_t)b * SEQ + qb * 256;
            fa::attn_block(uni_ptr(BQ + row0 * 1024 + h * 128), uni_ptr(BK + (size_t)b * SEQ * 1024 + h * 128), uni_ptr(BV + (size_t)b * SEQ * 1024 + h * 128),
                           uni_ptr(MASK + row0 * 256), uni_ptr(BRB + row0 * 1024 + h * 128), 4 * (qb + 1), qb * 256, slr, lds); }
    }
}


constexpr int NPH = 13;
#ifndef REPS
#define REPS 1,1,1,1,1,1,1,1,1,1,1,1,1,1,1,1
#endif
constexpr int REP[16] = {REPS};
__global__ void __launch_bounds__(NTHR, 2) mk_fwd(Args a) {
    extern __shared__ __attribute__((aligned(16))) unsigned char lds_raw[];
    LAS unsigned char* lds = (LAS unsigned char*)lds_raw;
    cg::grid_group grid = cg::this_grid();
    const int G = gridDim.x;
#define FRESH_TID() int tid = threadIdx.x; asm volatile("" : "+v"(tid)); const int lane = tid & 63, wave = tid >> 6; (void)lane; (void)wave

    unsigned char* ws = a.ws;
    const int lo = a.ph_lo, hi = a.ph_hi;
#define IN(k) (lo <= (k) && (k) < hi)
    if (threadIdx.x == 0) { ((volatile LAS unsigned*)(lds + LDS_BARST))[0] = 0u; ((volatile LAS unsigned*)(lds + LDS_BARST))[1] = 0u; }
    __syncthreads();
    (void)xcd_barrier_post((unsigned*)(ws + WS_CTL) + CW_BAR, (volatile LAS unsigned*)(lds + LDS_BARST));
#define SEAM(k) do { if (IN(k) && IN((k) + 1)) { if (lo < 0) grid.sync();   else { XcdBarrier b_; b_.bar = (unsigned*)(a.ws + WS_CTL) + CW_BAR; b_.x = xb_xcc_id(); b_.st = (volatile LAS unsigned*)(lds + LDS_BARST); xcd_barrier(b_); } } } while (0)

    if (IN(0)) { FRESH_TID(); for (int rp = 0; rp < REP[0]; ++rp) { phase_prologue(a, lds, tid, G); __syncthreads(); } }
    SEAM(0);
    if (IN(1)) { FRESH_TID(); pg8::Gemm g{(const bf16_t*)(ws + WS_XB), (const bf16_t*)(ws + WS_WIN), MT, NPROJ_PAD, DM}; pg8::StaticOrder S; S.init(MT, NPROJ_PAD, G, (int)blockIdx.x);
        for (int c8 = tid; c8 < NPROJ_PAD / 2; c8 += NTHR) { const int c = 2 * c8; float b0 = 0.f, b1 = 0.f;
            if (c < 7752) { b0 = a.in[I_BIN][c]; b1 = a.in[I_BIN][c + 1]; } else if (c >= 7936) { b0 = a.in[I_BIN][c - 184]; b1 = a.in[I_BIN][c - 183]; }
            *(LAS unsigned*)(lds + LDS_BIAS + c * 2) = cvt_pk(b0, b1); }
        __syncthreads();
        pg8::EpiProj E{ws, lds + LDS_BIAS};
        for (int rp = 0; rp < REP[1]; ++rp) pg8::gemm_phase<pg8::EpiProj, pg8::StaticOrder, true, true>(lds, g, S, E); }
    SEAM(1);
    if (IN(2)) { FRESH_TID(); hg_fill_lb(a, lds, tid);
        for (int rp = 0; rp < REP[2]; ++rp) for (int u = blockIdx.x; u < 2048; u += G) hgrn1_unit(a, u, lds, tid);
        for (int rp = 0; rp < REP[3]; ++rp) for (int u = blockIdx.x; u < MT / 4; u += G) indexer_unit(a, u, lds, tid); }
    SEAM(2);
    if (IN(3)) { FRESH_TID(); for (int rp = 0; rp < REP[4]; ++rp) hgrn_scan(a, tid, G);
        for (int rp = 0; rp < REP[5]; ++rp) phase_attention(a, (char*)lds_raw, G); }
    SEAM(3);
    if (IN(4)) { FRESH_TID(); for (int rp = 0; rp < REP[6]; ++rp) { float z[16]; unsigned qq[16], vv[16];
            if ((int)blockIdx.x < 2048) hg3_load(a, blockIdx.x, tid, z, qq, vv);
            hg_fill_lb(a, lds, tid);
            for (int u = blockIdx.x; u < 2048; u += G) hgrn3_unit(a, u, (u + G < 2048) ? u + G : -1, lds, tid, z, qq, vv); } }
    SEAM(4);
    if (IN(5)) { FRESH_TID(); for (int rp = 0; rp < REP[7]; ++rp) {
        { pg8::Gemm g{(const bf16_t*)(ws + WS_BRA), (const bf16_t*)(ws + WS_WA), MT, DM, 1024}; pg8::StaticOrder S; S.init(MT, DM, G, (int)blockIdx.x);
          pg8::EpiBranch<0> E{(bf16_t*)(ws + WS_MERGED), (const bf16_t*)(ws + WS_GATES)};
          pg8::gemm_phase<pg8::EpiBranch<0>, pg8::StaticOrder, true, true>(lds, g, S, E); }
        { pg8::Gemm g{(const bf16_t*)(ws + WS_BRB), (const bf16_t*)(ws + WS_WB), MT, DM, 1024}; pg8::StaticOrder S; S.init(MT, DM, G, (int)blockIdx.x);
          pg8::EpiBranch<1> E{(bf16_t*)(ws + WS_MERGED), (const bf16_t*)(ws + WS_GATES)};
          pg8::gemm_phase<pg8::EpiBranch<1>, pg8::StaticOrder, true, true>(lds, g, S, E); } } }
    SEAM(6);
    if (IN(7)) { FRESH_TID(); pg8::Gemm g{(const bf16_t*)(ws + WS_MERGED), (const bf16_t*)(ws + WS_WOUT), MT, DM, DM}; pg8::StaticOrder S; S.init(MT, DM, G, (int)blockIdx.x);
        pg8::EpiResBf16 E{(bf16_t*)(ws + WS_PRE1), a.in[I_X], DN_ALPHA};
        for (int rp = 0; rp < REP[8]; ++rp) pg8::gemm_phase<pg8::EpiResBf16, pg8::StaticOrder, true, true>(lds, g, S, E); }
    SEAM(7);
    if (IN(8)) { FRESH_TID(); for (int rp = 0; rp < REP[9]; ++rp) phase8_router_expw(a, lds, tid, G, rp == 0, rp == 0);
        for (int rp = 1; rp < REP[10]; ++rp) phase_expert_weights(a, lds, tid, G); }
    if (IN(8) && IN(10)) { XcdBarrier b_; b_.bar = (unsigned*)(a.ws + WS_CTL) + CW_BAR; b_.x = xb_xcc_id(); b_.st = (volatile LAS unsigned*)(lds + LDS_BARST); xcd_barrier(b_); }
    if (IN(10)) { FRESH_TID(); const unsigned* ctl = (const unsigned*)(ws + WS_CTL);
        LAS int* tb = (LAS int*)(lds + LDS_MOE_TB); LAS unsigned* TE = (LAS unsigned*)(lds + LDS_MOE_TE); LAS unsigned* TOK = (LAS unsigned*)(lds + LDS_MOE_TOK);
        __syncthreads(); load_tile_base(a, tb, tid);
        if (tid < NEXP) for (int t = tb[tid]; t < tb[tid + 1]; ++t) TE[t] = (unsigned)tid;
        __syncthreads();
        const int NT = tb[NEXP];
        pg8::GroupedOrder<true> S; S.init(NT, 8, G, (int)blockIdx.x, TE, TOK);
        { const int* rows = (const int*)(ws + WS_ROWS);
          for (int i = 0; i < 8; ++i) { pg8::Unit u; if (!S.next(i, u)) break;
              if (tid < 256) { const int e = (int)TE[u.pm], pos = (u.pm - tb[e]) * 256 + tid, cnt = (int)ctl[CW_CNT + 64 * e];
                  TOK[i * 256 + tid] = (pos < cnt) ? (unsigned)rows[e * MT + pos] * (unsigned)(DM * 2) : 0u; } } }
        __syncthreads();
        pg8::Gemm g{(const bf16_t*)(ws + WS_H1B), (const bf16_t*)(ws + WS_WGU), NT * 256, 2048, DM};
        pg8::EpiGateUp E{(bf16_t*)(ws + WS_HH)};
        for (int rp = 0; rp < REP[12]; ++rp) pg8::gemm_phase<pg8::EpiGateUp, pg8::GroupedOrder<true>, true, true>(lds, g, S, E); }
    SEAM(10);
    if (IN(11)) { FRESH_TID();
        LAS int* tb = (LAS int*)(lds + LDS_MOE_TB); LAS unsigned* TE = (LAS unsigned*)(lds + LDS_MOE_TE);
        __syncthreads(); load_tile_base(a, tb, tid);
        if (tid < NEXP) for (int t = tb[tid]; t < tb[tid + 1]; ++t) TE[t] = (unsigned)tid;
        __syncthreads();
        const int NT = tb[NEXP];
        pg8::Gemm g{(const bf16_t*)(ws + WS_HH), (const bf16_t*)(ws + WS_WD), NT * 256, 2048, DFF}; pg8::GroupedOrder<false> S; S.init(NT, 8, G, (int)blockIdx.x, TE, nullptr);
        pg8::EpiStoreBf16 E{(bf16_t*)(ws + WS_Y), DM, uni_f((float)(G > 0))};
        for (int rp = 0; rp < REP[13]; ++rp) pg8::gemm_phase<pg8::EpiStoreBf16, pg8::GroupedOrder<false>, true, true>(lds, g, S, E); }
    SEAM(11);
    if (IN(12)) { FRESH_TID(); LAS int* tb = (LAS int*)lds; __syncthreads(); load_tile_base(a, tb, tid);
        for (int rp = 0; rp < REP[14]; ++rp) for (int r = blockIdx.x * NWAVES + wave; r < MT; r += G * NWAVES) final_row(a, r, lane, tb); }
#undef IN
#undef SEAM
}

#ifndef MK_SPLIT
#define MK_SPLIT 0
#endif
extern "C" void kernel_launch(void* const* d_in, const int* in_sizes, int n_in, void* d_out, int out_size, void* d_ws, size_t ws_size, hipStream_t stream) {
    static int grid = 0;
    if (grid == 0) {
        int dev = 0, cus = 0, per_cu = 0;
        if (n_in != 19 || out_size != MT * DM || ws_size < WS_END) { fprintf(stderr, "kernel_launch: unexpected shapes: n_in %d out %d ws %zu (need %zu)\n", n_in, out_size, ws_size, (size_t)WS_END); grid = -1; return; }
        if (hipGetDevice(&dev) != hipSuccess || hipDeviceGetAttribute(&cus, hipDeviceAttributeMultiprocessorCount, dev) != hipSuccess) { grid = -1; return; }
        if (hipFuncSetAttribute((const void*)mk_fwd, hipFuncAttributeMaxDynamicSharedMemorySize, LDS_BYTES) != hipSuccess) { fprintf(stderr, "kernel_launch: hipFuncSetAttribute failed\n"); grid = -1; return; }
        if (hipOccupancyMaxActiveBlocksPerMultiprocessor(&per_cu, (const void*)mk_fwd, NTHR, LDS_BYTES) != hipSuccess || per_cu < 1) { fprintf(stderr, "kernel_launch: occupancy query says %d blocks/CU\n", per_cu); grid = -1; return; }
        grid = cus;
    }
    if (grid < 0) return;
    (void)hipMemsetAsync((char*)d_ws + WS_CTL, 0, 1 * MiB, stream);
    Args a{};
    for (int i = 0; i < 19; ++i) a.in[i] = (const float*)d_in[i];
    a.out = (float*)d_out; a.ws = (unsigned char*)d_ws;
#if MK_SPLIT
    for (int p = 0; p < NPH; ++p) { a.ph_lo = p; a.ph_hi = p + 1; void* args[] = {&a};
        hipError_t e = hipLaunchCooperativeKernel((const void*)mk_fwd, dim3(grid), dim3(NTHR), args, LDS_BYTES, stream);
        if (e != hipSuccess) { fprintf(stderr, "cooperative launch (phase %d) failed: %s (grid %d)\n", p, hipGetErrorString(e), grid); break; } }
#else
    a.ph_lo = 0; a.ph_hi = NPH; void* args[] = {&a};
    hipError_t e = hipLaunchCooperativeKernel((const void*)mk_fwd, dim3(grid), dim3(NTHR), args, LDS_BYTES, stream);
    if (e != hipSuccess) fprintf(stderr, "cooperative launch failed: %s (grid %d)\n", hipGetErrorString(e), grid);
#endif
}
```

```cpp
#include <hip/hip_runtime.h>
#include <hip/hip_cooperative_groups.h>
#include <cstdio>
#include <cstdint>
namespace cg = cooperative_groups;

#define LAS __attribute__((address_space(3)))
typedef unsigned short bf16_t;
typedef short bf16x8 __attribute__((ext_vector_type(8)));
typedef float f32x4 __attribute__((ext_vector_type(4)));
typedef float f32x2 __attribute__((ext_vector_type(2)));
typedef float f32x16 __attribute__((ext_vector_type(16)));
typedef unsigned u32x4 __attribute__((ext_vector_type(4)));
typedef unsigned u32x2 __attribute__((ext_vector_type(2)));

constexpr int MT = 16384, SEQ = 8192, DM = 2048, NHEAD = 8, HD = 128, NPROJ = 11848, NPROJ_PAD = 12032;
constexpr int NEXP = 32, DFF = 1024, MAXROWS = 40960;
constexpr float DN_ALPHA = 1.189207115002721f;
constexpr float LN_EPS = 1e-5f, RMS_EPS = 1e-6f;
constexpr int NWAVES = 8, NTHR = 512;
constexpr int LDS_BYTES = 163840;

constexpr size_t MiB = 1u << 20;
constexpr size_t WS_CTL = 0;
constexpr size_t WS_WIN = 1 * MiB;
constexpr size_t WS_WA = 48 * MiB, WS_WB = 52 * MiB, WS_WOUT = 56 * MiB;
constexpr size_t WS_XB = 64 * MiB;
constexpr size_t WS_MERGED = 64 * MiB;
constexpr size_t WS_AQ = 128 * MiB, WS_AI = 160 * MiB, WS_AG = 192 * MiB, WS_BQ = 224 * MiB, WS_BK = 256 * MiB, WS_BV = 288 * MiB;
constexpr size_t WS_AF = 320 * MiB;
constexpr size_t WS_IQ = 384 * MiB;
constexpr size_t WS_IKW = 400 * MiB;
constexpr size_t WS_GATES = 408 * MiB;
constexpr size_t WS_WGU = 128 * MiB;
constexpr size_t WS_WD = 384 * MiB;
constexpr size_t WS_MASK = 536 * MiB;
constexpr size_t WS_KV = 552 * MiB;
constexpr size_t WS_PRE1 = 552 * MiB;
constexpr size_t WS_ST = 680 * MiB;
constexpr size_t WS_H1B = 680 * MiB;
constexpr size_t WS_DECAY = 744 * MiB;
constexpr size_t WS_ROWS = 745 * MiB;
constexpr size_t WS_SLOT = 747 * MiB;
constexpr size_t WS_BRA = 750 * MiB, WS_BRB = 782 * MiB;
constexpr size_t WS_IK2 = 814 * MiB;
constexpr size_t WS_HH = 750 * MiB;
constexpr size_t WS_XG = 830 * MiB;
constexpr size_t WS_Y = 830 * MiB;
constexpr size_t WS_END = 990 * MiB;
constexpr int CW_CNT = 1024;
constexpr int CW_NT = 4096;
constexpr int CW_TILEE = 4160;
constexpr int CW_TBASE = 4400;
constexpr int CW_BAR = 8192;
constexpr int CW_TICKET = 12288;
constexpr int LDS_BIAS = 131072;
constexpr int LDS_MOE_TB = 131072, LDS_MOE_TE = 131072 + 256, LDS_MOE_TOK = 131072 + 1024;
constexpr int LDS_BARST = LDS_BYTES - 64;

__device__ __forceinline__ float bf2f(unsigned h) { return __uint_as_float(h << 16); }
__device__ __forceinline__ unsigned cvt_pk(float lo, float hi) { unsigned r; asm volatile("v_cvt_pk_bf16_f32 %0, %1, %2" : "=v"(r) : "v"(lo), "v"(hi)); return r; }
__device__ __forceinline__ unsigned cvt_pk_mfma(float lo, float hi) { unsigned r; asm volatile("s_nop 15\n\ts_nop 3\n\tv_cvt_pk_bf16_f32 %0, %1, %2" : "=v"(r) : "v"(lo), "v"(hi)); return r; }
__device__ __forceinline__ unsigned cvt_pk_to_mfma(float lo, float hi) { unsigned r; asm volatile("v_cvt_pk_bf16_f32 %0, %1, %2\n\ts_nop 1" : "=v"(r) : "v"(lo), "v"(hi)); return r; }
__device__ __forceinline__ float wave_sum(float v) {
#pragma unroll
    for (int o = 1; o < 64; o <<= 1) v += __shfl_xor(v, o);
    return v;
}
__device__ __forceinline__ float fast_exp(float x) { return __builtin_amdgcn_exp2f(x * 1.4426950408889634f); }
__device__ __forceinline__ float sigmoidf_(float x) { return __builtin_amdgcn_rcpf(1.0f + __expf(-x)); }
#define LDS_WAIT() asm volatile("s_waitcnt lgkmcnt(0)" ::: "memory")
template <typename T> __device__ __forceinline__ T* uni_ptr(T* p) { const unsigned long long v = (unsigned long long)p; const unsigned lo = __builtin_amdgcn_readfirstlane((unsigned)v), hi = __builtin_amdgcn_readfirstlane((unsigned)(v >> 32)); return (T*)(((unsigned long long)hi << 32) | lo); }
__device__ __forceinline__ float uni_f(float x) { return __uint_as_float(__builtin_amdgcn_readfirstlane(__float_as_uint(x))); }

namespace pg8 {
#define PG8_LAS __attribute__((address_space(3)))
typedef unsigned short bf16_t;
typedef short bf16x8 __attribute__((ext_vector_type(8)));
typedef float f32x4 __attribute__((ext_vector_type(4)));
typedef unsigned u32x4 __attribute__((ext_vector_type(4)));
constexpr int BM = 256, BK = 64, HALF = 128, HTB = HALF * BK * 2  , STAGE_BYTES = 8 * HTB, NXCD = 8, WGM = 8;

__host__ __device__ __forceinline__ int lds_byte(int r, int c) { const int st = (r >> 4) * 2 + (c >> 5), rr = r & 15, cc = c & 31, ob = rr * 64 + cc * 2; return st * 1024 + (ob ^ (((ob >> 9) & 1) << 5)); }
__host__ __device__ __forceinline__ void stage_rc(int b, int& R, int& C) { const int st = b / 1024, sb = b % 1024, swz = sb ^ (((sb >> 9) & 1) << 5); R = (st >> 1) * 16 + swz / 64; C = (st & 1) * 32 + (swz % 64) / 2; }
__host__ __device__ __forceinline__ int perm32(int rho) { const int n = rho >> 4, i = rho & 15; return 8 * (i >> 2) + 4 * n + (i & 3); }

struct Unit { int pm, pn, pb; };
struct Gemm { const bf16_t* A; const bf16_t* Bt; int M, N, K; };

struct StaticOrder {
    static constexpr bool GATHER = false; __device__ __forceinline__ unsigned row_off(int, int) const { return 0u; }
    int nM, nN, nwg, G, c;
    __host__ __device__ void init(int M, int N, int G_, int c_) { nM = M / BM; nN = N / BM; nwg = nM * nN; G = G_; c = c_; }
    __host__ __device__ bool next(int i, Unit& u) const {
        const long L = (long)i * G + c; if (L >= nwg) return false;
        int wgid = (int)L; { const int q = nwg / NXCD, r = nwg % NXCD, xcd = wgid % NXCD, off = wgid / NXCD; wgid = (xcd < r ? xcd * (q + 1) : r * (q + 1) + (xcd - r) * q) + off; }
        const int nig = WGM * nN, gid = wgid / nig, fm = gid * WGM, gsz = (nM - fm) < WGM ? (nM - fm) : WGM;
        u.pm = fm + ((wgid % nig) % gsz); u.pn = (wgid % nig) / gsz; u.pb = u.pn; return true;
    }
    __device__ __forceinline__ void a_ready(const Unit&) const {}
    __device__ __forceinline__ void done(const Unit&) const {}
};


__device__ __forceinline__ unsigned cvt_pk_bf16(float lo, float hi) { unsigned r; asm volatile("v_cvt_pk_bf16_f32 %0, %1, %2" : "=v"(r) : "v"(lo), "v"(hi)); return r; }
__device__ __forceinline__ float sigm(float x) { return __builtin_amdgcn_rcpf(1.0f + __expf(-x)); }

struct EpiProj {
    static constexpr bool PERM = true, AFTER_DRAIN = false;
    unsigned char* ws; const PG8_LAS unsigned char* lbias;
    __device__ __forceinline__ void operator()(const f32x4 (&acc)[2][2][4][2], const Unit& u, int wr, int wc, int fr, int fq) const {
        const int pn = u.pn, row0 = u.pm * BM + wr * 64 + fr, lc0 = wc * 32 + 8 * fq;
        f32x4 bv[2][2];
#pragma unroll
        for (int bj = 0; bj < 2; ++bj) { const u32x4 bw = *(const PG8_LAS u32x4*)(lbias + (size_t)(pn * 256 + lc0 + bj * HALF) * 2);
            bv[bj][0] = (f32x4){__uint_as_float(bw.x << 16), __uint_as_float(bw.x & 0xffff0000u), __uint_as_float(bw.y << 16), __uint_as_float(bw.y & 0xffff0000u)};
            bv[bj][1] = (f32x4){__uint_as_float(bw.z << 16), __uint_as_float(bw.z & 0xffff0000u), __uint_as_float(bw.w << 16), __uint_as_float(bw.w & 0xffff0000u)}; }
        if (pn >= 4 && pn < 8) {
            float* base = (float*)(ws + WS_AF);
#pragma unroll
            for (int ai = 0; ai < 2; ++ai)
#pragma unroll
                for (int m = 0; m < 4; ++m) { float* rowp = base + (size_t)(row0 + ai * HALF + m * 16) * 1024 + (pn - 4) * 256 + lc0;
#pragma unroll
                    for (int bj = 0; bj < 2; ++bj) { *(f32x4*)(rowp + bj * HALF) = acc[ai][bj][m][0] + bv[bj][0]; *(f32x4*)(rowp + bj * HALF + 4) = acc[ai][bj][m][1] + bv[bj][1]; } }
            return;
        }
        bf16_t* base; int ldc, colt; bool sg = false;
        if (pn < 28) { const int s = pn >> 2, idx = (s == 0) ? 0 : s - 1; base = (bf16_t*)(ws + WS_AQ + (size_t)idx * (32 * MiB)); ldc = 1024; colt = (pn & 3) * 256; }
        else if (pn < 30) { base = (bf16_t*)(ws + WS_IQ); ldc = 512; colt = (pn - 28) * 256; }
        else if (pn == 30) { base = (bf16_t*)(ws + WS_IKW); ldc = 256; colt = 0; }
        else { base = (bf16_t*)(ws + WS_GATES); ldc = 4096; colt = (pn - 31) * 256; sg = true; }
#pragma unroll
        for (int ai = 0; ai < 2; ++ai)
#pragma unroll
            for (int m = 0; m < 4; ++m) { bf16_t* rowp = base + (size_t)(row0 + ai * HALF + m * 16) * ldc + colt + lc0;
#pragma unroll
                for (int bj = 0; bj < 2; ++bj) { f32x4 v0 = acc[ai][bj][m][0] + bv[bj][0], v1 = acc[ai][bj][m][1] + bv[bj][1];
                    if (sg) { v0 = (f32x4){sigm(v0[0]), sigm(v0[1]), sigm(v0[2]), sigm(v0[3])}; v1 = (f32x4){sigm(v1[0]), sigm(v1[1]), sigm(v1[2]), sigm(v1[3])}; }
                    u32x4 w; w.x = cvt_pk_bf16(v0[0], v0[1]); w.y = cvt_pk_bf16(v0[2], v0[3]); w.z = cvt_pk_bf16(v1[0], v1[1]); w.w = cvt_pk_bf16(v1[2], v1[3]);
                    *(u32x4*)(rowp + bj * HALF) = w;
                    if (pn == 30 && bj == 0 && lc0 < 64) {
                        const int tok = row0 + ai * HALF + m * 16;
                        *(u32x4*)((bf16_t*)(ws + WS_IK2) + ((size_t)((tok >> 5) * 4 + (lc0 >> 4)) * 64 + ((lc0 >> 3) & 1) * 32 + (tok & 31)) * 8) = w; } } }
    }
};

__device__ __forceinline__ f32x4 bf4lo(u32x4 w) { return (f32x4){__uint_as_float(w.x << 16), __uint_as_float(w.x & 0xffff0000u), __uint_as_float(w.y << 16), __uint_as_float(w.y & 0xffff0000u)}; }
__device__ __forceinline__ f32x4 bf4hi(u32x4 w) { return (f32x4){__uint_as_float(w.z << 16), __uint_as_float(w.z & 0xffff0000u), __uint_as_float(w.w << 16), __uint_as_float(w.w & 0xffff0000u)}; }

template <int MODE> struct EpiBranch {
    static constexpr bool PERM = true, AFTER_DRAIN = false;
    bf16_t* merged; const bf16_t* gates;
    __device__ __forceinline__ void operator()(const f32x4 (&acc)[2][2][4][2], const Unit& u, int wr, int wc, int fr, int fq) const {
        const int row0 = u.pm * BM + wr * 64 + fr, col0 = u.pn * BM + wc * 32 + 8 * fq;
#pragma unroll
        for (int ai = 0; ai < 2; ++ai)
#pragma unroll
            for (int m = 0; m < 4; ++m) { const size_t r = (size_t)(row0 + ai * HALF + m * 16);
#pragma unroll
                for (int bj = 0; bj < 2; ++bj) { const int c = col0 + bj * HALF;
                    const u32x4 gw = *(const u32x4*)(gates + r * 4096 + MODE * 2048 + c);
                    f32x4 v0 = acc[ai][bj][m][0] * bf4lo(gw), v1 = acc[ai][bj][m][1] * bf4hi(gw);
                    if (MODE == 1) { const u32x4 pw = *(const u32x4*)(merged + r * 2048 + c); v0 = v0 + bf4lo(pw); v1 = v1 + bf4hi(pw); }
                    u32x4 w; w.x = cvt_pk_bf16(v0[0], v0[1]); w.y = cvt_pk_bf16(v0[2], v0[3]); w.z = cvt_pk_bf16(v1[0], v1[1]); w.w = cvt_pk_bf16(v1[2], v1[3]);
                    *(u32x4*)(merged + r * 2048 + c) = w; } }
    }
};

struct EpiResBf16 {
    static constexpr bool PERM = true, AFTER_DRAIN = false;
    bf16_t* C; const float* x; float alpha;
    __device__ __forceinline__ void operator()(const f32x4 (&acc)[2][2][4][2], const Unit& u, int wr, int wc, int fr, int fq) const {
        const int row0 = u.pm * BM + wr * 64 + fr, col0 = u.pn * BM + wc * 32 + 8 * fq;
#pragma unroll
        for (int ai = 0; ai < 2; ++ai)
#pragma unroll
            for (int m = 0; m < 4; ++m) { const size_t off = (size_t)(row0 + ai * HALF + m * 16) * 2048 + col0;
#pragma unroll
                for (int bj = 0; bj < 2; ++bj) { const f32x4 x0 = *(const f32x4*)(x + off + bj * HALF), x1 = *(const f32x4*)(x + off + bj * HALF + 4);
                    const f32x4 v0 = x0 * alpha + acc[ai][bj][m][0], v1 = x1 * alpha + acc[ai][bj][m][1];
                    u32x4 w; w.x = cvt_pk_bf16(v0[0], v0[1]); w.y = cvt_pk_bf16(v0[2], v0[3]); w.z = cvt_pk_bf16(v1[0], v1[1]); w.w = cvt_pk_bf16(v1[2], v1[3]);
                    *(u32x4*)(C + off + bj * HALF) = w; } }
    }
};

struct EpiGateUp {
    static constexpr bool PERM = true, AFTER_DRAIN = false;
    bf16_t* H;
    __device__ __forceinline__ void operator()(const f32x4 (&acc)[2][2][4][2], const Unit& u, int wr, int wc, int fr, int fq) const {
        const int row0 = u.pm * BM + wr * 64 + fr, hc0 = u.pn * 128 + wc * 16 + 4 * fq;
#pragma unroll
        for (int ai = 0; ai < 2; ++ai)
#pragma unroll
            for (int m = 0; m < 4; ++m) { bf16_t* rowp = H + (size_t)(row0 + ai * HALF + m * 16) * 1024 + hc0;
#pragma unroll
                for (int bj = 0; bj < 2; ++bj) { const f32x4 g = acc[ai][bj][m][0], up = acc[ai][bj][m][1];
                    f32x4 h;
#pragma unroll
                    for (int j = 0; j < 4; ++j) h[j] = g[j] * sigm(g[j]) * up[j];
                    u32x2 w; w.x = cvt_pk_bf16(h[0], h[1]); w.y = cvt_pk_bf16(h[2], h[3]);
                    *(u32x2*)(rowp + bj * 64) = w; } }
    }
};

struct EpiStoreBf16 {
    static constexpr bool PERM = true, AFTER_DRAIN = false;
    bf16_t* O; int ldc; float one;
    __device__ __forceinline__ void operator()(const f32x4 (&acc)[2][2][4][2], const Unit& u, int wr, int wc, int fr, int fq) const {
        const int row0 = u.pm * BM + wr * 64 + fr, col0 = u.pn * BM + wc * 32 + 8 * fq;
#pragma unroll
        for (int ai = 0; ai < 2; ++ai)
#pragma unroll
            for (int m = 0; m < 4; ++m) { bf16_t* rowp = O + (size_t)(row0 + ai * HALF + m * 16) * ldc + col0;
#pragma unroll
                for (int bj = 0; bj < 2; ++bj) { const f32x4 v0 = acc[ai][bj][m][0] * one, v1 = acc[ai][bj][m][1] * one;
                    u32x4 w; w.x = cvt_pk_bf16(v0[0], v0[1]); w.y = cvt_pk_bf16(v0[2], v0[3]); w.z = cvt_pk_bf16(v1[0], v1[1]); w.w = cvt_pk_bf16(v1[2], v1[3]);
                    *(u32x4*)(rowp + bj * HALF) = w; } }
    }
};

template <bool GATH> struct GroupedOrder {
    static constexpr bool GATHER = GATH;
    int nM, nN, nwg, G, c; const PG8_LAS unsigned* tile_e; const PG8_LAS unsigned* tokoff;
    __device__ __forceinline__ void init(int nT, int nN_, int G_, int c_, const PG8_LAS unsigned* te, const PG8_LAS unsigned* to) { nM = nT; nN = nN_; nwg = nM * nN; G = G_; c = c_; tile_e = te; tokoff = to; }
    __device__ __forceinline__ bool next(int i, Unit& u) const {
        const long L = (long)i * G + c; if (L >= nwg) return false;
        int wgid = (int)L; { const int q = nwg / NXCD, r = nwg % NXCD, xcd = wgid % NXCD, off = wgid / NXCD; wgid = (xcd < r ? xcd * (q + 1) : r * (q + 1) + (xcd - r) * q) + off; }
        const int nig = WGM * nN, gid = wgid / nig, fm = gid * WGM, gsz = (nM - fm) < WGM ? (nM - fm) : WGM;
        u.pm = fm + ((wgid % nig) % gsz); u.pn = (wgid % nig) / gsz; u.pb = (int)tile_e[u.pm] * nN + u.pn; return true;
    }
    __device__ __forceinline__ unsigned row_off(int ui, int r) const { return tokoff[ui * 256 + r]; }
    __device__ __forceinline__ void a_ready(const Unit&) const {}
    __device__ __forceinline__ void done(const Unit&) const {}
};

template <class Epi, class Sched, bool ALIGN_EPI = false, bool SP2 = false>
__device__ __forceinline__ void gemm_phase(PG8_LAS unsigned char* lds, const Gemm g, const Sched& S, const Epi& E) {
    int tid_ = threadIdx.x; asm volatile("" : "+v"(tid_));
    const int tid = tid_, wid = __builtin_amdgcn_readfirstlane(tid >> 6), lane = tid & 63, wr = wid >> 2, wc = wid & 3, fr = lane & 15, fq = lane >> 4;
    const int K = g.K, nt = K / BK;
    constexpr bool GATHER = Sched::GATHER;
    unsigned voffA[2], voffB[2], cAoff[2]; int rA[2];
#pragma unroll
    for (int i = 0; i < 2; ++i) { int R, C; stage_rc(tid * 16 + i * 8192, R, C); const int Rb = Epi::PERM ? ((R & ~31) + perm32(R & 31)) : R;
        voffA[i] = (unsigned)(R * K + C) * 2u; voffB[i] = (unsigned)(Rb * K + C) * 2u; cAoff[i] = (unsigned)C * 2u; rA[i] = R; }
    const size_t kstep = (size_t)(BK * 2);
    const size_t hstep = (size_t)HALF * K * 2;
    const size_t tstep = 2 * hstep;
    const unsigned ldsw = (unsigned)wid * 1024u;
    const int aoff = lds_byte(wr * 64 + fr, fq * 8), boff = lds_byte(wc * 32 + fr, fq * 8);
#define PG8_SA(b, h) (((b) * 2 + (h)) * HTB)
#define PG8_SB(b, h) ((4 + (b) * 2 + (h)) * HTB)
#define PG8_STAGE(bufoff, gbase, voff) do { _Pragma("unroll") for (int _i = 0; _i < 2; ++_i) \
        __builtin_amdgcn_global_load_lds((const unsigned*)((const char*)(gbase) + (voff)[_i]), (PG8_LAS unsigned*)(lds + (bufoff) + ldsw + _i * 8192), 16, 0, 0); } while (0)
#define PG8_STAGE_A(bufoff, gbase, h, nx) do { _Pragma("unroll") for (int _i = 0; _i < 2; ++_i) { const unsigned vo_ = GATHER ? ((nx) ? vAn[h][_i] : vAc[h][_i]) : voffA[_i]; \
        __builtin_amdgcn_global_load_lds((const unsigned*)((const char*)(gbase) + vo_), (PG8_LAS unsigned*)(lds + (bufoff) + ldsw + _i * 8192), 16, 0, 0); } } while (0)
#define PG8_LDA(dst, b, h) do { _Pragma("unroll") for (int m = 0; m < 4; ++m) _Pragma("unroll") for (int k = 0; k < 2; ++k) dst[m][k] = *(const PG8_LAS bf16x8*)(lds + PG8_SA(b, h) + aoff + m * 2048 + k * 1024); } while (0)
#define PG8_LDB(dst, b, h) do { _Pragma("unroll") for (int n = 0; n < 2; ++n) _Pragma("unroll") for (int k = 0; k < 2; ++k) dst[n][k] = *(const PG8_LAS bf16x8*)(lds + PG8_SB(b, h) + boff + n * 2048 + k * 1024); } while (0)
#define PG8_MMA(ai, bj, At, Bt) do { __builtin_amdgcn_s_setprio(1); _Pragma("unroll") for (int m = 0; m < 4; ++m) _Pragma("unroll") for (int n = 0; n < 2; ++n) _Pragma("unroll") for (int k = 0; k < 2; ++k) \
        acc[ai][bj][m][n] = __builtin_amdgcn_mfma_f32_16x16x32_bf16(Bt[n][k], At[m][k], acc[ai][bj][m][n], 0, 0, 0); __builtin_amdgcn_s_setprio(0); } while (0)
#define PG8_WAIT_V(n) asm volatile("s_waitcnt vmcnt(" #n ")" ::: "memory")
#define PG8_WAIT_L(n) asm volatile("s_waitcnt lgkmcnt(" #n ")" ::: "memory")
#define PG8_BAR __builtin_amdgcn_s_barrier()
#define PG8_SCHED __builtin_amdgcn_sched_barrier(0)
    Unit cur, nxt; int ui = 0;
    if (!S.next(0, cur)) return;
    f32x4 acc[2][2][4][2];
#pragma unroll
    for (int a = 0; a < 2; ++a)
#pragma unroll
        for (int b = 0; b < 2; ++b)
#pragma unroll
            for (int m = 0; m < 4; ++m)
#pragma unroll
                for (int n = 0; n < 2; ++n) acc[a][b][m][n] = (f32x4){0.f, 0.f, 0.f, 0.f};
    bf16x8 At[4][2], B0[2][2], B1[2][2];
    const size_t hstepA = GATHER ? 0 : hstep;
    unsigned vAc[2][2], vAn[2][2];
#pragma unroll
    for (int h = 0; h < 2; ++h)
#pragma unroll
        for (int i = 0; i < 2; ++i) { vAc[h][i] = GATHER ? S.row_off(0, h * HALF + rA[i]) + cAoff[i] : 0u; vAn[h][i] = vAc[h][i]; }
    const char* cA = (const char*)g.A + (GATHER ? (size_t)0 : (size_t)cur.pm * tstep); const char* cB = (const char*)g.Bt + (size_t)cur.pb * tstep;
    S.a_ready(cur);
    if constexpr (SP2) {
        PG8_STAGE(PG8_SB(0, 0), cB, voffB); PG8_STAGE(PG8_SB(0, 1), cB + hstep, voffB); PG8_STAGE_A(PG8_SA(0, 0), cA, 0, false); PG8_STAGE_A(PG8_SA(0, 1), cA + hstepA, 1, false);
        if (wr == 1) PG8_BAR;
        PG8_WAIT_V(2); PG8_BAR;
        PG8_STAGE(PG8_SB(1, 0), cB + kstep, voffB); PG8_STAGE_A(PG8_SA(1, 0), cA + kstep, 0, false); PG8_STAGE(PG8_SB(1, 1), cB + hstep + kstep, voffB);
        PG8_WAIT_V(6); PG8_BAR;
    } else {
        PG8_STAGE(PG8_SB(0, 0), cB, voffB); PG8_STAGE_A(PG8_SA(0, 0), cA, 0, false); PG8_STAGE(PG8_SB(0, 1), cB + hstep, voffB); PG8_STAGE_A(PG8_SA(0, 1), cA + hstepA, 1, false);
        if (wr == 1) PG8_BAR;
        PG8_WAIT_V(4); PG8_BAR;
        PG8_STAGE(PG8_SB(1, 0), cB + kstep, voffB); PG8_STAGE_A(PG8_SA(1, 0), cA + kstep, 0, false); PG8_STAGE(PG8_SB(1, 1), cB + hstep + kstep, voffB);
        PG8_WAIT_V(6); PG8_BAR;
    }
    for (;;) {
        const bool has_next = S.next(ui + 1, nxt);
        const char* nA = has_next ? (const char*)g.A + (GATHER ? (size_t)0 : (size_t)nxt.pm * tstep) : cA; const char* nB = has_next ? (const char*)g.Bt + (size_t)nxt.pb * tstep : cB;
        if (GATHER) {
#pragma unroll
            for (int h = 0; h < 2; ++h)
#pragma unroll
                for (int i = 0; i < 2; ++i) vAn[h][i] = has_next ? S.row_off(ui + 1, h * HALF + rA[i]) + cAoff[i] : vAc[h][i]; }
        for (int t = 0; t < nt; t += 2) {
            const bool last = (t == nt - 2);
            const char* a1 = cA + (size_t)(t + 1) * kstep;
            const char* a2 = last ? nA : cA + (size_t)(t + 2) * kstep; const char* b2 = last ? nB : cB + (size_t)(t + 2) * kstep;
            const char* a3 = a2 + kstep; const char* b3 = b2 + kstep;
            if (last && has_next) S.a_ready(nxt);
            if constexpr (SP2) {
            PG8_LDB(B0, 0, 0); PG8_LDB(B1, 0, 1); PG8_SCHED; PG8_LDA(At, 0, 0); PG8_STAGE_A(PG8_SA(1, 1), a1 + hstepA, 1, false);
            PG8_WAIT_V(8); PG8_WAIT_L(0); PG8_BAR; PG8_MMA(0, 0, At, B0); PG8_MMA(0, 1, At, B1); PG8_BAR; PG8_SCHED;
            PG8_LDA(At, 0, 1); PG8_STAGE(PG8_SB(0, 0), b2, voffB); PG8_STAGE(PG8_SB(0, 1), b2 + hstep, voffB); PG8_STAGE_A(PG8_SA(0, 0), a2, 0, last);
            PG8_WAIT_V(8); PG8_WAIT_L(0); PG8_BAR; PG8_MMA(1, 0, At, B0); PG8_MMA(1, 1, At, B1); PG8_BAR; PG8_SCHED;
            PG8_LDB(B0, 1, 0); PG8_LDB(B1, 1, 1); PG8_SCHED; PG8_LDA(At, 1, 0); PG8_STAGE_A(PG8_SA(0, 1), a2 + hstepA, 1, last);
            PG8_WAIT_V(8); PG8_WAIT_L(0); PG8_BAR; PG8_MMA(0, 0, At, B0); PG8_MMA(0, 1, At, B1); PG8_BAR; PG8_SCHED;
            PG8_LDA(At, 1, 1); PG8_STAGE(PG8_SB(1, 0), b3, voffB); PG8_STAGE(PG8_SB(1, 1), b3 + hstep, voffB); PG8_STAGE_A(PG8_SA(1, 0), a3, 0, last);
            PG8_WAIT_V(8); PG8_WAIT_L(0); PG8_BAR; PG8_MMA(1, 0, At, B0); PG8_MMA(1, 1, At, B1); PG8_BAR; PG8_SCHED;
            } else {
            PG8_LDB(B0, 0, 0); PG8_SCHED; PG8_LDA(At, 0, 0); PG8_STAGE_A(PG8_SA(1, 1), a1 + hstepA, 1, false);
            PG8_WAIT_L(8); PG8_BAR; PG8_WAIT_L(0); PG8_MMA(0, 0, At, B0); PG8_BAR; PG8_SCHED;
            PG8_LDB(B1, 0, 1); PG8_STAGE(PG8_SB(0, 0), b2, voffB);
            PG8_BAR; PG8_WAIT_L(0); PG8_MMA(0, 1, At, B1); PG8_BAR;
            PG8_LDA(At, 0, 1); PG8_STAGE_A(PG8_SA(0, 0), a2, 0, last);
            PG8_BAR; PG8_WAIT_L(0); PG8_MMA(1, 0, At, B0); PG8_BAR; PG8_SCHED;
            PG8_STAGE(PG8_SB(0, 1), b2 + hstep, voffB);
            PG8_WAIT_V(6); PG8_BAR; PG8_MMA(1, 1, At, B1); PG8_BAR;
            PG8_LDB(B0, 1, 0); PG8_SCHED; PG8_LDA(At, 1, 0); PG8_STAGE_A(PG8_SA(0, 1), a2 + hstepA, 1, last);
            PG8_WAIT_L(8); PG8_BAR; PG8_WAIT_L(0); PG8_MMA(0, 0, At, B0); PG8_BAR; PG8_SCHED;
            PG8_LDB(B1, 1, 1); PG8_STAGE(PG8_SB(1, 0), b3, voffB);
            PG8_BAR; PG8_WAIT_L(0); PG8_MMA(0, 1, At, B1); PG8_BAR;
            PG8_LDA(At, 1, 1); PG8_STAGE_A(PG8_SA(1, 0), a3, 0, last);
            PG8_BAR; PG8_WAIT_L(0); PG8_MMA(1, 0, At, B0); PG8_BAR; PG8_SCHED;
            PG8_STAGE(PG8_SB(1, 1), b3 + hstep, voffB);
            PG8_WAIT_V(6); PG8_BAR; PG8_MMA(1, 1, At, B1); PG8_BAR;
            }
        }
        if constexpr (ALIGN_EPI) { if (wr == 0) PG8_BAR; }
        if constexpr (!Epi::AFTER_DRAIN) { E(acc, cur, wr, wc, fr, fq); S.done(cur); }
        if (!has_next) break;
#pragma unroll
        for (int a = 0; a < 2; ++a)
#pragma unroll
            for (int b = 0; b < 2; ++b)
#pragma unroll
                for (int m = 0; m < 4; ++m)
#pragma unroll
                    for (int n = 0; n < 2; ++n) acc[a][b][m][n] = (f32x4){0.f, 0.f, 0.f, 0.f};
        cur = nxt; cA = nA; cB = nB; ++ui;
#pragma unroll
        for (int h = 0; h < 2; ++h)
#pragma unroll
            for (int i = 0; i < 2; ++i) vAc[h][i] = vAn[h][i];
        if constexpr (ALIGN_EPI) { if (wr == 1) PG8_BAR; }
    }
    PG8_WAIT_V(0);
    if constexpr (!ALIGN_EPI) { if (wr == 0) PG8_BAR; }
    PG8_BAR;
    if constexpr (Epi::AFTER_DRAIN) { E.fused(acc, cur, wr, wc, fr, fq, lds, wid, lane); S.done(cur); }
#undef PG8_SA
#undef PG8_SB
#undef PG8_STAGE
#undef PG8_STAGE_A
#undef PG8_LDA
#undef PG8_LDB
#undef PG8_MMA
#undef PG8_WAIT_V
#undef PG8_WAIT_L
#undef PG8_BAR
#undef PG8_SCHED
}
}
#define XB_TMO      128
#define XB_XCNT(j)  (256  + 64 * (j))
#define XB_XSUB(j)  (1280 + 64 * (j))
#define XB_XGEN(j)  (2304 + 64 * (j))
#define XB_TOP      3328
#define XB_TOPGEN   3392
#define XCD_BAR_WORDS 3456
#define XB_SPIN_CAP (1u << 18)

__device__ __forceinline__ unsigned xb_ld(unsigned* p)              { return __hip_atomic_load(p, __ATOMIC_RELAXED, __HIP_MEMORY_SCOPE_AGENT); }
__device__ __forceinline__ unsigned xb_add(unsigned* p, unsigned v) { return __hip_atomic_fetch_add(p, v, __ATOMIC_RELAXED, __HIP_MEMORY_SCOPE_AGENT); }
__device__ __forceinline__ unsigned xb_xcc_id() { return (unsigned)__builtin_amdgcn_s_getreg((3 << 11) | 20) & 0xFu; }
#define XB_SPIN(cond, bar) do { unsigned _sp = 0; while (cond) { __builtin_amdgcn_s_sleep(1); \
    if ((++_sp & 255u) == 0u) { if (xb_ld(&(bar)[XB_TMO])) break; if (_sp > XB_SPIN_CAP) { atomicAdd(&(bar)[XB_TMO], 1u); break; } } } } while (0)

struct XcdBarrier {
    unsigned* bar; unsigned x;
    volatile LAS unsigned* st;
};

__device__ __forceinline__ XcdBarrier xcd_barrier_post(unsigned* bar, volatile LAS unsigned* st) {
    XcdBarrier b; b.bar = bar; b.x = xb_xcc_id(); b.st = st;
    if (threadIdx.x == 0) (void)xb_add(&bar[XB_XCNT(b.x)], 1u);
    return b;
}
__device__ __forceinline__ void xcd_barrier_complete(unsigned* bar, unsigned x, unsigned& nloc, unsigned& nx) {
    const unsigned G = gridDim.x * gridDim.y * gridDim.z;
    unsigned sum, cnt, mine, sp = 0u;
    for (;;) {
        sum = 0u; cnt = 0u; mine = 0u;
#pragma unroll
        for (unsigned j = 0; j < 16; ++j) { const unsigned c = xb_ld(&bar[XB_XCNT(j)]); sum += c; cnt += (c > 0u) ? 1u : 0u; mine = (j == x) ? c : mine; }
        if (sum == G) break;
        __builtin_amdgcn_s_sleep(1);
        if ((++sp & 255u) == 0u) { if (xb_ld(&bar[XB_TMO])) break; if (sp > XB_SPIN_CAP) { atomicAdd(&bar[XB_TMO], 1u); break; } }
    }
    nloc = mine > 0u ? mine : 1u; nx = cnt > 0u ? cnt : 1u;
}

__device__ __forceinline__ void xcd_barrier(const XcdBarrier& b) {
    asm volatile("s_waitcnt vmcnt(0)" ::: "memory");
    __syncthreads();
    if (threadIdx.x == 0) {
        unsigned* bar = b.bar;
        __builtin_amdgcn_s_waitcnt(0);
        unsigned nloc = b.st[0], nx = b.st[1];
        if (nloc == 0u) { xcd_barrier_complete(bar, b.x, nloc, nx); b.st[0] = nloc; b.st[1] = nx; }
        const unsigned old = xb_add(&bar[XB_XSUB(b.x)], 1u);
        const unsigned gen = old / nloc;
        if (old + 1u == (gen + 1u) * nloc) {
            __builtin_amdgcn_fence(__ATOMIC_RELEASE, "agent");
            asm volatile("s_waitcnt vmcnt(0)" ::: "memory");
            const unsigned og = xb_add(&bar[XB_TOP], 1u);
            const unsigned tg = og / nx;
            if (og + 1u == (tg + 1u) * nx) xb_add(&bar[XB_TOPGEN], 1u);
            else XB_SPIN(xb_ld(&bar[XB_TOPGEN]) == tg, bar);
            __builtin_amdgcn_fence(__ATOMIC_ACQUIRE, "agent");
            xb_add(&bar[XB_XGEN(b.x)], 1u);
            asm volatile("s_waitcnt vmcnt(0)" ::: "memory");
        } else {
            XB_SPIN(xb_ld(&bar[XB_XGEN(b.x)]) == gen, bar);
            __builtin_amdgcn_fence(__ATOMIC_ACQUIRE, "agent");
            asm volatile("s_waitcnt vmcnt(0)" ::: "memory");
        }
    }
    __syncthreads();
}

struct Args { const float* in[19]; float* out; unsigned char* ws; int ph_lo, ph_hi; };
enum { I_X = 0, I_WIN, I_BIN, I_LB, I_HGNG, I_WA, I_WB, I_WOUT, I_LN1G, I_LN1B, I_WGRP, I_BGRP, I_WRT, I_BRT, I_WGATE, I_WUP, I_WDOWN, I_LN2G, I_LN2B };

__device__ __forceinline__ void transpose_item(const float* src4, size_t ldw, bf16_t* WT, size_t K, int dest_row0, int k0, LAS float* scr, int lane) {
    f32x4 v[8];
#pragma unroll
    for (int i = 0; i < 8; ++i) v[i] = src4 ? __builtin_nontemporal_load((const f32x4*)(src4 + (size_t)(8 * i) * ldw)) : (f32x4){0.f, 0.f, 0.f, 0.f};
#pragma unroll
    for (int i = 0; i < 8; ++i) { const int k = 8 * i + (lane >> 3), n4 = (lane & 7) * 4;
        scr[k * 33 + n4 + 0] = v[i][0]; scr[k * 33 + n4 + 1] = v[i][1]; scr[k * 33 + n4 + 2] = v[i][2]; scr[k * 33 + n4 + 3] = v[i][3]; }
    LDS_WAIT(); asm volatile("" ::: "memory");
    const int c = lane & 7;
#pragma unroll
    for (int j = 0; j < 4; ++j) { const int n = (lane >> 3) + 8 * j; const LAS float* s = scr + (8 * c) * 33 + n;
        u32x4 o; o.x = cvt_pk(s[0 * 33], s[1 * 33]); o.y = cvt_pk(s[2 * 33], s[3 * 33]); o.z = cvt_pk(s[4 * 33], s[5 * 33]); o.w = cvt_pk(s[6 * 33], s[7 * 33]);
        *(u32x4*)(WT + (size_t)(dest_row0 + n) * K + k0 + 8 * c) = o; }
    LDS_WAIT(); asm volatile("" ::: "memory");
}

__device__ __forceinline__ void phase_prologue(const Args& a, LAS unsigned char* lds, int tid, int G) {
    const int lane = tid & 63, wave = tid >> 6;
    unsigned char* ws = a.ws;
    { const float* x = a.in[I_X]; bf16_t* xb = (bf16_t*)(ws + WS_XB); const size_t n8 = (size_t)MT * DM / 8;
      for (size_t i = (size_t)blockIdx.x * NTHR + tid; i < n8; i += (size_t)G * NTHR) {
          const f32x4 p = __builtin_nontemporal_load((const f32x4*)(x + i * 8)), q = __builtin_nontemporal_load((const f32x4*)(x + i * 8 + 4));
          u32x4 o; o.x = cvt_pk(p[0], p[1]); o.y = cvt_pk(p[2], p[3]); o.z = cvt_pk(q[0], q[1]); o.w = cvt_pk(q[2], q[3]);
          *(u32x4*)(xb + i * 8) = o; } }
    LAS float* scr = (LAS float*)(lds + wave * 8704);
    const int gw = blockIdx.x * NWAVES + wave, NGW = G * NWAVES;
    constexpr int IT_IN = (NPROJ_PAD / 32) * (DM / 64);
    constexpr int IT_A = (DM / 32) * (1024 / 64);
    constexpr int IT_OUT = (DM / 32) * (DM / 64);
    constexpr int NIT = IT_IN + 2 * IT_A + IT_OUT;
    for (int it = gw; it < NIT; it += NGW) {
        int r = it;
        if (r < IT_IN) { const int kb = r / (NPROJ_PAD / 32), rb = r % (NPROJ_PAD / 32); const int n = rb * 32 + (lane & 7) * 4;
            int src = -1; if (n < 7752) src = n; else if (n >= 7936) src = n - 184;
            const float* p = (src >= 0) ? a.in[I_WIN] + (size_t)(kb * 64 + (lane >> 3)) * NPROJ + src : nullptr;
            transpose_item(p, NPROJ, (bf16_t*)(ws + WS_WIN), DM, rb * 32, kb * 64, scr, lane); continue; }
        r -= IT_IN;
        if (r < 2 * IT_A) { const int which = r / IT_A; r %= IT_A; const int kb = r / 64, rb = r % 64; const int n = rb * 32 + (lane & 7) * 4;
            const float* p = a.in[which ? I_WB : I_WA] + (size_t)(kb * 64 + (lane >> 3)) * DM + n;
            transpose_item(p, DM, (bf16_t*)(ws + (which ? WS_WB : WS_WA)), 1024, rb * 32, kb * 64, scr, lane); continue; }
        r -= 2 * IT_A;
        { const int kb = r / 64, rb = r % 64; const int n = rb * 32 + (lane & 7) * 4;
          const float* p = a.in[I_WOUT] + (size_t)(kb * 64 + (lane >> 3)) * DM + n;
          transpose_item(p, DM, (bf16_t*)(ws + WS_WOUT), DM, rb * 32, kb * 64, scr, lane); }
    }
}

constexpr int EW_GU = 64 * 32, EW_D = 64 * 16, EW_E = EW_GU + EW_D;
__device__ __forceinline__ const float* ew_src(const Args& a, int it, int lane, size_t& ldw) {
    const int e = it / EW_E; int r = it % EW_E;
    if (r < EW_GU) { const int kb = r / 64, rb = r % 64; const int n = rb * 32 + (lane & 7) * 4; const int j = n >> 3, up = (n >> 2) & 1; ldw = DFF;
        return a.in[up ? I_WUP : I_WGATE] + (size_t)e * DM * DFF + (size_t)(kb * 64 + (lane >> 3)) * DFF + 4 * j; }
    r -= EW_GU; const int kb = r / 64, rb = r % 64; const int n = rb * 32 + (lane & 7) * 4; ldw = DM;
    return a.in[I_WDOWN] + (size_t)e * DFF * DM + (size_t)(kb * 64 + (lane >> 3)) * DM + n;
}
__device__ __forceinline__ void ew_store(const Args& a, int it, const f32x4 (&v)[8], LAS float* scr, int lane) {
    const int e = it / EW_E; int r = it % EW_E; bf16_t* WT; size_t K; int rb, kb;
    if (r < EW_GU) { kb = r / 64; rb = r % 64; WT = (bf16_t*)(a.ws + WS_WGU) + (size_t)e * 2048 * 2048; K = 2048; }
    else { r -= EW_GU; kb = r / 64; rb = r % 64; WT = (bf16_t*)(a.ws + WS_WD) + (size_t)e * 2048 * 1024; K = 1024; }
#pragma unroll
    for (int i = 0; i < 8; ++i) { const int k = 8 * i + (lane >> 3), n4 = (lane & 7) * 4;
        scr[k * 33 + n4 + 0] = v[i][0]; scr[k * 33 + n4 + 1] = v[i][1]; scr[k * 33 + n4 + 2] = v[i][2]; scr[k * 33 + n4 + 3] = v[i][3]; }
    LDS_WAIT(); asm volatile("" ::: "memory");
    const int c = lane & 7;
#pragma unroll
    for (int j = 0; j < 4; ++j) { const int n = (lane >> 3) + 8 * j; const LAS float* s = scr + (8 * c) * 33 + n;
        u32x4 o; o.x = cvt_pk(s[0 * 33], s[1 * 33]); o.y = cvt_pk(s[2 * 33], s[3 * 33]); o.z = cvt_pk(s[4 * 33], s[5 * 33]); o.w = cvt_pk(s[6 * 33], s[7 * 33]);
        *(u32x4*)(WT + (size_t)(rb * 32 + n) * K + kb * 64 + 8 * c) = o; }
    LDS_WAIT(); asm volatile("" ::: "memory");
}
__device__ __forceinline__ void phase_expert_weights(const Args& a, LAS unsigned char* lds, int tid, int G) {
    const int lane = tid & 63, wave = tid >> 6;
    LAS float* scr = (LAS float*)(lds + wave * 8704);
    const int gw = blockIdx.x * NWAVES + wave, NGW = G * NWAVES, NIT = NEXP * EW_E;
    int it = gw; if (it >= NIT) return;
    f32x4 v[8]; { size_t ldw; const float* p = ew_src(a, it, lane, ldw);
#pragma unroll
        for (int i = 0; i < 8; ++i) v[i] = *(const f32x4*)(p + (size_t)(8 * i) * ldw); }
    for (;;) {
        const int nx = it + NGW; const bool has = nx < NIT;
        f32x4 vn[8];
        if (has) { size_t ldw; const float* p = ew_src(a, nx, lane, ldw);
#pragma unroll
            for (int i = 0; i < 8; ++i) vn[i] = *(const f32x4*)(p + (size_t)(8 * i) * ldw); }
        ew_store(a, it, v, scr, lane);
        if (!has) break;
#pragma unroll
        for (int i = 0; i < 8; ++i) v[i] = vn[i];
        it = nx;
    }
}

constexpr int HG_QD = 0, HG_KD = 17408, HG_P = 34816, HG_VT = 44032, HG_SEG = 62464, HG_RED = 64512;
constexpr int HG_LBT = 66560;
constexpr int HG_NGT = 70656;
constexpr int HG_ST = 74752, HG_STLD = 136;
constexpr int HG_LD128 = 136, HG_LD64 = 72;

struct HgPrep { float cum[16]; float kh[16]; float tot; };
__device__ __forceinline__ void hg_fill_lb(const Args& a, LAS unsigned char* lds, int tid) {
    for (int i = tid; i < 1024; i += NTHR) { const float l0 = a.in[I_LB][i], l1 = a.in[I_LB][1024 + i]; *(LAS float*)(lds + HG_LBT + i * 4) = 1.0f / (1.0f + __expf(l1 - l0)); *(LAS float*)(lds + HG_NGT + i * 4) = a.in[I_HGNG][i]; }
    __syncthreads();
}
__device__ __forceinline__ void hg_prep(HgPrep& P, const float (&z)[16], float lb, int d, int seg, LAS unsigned char* lds) {
    float run = 0.f;
#pragma unroll
    for (int j = 0; j < 16; ++j) { const float sg = sigmoidf_(z[j]); const float f = lb + (1.0f - lb) * sg; run += __logf(f); P.cum[j] = run; P.kh[j] = (1.0f - lb) * (1.0f - sg); }
    LAS float* segs = (LAS float*)(lds + HG_SEG);
    segs[seg * 128 + d] = run;
    __syncthreads();
    float off = 0.f, tot = 0.f;
#pragma unroll
    for (int s = 0; s < 4; ++s) { const float v = segs[s * 128 + d]; tot += v; if (s < seg) off += v; }
#pragma unroll
    for (int j = 0; j < 16; ++j) P.cum[j] += off;
    P.tot = tot;
}
__device__ __forceinline__ void hg_write_vt(const unsigned (&vv)[16], int d, int seg, LAS unsigned char* lds) {
    u32x4 w0, w1;
    w0.x = vv[0] | (vv[1] << 16); w0.y = vv[2] | (vv[3] << 16); w0.z = vv[4] | (vv[5] << 16); w0.w = vv[6] | (vv[7] << 16);
    w1.x = vv[8] | (vv[9] << 16); w1.y = vv[10] | (vv[11] << 16); w1.z = vv[12] | (vv[13] << 16); w1.w = vv[14] | (vv[15] << 16);
    LAS unsigned char* p = lds + HG_VT + d * (HG_LD64 * 2) + seg * 32;
    *(LAS u32x4*)p = w0; *(LAS u32x4*)(p + 16) = w1;
}

__device__ __forceinline__ void hgrn1_unit(const Args& a, int unit, LAS unsigned char* lds, int tid) {
    unsigned char* ws = a.ws;
    const int lane = tid & 63, wave = tid >> 6, d = tid & 127, seg = tid >> 7;
    const int b = unit >> 10, h = (unit >> 7) & 7, n = unit & 127, tok0 = b * SEQ + n * 64;
    float z[16]; unsigned vv[16];
    { const float* AF = (const float*)(ws + WS_AF); const bf16_t* AI = (const bf16_t*)(ws + WS_AI);
#pragma unroll
      for (int j = 0; j < 16; ++j) z[j] = AF[(size_t)(tok0 + seg * 16 + j) * 1024 + h * 128 + d];
#pragma unroll
      for (int j = 0; j < 16; ++j) vv[j] = AI[(size_t)(tok0 + seg * 16 + j) * 1024 + h * 128 + d]; }
    const float lbv = *(const LAS float*)(lds + HG_LBT + (h * 128 + d) * 4);
    HgPrep P;
    hg_prep(P, z, lbv, d, seg, lds);
    { unsigned pk[8];
#pragma unroll
      for (int j = 0; j < 8; ++j) pk[j] = cvt_pk(P.kh[2 * j] * __expf(P.tot - P.cum[2 * j]), P.kh[2 * j + 1] * __expf(P.tot - P.cum[2 * j + 1]));
      LAS unsigned char* p = lds + HG_KD + d * (HG_LD64 * 2) + seg * 32;
      *(LAS u32x4*)p = (u32x4){pk[0], pk[1], pk[2], pk[3]}; *(LAS u32x4*)(p + 16) = (u32x4){pk[4], pk[5], pk[6], pk[7]}; }
    if (seg == 0) ((float*)(ws + WS_DECAY))[(size_t)unit * 128 + d] = __expf(P.tot);
    hg_write_vt(vv, d, seg, lds);
    __syncthreads();
    const int fr = lane & 15, fq = lane >> 4;
    bf16x8 af[2];
#pragma unroll
    for (int ks = 0; ks < 2; ++ks) af[ks] = *(const LAS bf16x8*)(lds + HG_KD + (16 * wave + fr) * (HG_LD64 * 2) + (32 * ks + 8 * fq) * 2);
    float* kvo = (float*)(ws + WS_KV) + (size_t)unit * 16384;
#pragma unroll
    for (int vb = 0; vb < 8; ++vb) {
        f32x4 acc = {0.f, 0.f, 0.f, 0.f};
#pragma unroll
        for (int ks = 0; ks < 2; ++ks) { const bf16x8 bfr = *(const LAS bf16x8*)(lds + HG_VT + (16 * vb + fr) * (HG_LD64 * 2) + (32 * ks + 8 * fq) * 2);
            acc = __builtin_amdgcn_mfma_f32_16x16x32_bf16(af[ks], bfr, acc, 0, 0, 0); }
        *(f32x4*)(kvo + (size_t)(16 * vb + fr) * 128 + 16 * wave + 4 * fq) = acc;
    }
    __syncthreads();
}

__device__ __forceinline__ void hgrn_scan(const Args& a, int tid, int G) {
    unsigned char* ws = a.ws;
    const float* KV = (const float*)(ws + WS_KV); const float* DEC = (const float*)(ws + WS_DECAY); unsigned* ST = (unsigned*)(ws + WS_ST);
    for (int g = blockIdx.x * NTHR + tid; g < 16 * 8192; g += G * NTHR) {
        const int bh = g >> 13, rem = g & 8191, v = rem >> 6, d2 = (rem & 63) * 2;
        float s0 = 0.f, s1 = 0.f;
        for (int n0 = 0; n0 < 128; n0 += 8) {
            f32x2 kv[8], dc[8];
#pragma unroll
            for (int j = 0; j < 8; ++j) { const size_t unit = (size_t)bh * 128 + n0 + j; kv[j] = *(const f32x2*)(KV + unit * 16384 + v * 128 + d2); dc[j] = *(const f32x2*)(DEC + unit * 128 + d2); }
#pragma unroll
            for (int j = 0; j < 8; ++j) { const size_t unit = (size_t)bh * 128 + n0 + j; ST[(unit * 16384 + v * 128 + d2) >> 1] = cvt_pk(s0, s1);
                s0 = dc[j][0] * s0 + kv[j][0]; s1 = dc[j][1] * s1 + kv[j][1]; }
        }
    }
}

__device__ __forceinline__ void hg3_load(const Args& a, int unit, int tid, float (&z)[16], unsigned (&qq)[16], unsigned (&vv)[16], u32x4 (&stp)[4], u32x2 (&gwv)[4]) {
    unsigned char* ws = a.ws; const int d = tid & 127, seg = tid >> 7;
    const int b = unit >> 10, h = (unit >> 7) & 7, n = unit & 127, tok0 = b * SEQ + n * 64;
    const float* AF = (const float*)(ws + WS_AF); const bf16_t* AI = (const bf16_t*)(ws + WS_AI); const bf16_t* AQ = (const bf16_t*)(ws + WS_AQ);
#pragma unroll
    for (int j = 0; j < 16; ++j) z[j] = AF[(size_t)(tok0 + seg * 16 + j) * 1024 + h * 128 + d];
#pragma unroll
    for (int j = 0; j < 16; ++j) qq[j] = AQ[(size_t)(tok0 + seg * 16 + j) * 1024 + h * 128 + d];
#pragma unroll
    for (int j = 0; j < 16; ++j) vv[j] = AI[(size_t)(tok0 + seg * 16 + j) * 1024 + h * 128 + d];
    { const bf16_t* ST = (const bf16_t*)(ws + WS_ST) + (size_t)unit * 16384;
#pragma unroll
      for (int i = 0; i < 4; ++i) stp[i] = *(const u32x4*)(ST + (size_t)(tid + NTHR * i) * 8); }
    { const int lane = tid & 63, wave = tid >> 6, t_ = 16 * (wave & 3) + (lane & 15); const bf16_t* AG = (const bf16_t*)(ws + WS_AG);
#pragma unroll
      for (int vi = 0; vi < 4; ++vi) gwv[vi] = *(const u32x2*)(AG + (size_t)(tok0 + t_) * 1024 + h * 128 + 16 * (4 * (wave >> 2) + vi) + 4 * (lane >> 4)); }
}
__device__ __forceinline__ void hgrn3_unit(const Args& a, int unit, int next_unit, LAS unsigned char* lds, int tid, float (&z)[16], unsigned (&qq)[16], unsigned (&vv)[16], u32x4 (&stp)[4], u32x2 (&gwn)[4]) {
    unsigned char* ws = a.ws;
    const int lane = tid & 63, wave = tid >> 6, d = tid & 127, seg = tid >> 7;
    const int b = unit >> 10, h = (unit >> 7) & 7, n = unit & 127, tok0 = b * SEQ + n * 64;
    const float lbv = *(const LAS float*)(lds + HG_LBT + (h * 128 + d) * 4);
    u32x2 gwv[4];
#pragma unroll
    for (int vi = 0; vi < 4; ++vi) gwv[vi] = gwn[vi];
#ifndef HG3_RA
#define HG3_RA 1
#define HG3_RB 1
#define HG3_RC 1
#endif
    for (int ra = 0; ra < HG3_RA; ++ra) {
    HgPrep P;
    hg_prep(P, z, lbv, d, seg, lds);
    {
#pragma unroll
      for (int j = 0; j < 16; ++j) { const float q = bf2f(qq[j]); const float qs = q * sigmoidf_(q);
          const float qd = qs * __expf(P.cum[j]), kd = P.kh[j] * __expf(-P.cum[j]);
          const int t = seg * 16 + j;
          *(LAS bf16_t*)(lds + HG_QD + (t * HG_LD128 + d) * 2) = (bf16_t)(cvt_pk(qd, 0.f) & 0xffffu);
          *(LAS bf16_t*)(lds + HG_KD + (t * HG_LD128 + d) * 2) = (bf16_t)(cvt_pk(kd, 0.f) & 0xffffu); } }
    hg_write_vt(vv, d, seg, lds);
#pragma unroll
    for (int i = 0; i < 4; ++i) { const int id = tid + NTHR * i; *(LAS u32x4*)(lds + HG_ST + (id >> 4) * (HG_STLD * 2) + (id & 15) * 16) = stp[i]; }
    __syncthreads();
    }
    if (next_unit >= 0) hg3_load(a, next_unit, tid, z, qq, vv, stp, gwn);
    const int fr = lane & 15, fq = lane >> 4;
    for (int rb = 0; rb < HG3_RB; ++rb) {
    { const int tb = wave & 3;
      bf16x8 bq[4];
#pragma unroll
      for (int ks = 0; ks < 4; ++ks) bq[ks] = *(const LAS bf16x8*)(lds + HG_QD + ((16 * tb + fr) * HG_LD128 + 32 * ks + 8 * fq) * 2);
#pragma unroll
      for (int si = 0; si < 2; ++si) { const int sb = 2 * (wave >> 2) + si;
          f32x4 acc = {0.f, 0.f, 0.f, 0.f};
#pragma unroll
          for (int ks = 0; ks < 4; ++ks) { const bf16x8 ak = *(const LAS bf16x8*)(lds + HG_KD + ((16 * sb + fr) * HG_LD128 + 32 * ks + 8 * fq) * 2);
              acc = __builtin_amdgcn_mfma_f32_16x16x32_bf16(ak, bq[ks], acc, 0, 0, 0); }
          const int t = 16 * tb + fr, s0 = 16 * sb + 4 * fq;
          float p[4];
#pragma unroll
          for (int r = 0; r < 4; ++r) p[r] = (s0 + r <= t) ? acc[r] : 0.f;
          *(LAS u32x2*)(lds + HG_P + (t * HG_LD64 + s0) * 2) = (u32x2){cvt_pk(p[0], p[1]), cvt_pk(p[2], p[3])}; } }
    __syncthreads();
    }
    for (int rc = 0; rc < HG3_RC; ++rc) {
    const int tb = wave & 3, t = 16 * tb + fr;
    f32x4 o[4];
    { bf16x8 bp[2], bq[4];
#pragma unroll
      for (int ks = 0; ks < 2; ++ks) bp[ks] = *(const LAS bf16x8*)(lds + HG_P + ((16 * tb + fr) * HG_LD64 + 32 * ks + 8 * fq) * 2);
#pragma unroll
      for (int ks = 0; ks < 4; ++ks) bq[ks] = *(const LAS bf16x8*)(lds + HG_QD + ((16 * tb + fr) * HG_LD128 + 32 * ks + 8 * fq) * 2);
#pragma unroll
      for (int vi = 0; vi < 4; ++vi) { const int vb = 4 * (wave >> 2) + vi;
          f32x4 acc = {0.f, 0.f, 0.f, 0.f};
#pragma unroll
          for (int ks = 0; ks < 2; ++ks) { const bf16x8 av = *(const LAS bf16x8*)(lds + HG_VT + ((16 * vb + fr) * HG_LD64 + 32 * ks + 8 * fq) * 2);
              acc = __builtin_amdgcn_mfma_f32_16x16x32_bf16(av, bp[ks], acc, 0, 0, 0); }
#pragma unroll
          for (int ks = 0; ks < 4; ++ks) { const bf16x8 as = *(const LAS bf16x8*)(lds + HG_ST + ((16 * vb + fr) * HG_STLD + 32 * ks + 8 * fq) * 2);
              acc = __builtin_amdgcn_mfma_f32_16x16x32_bf16(as, bq[ks], acc, 0, 0, 0); }
          o[vi] = acc; } }
    float ss = 0.f;
#pragma unroll
    for (int vi = 0; vi < 4; ++vi) ss += (o[vi][0] * o[vi][0] + o[vi][1] * o[vi][1]) + (o[vi][2] * o[vi][2] + o[vi][3] * o[vi][3]);
    ss += __shfl_xor(ss, 16); ss += __shfl_xor(ss, 32);
    LAS float* red = (LAS float*)(lds + HG_RED);
    if (fq == 0) red[(wave >> 2) * 64 + t] = ss;
    __syncthreads();
    const float tot = red[t] + red[64 + t];
    const float rinv = 1.0f / sqrtf(tot * (1.0f / 128.0f) + RMS_EPS);
    bf16_t* BRA = (bf16_t*)(ws + WS_BRA);
#pragma unroll
    for (int vi = 0; vi < 4; ++vi) { const int v0 = 16 * (4 * (wave >> 2) + vi) + 4 * fq; const size_t off = (size_t)(tok0 + t) * 1024 + h * 128 + v0;
        const u32x2 gw = gwv[vi]; const f32x4 gn = *(const LAS f32x4*)(lds + HG_NGT + (h * 128 + v0) * 4);
        const float g0 = __uint_as_float(gw.x << 16), g1 = __uint_as_float(gw.x & 0xffff0000u), g2 = __uint_as_float(gw.y << 16), g3 = __uint_as_float(gw.y & 0xffff0000u);
        const float r0 = o[vi][0] * rinv * gn[0] * (g0 * sigmoidf_(g0)), r1 = o[vi][1] * rinv * gn[1] * (g1 * sigmoidf_(g1));
        const float r2 = o[vi][2] * rinv * gn[2] * (g2 * sigmoidf_(g2)), r3 = o[vi][3] * rinv * gn[3] * (g3 * sigmoidf_(g3));
        *(u32x2*)(BRA + off) = (u32x2){cvt_pk(r0, r1), cvt_pk(r2, r3)}; }
    __syncthreads();
    }
}


constexpr int IX_S = 0, IX_H = 131072, IX_L = 147456, IX_M = 155648, IX_C = 159744;
constexpr int IX_CAP = 512;
__device__ __forceinline__ unsigned ix_sortable(unsigned u) { return (u & 0x80000000u) ? ~u : (u | 0x80000000u); }

__device__ __forceinline__ void ix_radix_fallback(LAS unsigned* S, LAS unsigned* H, unsigned* MASK, int t0, int L, int tid) {
    const int lane = tid & 63, wave = __builtin_amdgcn_readfirstlane(tid >> 6);
    for (int q = 0; q < 4; ++q) for (int i = tid; i < L; i += NTHR) S[q * 8192 + i] = ix_sortable(S[q * 8192 + i]);
    for (int i = tid; i < 2048; i += NTHR) H[i] = 0u;
    __syncthreads();
    const int qs = wave >> 1, half = wave & 1;
    unsigned prefix = 0u; int kth = 256;
    for (int p = 0; p < 4; ++p) {
        const int shift = 24 - 8 * p;
        LAS unsigned* hist = H + (p & 1) * 1024 + qs * 256;
        for (int i = half * 64 + lane; i < L; i += 128) { const unsigned k = S[qs * 8192 + i];
            const bool in = (p == 0) || ((k >> (shift + 8)) == prefix);
            if (in) atomicAdd((unsigned*)(hist + ((k >> shift) & 255u)), 1u); }
        __syncthreads();
        const unsigned c0 = hist[255 - 4 * lane], c1 = hist[254 - 4 * lane], c2 = hist[253 - 4 * lane], c3 = hist[252 - 4 * lane];
        const int tot = (int)(c0 + c1 + c2 + c3);
        int incl = tot;
#pragma unroll
        for (int o = 1; o < 64; o <<= 1) { const int v = __shfl_up(incl, o); if (lane >= o) incl += v; }
        const unsigned long long bal = __ballot(incl >= kth);
        const int fl = __ffsll((long long)bal) - 1;
        const int rem = kth - (incl - tot);
        int dig, nk;
        if (rem <= (int)c0) { dig = 255 - 4 * lane; nk = rem; }
        else if (rem <= (int)(c0 + c1)) { dig = 254 - 4 * lane; nk = rem - (int)c0; }
        else if (rem <= (int)(c0 + c1 + c2)) { dig = 253 - 4 * lane; nk = rem - (int)(c0 + c1); }
        else { dig = 252 - 4 * lane; nk = rem - (int)(c0 + c1 + c2); }
        dig = __shfl(dig, fl); nk = __shfl(nk, fl);
        prefix = (prefix << 8) | (unsigned)dig; kth = nk;
        __syncthreads();
        if (p < 2) for (int i = tid; i < 1024; i += NTHR) H[(p & 1) * 1024 + i] = 0u;
    }
    const unsigned T = prefix;
    const int NG = L / 64;
    int tie_before = 0;
    if (half == 1) for (int g = 0; g < 64 && g < NG; ++g) { const unsigned k = S[qs * 8192 + 64 * g + lane]; tie_before += __popcll(__ballot(k == T)); }
    unsigned mlo = 0u, mhi = 0u;
    const unsigned long long lt = (1ull << lane) - 1ull;
    for (int g = 64 * half; g < NG && g < 64 * half + 64; ++g) {
        const unsigned k = S[qs * 8192 + 64 * g + lane];
        const bool eq = (k == T);
        const unsigned long long eqm = __ballot(eq);
        const int rank = tie_before + __popcll(eqm & lt);
        const bool sel = (k > T) || (eq && rank < kth);
        const unsigned long long m = __ballot(sel);
        if (lane == g - 64 * half) { mlo = (unsigned)m; mhi = (unsigned)(m >> 32); }
        tie_before += __popcll(eqm);
    }
    *(u32x2*)(MASK + (size_t)(t0 + qs) * 256 + 2 * (64 * half + lane)) = (u32x2){mlo, mhi};
    __syncthreads();
}

__device__ __forceinline__ void indexer_unit(const Args& a, int unit, LAS unsigned char* lds, int tid) {
    unsigned char* ws = a.ws;
    const int lane = tid & 63, wave = __builtin_amdgcn_readfirstlane(tid >> 6);
    const int t0 = unit * 4, b = t0 >> 13, qpos0 = t0 & (SEQ - 1), c = qpos0 >> 6, L = 64 * (c + 1);
    unsigned* MASK = (unsigned*)(ws + WS_MASK);
    if (c < 4) {
        const int qi = tid >> 7, w2 = (tid & 127) * 2;
        const unsigned m0 = (w2 * 32 < L) ? 0xffffffffu : 0u, m1 = ((w2 + 1) * 32 < L) ? 0xffffffffu : 0u;
        *(u32x2*)(MASK + (size_t)(t0 + qi) * 256 + w2) = (u32x2){m0, m1};
        return;
    }
    const bf16_t* IQ = (const bf16_t*)(ws + WS_IQ); const bf16_t* IKW = (const bf16_t*)(ws + WS_IKW);
    LAS unsigned* S = (LAS unsigned*)(lds + IX_S); LAS unsigned* H = (LAS unsigned*)(lds + IX_H); LAS unsigned* LST = (LAS unsigned*)(lds + IX_L);
    LAS unsigned* MB = (LAS unsigned*)(lds + IX_M); LAS float* MM = (LAS float*)(lds + IX_C); LAS unsigned* CC = (LAS unsigned*)(lds + IX_C + 256);
    const int r32 = lane & 31, hh = lane >> 5;
    for (int i = tid; i < 4096; i += NTHR) H[i] = 0u;
    for (int i = tid; i < 1024; i += NTHR) MB[i] = 0u;
    if (tid < 8) CC[tid] = 0u;
    bf16x8 af[4];
#pragma unroll
    for (int ks = 0; ks < 4; ++ks) af[ks] = *(const bf16x8*)(IQ + (size_t)(t0 + (r32 >> 3)) * 512 + (r32 & 7) * 64 + 16 * ks + 8 * hh);
    bf16x8 a2[2];
#pragma unroll
    for (int sI = 0; sI < 2; ++sI)
#pragma unroll
        for (int j = 0; j < 8; ++j) { const int qm = 2 * sI + (j >> 2), hm = 4 * hh + (j & 3);
            a2[sI][j] = (r32 == qm) ? (short)IKW[(size_t)(t0 + qm) * 256 + 64 + hm] : (short)0; }
    float mn[4], mx[4];
#pragma unroll
    for (int qi = 0; qi < 4; ++qi) { mn[qi] = 3.0e38f; mx[qi] = -3.0e38f; }
    const int NT32 = L / 32;
    const bf16_t* kbase = (const bf16_t*)(ws + WS_IK2) + (size_t)b * (SEQ / 32) * 2048 + lane * 8;
#define IX_LOADT(dst, kt_) do { const bf16_t* kp_ = kbase + (size_t)(kt_) * 2048; _Pragma("unroll") for (int ks = 0; ks < 4; ++ks) dst[ks] = *(const bf16x8*)(kp_ + 512 * ks); } while (0)
#define IX_MM(acc, bt) do { acc = f32x16{}; _Pragma("unroll") for (int ks = 0; ks < 4; ++ks) acc = __builtin_amdgcn_mfma_f32_32x32x16_bf16(af[ks], bt[ks], acc, 0, 0, 0); } while (0)
#define IX_HS(y_, acc) do { unsigned pk_[8]; _Pragma("unroll") for (int i = 0; i < 8; ++i) { const float x0_ = __builtin_amdgcn_fmed3f(acc[2 * i], 0.0f, 3.0e38f), x1_ = __builtin_amdgcn_fmed3f(acc[2 * i + 1], 0.0f, 3.0e38f); pk_[i] = cvt_pk_to_mfma(x0_, x1_); } \
        const u32x4 f0_ = {pk_[0], pk_[1], pk_[2], pk_[3]}, f1_ = {pk_[4], pk_[5], pk_[6], pk_[7]}; \
        y_ = f32x16{}; y_ = __builtin_amdgcn_mfma_f32_32x32x16_bf16(a2[0], *(const bf16x8*)&f0_, y_, 0, 0, 0); y_ = __builtin_amdgcn_mfma_f32_32x32x16_bf16(a2[1], *(const bf16x8*)&f1_, y_, 0, 0, 0); } while (0)
#define IX_ST(y_, kt_) do { const int key = (kt_) * 32 + r32; \
        if (hh == 0) { _Pragma("unroll") for (int qi = 0; qi < 4; ++qi) { const float s = y_[qi] + 0.0f; mn[qi] = fminf(mn[qi], s); mx[qi] = fmaxf(mx[qi], s); S[qi * 8192 + key] = __float_as_uint(s); } } } while (0)
#ifndef IX_REP_S1
#define IX_REP_S1 1
#endif
    for (int rp1 = 0; rp1 < IX_REP_S1; ++rp1) {
    bf16x8 bA[4], bB[4], bC[4];
    { const int kt = wave; if (kt < NT32) IX_LOADT(bA, kt); if (kt + 8 < NT32) IX_LOADT(bB, kt + 8); if (kt + 16 < NT32) IX_LOADT(bC, kt + 16); }
    for (int kt = wave; kt < NT32; kt += 3 * NWAVES) {
        const int kn = kt + 3 * NWAVES;
        bf16x8 nA[4], nB[4], nC[4];
        if (kn < NT32) IX_LOADT(nA, kn); if (kn + 8 < NT32) IX_LOADT(nB, kn + 8); if (kn + 16 < NT32) IX_LOADT(nC, kn + 16);
        const bool hB = kt + 8 < NT32, hC = kt + 16 < NT32;
#ifndef IX_REP_C
#define IX_REP_C 1
#endif
        for (int rc_ = 0; rc_ < IX_REP_C; ++rc_) {
        f32x16 xA, xB, xC;
        IX_MM(xA, bA); if (hB) IX_MM(xB, bB); if (hC) IX_MM(xC, bC);
        { f32x16 yy; IX_HS(yy, xA); IX_ST(yy, kt); }
        if (hB) { f32x16 yy; IX_HS(yy, xB); IX_ST(yy, kt + 8); }
        if (hC) { f32x16 yy; IX_HS(yy, xC); IX_ST(yy, kt + 16); }
        }
#pragma unroll
        for (int ks = 0; ks < 4; ++ks) { bA[ks] = nA[ks]; bB[ks] = nB[ks]; bC[ks] = nC[ks]; }
    }
    }
#undef IX_LOADT
#undef IX_MM
#undef IX_HS
#undef IX_ST
#pragma unroll
    for (int qi = 0; qi < 4; ++qi) {
#pragma unroll
        for (int o = 1; o < 32; o <<= 1) { mn[qi] = fminf(mn[qi], __shfl_xor(mn[qi], o)); mx[qi] = fmaxf(mx[qi], __shfl_xor(mx[qi], o)); }
        if (lane == 0) { MM[(wave * 4 + qi) * 2] = mn[qi]; MM[(wave * 4 + qi) * 2 + 1] = mx[qi]; } }
    __syncthreads();
    const int qs = wave >> 1, half = wave & 1;
    float mnq = 3.0e38f, mxq = -3.0e38f;
#pragma unroll
    for (int w = 0; w < NWAVES; ++w) { mnq = fminf(mnq, MM[(w * 4 + qs) * 2]); mxq = fmaxf(mxq, MM[(w * 4 + qs) * 2 + 1]); }
    const float scl = (mxq > mnq) ? 1023.0f / (mxq - mnq) : 0.0f;
#define IX_BIN(sbits) min((int)((__uint_as_float(sbits) - mnq) * scl), 1023)
    { LAS unsigned* hist = H + qs * 1024;
      int i = half * 64 + lane;
      for (; i + 384 < L; i += 512) { const unsigned s0 = S[qs * 8192 + i], s1 = S[qs * 8192 + i + 128], s2 = S[qs * 8192 + i + 256], s3 = S[qs * 8192 + i + 384];
          const int b0 = IX_BIN(s0), b1 = IX_BIN(s1), b2 = IX_BIN(s2), b3 = IX_BIN(s3);
          atomicAdd((unsigned*)(hist + b0), 1u); atomicAdd((unsigned*)(hist + b1), 1u); atomicAdd((unsigned*)(hist + b2), 1u); atomicAdd((unsigned*)(hist + b3), 1u); }
      for (; i < L; i += 128) { const int bin = IX_BIN(S[qs * 8192 + i]); atomicAdd((unsigned*)(hist + bin), 1u); } }
    __syncthreads();
    int bstar, rtake, cntb;
    { const LAS u32x4* hp = (const LAS u32x4*)(H + qs * 1024 + 1008 - 16 * lane);
      const u32x4 h0 = hp[0], h1 = hp[1], h2 = hp[2], h3 = hp[3];
      const unsigned cb[16] = {h0.x, h0.y, h0.z, h0.w, h1.x, h1.y, h1.z, h1.w, h2.x, h2.y, h2.z, h2.w, h3.x, h3.y, h3.z, h3.w};
      int tot = 0;
#pragma unroll
      for (int j = 0; j < 16; ++j) tot += (int)cb[j];
      int incl = tot;
#pragma unroll
      for (int o = 1; o < 64; o <<= 1) { const int v = __shfl_up(incl, o); if (lane >= o) incl += v; }
      const unsigned long long bal = __ballot(incl >= 256);
      const int fl = __ffsll((long long)bal) - 1;
      const int rem = 256 - (incl - tot);
      int cum = 0, bs = 0, rt = 0, cn = 0; bool found = false;
#pragma unroll
      for (int j = 15; j >= 0; --j) { const int cj = (int)cb[j]; if (!found && cum + cj >= rem) { bs = 1008 - 16 * lane + j; rt = rem - cum; cn = cj; found = true; } cum += cj; }
      bstar = __shfl(bs, fl); rtake = __shfl(rt, fl); cntb = __shfl(cn, fl); }
    const int NG = L / 64;
    const bool all_eq = (cntb == rtake);
    const unsigned long long lt = (1ull << lane) - 1ull;
    { unsigned mlo = 0u, mhi = 0u;
      const int gh = (NG + 1) >> 1, gbeg = half ? gh : 0, gend = half ? NG : gh;
      const float tge = (float)bstar, tgt = (bstar >= 1023) ? 3.0e38f : (float)(bstar + 1);
      unsigned sv[4] = {0u, 0u, 0u, 0u};
      for (int g = gbeg; g < gend; ++g) {
          const int gi = (g - gbeg) & 3;
          if (gi == 0) {
#pragma unroll
              for (int j = 0; j < 4; ++j) if (g + j < gend) sv[j] = S[qs * 8192 + 64 * (g + j) + lane]; }
          const unsigned sb = (gi == 0) ? sv[0] : (gi == 1) ? sv[1] : (gi == 2) ? sv[2] : sv[3];
          const float tq = (__uint_as_float(sb) - mnq) * scl;
          unsigned long long m = __ballot(tq >= tgt);
          const unsigned long long eqm = __ballot(tq >= tge) & ~m;
          if (all_eq) m |= eqm;
          else if (eqm != 0ull) {
              unsigned base = 0u;
              if (lane == 0) base = atomicAdd((unsigned*)(CC + qs), (unsigned)__popcll(eqm));
              base = __builtin_amdgcn_readfirstlane(base);
              const unsigned pos = base + (unsigned)__popcll(eqm & lt);
              if (((eqm >> lane) & 1ull) && pos < (unsigned)IX_CAP) LST[qs * IX_CAP + pos] = (unsigned)(64 * g + lane); }
          if (lane == g - gbeg) { mlo = (unsigned)m; mhi = (unsigned)(m >> 32); }
      }
      if (lane < gend - gbeg) *(LAS u32x2*)(MB + qs * 256 + 2 * (gbeg + lane)) = (u32x2){mlo, mhi}; }
    __syncthreads();
    if (half == 0 && !all_eq) {
        const int nc = cntb;
        if (nc > IX_CAP) { if (lane == 0) CC[4] = 1u; }
        else {
            unsigned myk[8], myi[8]; int rk[8];
#pragma unroll
            for (int sI = 0; sI < 8; ++sI) { const int j = sI * 64 + lane; rk[sI] = 0; myi[sI] = 0u; myk[sI] = 0u;
                if (sI * 64 < nc && j < nc) { myi[sI] = LST[qs * IX_CAP + j]; myk[sI] = ix_sortable(S[qs * 8192 + myi[sI]]); } }
            for (int t = 0; t < nc; ++t) { const unsigned it = LST[qs * IX_CAP + t]; const unsigned kt_ = ix_sortable(S[qs * 8192 + it]);
#pragma unroll
                for (int sI = 0; sI < 8; ++sI) if (sI * 64 < nc) rk[sI] += (kt_ > myk[sI] || (kt_ == myk[sI] && it < myi[sI])) ? 1 : 0; }
#pragma unroll
            for (int sI = 0; sI < 8; ++sI) { const int j = sI * 64 + lane;
                if (sI * 64 < nc && j < nc && rk[sI] < rtake) atomicOr((unsigned*)(MB + qs * 256 + (myi[sI] >> 5)), 1u << (myi[sI] & 31u)); }
        }
    }
#undef IX_BIN
    __syncthreads();
    if (CC[4] != 0u) { __syncthreads(); ix_radix_fallback(S, H, MASK, t0, L, tid); return; }
    { const int qi = tid >> 7, w2 = (tid & 127) * 2;
      *(u32x2*)(MASK + (size_t)(t0 + qi) * 256 + w2) = *(const LAS u32x2*)(MB + qi * 256 + w2); }
    __syncthreads();
}

constexpr int NA_IDX = 0, NA_LG = 1024, NA_SCAN = 1024 + 8192;
__device__ __forceinline__ void attn_gather_unit(const Args& a, int tok, LAS unsigned char* lds, int tid) {
    unsigned char* ws = a.ws;
    const int lane = tid & 63, wave = __builtin_amdgcn_readfirstlane(tid >> 6);
    const int b = tok >> 13, qpos = tok & (SEQ - 1), c = qpos >> 6, L = 64 * (c + 1), nsel = L < 256 ? L : 256;
    const unsigned* MASK = (const unsigned*)(ws + WS_MASK);
    LAS int* idxs = (LAS int*)(lds + NA_IDX); LAS float* lg = (LAS float*)(lds + NA_LG) + wave * 256; LAS int* wsum = (LAS int*)(lds + NA_SCAN);
    unsigned w = 0u; int cnt = 0;
    if (tid < 256) { w = MASK[(size_t)tok * 256 + tid]; cnt = __popc(w); }
    int incl = cnt;
#pragma unroll
    for (int o = 1; o < 64; o <<= 1) { const int v = __shfl_up(incl, o); if (lane >= o) incl += v; }
    if (lane == 63) wsum[wave] = incl;
    __syncthreads();
    if (tid < 256) { int off = incl - cnt; for (int ww = 0; ww < wave; ++ww) off += wsum[ww];
        while (w) { const int bit = __ffs(w) - 1; w &= w - 1; if (off < 256) idxs[off] = tid * 32 + bit; ++off; } }
    __syncthreads();
    const int h = wave;
    const bf16_t* BQ = (const bf16_t*)(ws + WS_BQ); const bf16_t* BK = (const bf16_t*)(ws + WS_BK); const bf16_t* BV = (const bf16_t*)(ws + WS_BV);
    const float slope = exp2f(-(float)(h + 1));
    float qv[8];
    { const u32x4 qw = *(const u32x4*)(BQ + (size_t)tok * 1024 + h * 128 + 8 * (lane & 15));
      qv[0] = __uint_as_float(qw.x << 16); qv[1] = __uint_as_float(qw.x & 0xffff0000u); qv[2] = __uint_as_float(qw.y << 16); qv[3] = __uint_as_float(qw.y & 0xffff0000u);
      qv[4] = __uint_as_float(qw.z << 16); qv[5] = __uint_as_float(qw.z & 0xffff0000u); qv[6] = __uint_as_float(qw.w << 16); qv[7] = __uint_as_float(qw.w & 0xffff0000u); }
    for (int it = 0; it < nsel / 4; ++it) {
        const int key = idxs[4 * it + (lane >> 4)];
        const u32x4 kw = *(const u32x4*)(BK + (size_t)(b * SEQ + key) * 1024 + h * 128 + 8 * (lane & 15));
        float s = qv[0] * __uint_as_float(kw.x << 16) + qv[1] * __uint_as_float(kw.x & 0xffff0000u) + qv[2] * __uint_as_float(kw.y << 16) + qv[3] * __uint_as_float(kw.y & 0xffff0000u)
                + qv[4] * __uint_as_float(kw.z << 16) + qv[5] * __uint_as_float(kw.z & 0xffff0000u) + qv[6] * __uint_as_float(kw.w << 16) + qv[7] * __uint_as_float(kw.w & 0xffff0000u);
        s += __shfl_xor(s, 1); s += __shfl_xor(s, 2); s += __shfl_xor(s, 4); s += __shfl_xor(s, 8);
        const float dist = fabsf((float)(qpos - key));
        if ((lane & 15) == 0) lg[4 * it + (lane >> 4)] = s * 0.08838834764831845f - slope * dist;
    }
    LDS_WAIT();
    float mx = -3.0e38f;
    for (int k = lane; k < nsel; k += 64) mx = fmaxf(mx, lg[k]);
#pragma unroll
    for (int o = 1; o < 64; o <<= 1) mx = fmaxf(mx, __shfl_xor(mx, o));
    float sm = 0.f;
    for (int k = lane; k < nsel; k += 64) { const float e = __expf(lg[k] - mx); lg[k] = e; sm += e; }
    sm = wave_sum(sm);
    const float rs = 1.0f / sm;
    LDS_WAIT();
    float o0 = 0.f, o1 = 0.f;
    for (int k = 0; k < nsel; k += 4) {
        unsigned vw[4]; float pp[4];
#pragma unroll
        for (int j = 0; j < 4; ++j) { const int key = idxs[k + j]; pp[j] = lg[k + j]; vw[j] = *(const unsigned*)(BV + (size_t)(b * SEQ + key) * 1024 + h * 128 + 2 * lane); }
#pragma unroll
        for (int j = 0; j < 4; ++j) { o0 += pp[j] * __uint_as_float(vw[j] << 16); o1 += pp[j] * __uint_as_float(vw[j] & 0xffff0000u); }
    }
    *(unsigned*)((bf16_t*)(ws + WS_BRB) + (size_t)tok * 1024 + h * 128 + 2 * lane) = cvt_pk(o0 * rs, o1 * rs);
    __syncthreads();
}

constexpr int RT_BLK = 148, RT_BUF = 64 * RT_BLK * 4;
constexpr int RT_SCR = 2 * RT_BUF;
__device__ __forceinline__ void phase8_router_expw(const Args& a, LAS unsigned char* lds, int tid, int G, bool route, bool do_expw) {
    unsigned char* ws = a.ws; const int wave = __builtin_amdgcn_readfirstlane(tid >> 6);
    const int npass = MT / 8;
    if (wave < 4) {
        __syncthreads();
        int cbuf = 0;
        for (int ps = blockIdx.x; ps < npass; ps += G) {
            int lane = tid & 63; asm volatile("" : "+v"(lane));
            f32x4 v[2][8];
#pragma unroll
            for (int r = 0; r < 2; ++r) { const int row = ps * 8 + wave * 2 + r;
                const bf16_t* pre = (const bf16_t*)(ws + WS_PRE1) + (size_t)row * DM; float s = 0.f;
#pragma unroll
                for (int i = 0; i < 8; ++i) { const u32x2 pw = *(const u32x2*)(pre + 256 * i + 4 * lane);
                    v[r][i] = (f32x4){__uint_as_float(pw.x << 16), __uint_as_float(pw.x & 0xffff0000u), __uint_as_float(pw.y << 16), __uint_as_float(pw.y & 0xffff0000u)};
                    s += (v[r][i][0] + v[r][i][1]) + (v[r][i][2] + v[r][i][3]); }
                const float mean = wave_sum(s) * (1.0f / DM); float s2 = 0.f;
#pragma unroll
                for (int i = 0; i < 8; ++i) { v[r][i] = v[r][i] - mean; s2 += (v[r][i][0] * v[r][i][0] + v[r][i][1] * v[r][i][1]) + (v[r][i][2] * v[r][i][2] + v[r][i][3] * v[r][i][3]); }
                const float rstd = 1.0f / sqrtf(wave_sum(s2) * (1.0f / DM) + LN_EPS);
                bf16_t* H1B = (bf16_t*)(ws + WS_H1B) + (size_t)row * DM;
#pragma unroll
                for (int i = 0; i < 8; ++i) { const f32x4 gg = *(const f32x4*)(a.in[I_LN1G] + 256 * i + 4 * lane), bb = *(const f32x4*)(a.in[I_LN1B] + 256 * i + 4 * lane);
                    v[r][i] = v[r][i] * rstd * gg + bb;
                    *(u32x2*)(H1B + 256 * i + 4 * lane) = (u32x2){cvt_pk(v[r][i][0], v[r][i][1]), cvt_pk(v[r][i][2], v[r][i][3])}; } }
            f32x2 acc2[36];
#pragma unroll
            for (int j = 0; j < 36; ++j) acc2[j] = (f32x2){0.f, 0.f};
#pragma unroll
            for (int i = 0; i < 8; ++i) {
                int lq = lane; asm volatile("" : "+v"(lq));
                const LAS float* blk = (const LAS float*)(lds + cbuf * RT_BUF) + lq * RT_BLK;
#pragma unroll
                for (int kk = 0; kk < 4; ++kk) {
                    __builtin_amdgcn_sched_barrier(0);
                    const f32x2 hv = (f32x2){v[0][i][kk], v[1][i][kk]};
#pragma unroll
                    for (int q = 0; q < 9; ++q) { const f32x4 w4 = *(const LAS f32x4*)(blk + kk * 36 + 4 * q);
                        acc2[4 * q + 0] += hv * (f32x2){w4[0], w4[0]}; acc2[4 * q + 1] += hv * (f32x2){w4[1], w4[1]};
                        acc2[4 * q + 2] += hv * (f32x2){w4[2], w4[2]}; acc2[4 * q + 3] += hv * (f32x2){w4[3], w4[3]}; } }
                __syncthreads();
                cbuf ^= 1;
            }
#pragma unroll
            for (int r = 0; r < 2; ++r) {
                const int row = ps * 8 + wave * 2 + r;
                float lgt[36];
#pragma unroll
                for (int j = 0; j < 36; ++j) lgt[j] = wave_sum(r == 0 ? acc2[j][0] : acc2[j][1]);
                float gl[4]; float gm = -3.0e38f; int gt = 0;
#pragma unroll
                for (int j = 0; j < 4; ++j) { gl[j] = lgt[j] + a.in[I_BGRP][j]; if (gl[j] > gm) { gm = gl[j]; gt = j; } }
                float gs = 0.f;
#pragma unroll
                for (int j = 0; j < 4; ++j) gs += __expf(gl[j] - gm);
                const float gp = 1.0f / gs;
                float e1 = -3.0e38f, e2 = -3.0e38f; int i1 = 0, i2 = 0;
#pragma unroll
                for (int j = 0; j < 8; ++j) { float ev = 0.f;
#pragma unroll
                    for (int gq = 0; gq < 4; ++gq) if (gq == gt) ev = lgt[4 + 8 * gq + j] + a.in[I_BRT][8 * gq + j];
                    if (ev > e1) { e2 = e1; i2 = i1; e1 = ev; i1 = j; } else if (ev > e2) { e2 = ev; i2 = j; } }
                const float x2 = __expf(e2 - e1), w1 = gp / (1.0f + x2), w2 = gp * x2 / (1.0f + x2);
                if (lane == 0 && route) {
                    unsigned* ctl = (unsigned*)(ws + WS_CTL);
                    int* rows = (int*)(ws + WS_ROWS); int* slot_e = (int*)(ws + WS_SLOT); int* slot_p = slot_e + 2 * MT; float* slot_w = (float*)(slot_p + 2 * MT);
                    const int ea = gt * 8 + i1, eb = gt * 8 + i2;
                    const int pa = (int)atomicAdd(ctl + CW_CNT + 64 * ea, 1u), pb = (int)atomicAdd(ctl + CW_CNT + 64 * eb, 1u);
                    rows[ea * MT + pa] = row; rows[eb * MT + pb] = row;
                    slot_e[2 * row] = ea; slot_e[2 * row + 1] = eb; slot_p[2 * row] = pa; slot_p[2 * row + 1] = pb; slot_w[2 * row] = w1; slot_w[2 * row + 1] = w2;
                }
            }
        }
    } else {
        const int lane = tid & 63, te = tid - 256;
        const float* wg = a.in[I_WGRP]; const float* wr = a.in[I_WRT];
        LAS float* scr = (LAS float*)(lds + RT_SCR + (wave - 4) * 8704);
        f32x4 sa[9], sb[9];
#define RT_LOADW(dst, chunk) do { const int k_ = (chunk) * 256 + te; dst[0] = *(const f32x4*)(wg + (size_t)k_ * 4); _Pragma("unroll") for (int j_ = 0; j_ < 8; ++j_) dst[1 + j_] = *(const f32x4*)(wr + (size_t)k_ * 32 + 4 * j_); } while (0)
#define RT_WRITEW(src, buf) do { LAS float* p_ = (LAS float*)(buf) + (te >> 2) * RT_BLK + (te & 3) * 36; _Pragma("unroll") for (int j_ = 0; j_ < 9; ++j_) *(LAS f32x4*)(p_ + 4 * j_) = src[j_]; } while (0)
        RT_LOADW(sa, 0); RT_WRITEW(sa, lds); RT_LOADW(sb, 1);
        const int ge = blockIdx.x * 4 + (wave - 4), NGE = G * 4, NIT = do_expw ? NEXP * EW_E : 0;
        int it = ge; f32x4 e0[8], e1[8], e2[8];
#define EW_LOAD(dst, item) do { if ((item) < NIT) { size_t ldw_; const float* p_ = ew_src(a, (item), lane, ldw_); _Pragma("unroll") for (int i_ = 0; i_ < 8; ++i_) dst[i_] = __builtin_nontemporal_load((const f32x4*)(p_ + (size_t)(8 * i_) * ldw_)); } } while (0)
#define EW_STEPX(cur, fre) do { if (it < NIT) { EW_LOAD(fre, it + 2 * NGE); ew_store(a, it, cur, scr, lane); it += NGE; } } while (0)
        EW_LOAD(e0, it); EW_LOAD(e1, it + NGE);
        __syncthreads();
        int cbuf = 0;
        for (int ps = blockIdx.x; ps < npass; ps += G) {
#pragma unroll
            for (int i = 0; i < 8; ++i) {
                if (i & 1) { RT_LOADW(sb, (i + 2) & 7); RT_WRITEW(sa, lds + (cbuf ^ 1) * RT_BUF); }
                else { RT_LOADW(sa, (i + 2) & 7); RT_WRITEW(sb, lds + (cbuf ^ 1) * RT_BUF); }
                if (i == 0) { EW_STEPX(e0, e2); EW_STEPX(e1, e0); } else if (i == 1) { EW_STEPX(e2, e1); } else if (i == 2) { EW_STEPX(e0, e2); EW_STEPX(e1, e0); } else if (i == 3) { EW_STEPX(e2, e1); }
                else if (i == 4) { EW_STEPX(e0, e2); EW_STEPX(e1, e0); } else if (i == 5) { EW_STEPX(e2, e1); } else if (i == 6) { EW_STEPX(e0, e2); EW_STEPX(e1, e0); } else { EW_STEPX(e2, e1); }
                __syncthreads();
                cbuf ^= 1;
            }
        }
        while (it < NIT) { EW_STEPX(e0, e2); EW_STEPX(e1, e0); EW_STEPX(e2, e1); }
#undef RT_LOADW
#undef RT_WRITEW
#undef EW_STEPX
#undef EW_LOAD
    }
    __syncthreads();
}

__device__ __forceinline__ void load_tile_base(const Args& a, LAS int* tb, int tid) {
    const unsigned* ctl = (const unsigned*)(a.ws + WS_CTL);
    if (tid == 0) { int acc = 0; for (int e = 0; e < NEXP; ++e) { tb[e] = acc; acc += ((int)ctl[CW_CNT + 64 * e] + 255) >> 8; } tb[NEXP] = acc; }
    __syncthreads();
}

__device__ __forceinline__ void phase_gather(const Args& a, LAS unsigned char* lds, int tid, int G) {
    unsigned char* ws = a.ws; const int lane = tid & 63, wave = tid >> 6;
    LAS int* tb = (LAS int*)lds;
    load_tile_base(a, tb, tid);
    unsigned* ctl = (unsigned*)(ws + WS_CTL);
    const int NT = tb[NEXP];
    if (blockIdx.x == 0) { if (tid == 0) ctl[CW_NT] = (unsigned)NT;
        if (tid < NEXP) for (int t = tb[tid]; t < tb[tid + 1]; ++t) ctl[CW_TILEE + t] = (unsigned)tid;
        if (tid <= NEXP) ctl[CW_TBASE + tid] = (unsigned)tb[tid]; }
    const int* rows = (const int*)(ws + WS_ROWS); const bf16_t* H1B = (const bf16_t*)(ws + WS_H1B); bf16_t* XG = (bf16_t*)(ws + WS_XG);
    for (int r = blockIdx.x * NWAVES + wave; r < NT * 256; r += G * NWAVES) {
        const int tile = r >> 8; int e = 0;
        for (int j = 1; j < NEXP; ++j) if (tb[j] <= tile) e = j;
        const int pos = r - tb[e] * 256; const int cnt = (int)ctl[CW_CNT + 64 * e];
        u32x4 v[4];
        if (pos < cnt) { const int tok = rows[e * MT + pos];
#pragma unroll
            for (int i = 0; i < 4; ++i) v[i] = *(const u32x4*)(H1B + (size_t)tok * DM + 512 * i + 8 * lane); }
        else {
#pragma unroll
            for (int i = 0; i < 4; ++i) v[i] = (u32x4){0u, 0u, 0u, 0u}; }
#pragma unroll
        for (int i = 0; i < 4; ++i) *(u32x4*)(XG + (size_t)r * DM + 512 * i + 8 * lane) = v[i];
    }
}

__device__ __forceinline__ void final_row(const Args& a, int row, int lane, const LAS int* tb) {
    unsigned char* ws = a.ws;
    const int* slot_e = (const int*)(ws + WS_SLOT); const int* slot_p = slot_e + 2 * MT; const float* slot_w = (const float*)(slot_p + 2 * MT);
    const int e0 = slot_e[2 * row], e1 = slot_e[2 * row + 1];
    const size_t r0 = (size_t)tb[e0] * 256 + slot_p[2 * row], r1 = (size_t)tb[e1] * 256 + slot_p[2 * row + 1];
    const float w0 = slot_w[2 * row], w1 = slot_w[2 * row + 1];
    const bf16_t* H1B = (const bf16_t*)(ws + WS_H1B) + (size_t)row * DM; const bf16_t* Y = (const bf16_t*)(ws + WS_Y);
    f32x4 v[8]; float s = 0.f;
#pragma unroll
    for (int i = 0; i < 8; ++i) { const u32x2 hw = *(const u32x2*)(H1B + 256 * i + 4 * lane);
        const f32x4 hv = {__uint_as_float(hw.x << 16), __uint_as_float(hw.x & 0xffff0000u), __uint_as_float(hw.y << 16), __uint_as_float(hw.y & 0xffff0000u)};
        const u32x2 ya = *(const u32x2*)(Y + r0 * DM + 256 * i + 4 * lane), yb = *(const u32x2*)(Y + r1 * DM + 256 * i + 4 * lane);
        const f32x4 fa = {__uint_as_float(ya.x << 16), __uint_as_float(ya.x & 0xffff0000u), __uint_as_float(ya.y << 16), __uint_as_float(ya.y & 0xffff0000u)};
        const f32x4 fb = {__uint_as_float(yb.x << 16), __uint_as_float(yb.x & 0xffff0000u), __uint_as_float(yb.y << 16), __uint_as_float(yb.y & 0xffff0000u)};
        v[i] = hv * DN_ALPHA + fa * w0 + fb * w1; s += (v[i][0] + v[i][1]) + (v[i][2] + v[i][3]); }
    const float mean = wave_sum(s) * (1.0f / DM); float s2 = 0.f;
#pragma unroll
    for (int i = 0; i < 8; ++i) { v[i] = v[i] - mean; s2 += (v[i][0] * v[i][0] + v[i][1] * v[i][1]) + (v[i][2] * v[i][2] + v[i][3] * v[i][3]); }
    const float rstd = 1.0f / sqrtf(wave_sum(s2) * (1.0f / DM) + LN_EPS);
    float* O = a.out + (size_t)row * DM;
#pragma unroll
    for (int i = 0; i < 8; ++i) { const f32x4 g = *(const f32x4*)(a.in[I_LN2G] + 256 * i + 4 * lane), bb = *(const f32x4*)(a.in[I_LN2B] + 256 * i + 4 * lane);
        *(f32x4*)(O + 256 * i + 4 * lane) = v[i] * rstd * g + bb; }
}


namespace fa {
constexpr int D = 128, NW = 8, QBLK = 32, KVBLK = 64, LDX = 1024;
constexpr float SCALE = 0.088388347648318440f, THR = 8.f;
constexpr size_t SHM_V = KVBLK * D * 2, SHM_K = KVBLK * D * 2, SHM_ATTN = 2 * SHM_V + 2 * SHM_K + NW * 64 * 4;
using s16x4 = __attribute__((ext_vector_type(4))) short;
#define KSWZ(row, colB) ((row) * 256 + ((colB) ^ (((row) & 7) << 4)))
#define SBAR() __builtin_amdgcn_sched_barrier(0)
__device__ __forceinline__ int crow(int r, int hi) { return (r & 3) + 8 * (r >> 2) + 4 * hi; }

__device__ __forceinline__ void partialSM(f32x16& p0, f32x16& p1, float& m_reg, float& mn, float& alpha) {
  constexpr float C = SCALE * 1.4426950408889634f;
  float pmax = p0[0];
#pragma unroll
  for (int r = 1; r < 16; ++r) pmax = fmaxf(pmax, p0[r]);
#pragma unroll
  for (int r = 0; r < 16; ++r) pmax = fmaxf(pmax, p1[r]);
  { auto rr = __builtin_amdgcn_permlane32_swap(__float_as_uint(pmax), __float_as_uint(pmax), false, false);
    pmax = fmaxf(__uint_as_float(rr[0]), __uint_as_float(rr[1])); }
  if (__builtin_expect(__all(pmax - m_reg <= THR / SCALE), 1)) { mn = m_reg; alpha = 1.f; }
  else { mn = fmaxf(m_reg, pmax); alpha = __builtin_amdgcn_exp2f((m_reg - mn) * C); m_reg = mn; }
  float mnC = -mn * C;
#pragma unroll
  for (int r = 0; r < 16; ++r) p0[r] = fmaf(p0[r], C, mnC);
#pragma unroll
  for (int r = 0; r < 16; ++r) p1[r] = fmaf(p1[r], C, mnC);
#pragma unroll
  for (int r = 0; r < 16; ++r) p0[r] = __builtin_amdgcn_exp2f(p0[r]);
}
__device__ __forceinline__ void finishSM(f32x16& p0, f32x16& p1, float alpha, float& l_reg, bf16x8& pa0, bf16x8& pa1, bf16x8& pa2, bf16x8& pa3) {
#pragma unroll
  for (int r = 0; r < 16; ++r) p1[r] = __builtin_amdgcn_exp2f(p1[r]);
  float ps = 0;
#pragma unroll
  for (int r = 0; r < 16; ++r) ps += p0[r];
#pragma unroll
  for (int r = 0; r < 16; ++r) ps += p1[r];
  { auto rr = __builtin_amdgcn_permlane32_swap(__float_as_uint(ps), __float_as_uint(ps), false, false);
    ps = __uint_as_float(rr[0]) + __uint_as_float(rr[1]); }
  l_reg = l_reg * alpha + ps;
#define PK4(P, BASE, OUT) do { unsigned a0 = cvt_pk(P[BASE + 0], P[BASE + 1]), a1 = cvt_pk(P[BASE + 2], P[BASE + 3]);   \
    unsigned b0 = cvt_pk(P[BASE + 4], P[BASE + 5]), b1 = cvt_pk(P[BASE + 6], P[BASE + 7]);                              \
    auto r0 = __builtin_amdgcn_permlane32_swap(a0, b0, false, false); auto r1 = __builtin_amdgcn_permlane32_swap(a1, b1, false, false); \
    u32x4 w = {r0[0], r1[0], r0[1], r1[1]}; OUT = *reinterpret_cast<bf16x8*>(&w); } while (0)
  PK4(p0, 0, pa0); PK4(p0, 8, pa1); PK4(p1, 0, pa2); PK4(p1, 8, pa3);
#undef PK4
}
__device__ __forceinline__ void qkt(f32x16& p0, f32x16& p1, const char* Ks, const bf16x8* qr, int r32, int hi) {
  p0 = f32x16{}; p1 = f32x16{};
#pragma unroll
  for (int d0 = 0; d0 < 8; ++d0) { int cb = (d0 * 16 + hi * 8) * 2;
    bf16x8 b0 = *reinterpret_cast<const bf16x8*>(Ks + KSWZ(r32, cb));
    bf16x8 b1 = *reinterpret_cast<const bf16x8*>(Ks + KSWZ(32 + r32, cb));
    p0 = __builtin_amdgcn_mfma_f32_32x32x16_bf16(b0, qr[d0], p0, 0, 0, 0);
    p1 = __builtin_amdgcn_mfma_f32_32x32x16_bf16(b1, qr[d0], p1, 0, 0, 0); }
}
__device__ __forceinline__ void mask_bias(f32x16& p0, f32x16& p1, u32x2 mw, float dq, float slr, int hi) {
  const unsigned w0 = mw.x >> (4 * hi), w1 = mw.y >> (4 * hi);
  const unsigned NEG = 0xf149f2cau;
#pragma unroll
  for (int r = 0; r < 16; ++r) { const int c = (r & 3) + 8 * (r >> 2);
    const float d0 = dq - (float)c, d1 = dq - (float)(32 + c);
    const float s0 = fmaf(-slr, fabsf(d0), p0[r]), s1 = fmaf(-slr, fabsf(d1), p1[r]);
    const unsigned t0 = (unsigned)(((int)(w0 << (31 - c))) >> 31), t1 = (unsigned)(((int)(w1 << (31 - c))) >> 31);
    p0[r] = __uint_as_float((__float_as_uint(s0) & t0) | (NEG & ~t0));
    p1[r] = __uint_as_float((__float_as_uint(s1) & t1) | (NEG & ~t1)); }
}
__device__ __forceinline__ int v_st(int k, int c) { const int kk = (k & ~0xC) | ((k & 4) << 1) | ((k & 8) >> 1); return ((kk >> 3) * 4 + (c >> 5)) * 512 + ((kk & 7) * 32 + (c & 31)) * 2; }
__device__ __forceinline__ int v_rd_base(int lane) { return ((lane & 3) << 3) | (((lane >> 2) & 3) << 6) | (((lane >> 4) & 1) << 5) | (((lane >> 5) & 1) << 8); }
constexpr int v_rd_off(int d0, int ks, int half) { return d0 * 512 + ks * 4096 + half * 2048; }
template <int OFF> __device__ __forceinline__ s16x4 tr_read(int vb) {
  s16x4 r; asm volatile("ds_read_b64_tr_b16 %0, %1 offset:%2" : "=&v"(r) : "v"(vb), "i"(OFF) : "memory"); return r;
}
template <int D0> __device__ __forceinline__ void pv_one(f32x16& od, int vb, bf16x8 pa0, bf16x8 pa1, bf16x8 pa2, bf16x8 pa3) {
  const s16x4 l0 = tr_read<v_rd_off(D0, 0, 0)>(vb), h0 = tr_read<v_rd_off(D0, 0, 1)>(vb), l1 = tr_read<v_rd_off(D0, 1, 0)>(vb), h1 = tr_read<v_rd_off(D0, 1, 1)>(vb);
  const s16x4 l2 = tr_read<v_rd_off(D0, 2, 0)>(vb), h2 = tr_read<v_rd_off(D0, 2, 1)>(vb), l3 = tr_read<v_rd_off(D0, 3, 0)>(vb), h3 = tr_read<v_rd_off(D0, 3, 1)>(vb);
  asm volatile("s_waitcnt lgkmcnt(0)" ::: "memory"); SBAR();
#define PK(L, H) (bf16x8){L[0], L[1], L[2], L[3], H[0], H[1], H[2], H[3]}
  od = __builtin_amdgcn_mfma_f32_32x32x16_bf16(pa0, PK(l0, h0), od, 0, 0, 0);
  od = __builtin_amdgcn_mfma_f32_32x32x16_bf16(pa1, PK(l1, h1), od, 0, 0, 0);
  od = __builtin_amdgcn_mfma_f32_32x32x16_bf16(pa2, PK(l2, h2), od, 0, 0, 0);
  od = __builtin_amdgcn_mfma_f32_32x32x16_bf16(pa3, PK(l3, h3), od, 0, 0, 0);
#undef PK
}
__device__ __forceinline__ void pv_d0(f32x16* o, int vb, bf16x8 pa0, bf16x8 pa1, bf16x8 pa2, bf16x8 pa3) {
  pv_one<0>(o[0], vb, pa0, pa1, pa2, pa3); pv_one<1>(o[1], vb, pa0, pa1, pa2, pa3); pv_one<2>(o[2], vb, pa0, pa1, pa2, pa3); pv_one<3>(o[3], vb, pa0, pa1, pa2, pa3);
}

#define FA_GAS __attribute__((address_space(1)))
__device__ __forceinline__ void attn_block(const bf16_t* Qb_, const bf16_t* Kh_, const bf16_t* Vh_, const unsigned* maskrow_,
                                           bf16_t* Ob_, int NT, int qpos0, float slr, char* lds) {
  const FA_GAS bf16_t* Qb = (const FA_GAS bf16_t*)Qb_; const FA_GAS bf16_t* Kh = (const FA_GAS bf16_t*)Kh_; const FA_GAS bf16_t* Vh = (const FA_GAS bf16_t*)Vh_;
  const FA_GAS unsigned* maskrow = (const FA_GAS unsigned*)maskrow_; FA_GAS bf16_t* Ob = (FA_GAS bf16_t*)Ob_;
  int tid_ = threadIdx.x; asm volatile("" : "+v"(tid_));
  const int tid = tid_, wid = tid >> 6, lane = tid & 63, r32 = lane & 31, hi = lane >> 5;
  char* V_lds = lds; char* K_lds = lds + 2 * SHM_V;
  float* wsm = (float*)(lds + 2 * SHM_V + 2 * SHM_K) + wid * 64; float* li_l = wsm; float* al_l = wsm + 32;
  float m_reg = -1e30f, l_reg = 0; f32x16 o[4] = {}; bf16x8 qr[8];
  const FA_GAS bf16_t* Qw = Qb + (long)(wid * QBLK + r32) * LDX + hi * 8;
#pragma unroll
  for (int d0 = 0; d0 < 8; ++d0) qr[d0] = *reinterpret_cast<const FA_GAS bf16x8*>(Qw + d0 * 16);
  const unsigned moff = (unsigned)(wid * QBLK + r32) * 256u;
  const float qposf = (float)(qpos0 + wid * QBLK + r32 - 4 * hi);
  const int sr = tid >> 4, sc = (tid & 15) * 8, vst0 = v_st(sr, sc), vst1 = v_st(32 + sr, sc);
  const int vb0 = (int)(uintptr_t)V_lds + v_rd_base(lane);
  constexpr int SDEPTH = 1;
  struct { bf16x8 vs0, vs1, ks0, ks1; } sr_[SDEPTH];
#define KOFF(j) ((NT - 1 - (j)) * KVBLK)
#define SLOAD(i, k0) do { sr_[i].vs0 = *reinterpret_cast<const FA_GAS bf16x8*>(&Vh[(long)((k0) + sr) * LDX + sc]); sr_[i].vs1 = *reinterpret_cast<const FA_GAS bf16x8*>(&Vh[(long)((k0) + 32 + sr) * LDX + sc]); \
    sr_[i].ks0 = *reinterpret_cast<const FA_GAS bf16x8*>(&Kh[(long)((k0) + sr) * LDX + sc]); sr_[i].ks1 = *reinterpret_cast<const FA_GAS bf16x8*>(&Kh[(long)((k0) + 32 + sr) * LDX + sc]); } while (0)
#define SWRITE(b, i) do { *(bf16x8*)(V_lds + (b) * SHM_V + vst0) = sr_[i].vs0;          \
    *(bf16x8*)(V_lds + (b) * SHM_V + vst1) = sr_[i].vs1; int kc = sc * 2;               \
    *(bf16x8*)(K_lds + (b) * SHM_K + KSWZ(sr, kc)) = sr_[i].ks0;                       \
    *(bf16x8*)(K_lds + (b) * SHM_K + KSWZ(32 + sr, kc)) = sr_[i].ks1; } while (0)
#define SWAIT() do { if constexpr (SDEPTH == 2) asm volatile("s_waitcnt vmcnt(4)" ::: "memory"); else asm volatile("s_waitcnt vmcnt(0)" ::: "memory"); } while (0)
#define RESC(a) do { if (__any((a) < 1.f)) { if (hi == 0) al_l[r32] = (a); asm volatile("s_waitcnt lgkmcnt(0)" ::: "memory"); \
    _Pragma("unroll") for (int d = 0; d < 4; ++d) _Pragma("unroll") for (int r = 0; r < 16; ++r) o[d][r] *= al_l[crow(r, hi)]; } } while (0)
#define MASKW(j) (*reinterpret_cast<const FA_GAS u32x2*>(maskrow + (moff + 2u * (unsigned)(NT - 1 - (j)))))
#define MB(P0, P1, j, MW) mask_bias(P0, P1, MW, qposf - (float)KOFF(j), slr, hi)
  f32x16 pA0, pA1, pB0, pB1; float mnA, mnB, alA, alB; bf16x8 pa0, pa1, pa2, pa3;
  constexpr int SE = 0, SO = SDEPTH - 1;
  SLOAD(SE, KOFF(0)); asm volatile("s_waitcnt vmcnt(0)" ::: "memory"); SWRITE(0, SE); __syncthreads();
  u32x2 mA = MASKW(0), mB = MASKW(1);
  { qkt(pA0, pA1, K_lds, qr, r32, hi); MB(pA0, pA1, 0, mA); } partialSM(pA0, pA1, m_reg, mnA, alA);
  SLOAD(SO, KOFF(1)); if constexpr (SDEPTH == 2) { if (2 < NT) SLOAD(SE, KOFF(2)); }
  SWAIT(); SWRITE(1, SO); __syncthreads();
  for (int j = 1; j + 1 < NT; j += 2) {
    SBAR(); mA = MASKW(j + 1); { qkt(pB0, pB1, K_lds + SHM_K, qr, r32, hi); MB(pB0, pB1, j, mB); }
    finishSM(pA0, pA1, alA, l_reg, pa0, pa1, pa2, pa3); SBAR();
    SLOAD(SO, KOFF(j + SDEPTH)); SBAR();
    pv_d0(o, vb0, pa0, pa1, pa2, pa3); partialSM(pB0, pB1, m_reg, mnB, alB);
    __syncthreads(); SWAIT(); SWRITE(0, SE);
    RESC(alB); __syncthreads();
    SBAR(); mB = MASKW(j + 2); { qkt(pA0, pA1, K_lds, qr, r32, hi); MB(pA0, pA1, j + 1, mA); }
    finishSM(pB0, pB1, alB, l_reg, pa0, pa1, pa2, pa3); SBAR();
    if (SDEPTH == 1 || j + 3 < NT) SLOAD(SE, KOFF(j + 1 + SDEPTH)); SBAR();
    pv_d0(o, vb0 + (int)SHM_V, pa0, pa1, pa2, pa3); partialSM(pA0, pA1, m_reg, mnA, alA);
    __syncthreads(); SWAIT(); SWRITE(1, SO);
    RESC(alA); __syncthreads();
  }
  SBAR(); { qkt(pB0, pB1, K_lds + SHM_K, qr, r32, hi); MB(pB0, pB1, NT - 1, mB); }
  finishSM(pA0, pA1, alA, l_reg, pa0, pa1, pa2, pa3); SBAR();
  pv_d0(o, vb0, pa0, pa1, pa2, pa3); partialSM(pB0, pB1, m_reg, mnB, alB);
  __syncthreads(); RESC(alB);
  finishSM(pB0, pB1, alB, l_reg, pa0, pa1, pa2, pa3); SBAR();
  pv_d0(o, vb0 + (int)SHM_V, pa0, pa1, pa2, pa3);
  if (hi == 0) li_l[r32] = l_reg; asm volatile("s_waitcnt lgkmcnt(0)" ::: "memory");
  float rli[16];
#pragma unroll
  for (int r = 0; r < 16; ++r) rli[r] = __builtin_amdgcn_rcpf(li_l[crow(r, hi)]);
  FA_GAS bf16_t* Ow = Ob + (long)(wid * QBLK) * LDX;
#pragma unroll
  for (int r = 0; r < 16; ++r) { int orow = crow(r, hi);
#pragma unroll
    for (int d0 = 0; d0 < 4; ++d0) Ow[(long)orow * LDX + d0 * 32 + r32] = (bf16_t)(cvt_pk(o[d0][r] * rli[r], 0.f) & 0xffffu); }
  __syncthreads();
#undef KOFF
#undef SLOAD
#undef SWRITE
#undef SWAIT
#undef RESC
#undef MASKW
#undef MB
}
#undef KSWZ
#undef SBAR
}

__device__ __forceinline__ void phase_attention(const Args& a, char* lds, int G, int bid) {
    unsigned char* ws = uni_ptr(a.ws);
    const bf16_t* BQ = (const bf16_t*)(ws + WS_BQ); const bf16_t* BK = (const bf16_t*)(ws + WS_BK); const bf16_t* BV = (const bf16_t*)(ws + WS_BV);
    const unsigned* MASK = (const unsigned*)(ws + WS_MASK); bf16_t* BRB = (bf16_t*)(ws + WS_BRB);
    const int bx = bid; const int vcu = (G % 8 == 0) ? (bx % 8) * (G / 8) + bx / 8 : bx;
    for (int p0 = vcu; p0 < 256; p0 += G) { const int p = __builtin_amdgcn_readfirstlane(p0);
        const int b = p >> 7, h = (p >> 4) & 7, x = p & 15;
        const float slr = uni_f((1.0f / fa::SCALE) / (float)(2 << h));
#pragma unroll 1
        for (int half = 0; half < 2; ++half) { const int qb = half ? 31 - x : x; const size_t row0 = (size_t)b * SEQ + qb * 256;
            fa::attn_block(uni_ptr(BQ + row0 * 1024 + h * 128), uni_ptr(BK + (size_t)b * SEQ * 1024 + h * 128), uni_ptr(BV + (size_t)b * SEQ * 1024 + h * 128),
                           uni_ptr(MASK + row0 * 256), uni_ptr(BRB + row0 * 1024 + h * 128), 4 * (qb + 1), qb * 256, slr, lds); }
    }
}


constexpr int NPH = 13;
#ifndef REPS
#define REPS 1,1,1,1,1,1,1,1,1,1,1,1,1,1,1,1
#endif
constexpr int REP[16] = {REPS};
__global__ void __launch_bounds__(NTHR, 2) mk_fwd(Args a) {
    extern __shared__ __attribute__((aligned(16))) unsigned char lds_raw[];
    LAS unsigned char* lds = (LAS unsigned char*)lds_raw;
    cg::grid_group grid = cg::this_grid();
    const int G = gridDim.x;
#define FRESH_TID() int tid = threadIdx.x; asm volatile("" : "+v"(tid)); const int lane = tid & 63, wave = tid >> 6; (void)lane; (void)wave

    unsigned char* ws = a.ws;
    const int lo = a.ph_lo, hi = a.ph_hi;
#define IN(k) (lo <= (k) && (k) < hi)
    if (threadIdx.x == 0) { ((volatile LAS unsigned*)(lds + LDS_BARST))[0] = 0u; ((volatile LAS unsigned*)(lds + LDS_BARST))[1] = 0u; }
    __syncthreads();
    (void)xcd_barrier_post((unsigned*)(ws + WS_CTL) + CW_BAR, (volatile LAS unsigned*)(lds + LDS_BARST));
    int bid = blockIdx.x;
    if (lo == 0 && hi == NPH && (G % 8) == 0) {
        if (threadIdx.x == 0) { const unsigned x = xb_xcc_id(); const unsigned r = atomicAdd((unsigned*)(ws + WS_CTL) + CW_TICKET + 64 * x, 1u); ((volatile LAS unsigned*)(lds + LDS_BARST))[2] = r * 8u + (x & 7u); }
    }
#define SEAM(k) do { if (IN(k) && IN((k) + 1)) { if (lo < 0) grid.sync();   else { XcdBarrier b_; b_.bar = (unsigned*)(a.ws + WS_CTL) + CW_BAR; b_.x = xb_xcc_id(); b_.st = (volatile LAS unsigned*)(lds + LDS_BARST); xcd_barrier(b_); } } } while (0)

    if (IN(0)) { FRESH_TID(); for (int rp = 0; rp < REP[0]; ++rp) { phase_prologue(a, lds, tid, G); __syncthreads(); } }
    SEAM(0);
    if (lo == 0 && hi == NPH && (G % 8) == 0) {
        const unsigned* bw = (const unsigned*)(ws + WS_CTL) + CW_BAR; bool ok = true;
        for (int j = 0; j < 8; ++j) ok = ok && (__hip_atomic_load(bw + XB_XCNT(j), __ATOMIC_RELAXED, __HIP_MEMORY_SCOPE_AGENT) == (unsigned)(G / 8));
        if (ok) bid = __builtin_amdgcn_readfirstlane((int)((volatile LAS unsigned*)(lds + LDS_BARST))[2]);
    }
    if (IN(1)) { FRESH_TID(); pg8::Gemm g{(const bf16_t*)(ws + WS_XB), (const bf16_t*)(ws + WS_WIN), MT, NPROJ_PAD, DM}; pg8::StaticOrder S; S.init(MT, NPROJ_PAD, G, bid);
        for (int c8 = tid; c8 < NPROJ_PAD / 2; c8 += NTHR) { const int c = 2 * c8; float b0 = 0.f, b1 = 0.f;
            if (c < 7752) { b0 = a.in[I_BIN][c]; b1 = a.in[I_BIN][c + 1]; } else if (c >= 7936) { b0 = a.in[I_BIN][c - 184]; b1 = a.in[I_BIN][c - 183]; }
            *(LAS unsigned*)(lds + LDS_BIAS + c * 2) = cvt_pk(b0, b1); }
        __syncthreads();
        pg8::EpiProj E{ws, lds + LDS_BIAS};
        for (int rp = 0; rp < REP[1]; ++rp) pg8::gemm_phase<pg8::EpiProj, pg8::StaticOrder, true, true>(lds, g, S, E); }
    SEAM(1);
    if (IN(2)) { FRESH_TID(); hg_fill_lb(a, lds, tid);
        for (int rp = 0; rp < REP[2]; ++rp) for (int u = blockIdx.x; u < 2048; u += G) hgrn1_unit(a, u, lds, tid);
        for (int rp = 0; rp < REP[3]; ++rp) for (int k = 0; k * G < MT / 4; ++k) { const int u = k * G + ((k & 1) ? (G - 1 - (int)blockIdx.x) : (int)blockIdx.x); if (u < MT / 4) indexer_unit(a, u, lds, tid); } }
    SEAM(2);
    if (IN(3)) { FRESH_TID(); for (int rp = 0; rp < REP[4]; ++rp) hgrn_scan(a, tid, G);
        for (int rp = 0; rp < REP[5]; ++rp) phase_attention(a, (char*)lds_raw, G, bid); }
    SEAM(3);
    if (IN(4)) { FRESH_TID(); for (int rp = 0; rp < REP[6]; ++rp) { float z[16]; unsigned qq[16], vv[16]; u32x4 stp[4]; u32x2 gwn[4];
            if ((int)blockIdx.x < 2048) hg3_load(a, blockIdx.x, tid, z, qq, vv, stp, gwn);
            hg_fill_lb(a, lds, tid);
            for (int u = blockIdx.x; u < 2048; u += G) hgrn3_unit(a, u, (u + G < 2048) ? u + G : -1, lds, tid, z, qq, vv, stp, gwn); } }
    SEAM(4);
    if (IN(5)) { FRESH_TID(); for (int rp = 0; rp < REP[7]; ++rp) {
        { pg8::Gemm g{(const bf16_t*)(ws + WS_BRA), (const bf16_t*)(ws + WS_WA), MT, DM, 1024}; pg8::StaticOrder S; S.init(MT, DM, G, bid);
          pg8::EpiBranch<0> E{(bf16_t*)(ws + WS_MERGED), (const bf16_t*)(ws + WS_GATES)};
          pg8::gemm_phase<pg8::EpiBranch<0>, pg8::StaticOrder, true, true>(lds, g, S, E); }
        { pg8::Gemm g{(const bf16_t*)(ws + WS_BRB), (const bf16_t*)(ws + WS_WB), MT, DM, 1024}; pg8::StaticOrder S; S.init(MT, DM, G, bid);
          pg8::EpiBranch<1> E{(bf16_t*)(ws + WS_MERGED), (const bf16_t*)(ws + WS_GATES)};
          pg8::gemm_phase<pg8::EpiBranch<1>, pg8::StaticOrder, true, true>(lds, g, S, E); } } }
    SEAM(6);
    if (IN(7)) { FRESH_TID(); pg8::Gemm g{(const bf16_t*)(ws + WS_MERGED), (const bf16_t*)(ws + WS_WOUT), MT, DM, DM}; pg8::StaticOrder S; S.init(MT, DM, G, bid);
        pg8::EpiResBf16 E{(bf16_t*)(ws + WS_PRE1), a.in[I_X], DN_ALPHA};
        for (int rp = 0; rp < REP[8]; ++rp) pg8::gemm_phase<pg8::EpiResBf16, pg8::StaticOrder, true, true>(lds, g, S, E); }
    SEAM(7);
    if (IN(8)) { FRESH_TID(); for (int rp = 0; rp < REP[9]; ++rp) phase8_router_expw(a, lds, tid, G, rp == 0, rp == 0);
        for (int rp = 1; rp < REP[10]; ++rp) phase_expert_weights(a, lds, tid, G); }
    if (IN(8) && IN(10)) { XcdBarrier b_; b_.bar = (unsigned*)(a.ws + WS_CTL) + CW_BAR; b_.x = xb_xcc_id(); b_.st = (volatile LAS unsigned*)(lds + LDS_BARST); xcd_barrier(b_); }
    if (IN(10)) { FRESH_TID(); const unsigned* ctl = (const unsigned*)(ws + WS_CTL);
        LAS int* tb = (LAS int*)(lds + LDS_MOE_TB); LAS unsigned* TE = (LAS unsigned*)(lds + LDS_MOE_TE); LAS unsigned* TOK = (LAS unsigned*)(lds + LDS_MOE_TOK);
        __syncthreads(); load_tile_base(a, tb, tid);
        if (tid < NEXP) for (int t = tb[tid]; t < tb[tid + 1]; ++t) TE[t] = (unsigned)tid;
        __syncthreads();
        const int NT = tb[NEXP];
        pg8::GroupedOrder<true> S; S.init(NT, 8, G, bid, TE, TOK);
        { const int* rows = (const int*)(ws + WS_ROWS);
          for (int i = 0; i < 8; ++i) { pg8::Unit u; if (!S.next(i, u)) break;
              if (tid < 256) { const int e = (int)TE[u.pm], pos = (u.pm - tb[e]) * 256 + tid, cnt = (int)ctl[CW_CNT + 64 * e];
                  TOK[i * 256 + tid] = (pos < cnt) ? (unsigned)rows[e * MT + pos] * (unsigned)(DM * 2) : 0u; } } }
        __syncthreads();
        pg8::Gemm g{(const bf16_t*)(ws + WS_H1B), (const bf16_t*)(ws + WS_WGU), NT * 256, 2048, DM};
        pg8::EpiGateUp E{(bf16_t*)(ws + WS_HH)};
        for (int rp = 0; rp < REP[12]; ++rp) pg8::gemm_phase<pg8::EpiGateUp, pg8::GroupedOrder<true>, true, true>(lds, g, S, E); }
    SEAM(10);
    if (IN(11)) { FRESH_TID();
        LAS int* tb = (LAS int*)(lds + LDS_MOE_TB); LAS unsigned* TE = (LAS unsigned*)(lds + LDS_MOE_TE);
        __syncthreads(); load_tile_base(a, tb, tid);
        if (tid < NEXP) for (int t = tb[tid]; t < tb[tid + 1]; ++t) TE[t] = (unsigned)tid;
        __syncthreads();
        const int NT = tb[NEXP];
        pg8::Gemm g{(const bf16_t*)(ws + WS_HH), (const bf16_t*)(ws + WS_WD), NT * 256, 2048, DFF}; pg8::GroupedOrder<false> S; S.init(NT, 8, G, bid, TE, nullptr);
        pg8::EpiStoreBf16 E{(bf16_t*)(ws + WS_Y), DM, uni_f((float)(G > 0))};
        for (int rp = 0; rp < REP[13]; ++rp) pg8::gemm_phase<pg8::EpiStoreBf16, pg8::GroupedOrder<false>, true, true>(lds, g, S, E); }
    SEAM(11);
    if (IN(12)) { FRESH_TID(); LAS int* tb = (LAS int*)lds; __syncthreads(); load_tile_base(a, tb, tid);
        for (int rp = 0; rp < REP[14]; ++rp) for (int r = blockIdx.x * NWAVES + wave; r < MT; r += G * NWAVES) final_row(a, r, lane, tb); }
#undef IN
#undef SEAM
}

#ifndef MK_SPLIT
#define MK_SPLIT 0
#endif
extern "C" void kernel_launch(void* const* d_in, const int* in_sizes, int n_in, void* d_out, int out_size, void* d_ws, size_t ws_size, hipStream_t stream) {
    static int grid = 0;
    if (grid == 0) {
        int dev = 0, cus = 0, per_cu = 0;
        if (n_in != 19 || out_size != MT * DM || ws_size < WS_END) { fprintf(stderr, "kernel_launch: unexpected shapes: n_in %d out %d ws %zu (need %zu)\n", n_in, out_size, ws_size, (size_t)WS_END); grid = -1; return; }
        if (hipGetDevice(&dev) != hipSuccess || hipDeviceGetAttribute(&cus, hipDeviceAttributeMultiprocessorCount, dev) != hipSuccess) { grid = -1; return; }
        if (hipFuncSetAttribute((const void*)mk_fwd, hipFuncAttributeMaxDynamicSharedMemorySize, LDS_BYTES) != hipSuccess) { fprintf(stderr, "kernel_launch: hipFuncSetAttribute failed\n"); grid = -1; return; }
        if (hipOccupancyMaxActiveBlocksPerMultiprocessor(&per_cu, (const void*)mk_fwd, NTHR, LDS_BYTES) != hipSuccess || per_cu < 1) { fprintf(stderr, "kernel_launch: occupancy query says %d blocks/CU\n", per_cu); grid = -1; return; }
        grid = cus;
    }
    if (grid < 0) return;
    (void)hipMemsetAsync((char*)d_ws + WS_CTL, 0, 1 * MiB, stream);
    Args a{};
    for (int i = 0; i < 19; ++i) a.in[i] = (const float*)d_in[i];
    a.out = (float*)d_out; a.ws = (unsigned char*)d_ws;
#if MK_SPLIT
    for (int p = 0; p < NPH; ++p) { a.ph_lo = p; a.ph_hi = p + 1; void* args[] = {&a};
        hipError_t e = hipLaunchCooperativeKernel((const void*)mk_fwd, dim3(grid), dim3(NTHR), args, LDS_BYTES, stream);
        if (e != hipSuccess) { fprintf(stderr, "cooperative launch (phase %d) failed: %s (grid %d)\n", p, hipGetErrorString(e), grid); break; } }
#else
    a.ph_lo = 0; a.ph_hi = NPH; void* args[] = {&a};
    hipError_t e = hipLaunchCooperativeKernel((const void*)mk_fwd, dim3(grid), dim3(NTHR), args, LDS_BYTES, stream);
    if (e != hipSuccess) fprintf(stderr, "cooperative launch failed: %s (grid %d)\n", hipGetErrorString(e), grid);
#endif
}
```

```cpp
#include <hip/hip_runtime.h>
#include <hip/hip_cooperative_groups.h>
#include <cstdio>
#include <cstdint>
namespace cg = cooperative_groups;

#define LAS __attribute__((address_space(3)))
typedef unsigned short bf16_t;
typedef short bf16x8 __attribute__((ext_vector_type(8)));
typedef float f32x4 __attribute__((ext_vector_type(4)));
typedef float f32x2 __attribute__((ext_vector_type(2)));
typedef float f32x16 __attribute__((ext_vector_type(16)));
typedef unsigned u32x4 __attribute__((ext_vector_type(4)));
typedef unsigned u32x2 __attribute__((ext_vector_type(2)));

constexpr int MT = 16384, SEQ = 8192, DM = 2048, NHEAD = 8, HD = 128, NPROJ = 11848, NPROJ_PAD = 12032;
constexpr int NEXP = 32, DFF = 1024, MAXROWS = 40960;
constexpr float DN_ALPHA = 1.189207115002721f;
constexpr float LN_EPS = 1e-5f, RMS_EPS = 1e-6f;
constexpr int NWAVES = 8, NTHR = 512;
constexpr int LDS_BYTES = 163840;

constexpr size_t MiB = 1u << 20;
constexpr size_t WS_CTL = 0;
constexpr size_t WS_WIN = 1 * MiB;
constexpr size_t WS_WA = 48 * MiB, WS_WB = 52 * MiB, WS_WOUT = 56 * MiB;
constexpr size_t WS_XB = 64 * MiB;
constexpr size_t WS_MERGED = 64 * MiB;
constexpr size_t WS_AQ = 128 * MiB, WS_AI = 160 * MiB, WS_AG = 192 * MiB, WS_BQ = 224 * MiB, WS_BK = 256 * MiB, WS_BV = 288 * MiB;
constexpr size_t WS_AF = 320 * MiB;
constexpr size_t WS_IQ = 384 * MiB;
constexpr size_t WS_IKW = 400 * MiB;
constexpr size_t WS_GATES = 408 * MiB;
constexpr size_t WS_WGU = 128 * MiB;
constexpr size_t WS_WD = 384 * MiB;
constexpr size_t WS_MASK = 536 * MiB;
constexpr size_t WS_KV = 552 * MiB;
constexpr size_t WS_PRE1 = 552 * MiB;
constexpr size_t WS_ST = 680 * MiB;
constexpr size_t WS_H1B = 680 * MiB;
constexpr size_t WS_DECAY = 744 * MiB;
constexpr size_t WS_ROWS = 745 * MiB;
constexpr size_t WS_SLOT = 747 * MiB;
constexpr size_t WS_BRA = 750 * MiB, WS_BRB = 782 * MiB;
constexpr size_t WS_IK2 = 814 * MiB;
constexpr size_t WS_HH = 750 * MiB;
constexpr size_t WS_XG = 830 * MiB;
constexpr size_t WS_Y = 830 * MiB;
constexpr size_t WS_END = 990 * MiB;
constexpr int CW_CNT = 1024;
constexpr int CW_NT = 4096;
constexpr int CW_TILEE = 4160;
constexpr int CW_TBASE = 4400;
constexpr int CW_BAR = 8192;
constexpr int CW_TICKET = 12288;
constexpr int LDS_BIAS = 131072;
constexpr int LDS_MOE_TB = 131072, LDS_MOE_TE = 131072 + 256, LDS_MOE_TOK = 131072 + 1024;
constexpr int LDS_BARST = LDS_BYTES - 64;

__device__ __forceinline__ float bf2f(unsigned h) { return __uint_as_float(h << 16); }
__device__ __forceinline__ unsigned cvt_pk(float lo, float hi) { unsigned r; asm volatile("v_cvt_pk_bf16_f32 %0, %1, %2" : "=v"(r) : "v"(lo), "v"(hi)); return r; }
__device__ __forceinline__ unsigned cvt_pk_mfma(float lo, float hi) { unsigned r; asm volatile("s_nop 15\n\ts_nop 3\n\tv_cvt_pk_bf16_f32 %0, %1, %2" : "=v"(r) : "v"(lo), "v"(hi)); return r; }
__device__ __forceinline__ unsigned cvt_pk_to_mfma(float lo, float hi) { unsigned r; asm volatile("v_cvt_pk_bf16_f32 %0, %1, %2\n\ts_nop 1" : "=v"(r) : "v"(lo), "v"(hi)); return r; }
__device__ __forceinline__ float wave_sum(float v) {
#pragma unroll
    for (int o = 1; o < 64; o <<= 1) v += __shfl_xor(v, o);
    return v;
}
__device__ __forceinline__ float fast_exp(float x) { return __builtin_amdgcn_exp2f(x * 1.4426950408889634f); }
__device__ __forceinline__ float sigmoidf_(float x) { return __builtin_amdgcn_rcpf(1.0f + __expf(-x)); }
#define LDS_WAIT() asm volatile("s_waitcnt lgkmcnt(0)" ::: "memory")
template <typename T> __device__ __forceinline__ T* uni_ptr(T* p) { const unsigned long long v = (unsigned long long)p; const unsigned lo = __builtin_amdgcn_readfirstlane((unsigned)v), hi = __builtin_amdgcn_readfirstlane((unsigned)(v >> 32)); return (T*)(((unsigned long long)hi << 32) | lo); }
__device__ __forceinline__ float uni_f(float x) { return __uint_as_float(__builtin_amdgcn_readfirstlane(__float_as_uint(x))); }

namespace pg8 {
#define PG8_LAS __attribute__((address_space(3)))
typedef unsigned short bf16_t;
typedef short bf16x8 __attribute__((ext_vector_type(8)));
typedef float f32x4 __attribute__((ext_vector_type(4)));
typedef unsigned u32x4 __attribute__((ext_vector_type(4)));
constexpr int BM = 256, BK = 64, HALF = 128, HTB = HALF * BK * 2  , STAGE_BYTES = 8 * HTB, NXCD = 8, WGM = 8;

__host__ __device__ __forceinline__ int lds_byte(int r, int c) { const int st = (r >> 4) * 2 + (c >> 5), rr = r & 15, cc = c & 31, ob = rr * 64 + cc * 2; return st * 1024 + (ob ^ (((ob >> 9) & 1) << 5)); }
__host__ __device__ __forceinline__ void stage_rc(int b, int& R, int& C) { const int st = b / 1024, sb = b % 1024, swz = sb ^ (((sb >> 9) & 1) << 5); R = (st >> 1) * 16 + swz / 64; C = (st & 1) * 32 + (swz % 64) / 2; }
__host__ __device__ __forceinline__ int perm32(int rho) { const int n = rho >> 4, i = rho & 15; return 8 * (i >> 2) + 4 * n + (i & 3); }

struct Unit { int pm, pn, pb; };
struct Gemm { const bf16_t* A; const bf16_t* Bt; int M, N, K; };

struct StaticOrder {
    static constexpr bool GATHER = false; __device__ __forceinline__ unsigned row_off(int, int) const { return 0u; }
    int nM, nN, nwg, G, c;
    __host__ __device__ void init(int M, int N, int G_, int c_) { nM = M / BM; nN = N / BM; nwg = nM * nN; G = G_; c = c_; }
    __host__ __device__ bool next(int i, Unit& u) const {
        const long L = (long)i * G + c; if (L >= nwg) return false;
        int wgid = (int)L; { const int q = nwg / NXCD, r = nwg % NXCD, xcd = wgid % NXCD, off = wgid / NXCD; wgid = (xcd < r ? xcd * (q + 1) : r * (q + 1) + (xcd - r) * q) + off; }
        const int nig = WGM * nN, gid = wgid / nig, fm = gid * WGM, gsz = (nM - fm) < WGM ? (nM - fm) : WGM;
        u.pm = fm + ((wgid % nig) % gsz); u.pn = (wgid % nig) / gsz; u.pb = u.pn; return true;
    }
    __device__ __forceinline__ void a_ready(const Unit&) const {}
    __device__ __forceinline__ void done(const Unit&) const {}
};


__device__ __forceinline__ unsigned cvt_pk_bf16(float lo, float hi) { unsigned r; asm volatile("v_cvt_pk_bf16_f32 %0, %1, %2" : "=v"(r) : "v"(lo), "v"(hi)); return r; }
__device__ __forceinline__ float sigm(float x) { return __builtin_amdgcn_rcpf(1.0f + __expf(-x)); }

struct EpiProj {
    static constexpr bool PERM = true, AFTER_DRAIN = false;
    unsigned char* ws; const PG8_LAS unsigned char* lbias;
    __device__ __forceinline__ void operator()(const f32x4 (&acc)[2][2][4][2], const Unit& u, int wr, int wc, int fr, int fq) const {
        const int pn = u.pn, row0 = u.pm * BM + wr * 64 + fr, lc0 = wc * 32 + 8 * fq;
        f32x4 bv[2][2];
#pragma unroll
        for (int bj = 0; bj < 2; ++bj) { const u32x4 bw = *(const PG8_LAS u32x4*)(lbias + (size_t)(pn * 256 + lc0 + bj * HALF) * 2);
            bv[bj][0] = (f32x4){__uint_as_float(bw.x << 16), __uint_as_float(bw.x & 0xffff0000u), __uint_as_float(bw.y << 16), __uint_as_float(bw.y & 0xffff0000u)};
            bv[bj][1] = (f32x4){__uint_as_float(bw.z << 16), __uint_as_float(bw.z & 0xffff0000u), __uint_as_float(bw.w << 16), __uint_as_float(bw.w & 0xffff0000u)}; }
        if (pn >= 4 && pn < 8) {
            float* base = (float*)(ws + WS_AF);
#pragma unroll
            for (int ai = 0; ai < 2; ++ai)
#pragma unroll
                for (int m = 0; m < 4; ++m) { float* rowp = base + (size_t)(row0 + ai * HALF + m * 16) * 1024 + (pn - 4) * 256 + lc0;
#pragma unroll
                    for (int bj = 0; bj < 2; ++bj) { *(f32x4*)(rowp + bj * HALF) = acc[ai][bj][m][0] + bv[bj][0]; *(f32x4*)(rowp + bj * HALF + 4) = acc[ai][bj][m][1] + bv[bj][1]; } }
            return;
        }
        bf16_t* base; int ldc, colt; bool sg = false;
        if (pn < 28) { const int s = pn >> 2, idx = (s == 0) ? 0 : s - 1; base = (bf16_t*)(ws + WS_AQ + (size_t)idx * (32 * MiB)); ldc = 1024; colt = (pn & 3) * 256; }
        else if (pn < 30) { base = (bf16_t*)(ws + WS_IQ); ldc = 512; colt = (pn - 28) * 256; }
        else if (pn == 30) { base = (bf16_t*)(ws + WS_IKW); ldc = 256; colt = 0; }
        else { base = (bf16_t*)(ws + WS_GATES); ldc = 4096; colt = (pn - 31) * 256; sg = true; }
#pragma unroll
        for (int ai = 0; ai < 2; ++ai)
#pragma unroll
            for (int m = 0; m < 4; ++m) { bf16_t* rowp = base + (size_t)(row0 + ai * HALF + m * 16) * ldc + colt + lc0;
#pragma unroll
                for (int bj = 0; bj < 2; ++bj) { f32x4 v0 = acc[ai][bj][m][0] + bv[bj][0], v1 = acc[ai][bj][m][1] + bv[bj][1];
                    if (sg) { v0 = (f32x4){sigm(v0[0]), sigm(v0[1]), sigm(v0[2]), sigm(v0[3])}; v1 = (f32x4){sigm(v1[0]), sigm(v1[1]), sigm(v1[2]), sigm(v1[3])}; }
                    u32x4 w; w.x = cvt_pk_bf16(v0[0], v0[1]); w.y = cvt_pk_bf16(v0[2], v0[3]); w.z = cvt_pk_bf16(v1[0], v1[1]); w.w = cvt_pk_bf16(v1[2], v1[3]);
                    *(u32x4*)(rowp + bj * HALF) = w;
                    if (pn == 30 && bj == 0 && lc0 < 64) {
                        const int tok = row0 + ai * HALF + m * 16;
                        *(u32x4*)((bf16_t*)(ws + WS_IK2) + ((size_t)((tok >> 5) * 4 + (lc0 >> 4)) * 64 + ((lc0 >> 3) & 1) * 32 + (tok & 31)) * 8) = w; } } }
    }
};

__device__ __forceinline__ f32x4 bf4lo(u32x4 w) { return (f32x4){__uint_as_float(w.x << 16), __uint_as_float(w.x & 0xffff0000u), __uint_as_float(w.y << 16), __uint_as_float(w.y & 0xffff0000u)}; }
__device__ __forceinline__ f32x4 bf4hi(u32x4 w) { return (f32x4){__uint_as_float(w.z << 16), __uint_as_float(w.z & 0xffff0000u), __uint_as_float(w.w << 16), __uint_as_float(w.w & 0xffff0000u)}; }

template <int MODE> struct EpiBranch {
    static constexpr bool PERM = true, AFTER_DRAIN = false;
    bf16_t* merged; const bf16_t* gates;
    __device__ __forceinline__ void operator()(const f32x4 (&acc)[2][2][4][2], const Unit& u, int wr, int wc, int fr, int fq) const {
        const int row0 = u.pm * BM + wr * 64 + fr, col0 = u.pn * BM + wc * 32 + 8 * fq;
#pragma unroll
        for (int ai = 0; ai < 2; ++ai)
#pragma unroll
            for (int m = 0; m < 4; ++m) { const size_t r = (size_t)(row0 + ai * HALF + m * 16);
#pragma unroll
                for (int bj = 0; bj < 2; ++bj) { const int c = col0 + bj * HALF;
                    const u32x4 gw = *(const u32x4*)(gates + r * 4096 + MODE * 2048 + c);
                    f32x4 v0 = acc[ai][bj][m][0] * bf4lo(gw), v1 = acc[ai][bj][m][1] * bf4hi(gw);
                    if (MODE == 1) { const u32x4 pw = *(const u32x4*)(merged + r * 2048 + c); v0 = v0 + bf4lo(pw); v1 = v1 + bf4hi(pw); }
                    u32x4 w; w.x = cvt_pk_bf16(v0[0], v0[1]); w.y = cvt_pk_bf16(v0[2], v0[3]); w.z = cvt_pk_bf16(v1[0], v1[1]); w.w = cvt_pk_bf16(v1[2], v1[3]);
                    *(u32x4*)(merged + r * 2048 + c) = w; } }
    }
};

struct EpiResBf16 {
    static constexpr bool PERM = true, AFTER_DRAIN = false;
    bf16_t* C; const float* x; float alpha;
    __device__ __forceinline__ void operator()(const f32x4 (&acc)[2][2][4][2], const Unit& u, int wr, int wc, int fr, int fq) const {
        const int row0 = u.pm * BM + wr * 64 + fr, col0 = u.pn * BM + wc * 32 + 8 * fq;
#pragma unroll
        for (int ai = 0; ai < 2; ++ai)
#pragma unroll
            for (int m = 0; m < 4; ++m) { const size_t off = (size_t)(row0 + ai * HALF + m * 16) * 2048 + col0;
#pragma unroll
                for (int bj = 0; bj < 2; ++bj) { const f32x4 x0 = *(const f32x4*)(x + off + bj * HALF), x1 = *(const f32x4*)(x + off + bj * HALF + 4);
                    const f32x4 v0 = x0 * alpha + acc[ai][bj][m][0], v1 = x1 * alpha + acc[ai][bj][m][1];
                    u32x4 w; w.x = cvt_pk_bf16(v0[0], v0[1]); w.y = cvt_pk_bf16(v0[2], v0[3]); w.z = cvt_pk_bf16(v1[0], v1[1]); w.w = cvt_pk_bf16(v1[2], v1[3]);
                    *(u32x4*)(C + off + bj * HALF) = w; } }
    }
};

struct EpiGateUp {
    static constexpr bool PERM = true, AFTER_DRAIN = false;
    bf16_t* H;
    __device__ __forceinline__ void operator()(const f32x4 (&acc)[2][2][4][2], const Unit& u, int wr, int wc, int fr, int fq) const {
        const int row0 = u.pm * BM + wr * 64 + fr, hc0 = u.pn * 128 + wc * 16 + 4 * fq;
#pragma unroll
        for (int ai = 0; ai < 2; ++ai)
#pragma unroll
            for (int m = 0; m < 4; ++m) { bf16_t* rowp = H + (size_t)(row0 + ai * HALF + m * 16) * 1024 + hc0;
#pragma unroll
                for (int bj = 0; bj < 2; ++bj) { const f32x4 g = acc[ai][bj][m][0], up = acc[ai][bj][m][1];
                    f32x4 h;
#pragma unroll
                    for (int j = 0; j < 4; ++j) h[j] = g[j] * sigm(g[j]) * up[j];
                    u32x2 w; w.x = cvt_pk_bf16(h[0], h[1]); w.y = cvt_pk_bf16(h[2], h[3]);
                    *(u32x2*)(rowp + bj * 64) = w; } }
    }
};

struct EpiStoreBf16 {
    static constexpr bool PERM = true, AFTER_DRAIN = false;
    bf16_t* O; int ldc; float one;
    __device__ __forceinline__ void operator()(const f32x4 (&acc)[2][2][4][2], const Unit& u, int wr, int wc, int fr, int fq) const {
        const int row0 = u.pm * BM + wr * 64 + fr, col0 = u.pn * BM + wc * 32 + 8 * fq;
#pragma unroll
        for (int ai = 0; ai < 2; ++ai)
#pragma unroll
            for (int m = 0; m < 4; ++m) { bf16_t* rowp = O + (size_t)(row0 + ai * HALF + m * 16) * ldc + col0;
#pragma unroll
                for (int bj = 0; bj < 2; ++bj) { const f32x4 v0 = acc[ai][bj][m][0] * one, v1 = acc[ai][bj][m][1] * one;
                    u32x4 w; w.x = cvt_pk_bf16(v0[0], v0[1]); w.y = cvt_pk_bf16(v0[2], v0[3]); w.z = cvt_pk_bf16(v1[0], v1[1]); w.w = cvt_pk_bf16(v1[2], v1[3]);
                    *(u32x4*)(rowp + bj * HALF) = w; } }
    }
};

template <bool GATH> struct GroupedOrder {
    static constexpr bool GATHER = GATH;
    int nM, nN, nwg, G, c; const PG8_LAS unsigned* tile_e; const PG8_LAS unsigned* tokoff;
    __device__ __forceinline__ void init(int nT, int nN_, int G_, int c_, const PG8_LAS unsigned* te, const PG8_LAS unsigned* to) { nM = nT; nN = nN_; nwg = nM * nN; G = G_; c = c_; tile_e = te; tokoff = to; }
    __device__ __forceinline__ bool next(int i, Unit& u) const {
        const long L = (long)i * G + c; if (L >= nwg) return false;
        int wgid = (int)L; { const int q = nwg / NXCD, r = nwg % NXCD, xcd = wgid % NXCD, off = wgid / NXCD; wgid = (xcd < r ? xcd * (q + 1) : r * (q + 1) + (xcd - r) * q) + off; }
        const int nig = WGM * nN, gid = wgid / nig, fm = gid * WGM, gsz = (nM - fm) < WGM ? (nM - fm) : WGM;
        u.pm = fm + ((wgid % nig) % gsz); u.pn = (wgid % nig) / gsz; u.pb = (int)tile_e[u.pm] * nN + u.pn; return true;
    }
    __device__ __forceinline__ unsigned row_off(int ui, int r) const { return tokoff[ui * 256 + r]; }
    __device__ __forceinline__ void a_ready(const Unit&) const {}
    __device__ __forceinline__ void done(const Unit&) const {}
};

template <class Epi, class Sched, bool ALIGN_EPI = false, bool SP2 = false>
__device__ __forceinline__ void gemm_phase(PG8_LAS unsigned char* lds, const Gemm g, const Sched& S, const Epi& E) {
    int tid_ = threadIdx.x; asm volatile("" : "+v"(tid_));
    const int tid = tid_, wid = __builtin_amdgcn_readfirstlane(tid >> 6), lane = tid & 63, wr = wid >> 2, wc = wid & 3, fr = lane & 15, fq = lane >> 4;
    const int K = g.K, nt = K / BK;
    constexpr bool GATHER = Sched::GATHER;
    unsigned voffA[2], voffB[2], cAoff[2]; int rA[2];
#pragma unroll
    for (int i = 0; i < 2; ++i) { int R, C; stage_rc(tid * 16 + i * 8192, R, C); const int Rb = Epi::PERM ? ((R & ~31) + perm32(R & 31)) : R;
        voffA[i] = (unsigned)(R * K + C) * 2u; voffB[i] = (unsigned)(Rb * K + C) * 2u; cAoff[i] = (unsigned)C * 2u; rA[i] = R; }
    const size_t kstep = (size_t)(BK * 2);
    const size_t hstep = (size_t)HALF * K * 2;
    const size_t tstep = 2 * hstep;
    const unsigned ldsw = (unsigned)wid * 1024u;
    const int aoff = lds_byte(wr * 64 + fr, fq * 8), boff = lds_byte(wc * 32 + fr, fq * 8);
#define PG8_SA(b, h) (((b) * 2 + (h)) * HTB)
#define PG8_SB(b, h) ((4 + (b) * 2 + (h)) * HTB)
#define PG8_STAGE(bufoff, gbase, voff) do { _Pragma("unroll") for (int _i = 0; _i < 2; ++_i) \
        __builtin_amdgcn_global_load_lds((const unsigned*)((const char*)(gbase) + (voff)[_i]), (PG8_LAS unsigned*)(lds + (bufoff) + ldsw + _i * 8192), 16, 0, 0); } while (0)
#define PG8_STAGE_A(bufoff, gbase, h, nx) do { _Pragma("unroll") for (int _i = 0; _i < 2; ++_i) { const unsigned vo_ = GATHER ? ((nx) ? vAn[h][_i] : vAc[h][_i]) : voffA[_i]; \
        __builtin_amdgcn_global_load_lds((const unsigned*)((const char*)(gbase) + vo_), (PG8_LAS unsigned*)(lds + (bufoff) + ldsw + _i * 8192), 16, 0, 0); } } while (0)
#define PG8_LDA(dst, b, h) do { _Pragma("unroll") for (int m = 0; m < 4; ++m) _Pragma("unroll") for (int k = 0; k < 2; ++k) dst[m][k] = *(const PG8_LAS bf16x8*)(lds + PG8_SA(b, h) + aoff + m * 2048 + k * 1024); } while (0)
#define PG8_LDB(dst, b, h) do { _Pragma("unroll") for (int n = 0; n < 2; ++n) _Pragma("unroll") for (int k = 0; k < 2; ++k) dst[n][k] = *(const PG8_LAS bf16x8*)(lds + PG8_SB(b, h) + boff + n * 2048 + k * 1024); } while (0)
#define PG8_MMA(ai, bj, At, Bt) do { __builtin_amdgcn_s_setprio(1); _Pragma("unroll") for (int m = 0; m < 4; ++m) _Pragma("unroll") for (int n = 0; n < 2; ++n) _Pragma("unroll") for (int k = 0; k < 2; ++k) \
        acc[ai][bj][m][n] = __builtin_amdgcn_mfma_f32_16x16x32_bf16(Bt[n][k], At[m][k], acc[ai][bj][m][n], 0, 0, 0); __builtin_amdgcn_s_setprio(0); } while (0)
#define PG8_WAIT_V(n) asm volatile("s_waitcnt vmcnt(" #n ")" ::: "memory")
#define PG8_WAIT_L(n) asm volatile("s_waitcnt lgkmcnt(" #n ")" ::: "memory")
#define PG8_BAR __builtin_amdgcn_s_barrier()
#define PG8_SCHED __builtin_amdgcn_sched_barrier(0)
    Unit cur, nxt; int ui = 0;
    if (!S.next(0, cur)) return;
    f32x4 acc[2][2][4][2];
#pragma unroll
    for (int a = 0; a < 2; ++a)
#pragma unroll
        for (int b = 0; b < 2; ++b)
#pragma unroll
            for (int m = 0; m < 4; ++m)
#pragma unroll
                for (int n = 0; n < 2; ++n) acc[a][b][m][n] = (f32x4){0.f, 0.f, 0.f, 0.f};
    bf16x8 At[4][2], B0[2][2], B1[2][2];
    const size_t hstepA = GATHER ? 0 : hstep;
    unsigned vAc[2][2], vAn[2][2];
#pragma unroll
    for (int h = 0; h < 2; ++h)
#pragma unroll
        for (int i = 0; i < 2; ++i) { vAc[h][i] = GATHER ? S.row_off(0, h * HALF + rA[i]) + cAoff[i] : 0u; vAn[h][i] = vAc[h][i]; }
    const char* cA = (const char*)g.A + (GATHER ? (size_t)0 : (size_t)cur.pm * tstep); const char* cB = (const char*)g.Bt + (size_t)cur.pb * tstep;
    S.a_ready(cur);
    if constexpr (SP2) {
        PG8_STAGE(PG8_SB(0, 0), cB, voffB); PG8_STAGE(PG8_SB(0, 1), cB + hstep, voffB); PG8_STAGE_A(PG8_SA(0, 0), cA, 0, false); PG8_STAGE_A(PG8_SA(0, 1), cA + hstepA, 1, false);
        if (wr == 1) PG8_BAR;
        PG8_WAIT_V(2); PG8_BAR;
        PG8_STAGE(PG8_SB(1, 0), cB + kstep, voffB); PG8_STAGE_A(PG8_SA(1, 0), cA + kstep, 0, false); PG8_STAGE(PG8_SB(1, 1), cB + hstep + kstep, voffB);
        PG8_WAIT_V(6); PG8_BAR;
    } else {
        PG8_STAGE(PG8_SB(0, 0), cB, voffB); PG8_STAGE_A(PG8_SA(0, 0), cA, 0, false); PG8_STAGE(PG8_SB(0, 1), cB + hstep, voffB); PG8_STAGE_A(PG8_SA(0, 1), cA + hstepA, 1, false);
        if (wr == 1) PG8_BAR;
        PG8_WAIT_V(4); PG8_BAR;
        PG8_STAGE(PG8_SB(1, 0), cB + kstep, voffB); PG8_STAGE_A(PG8_SA(1, 0), cA + kstep, 0, false); PG8_STAGE(PG8_SB(1, 1), cB + hstep + kstep, voffB);
        PG8_WAIT_V(6); PG8_BAR;
    }
    for (;;) {
        const bool has_next = S.next(ui + 1, nxt);
        const char* nA = has_next ? (const char*)g.A + (GATHER ? (size_t)0 : (size_t)nxt.pm * tstep) : cA; const char* nB = has_next ? (const char*)g.Bt + (size_t)nxt.pb * tstep : cB;
        if (GATHER) {
#pragma unroll
            for (int h = 0; h < 2; ++h)
#pragma unroll
                for (int i = 0; i < 2; ++i) vAn[h][i] = has_next ? S.row_off(ui + 1, h * HALF + rA[i]) + cAoff[i] : vAc[h][i]; }
        for (int t = 0; t < nt; t += 2) {
            const bool last = (t == nt - 2);
            const char* a1 = cA + (size_t)(t + 1) * kstep;
            const char* a2 = last ? nA : cA + (size_t)(t + 2) * kstep; const char* b2 = last ? nB : cB + (size_t)(t + 2) * kstep;
            const char* a3 = a2 + kstep; const char* b3 = b2 + kstep;
            if (last && has_next) S.a_ready(nxt);
            if constexpr (SP2) {
            PG8_LDB(B0, 0, 0); PG8_LDB(B1, 0, 1); PG8_SCHED; PG8_LDA(At, 0, 0); PG8_STAGE_A(PG8_SA(1, 1), a1 + hstepA, 1, false);
            PG8_WAIT_V(8); PG8_WAIT_L(0); PG8_BAR; PG8_MMA(0, 0, At, B0); PG8_MMA(0, 1, At, B1); PG8_BAR; PG8_SCHED;
            PG8_LDA(At, 0, 1); PG8_STAGE(PG8_SB(0, 0), b2, voffB); PG8_STAGE(PG8_SB(0, 1), b2 + hstep, voffB); PG8_STAGE_A(PG8_SA(0, 0), a2, 0, last);
            PG8_WAIT_V(8); PG8_WAIT_L(0); PG8_BAR; PG8_MMA(1, 0, At, B0); PG8_MMA(1, 1, At, B1); PG8_BAR; PG8_SCHED;
            PG8_LDB(B0, 1, 0); PG8_LDB(B1, 1, 1); PG8_SCHED; PG8_LDA(At, 1, 0); PG8_STAGE_A(PG8_SA(0, 1), a2 + hstepA, 1, last);
            PG8_WAIT_V(8); PG8_WAIT_L(0); PG8_BAR; PG8_MMA(0, 0, At, B0); PG8_MMA(0, 1, At, B1); PG8_BAR; PG8_SCHED;
            PG8_LDA(At, 1, 1); PG8_STAGE(PG8_SB(1, 0), b3, voffB); PG8_STAGE(PG8_SB(1, 1), b3 + hstep, voffB); PG8_STAGE_A(PG8_SA(1, 0), a3, 0, last);
            PG8_WAIT_V(8); PG8_WAIT_L(0); PG8_BAR; PG8_MMA(1, 0, At, B0); PG8_MMA(1, 1, At, B1); PG8_BAR; PG8_SCHED;
            } else {
            PG8_LDB(B0, 0, 0); PG8_SCHED; PG8_LDA(At, 0, 0); PG8_STAGE_A(PG8_SA(1, 1), a1 + hstepA, 1, false);
            PG8_WAIT_L(8); PG8_BAR; PG8_WAIT_L(0); PG8_MMA(0, 0, At, B0); PG8_BAR; PG8_SCHED;
            PG8_LDB(B1, 0, 1); PG8_STAGE(PG8_SB(0, 0), b2, voffB);
            PG8_BAR; PG8_WAIT_L(0); PG8_MMA(0, 1, At, B1); PG8_BAR;
            PG8_LDA(At, 0, 1); PG8_STAGE_A(PG8_SA(0, 0), a2, 0, last);
            PG8_BAR; PG8_WAIT_L(0); PG8_MMA(1, 0, At, B0); PG8_BAR; PG8_SCHED;
            PG8_STAGE(PG8_SB(0, 1), b2 + hstep, voffB);
            PG8_WAIT_V(6); PG8_BAR; PG8_MMA(1, 1, At, B1); PG8_BAR;
            PG8_LDB(B0, 1, 0); PG8_SCHED; PG8_LDA(At, 1, 0); PG8_STAGE_A(PG8_SA(0, 1), a2 + hstepA, 1, last);
            PG8_WAIT_L(8); PG8_BAR; PG8_WAIT_L(0); PG8_MMA(0, 0, At, B0); PG8_BAR; PG8_SCHED;
            PG8_LDB(B1, 1, 1); PG8_STAGE(PG8_SB(1, 0), b3, voffB);
            PG8_BAR; PG8_WAIT_L(0); PG8_MMA(0, 1, At, B1); PG8_BAR;
            PG8_LDA(At, 1, 1); PG8_STAGE_A(PG8_SA(1, 0), a3, 0, last);
            PG8_BAR; PG8_WAIT_L(0); PG8_MMA(1, 0, At, B0); PG8_BAR; PG8_SCHED;
            PG8_STAGE(PG8_SB(1, 1), b3 + hstep, voffB);
            PG8_WAIT_V(6); PG8_BAR; PG8_MMA(1, 1, At, B1); PG8_BAR;
            }
        }
        if constexpr (ALIGN_EPI) { if (wr == 0) PG8_BAR; }
        if constexpr (!Epi::AFTER_DRAIN) { E(acc, cur, wr, wc, fr, fq); S.done(cur); }
        if (!has_next) break;
#pragma unroll
        for (int a = 0; a < 2; ++a)
#pragma unroll
            for (int b = 0; b < 2; ++b)
#pragma unroll
                for (int m = 0; m < 4; ++m)
#pragma unroll
                    for (int n = 0; n < 2; ++n) acc[a][b][m][n] = (f32x4){0.f, 0.f, 0.f, 0.f};
        cur = nxt; cA = nA; cB = nB; ++ui;
#pragma unroll
        for (int h = 0; h < 2; ++h)
#pragma unroll
            for (int i = 0; i < 2; ++i) vAc[h][i] = vAn[h][i];
        if constexpr (ALIGN_EPI) { if (wr == 1) PG8_BAR; }
    }
    PG8_WAIT_V(0);
    if constexpr (!ALIGN_EPI) { if (wr == 0) PG8_BAR; }
    PG8_BAR;
    if constexpr (Epi::AFTER_DRAIN) { E.fused(acc, cur, wr, wc, fr, fq, lds, wid, lane); S.done(cur); }
#undef PG8_SA
#undef PG8_SB
#undef PG8_STAGE
#undef PG8_STAGE_A
#undef PG8_LDA
#undef PG8_LDB
#undef PG8_MMA
#undef PG8_WAIT_V
#undef PG8_WAIT_L
#undef PG8_BAR
#undef PG8_SCHED
}
}
#define XB_TMO      128
#define XB_XCNT(j)  (256  + 64 * (j))
#define XB_XSUB(j)  (1280 + 64 * (j))
#define XB_XGEN(j)  (2304 + 64 * (j))
#define XB_TOP      3328
#define XB_TOPGEN   3392
#define XCD_BAR_WORDS 3456
#define XB_SPIN_CAP (1u << 18)

__device__ __forceinline__ unsigned xb_ld(unsigned* p)              { return __hip_atomic_load(p, __ATOMIC_RELAXED, __HIP_MEMORY_SCOPE_AGENT); }
__device__ __forceinline__ unsigned xb_add(unsigned* p, unsigned v) { return __hip_atomic_fetch_add(p, v, __ATOMIC_RELAXED, __HIP_MEMORY_SCOPE_AGENT); }
__device__ __forceinline__ unsigned xb_xcc_id() { return (unsigned)__builtin_amdgcn_s_getreg((3 << 11) | 20) & 0xFu; }
#define XB_SPIN(cond, bar) do { unsigned _sp = 0; while (cond) { __builtin_amdgcn_s_sleep(1); \
    if ((++_sp & 255u) == 0u) { if (xb_ld(&(bar)[XB_TMO])) break; if (_sp > XB_SPIN_CAP) { atomicAdd(&(bar)[XB_TMO], 1u); break; } } } } while (0)

struct XcdBarrier {
    unsigned* bar; unsigned x;
    volatile LAS unsigned* st;
};

__device__ __forceinline__ XcdBarrier xcd_barrier_post(unsigned* bar, volatile LAS unsigned* st) {
    XcdBarrier b; b.bar = bar; b.x = xb_xcc_id(); b.st = st;
    if (threadIdx.x == 0) (void)xb_add(&bar[XB_XCNT(b.x)], 1u);
    return b;
}
__device__ __forceinline__ void xcd_barrier_complete(unsigned* bar, unsigned x, unsigned& nloc, unsigned& nx) {
    const unsigned G = gridDim.x * gridDim.y * gridDim.z;
    unsigned sum, cnt, mine, sp = 0u;
    for (;;) {
        sum = 0u; cnt = 0u; mine = 0u;
#pragma unroll
        for (unsigned j = 0; j < 16; ++j) { const unsigned c = xb_ld(&bar[XB_XCNT(j)]); sum += c; cnt += (c > 0u) ? 1u : 0u; mine = (j == x) ? c : mine; }
        if (sum == G) break;
        __builtin_amdgcn_s_sleep(1);
        if ((++sp & 255u) == 0u) { if (xb_ld(&bar[XB_TMO])) break; if (sp > XB_SPIN_CAP) { atomicAdd(&bar[XB_TMO], 1u); break; } }
    }
    nloc = mine > 0u ? mine : 1u; nx = cnt > 0u ? cnt : 1u;
}

__device__ __forceinline__ void xcd_barrier(const XcdBarrier& b) {
    asm volatile("s_waitcnt vmcnt(0)" ::: "memory");
    __syncthreads();
    if (threadIdx.x == 0) {
        unsigned* bar = b.bar;
        __builtin_amdgcn_s_waitcnt(0);
        unsigned nloc = b.st[0], nx = b.st[1];
        if (nloc == 0u) { xcd_barrier_complete(bar, b.x, nloc, nx); b.st[0] = nloc; b.st[1] = nx; }
        const unsigned old = xb_add(&bar[XB_XSUB(b.x)], 1u);
        const unsigned gen = old / nloc;
        if (old + 1u == (gen + 1u) * nloc) {
            __builtin_amdgcn_fence(__ATOMIC_RELEASE, "agent");
            asm volatile("s_waitcnt vmcnt(0)" ::: "memory");
            const unsigned og = xb_add(&bar[XB_TOP], 1u);
            const unsigned tg = og / nx;
            if (og + 1u == (tg + 1u) * nx) xb_add(&bar[XB_TOPGEN], 1u);
            else XB_SPIN(xb_ld(&bar[XB_TOPGEN]) == tg, bar);
            __builtin_amdgcn_fence(__ATOMIC_ACQUIRE, "agent");
            xb_add(&bar[XB_XGEN(b.x)], 1u);
            asm volatile("s_waitcnt vmcnt(0)" ::: "memory");
        } else {
            XB_SPIN(xb_ld(&bar[XB_XGEN(b.x)]) == gen, bar);
            __builtin_amdgcn_fence(__ATOMIC_ACQUIRE, "agent");
            asm volatile("s_waitcnt vmcnt(0)" ::: "memory");
        }
    }
    __syncthreads();
}

struct Args { const float* in[19]; float* out; unsigned char* ws; int ph_lo, ph_hi; };
enum { I_X = 0, I_WIN, I_BIN, I_LB, I_HGNG, I_WA, I_WB, I_WOUT, I_LN1G, I_LN1B, I_WGRP, I_BGRP, I_WRT, I_BRT, I_WGATE, I_WUP, I_WDOWN, I_LN2G, I_LN2B };

__device__ __forceinline__ void transpose_item(const float* src4, size_t ldw, bf16_t* WT, size_t K, int dest_row0, int k0, LAS float* scr, int lane) {
    f32x4 v[8];
#pragma unroll
    for (int i = 0; i < 8; ++i) v[i] = src4 ? __builtin_nontemporal_load((const f32x4*)(src4 + (size_t)(8 * i) * ldw)) : (f32x4){0.f, 0.f, 0.f, 0.f};
#pragma unroll
    for (int i = 0; i < 8; ++i) { const int k = 8 * i + (lane >> 3), n4 = (lane & 7) * 4;
        scr[k * 33 + n4 + 0] = v[i][0]; scr[k * 33 + n4 + 1] = v[i][1]; scr[k * 33 + n4 + 2] = v[i][2]; scr[k * 33 + n4 + 3] = v[i][3]; }
    LDS_WAIT(); asm volatile("" ::: "memory");
    const int c = lane & 7;
#pragma unroll
    for (int j = 0; j < 4; ++j) { const int n = (lane >> 3) + 8 * j; const LAS float* s = scr + (8 * c) * 33 + n;
        u32x4 o; o.x = cvt_pk(s[0 * 33], s[1 * 33]); o.y = cvt_pk(s[2 * 33], s[3 * 33]); o.z = cvt_pk(s[4 * 33], s[5 * 33]); o.w = cvt_pk(s[6 * 33], s[7 * 33]);
        *(u32x4*)(WT + (size_t)(dest_row0 + n) * K + k0 + 8 * c) = o; }
    LDS_WAIT(); asm volatile("" ::: "memory");
}

__device__ __forceinline__ void phase_prologue(const Args& a, LAS unsigned char* lds, int tid, int G) {
    const int lane = tid & 63, wave = tid >> 6;
    unsigned char* ws = a.ws;
    { const float* x = a.in[I_X]; bf16_t* xb = (bf16_t*)(ws + WS_XB); const size_t n8 = (size_t)MT * DM / 8;
      for (size_t i = (size_t)blockIdx.x * NTHR + tid; i < n8; i += (size_t)G * NTHR) {
          const f32x4 p = __builtin_nontemporal_load((const f32x4*)(x + i * 8)), q = __builtin_nontemporal_load((const f32x4*)(x + i * 8 + 4));
          u32x4 o; o.x = cvt_pk(p[0], p[1]); o.y = cvt_pk(p[2], p[3]); o.z = cvt_pk(q[0], q[1]); o.w = cvt_pk(q[2], q[3]);
          *(u32x4*)(xb + i * 8) = o; } }
    LAS float* scr = (LAS float*)(lds + wave * 8704);
    const int gw = blockIdx.x * NWAVES + wave, NGW = G * NWAVES;
    constexpr int IT_IN = (NPROJ_PAD / 32) * (DM / 64);
    constexpr int IT_A = (DM / 32) * (1024 / 64);
    constexpr int IT_OUT = (DM / 32) * (DM / 64);
    constexpr int NIT = IT_IN + 2 * IT_A + IT_OUT;
    for (int it = gw; it < NIT; it += NGW) {
        int r = it;
        if (r < IT_IN) { const int kb = r / (NPROJ_PAD / 32), rb = r % (NPROJ_PAD / 32); const int n = rb * 32 + (lane & 7) * 4;
            int src = -1; if (n < 7752) src = n; else if (n >= 7936) src = n - 184;
            const float* p = (src >= 0) ? a.in[I_WIN] + (size_t)(kb * 64 + (lane >> 3)) * NPROJ + src : nullptr;
            transpose_item(p, NPROJ, (bf16_t*)(ws + WS_WIN), DM, rb * 32, kb * 64, scr, lane); continue; }
        r -= IT_IN;
        if (r < 2 * IT_A) { const int which = r / IT_A; r %= IT_A; const int kb = r / 64, rb = r % 64; const int n = rb * 32 + (lane & 7) * 4;
            const float* p = a.in[which ? I_WB : I_WA] + (size_t)(kb * 64 + (lane >> 3)) * DM + n;
            transpose_item(p, DM, (bf16_t*)(ws + (which ? WS_WB : WS_WA)), 1024, rb * 32, kb * 64, scr, lane); continue; }
        r -= 2 * IT_A;
        { const int kb = r / 64, rb = r % 64; const int n = rb * 32 + (lane & 7) * 4;
          const float* p = a.in[I_WOUT] + (size_t)(kb * 64 + (lane >> 3)) * DM + n;
          transpose_item(p, DM, (bf16_t*)(ws + WS_WOUT), DM, rb * 32, kb * 64, scr, lane); }
    }
}

constexpr int EW_GU = 64 * 32, EW_D = 64 * 16, EW_E = EW_GU + EW_D;
__device__ __forceinline__ const float* ew_src(const Args& a, int it, int lane, size_t& ldw) {
    const int e = it / EW_E; int r = it % EW_E;
    if (r < EW_GU) { const int kb = r / 64, rb = r % 64; const int n = rb * 32 + (lane & 7) * 4; const int j = n >> 3, up = (n >> 2) & 1; ldw = DFF;
        return a.in[up ? I_WUP : I_WGATE] + (size_t)e * DM * DFF + (size_t)(kb * 64 + (lane >> 3)) * DFF + 4 * j; }
    r -= EW_GU; const int kb = r / 64, rb = r % 64; const int n = rb * 32 + (lane & 7) * 4; ldw = DM;
    return a.in[I_WDOWN] + (size_t)e * DFF * DM + (size_t)(kb * 64 + (lane >> 3)) * DM + n;
}
__device__ __forceinline__ void ew_store(const Args& a, int it, const f32x4 (&v)[8], LAS float* scr, int lane) {
    const int e = it / EW_E; int r = it % EW_E; bf16_t* WT; size_t K; int rb, kb;
    if (r < EW_GU) { kb = r / 64; rb = r % 64; WT = (bf16_t*)(a.ws + WS_WGU) + (size_t)e * 2048 * 2048; K = 2048; }
    else { r -= EW_GU; kb = r / 64; rb = r % 64; WT = (bf16_t*)(a.ws + WS_WD) + (size_t)e * 2048 * 1024; K = 1024; }
#pragma unroll
    for (int i = 0; i < 8; ++i) { const int k = 8 * i + (lane >> 3), n4 = (lane & 7) * 4;
        scr[k * 33 + n4 + 0] = v[i][0]; scr[k * 33 + n4 + 1] = v[i][1]; scr[k * 33 + n4 + 2] = v[i][2]; scr[k * 33 + n4 + 3] = v[i][3]; }
    LDS_WAIT(); asm volatile("" ::: "memory");
    const int c = lane & 7;
#pragma unroll
    for (int j = 0; j < 4; ++j) { const int n = (lane >> 3) + 8 * j; const LAS float* s = scr + (8 * c) * 33 + n;
        u32x4 o; o.x = cvt_pk(s[0 * 33], s[1 * 33]); o.y = cvt_pk(s[2 * 33], s[3 * 33]); o.z = cvt_pk(s[4 * 33], s[5 * 33]); o.w = cvt_pk(s[6 * 33], s[7 * 33]);
        *(u32x4*)(WT + (size_t)(rb * 32 + n) * K + kb * 64 + 8 * c) = o; }
    LDS_WAIT(); asm volatile("" ::: "memory");
}
__device__ __forceinline__ void phase_expert_weights(const Args& a, LAS unsigned char* lds, int tid, int G) {
    const int lane = tid & 63, wave = tid >> 6;
    LAS float* scr = (LAS float*)(lds + wave * 8704);
    const int gw = blockIdx.x * NWAVES + wave, NGW = G * NWAVES, NIT = NEXP * EW_E;
    int it = gw; if (it >= NIT) return;
    f32x4 v[8]; { size_t ldw; const float* p = ew_src(a, it, lane, ldw);
#pragma unroll
        for (int i = 0; i < 8; ++i) v[i] = *(const f32x4*)(p + (size_t)(8 * i) * ldw); }
    for (;;) {
        const int nx = it + NGW; const bool has = nx < NIT;
        f32x4 vn[8];
        if (has) { size_t ldw; const float* p = ew_src(a, nx, lane, ldw);
#pragma unroll
            for (int i = 0; i < 8; ++i) vn[i] = *(const f32x4*)(p + (size_t)(8 * i) * ldw); }
        ew_store(a, it, v, scr, lane);
        if (!has) break;
#pragma unroll
        for (int i = 0; i < 8; ++i) v[i] = vn[i];
        it = nx;
    }
}

constexpr int HG_QD = 0, HG_KD = 17408, HG_P = 34816, HG_VT = 44032, HG_SEG = 62464, HG_RED = 64512;
constexpr int HG_LBT = 66560;
constexpr int HG_NGT = 70656;
constexpr int HG_ST = 74752, HG_STLD = 136;
constexpr int HG_LD128 = 136, HG_LD64 = 72;

struct HgPrep { float cum[16]; float kh[16]; float tot; };
__device__ __forceinline__ void hg_fill_lb(const Args& a, LAS unsigned char* lds, int tid) {
    for (int i = tid; i < 1024; i += NTHR) { const float l0 = a.in[I_LB][i], l1 = a.in[I_LB][1024 + i]; *(LAS float*)(lds + HG_LBT + i * 4) = 1.0f / (1.0f + __expf(l1 - l0)); *(LAS float*)(lds + HG_NGT + i * 4) = a.in[I_HGNG][i]; }
    __syncthreads();
}
__device__ __forceinline__ void hg_prep(HgPrep& P, const float (&z)[16], float lb, int d, int seg, LAS unsigned char* lds) {
    float run = 0.f;
#pragma unroll
    for (int j = 0; j < 16; ++j) { const float sg = sigmoidf_(z[j]); const float f = lb + (1.0f - lb) * sg; run += __logf(f); P.cum[j] = run; P.kh[j] = (1.0f - lb) * (1.0f - sg); }
    LAS float* segs = (LAS float*)(lds + HG_SEG);
    segs[seg * 128 + d] = run;
    __syncthreads();
    float off = 0.f, tot = 0.f;
#pragma unroll
    for (int s = 0; s < 4; ++s) { const float v = segs[s * 128 + d]; tot += v; if (s < seg) off += v; }
#pragma unroll
    for (int j = 0; j < 16; ++j) P.cum[j] += off;
    P.tot = tot;
}
__device__ __forceinline__ void hg_write_vt(const unsigned (&vv)[16], int d, int seg, LAS unsigned char* lds) {
    u32x4 w0, w1;
    w0.x = vv[0] | (vv[1] << 16); w0.y = vv[2] | (vv[3] << 16); w0.z = vv[4] | (vv[5] << 16); w0.w = vv[6] | (vv[7] << 16);
    w1.x = vv[8] | (vv[9] << 16); w1.y = vv[10] | (vv[11] << 16); w1.z = vv[12] | (vv[13] << 16); w1.w = vv[14] | (vv[15] << 16);
    LAS unsigned char* p = lds + HG_VT + d * (HG_LD64 * 2) + seg * 32;
    *(LAS u32x4*)p = w0; *(LAS u32x4*)(p + 16) = w1;
}

__device__ __forceinline__ void hgrn1_unit(const Args& a, int unit, LAS unsigned char* lds, int tid) {
    unsigned char* ws = a.ws;
    const int lane = tid & 63, wave = tid >> 6, d = tid & 127, seg = tid >> 7;
    const int b = unit >> 10, h = (unit >> 7) & 7, n = unit & 127, tok0 = b * SEQ + n * 64;
    float z[16]; unsigned vv[16];
    { const float* AF = (const float*)(ws + WS_AF); const bf16_t* AI = (const bf16_t*)(ws + WS_AI);
#pragma unroll
      for (int j = 0; j < 16; ++j) z[j] = AF[(size_t)(tok0 + seg * 16 + j) * 1024 + h * 128 + d];
#pragma unroll
      for (int j = 0; j < 16; ++j) vv[j] = AI[(size_t)(tok0 + seg * 16 + j) * 1024 + h * 128 + d]; }
    const float lbv = *(const LAS float*)(lds + HG_LBT + (h * 128 + d) * 4);
    HgPrep P;
    hg_prep(P, z, lbv, d, seg, lds);
    { unsigned pk[8];
#pragma unroll
      for (int j = 0; j < 8; ++j) pk[j] = cvt_pk(P.kh[2 * j] * __expf(P.tot - P.cum[2 * j]), P.kh[2 * j + 1] * __expf(P.tot - P.cum[2 * j + 1]));
      LAS unsigned char* p = lds + HG_KD + d * (HG_LD64 * 2) + seg * 32;
      *(LAS u32x4*)p = (u32x4){pk[0], pk[1], pk[2], pk[3]}; *(LAS u32x4*)(p + 16) = (u32x4){pk[4], pk[5], pk[6], pk[7]}; }
    if (seg == 0) ((float*)(ws + WS_DECAY))[(size_t)unit * 128 + d] = __expf(P.tot);
    hg_write_vt(vv, d, seg, lds);
    __syncthreads();
    const int fr = lane & 15, fq = lane >> 4;
    bf16x8 af[2];
#pragma unroll
    for (int ks = 0; ks < 2; ++ks) af[ks] = *(const LAS bf16x8*)(lds + HG_KD + (16 * wave + fr) * (HG_LD64 * 2) + (32 * ks + 8 * fq) * 2);
    float* kvo = (float*)(ws + WS_KV) + (size_t)unit * 16384;
#pragma unroll
    for (int vb = 0; vb < 8; ++vb) {
        f32x4 acc = {0.f, 0.f, 0.f, 0.f};
#pragma unroll
        for (int ks = 0; ks < 2; ++ks) { const bf16x8 bfr = *(const LAS bf16x8*)(lds + HG_VT + (16 * vb + fr) * (HG_LD64 * 2) + (32 * ks + 8 * fq) * 2);
            acc = __builtin_amdgcn_mfma_f32_16x16x32_bf16(af[ks], bfr, acc, 0, 0, 0); }
        *(f32x4*)(kvo + (size_t)(16 * vb + fr) * 128 + 16 * wave + 4 * fq) = acc;
    }
    __syncthreads();
}

__device__ __forceinline__ void hgrn_scan(const Args& a, int tid, int G) {
    unsigned char* ws = a.ws;
    const float* KV = (const float*)(ws + WS_KV); const float* DEC = (const float*)(ws + WS_DECAY); unsigned* ST = (unsigned*)(ws + WS_ST);
    for (int g = blockIdx.x * NTHR + tid; g < 16 * 8192; g += G * NTHR) {
        const int bh = g >> 13, rem = g & 8191, v = rem >> 6, d2 = (rem & 63) * 2;
        float s0 = 0.f, s1 = 0.f;
        for (int n0 = 0; n0 < 128; n0 += 8) {
            f32x2 kv[8], dc[8];
#pragma unroll
            for (int j = 0; j < 8; ++j) { const size_t unit = (size_t)bh * 128 + n0 + j; kv[j] = *(const f32x2*)(KV + unit * 16384 + v * 128 + d2); dc[j] = *(const f32x2*)(DEC + unit * 128 + d2); }
#pragma unroll
            for (int j = 0; j < 8; ++j) { const size_t unit = (size_t)bh * 128 + n0 + j; ST[(unit * 16384 + v * 128 + d2) >> 1] = cvt_pk(s0, s1);
                s0 = dc[j][0] * s0 + kv[j][0]; s1 = dc[j][1] * s1 + kv[j][1]; }
        }
    }
}

__device__ __forceinline__ void hg3_load(const Args& a, int unit, int tid, float (&z)[16], unsigned (&qq)[16], unsigned (&vv)[16], u32x4 (&stp)[4], u32x2 (&gwv)[4]) {
    unsigned char* ws = a.ws; const int d = tid & 127, seg = tid >> 7;
    const int b = unit >> 10, h = (unit >> 7) & 7, n = unit & 127, tok0 = b * SEQ + n * 64;
    const float* AF = (const float*)(ws + WS_AF); const bf16_t* AI = (const bf16_t*)(ws + WS_AI); const bf16_t* AQ = (const bf16_t*)(ws + WS_AQ);
#pragma unroll
    for (int j = 0; j < 16; ++j) z[j] = AF[(size_t)(tok0 + seg * 16 + j) * 1024 + h * 128 + d];
#pragma unroll
    for (int j = 0; j < 16; ++j) qq[j] = AQ[(size_t)(tok0 + seg * 16 + j) * 1024 + h * 128 + d];
#pragma unroll
    for (int j = 0; j < 16; ++j) vv[j] = AI[(size_t)(tok0 + seg * 16 + j) * 1024 + h * 128 + d];
    { const bf16_t* ST = (const bf16_t*)(ws + WS_ST) + (size_t)unit * 16384;
#pragma unroll
      for (int i = 0; i < 4; ++i) stp[i] = *(const u32x4*)(ST + (size_t)(tid + NTHR * i) * 8); }
    { const int lane = tid & 63, wave = tid >> 6, t_ = 16 * (wave & 3) + (lane & 15); const bf16_t* AG = (const bf16_t*)(ws + WS_AG);
#pragma unroll
      for (int vi = 0; vi < 4; ++vi) gwv[vi] = *(const u32x2*)(AG + (size_t)(tok0 + t_) * 1024 + h * 128 + 16 * (4 * (wave >> 2) + vi) + 4 * (lane >> 4)); }
}
__device__ __forceinline__ void hgrn3_unit(const Args& a, int unit, int next_unit, LAS unsigned char* lds, int tid, float (&z)[16], unsigned (&qq)[16], unsigned (&vv)[16], u32x4 (&stp)[4], u32x2 (&gwn)[4]) {
    unsigned char* ws = a.ws;
    const int lane = tid & 63, wave = tid >> 6, d = tid & 127, seg = tid >> 7;
    const int b = unit >> 10, h = (unit >> 7) & 7, n = unit & 127, tok0 = b * SEQ + n * 64;
    const float lbv = *(const LAS float*)(lds + HG_LBT + (h * 128 + d) * 4);
    u32x2 gwv[4];
#pragma unroll
    for (int vi = 0; vi < 4; ++vi) gwv[vi] = gwn[vi];
#ifndef HG3_RA
#define HG3_RA 1
#define HG3_RB 1
#define HG3_RC 1
#endif
    for (int ra = 0; ra < HG3_RA; ++ra) {
    HgPrep P;
    hg_prep(P, z, lbv, d, seg, lds);
    {
#pragma unroll
      for (int j = 0; j < 16; ++j) { const float q = bf2f(qq[j]); const float qs = q * sigmoidf_(q);
          const float qd = qs * __expf(P.cum[j]), kd = P.kh[j] * __expf(-P.cum[j]);
          const int t = seg * 16 + j;
          *(LAS bf16_t*)(lds + HG_QD + (t * HG_LD128 + d) * 2) = (bf16_t)(cvt_pk(qd, 0.f) & 0xffffu);
          *(LAS bf16_t*)(lds + HG_KD + (t * HG_LD128 + d) * 2) = (bf16_t)(cvt_pk(kd, 0.f) & 0xffffu); } }
    hg_write_vt(vv, d, seg, lds);
#pragma unroll
    for (int i = 0; i < 4; ++i) { const int id = tid + NTHR * i; *(LAS u32x4*)(lds + HG_ST + (id >> 4) * (HG_STLD * 2) + (id & 15) * 16) = stp[i]; }
    __syncthreads();
    }
    if (next_unit >= 0) hg3_load(a, next_unit, tid, z, qq, vv, stp, gwn);
    const int fr = lane & 15, fq = lane >> 4;
    for (int rb = 0; rb < HG3_RB; ++rb) {
    { const int tb = wave & 3;
      bf16x8 bq[4];
#pragma unroll
      for (int ks = 0; ks < 4; ++ks) bq[ks] = *(const LAS bf16x8*)(lds + HG_QD + ((16 * tb + fr) * HG_LD128 + 32 * ks + 8 * fq) * 2);
#pragma unroll
      for (int si = 0; si < 2; ++si) { const int sb = 2 * (wave >> 2) + si;
          f32x4 acc = {0.f, 0.f, 0.f, 0.f};
#pragma unroll
          for (int ks = 0; ks < 4; ++ks) { const bf16x8 ak = *(const LAS bf16x8*)(lds + HG_KD + ((16 * sb + fr) * HG_LD128 + 32 * ks + 8 * fq) * 2);
              acc = __builtin_amdgcn_mfma_f32_16x16x32_bf16(ak, bq[ks], acc, 0, 0, 0); }
          const int t = 16 * tb + fr, s0 = 16 * sb + 4 * fq;
          float p[4];
#pragma unroll
          for (int r = 0; r < 4; ++r) p[r] = (s0 + r <= t) ? acc[r] : 0.f;
          *(LAS u32x2*)(lds + HG_P + (t * HG_LD64 + s0) * 2) = (u32x2){cvt_pk(p[0], p[1]), cvt_pk(p[2], p[3])}; } }
    __syncthreads();
    }
    for (int rc = 0; rc < HG3_RC; ++rc) {
    const int tb = wave & 3, t = 16 * tb + fr;
    f32x4 o[4];
    { bf16x8 bp[2], bq[4];
#pragma unroll
      for (int ks = 0; ks < 2; ++ks) bp[ks] = *(const LAS bf16x8*)(lds + HG_P + ((16 * tb + fr) * HG_LD64 + 32 * ks + 8 * fq) * 2);
#pragma unroll
      for (int ks = 0; ks < 4; ++ks) bq[ks] = *(const LAS bf16x8*)(lds + HG_QD + ((16 * tb + fr) * HG_LD128 + 32 * ks + 8 * fq) * 2);
#pragma unroll
      for (int vi = 0; vi < 4; ++vi) { const int vb = 4 * (wave >> 2) + vi;
          f32x4 acc = {0.f, 0.f, 0.f, 0.f};
#pragma unroll
          for (int ks = 0; ks < 2; ++ks) { const bf16x8 av = *(const LAS bf16x8*)(lds + HG_VT + ((16 * vb + fr) * HG_LD64 + 32 * ks + 8 * fq) * 2);
              acc = __builtin_amdgcn_mfma_f32_16x16x32_bf16(av, bp[ks], acc, 0, 0, 0); }
#pragma unroll
          for (int ks = 0; ks < 4; ++ks) { const bf16x8 as = *(const LAS bf16x8*)(lds + HG_ST + ((16 * vb + fr) * HG_STLD + 32 * ks + 8 * fq) * 2);
              acc = __builtin_amdgcn_mfma_f32_16x16x32_bf16(as, bq[ks], acc, 0, 0, 0); }
          o[vi] = acc; } }
    float ss = 0.f;
#pragma unroll
    for (int vi = 0; vi < 4; ++vi) ss += (o[vi][0] * o[vi][0] + o[vi][1] * o[vi][1]) + (o[vi][2] * o[vi][2] + o[vi][3] * o[vi][3]);
    ss += __shfl_xor(ss, 16); ss += __shfl_xor(ss, 32);
    LAS float* red = (LAS float*)(lds + HG_RED);
    if (fq == 0) red[(wave >> 2) * 64 + t] = ss;
    __syncthreads();
    const float tot = red[t] + red[64 + t];
    const float rinv = 1.0f / sqrtf(tot * (1.0f / 128.0f) + RMS_EPS);
    bf16_t* BRA = (bf16_t*)(ws + WS_BRA);
#pragma unroll
    for (int vi = 0; vi < 4; ++vi) { const int v0 = 16 * (4 * (wave >> 2) + vi) + 4 * fq; const size_t off = (size_t)(tok0 + t) * 1024 + h * 128 + v0;
        const u32x2 gw = gwv[vi]; const f32x4 gn = *(const LAS f32x4*)(lds + HG_NGT + (h * 128 + v0) * 4);
        const float g0 = __uint_as_float(gw.x << 16), g1 = __uint_as_float(gw.x & 0xffff0000u), g2 = __uint_as_float(gw.y << 16), g3 = __uint_as_float(gw.y & 0xffff0000u);
        const float r0 = o[vi][0] * rinv * gn[0] * (g0 * sigmoidf_(g0)), r1 = o[vi][1] * rinv * gn[1] * (g1 * sigmoidf_(g1));
        const float r2 = o[vi][2] * rinv * gn[2] * (g2 * sigmoidf_(g2)), r3 = o[vi][3] * rinv * gn[3] * (g3 * sigmoidf_(g3));
        *(u32x2*)(BRA + off) = (u32x2){cvt_pk(r0, r1), cvt_pk(r2, r3)}; }
    __syncthreads();
    }
}


constexpr int IX_S = 0, IX_H = 131072, IX_L = 147456, IX_M = 155648, IX_C = 159744;
constexpr int IX_CAP = 512;
__device__ __forceinline__ unsigned ix_sortable(unsigned u) { return (u & 0x80000000u) ? ~u : (u | 0x80000000u); }

__device__ __forceinline__ void ix_radix_fallback(LAS unsigned* S, LAS unsigned* H, unsigned* MASK, int t0, int L, int tid) {
    const int lane = tid & 63, wave = __builtin_amdgcn_readfirstlane(tid >> 6);
    for (int q = 0; q < 4; ++q) for (int i = tid; i < L; i += NTHR) S[q * 8192 + i] = ix_sortable(S[q * 8192 + i]);
    for (int i = tid; i < 2048; i += NTHR) H[i] = 0u;
    __syncthreads();
    const int qs = wave >> 1, half = wave & 1;
    unsigned prefix = 0u; int kth = 256;
    for (int p = 0; p < 4; ++p) {
        const int shift = 24 - 8 * p;
        LAS unsigned* hist = H + (p & 1) * 1024 + qs * 256;
        for (int i = half * 64 + lane; i < L; i += 128) { const unsigned k = S[qs * 8192 + i];
            const bool in = (p == 0) || ((k >> (shift + 8)) == prefix);
            if (in) atomicAdd((unsigned*)(hist + ((k >> shift) & 255u)), 1u); }
        __syncthreads();
        const unsigned c0 = hist[255 - 4 * lane], c1 = hist[254 - 4 * lane], c2 = hist[253 - 4 * lane], c3 = hist[252 - 4 * lane];
        const int tot = (int)(c0 + c1 + c2 + c3);
        int incl = tot;
#pragma unroll
        for (int o = 1; o < 64; o <<= 1) { const int v = __shfl_up(incl, o); if (lane >= o) incl += v; }
        const unsigned long long bal = __ballot(incl >= kth);
        const int fl = __ffsll((long long)bal) - 1;
        const int rem = kth - (incl - tot);
        int dig, nk;
        if (rem <= (int)c0) { dig = 255 - 4 * lane; nk = rem; }
        else if (rem <= (int)(c0 + c1)) { dig = 254 - 4 * lane; nk = rem - (int)c0; }
        else if (rem <= (int)(c0 + c1 + c2)) { dig = 253 - 4 * lane; nk = rem - (int)(c0 + c1); }
        else { dig = 252 - 4 * lane; nk = rem - (int)(c0 + c1 + c2); }
        dig = __shfl(dig, fl); nk = __shfl(nk, fl);
        prefix = (prefix << 8) | (unsigned)dig; kth = nk;
        __syncthreads();
        if (p < 2) for (int i = tid; i < 1024; i += NTHR) H[(p & 1) * 1024 + i] = 0u;
    }
    const unsigned T = prefix;
    const int NG = L / 64;
    int tie_before = 0;
    if (half == 1) for (int g = 0; g < 64 && g < NG; ++g) { const unsigned k = S[qs * 8192 + 64 * g + lane]; tie_before += __popcll(__ballot(k == T)); }
    unsigned mlo = 0u, mhi = 0u;
    const unsigned long long lt = (1ull << lane) - 1ull;
    for (int g = 64 * half; g < NG && g < 64 * half + 64; ++g) {
        const unsigned k = S[qs * 8192 + 64 * g + lane];
        const bool eq = (k == T);
        const unsigned long long eqm = __ballot(eq);
        const int rank = tie_before + __popcll(eqm & lt);
        const bool sel = (k > T) || (eq && rank < kth);
        const unsigned long long m = __ballot(sel);
        if (lane == g - 64 * half) { mlo = (unsigned)m; mhi = (unsigned)(m >> 32); }
        tie_before += __popcll(eqm);
    }
    *(u32x2*)(MASK + (size_t)(t0 + qs) * 256 + 2 * (64 * half + lane)) = (u32x2){mlo, mhi};
    __syncthreads();
}

__device__ __forceinline__ void indexer_unit(const Args& a, int unit, LAS unsigned char* lds, int tid) {
    unsigned char* ws = a.ws;
    const int lane = tid & 63, wave = __builtin_amdgcn_readfirstlane(tid >> 6);
    const int t0 = unit * 4, b = t0 >> 13, qpos0 = t0 & (SEQ - 1), c = qpos0 >> 6, L = 64 * (c + 1);
    unsigned* MASK = (unsigned*)(ws + WS_MASK);
    if (c < 4) {
        const int qi = tid >> 7, w2 = (tid & 127) * 2;
        const unsigned m0 = (w2 * 32 < L) ? 0xffffffffu : 0u, m1 = ((w2 + 1) * 32 < L) ? 0xffffffffu : 0u;
        *(u32x2*)(MASK + (size_t)(t0 + qi) * 256 + w2) = (u32x2){m0, m1};
        return;
    }
    const bf16_t* IQ = (const bf16_t*)(ws + WS_IQ); const bf16_t* IKW = (const bf16_t*)(ws + WS_IKW);
    LAS unsigned* S = (LAS unsigned*)(lds + IX_S); LAS unsigned* H = (LAS unsigned*)(lds + IX_H); LAS unsigned* LST = (LAS unsigned*)(lds + IX_L);
    LAS unsigned* MB = (LAS unsigned*)(lds + IX_M); LAS float* MM = (LAS float*)(lds + IX_C); LAS unsigned* CC = (LAS unsigned*)(lds + IX_C + 256);
    const int r32 = lane & 31, hh = lane >> 5;
    for (int i = tid; i < 4096; i += NTHR) H[i] = 0u;
    for (int i = tid; i < 1024; i += NTHR) MB[i] = 0u;
    if (tid < 8) CC[tid] = 0u;
    bf16x8 af[4];
#pragma unroll
    for (int ks = 0; ks < 4; ++ks) af[ks] = *(const bf16x8*)(IQ + (size_t)(t0 + (r32 >> 3)) * 512 + (r32 & 7) * 64 + 16 * ks + 8 * hh);
    bf16x8 a2[2];
#pragma unroll
    for (int sI = 0; sI < 2; ++sI)
#pragma unroll
        for (int j = 0; j < 8; ++j) { const int qm = 2 * sI + (j >> 2), hm = 4 * hh + (j & 3);
            a2[sI][j] = (r32 == qm) ? (short)IKW[(size_t)(t0 + qm) * 256 + 64 + hm] : (short)0; }
    float mn[4], mx[4];
#pragma unroll
    for (int qi = 0; qi < 4; ++qi) { mn[qi] = 3.0e38f; mx[qi] = -3.0e38f; }
    const int NT32 = L / 32;
    const bf16_t* kbase = (const bf16_t*)(ws + WS_IK2) + (size_t)b * (SEQ / 32) * 2048 + lane * 8;
#define IX_LOADT(dst, kt_) do { const bf16_t* kp_ = kbase + (size_t)(kt_) * 2048; _Pragma("unroll") for (int ks = 0; ks < 4; ++ks) dst[ks] = *(const bf16x8*)(kp_ + 512 * ks); } while (0)
#define IX_MM(acc, bt) do { acc = f32x16{}; _Pragma("unroll") for (int ks = 0; ks < 4; ++ks) acc = __builtin_amdgcn_mfma_f32_32x32x16_bf16(af[ks], bt[ks], acc, 0, 0, 0); } while (0)
#define IX_HS(y_, acc) do { unsigned pk_[8]; _Pragma("unroll") for (int i = 0; i < 8; ++i) { const float x0_ = __builtin_amdgcn_fmed3f(acc[2 * i], 0.0f, 3.0e38f), x1_ = __builtin_amdgcn_fmed3f(acc[2 * i + 1], 0.0f, 3.0e38f); pk_[i] = cvt_pk_to_mfma(x0_, x1_); } \
        const u32x4 f0_ = {pk_[0], pk_[1], pk_[2], pk_[3]}, f1_ = {pk_[4], pk_[5], pk_[6], pk_[7]}; \
        y_ = f32x16{}; y_ = __builtin_amdgcn_mfma_f32_32x32x16_bf16(a2[0], *(const bf16x8*)&f0_, y_, 0, 0, 0); y_ = __builtin_amdgcn_mfma_f32_32x32x16_bf16(a2[1], *(const bf16x8*)&f1_, y_, 0, 0, 0); } while (0)
#define IX_ST(y_, kt_) do { const int key = (kt_) * 32 + r32; \
        if (hh == 0) { _Pragma("unroll") for (int qi = 0; qi < 4; ++qi) { const float s = y_[qi] + 0.0f; mn[qi] = fminf(mn[qi], s); mx[qi] = fmaxf(mx[qi], s); S[qi * 8192 + key] = __float_as_uint(s); } } } while (0)
#ifndef IX_REP_S1
#define IX_REP_S1 1
#endif
    for (int rp1 = 0; rp1 < IX_REP_S1; ++rp1) {
    bf16x8 bA[4], bB[4], bC[4];
    { const int kt = wave; if (kt < NT32) IX_LOADT(bA, kt); if (kt + 8 < NT32) IX_LOADT(bB, kt + 8); if (kt + 16 < NT32) IX_LOADT(bC, kt + 16); }
    for (int kt = wave; kt < NT32; kt += 3 * NWAVES) {
        const int kn = kt + 3 * NWAVES;
        bf16x8 nA[4], nB[4], nC[4];
        if (kn < NT32) IX_LOADT(nA, kn); if (kn + 8 < NT32) IX_LOADT(nB, kn + 8); if (kn + 16 < NT32) IX_LOADT(nC, kn + 16);
        const bool hB = kt + 8 < NT32, hC = kt + 16 < NT32;
#ifndef IX_REP_C
#define IX_REP_C 1
#endif
        for (int rc_ = 0; rc_ < IX_REP_C; ++rc_) {
        f32x16 xA, xB, xC;
        IX_MM(xA, bA); if (hB) IX_MM(xB, bB); if (hC) IX_MM(xC, bC);
        { f32x16 yy; IX_HS(yy, xA); IX_ST(yy, kt); }
        if (hB) { f32x16 yy; IX_HS(yy, xB); IX_ST(yy, kt + 8); }
        if (hC) { f32x16 yy; IX_HS(yy, xC); IX_ST(yy, kt + 16); }
        }
#pragma unroll
        for (int ks = 0; ks < 4; ++ks) { bA[ks] = nA[ks]; bB[ks] = nB[ks]; bC[ks] = nC[ks]; }
    }
    }
#undef IX_LOADT
#undef IX_MM
#undef IX_HS
#undef IX_ST
#pragma unroll
    for (int qi = 0; qi < 4; ++qi) {
#pragma unroll
        for (int o = 1; o < 32; o <<= 1) { mn[qi] = fminf(mn[qi], __shfl_xor(mn[qi], o)); mx[qi] = fmaxf(mx[qi], __shfl_xor(mx[qi], o)); }
        if (lane == 0) { MM[(wave * 4 + qi) * 2] = mn[qi]; MM[(wave * 4 + qi) * 2 + 1] = mx[qi]; } }
    __syncthreads();
    const int qs = wave >> 1, half = wave & 1;
    float mnq = 3.0e38f, mxq = -3.0e38f;
#pragma unroll
    for (int w = 0; w < NWAVES; ++w) { mnq = fminf(mnq, MM[(w * 4 + qs) * 2]); mxq = fmaxf(mxq, MM[(w * 4 + qs) * 2 + 1]); }
    const float scl = (mxq > mnq) ? 1023.0f / (mxq - mnq) : 0.0f;
#define IX_BIN(sbits) min((int)((__uint_as_float(sbits) - mnq) * scl), 1023)
    { LAS unsigned* hist = H + qs * 1024;
      int i = half * 64 + lane;
      for (; i + 384 < L; i += 512) { const unsigned s0 = S[qs * 8192 + i], s1 = S[qs * 8192 + i + 128], s2 = S[qs * 8192 + i + 256], s3 = S[qs * 8192 + i + 384];
          const int b0 = IX_BIN(s0), b1 = IX_BIN(s1), b2 = IX_BIN(s2), b3 = IX_BIN(s3);
          atomicAdd((unsigned*)(hist + b0), 1u); atomicAdd((unsigned*)(hist + b1), 1u); atomicAdd((unsigned*)(hist + b2), 1u); atomicAdd((unsigned*)(hist + b3), 1u); }
      for (; i < L; i += 128) { const int bin = IX_BIN(S[qs * 8192 + i]); atomicAdd((unsigned*)(hist + bin), 1u); } }
    __syncthreads();
    int bstar, rtake, cntb;
    { const LAS u32x4* hp = (const LAS u32x4*)(H + qs * 1024 + 1008 - 16 * lane);
      const u32x4 h0 = hp[0], h1 = hp[1], h2 = hp[2], h3 = hp[3];
      const unsigned cb[16] = {h0.x, h0.y, h0.z, h0.w, h1.x, h1.y, h1.z, h1.w, h2.x, h2.y, h2.z, h2.w, h3.x, h3.y, h3.z, h3.w};
      int tot = 0;
#pragma unroll
      for (int j = 0; j < 16; ++j) tot += (int)cb[j];
      int incl = tot;
#pragma unroll
      for (int o = 1; o < 64; o <<= 1) { const int v = __shfl_up(incl, o); if (lane >= o) incl += v; }
      const unsigned long long bal = __ballot(incl >= 256);
      const int fl = __ffsll((long long)bal) - 1;
      const int rem = 256 - (incl - tot);
      int cum = 0, bs = 0, rt = 0, cn = 0; bool found = false;
#pragma unroll
      for (int j = 15; j >= 0; --j) { const int cj = (int)cb[j]; if (!found && cum + cj >= rem) { bs = 1008 - 16 * lane + j; rt = rem - cum; cn = cj; found = true; } cum += cj; }
      bstar = __shfl(bs, fl); rtake = __shfl(rt, fl); cntb = __shfl(cn, fl); }
    const int NG = L / 64;
    const bool all_eq = (cntb == rtake);
    const unsigned long long lt = (1ull << lane) - 1ull;
    { unsigned mlo = 0u, mhi = 0u;
      const int gh = (NG + 1) >> 1, gbeg = half ? gh : 0, gend = half ? NG : gh;
      const float tge = (float)bstar, tgt = (bstar >= 1023) ? 3.0e38f : (float)(bstar + 1);
      unsigned sv[4] = {0u, 0u, 0u, 0u};
      for (int g = gbeg; g < gend; ++g) {
          const int gi = (g - gbeg) & 3;
          if (gi == 0) {
#pragma unroll
              for (int j = 0; j < 4; ++j) if (g + j < gend) sv[j] = S[qs * 8192 + 64 * (g + j) + lane]; }
          const unsigned sb = (gi == 0) ? sv[0] : (gi == 1) ? sv[1] : (gi == 2) ? sv[2] : sv[3];
          const float tq = (__uint_as_float(sb) - mnq) * scl;
          unsigned long long m = __ballot(tq >= tgt);
          const unsigned long long eqm = __ballot(tq >= tge) & ~m;
          if (all_eq) m |= eqm;
          else if (eqm != 0ull) {
              unsigned base = 0u;
              if (lane == 0) base = atomicAdd((unsigned*)(CC + qs), (unsigned)__popcll(eqm));
              base = __builtin_amdgcn_readfirstlane(base);
              const unsigned pos = base + (unsigned)__popcll(eqm & lt);
              if (((eqm >> lane) & 1ull) && pos < (unsigned)IX_CAP) LST[qs * IX_CAP + pos] = (unsigned)(64 * g + lane); }
          if (lane == g - gbeg) { mlo = (unsigned)m; mhi = (unsigned)(m >> 32); }
      }
      if (lane < gend - gbeg) *(LAS u32x2*)(MB + qs * 256 + 2 * (gbeg + lane)) = (u32x2){mlo, mhi}; }
    __syncthreads();
    if (half == 0 && !all_eq) {
        const int nc = cntb;
        if (nc > IX_CAP) { if (lane == 0) CC[4] = 1u; }
        else {
            unsigned myk[8], myi[8]; int rk[8];
#pragma unroll
            for (int sI = 0; sI < 8; ++sI) { const int j = sI * 64 + lane; rk[sI] = 0; myi[sI] = 0u; myk[sI] = 0u;
                if (sI * 64 < nc && j < nc) { myi[sI] = LST[qs * IX_CAP + j]; myk[sI] = ix_sortable(S[qs * 8192 + myi[sI]]); } }
            for (int t = 0; t < nc; ++t) { const unsigned it = LST[qs * IX_CAP + t]; const unsigned kt_ = ix_sortable(S[qs * 8192 + it]);
#pragma unroll
                for (int sI = 0; sI < 8; ++sI) if (sI * 64 < nc) rk[sI] += (kt_ > myk[sI] || (kt_ == myk[sI] && it < myi[sI])) ? 1 : 0; }
#pragma unroll
            for (int sI = 0; sI < 8; ++sI) { const int j = sI * 64 + lane;
                if (sI * 64 < nc && j < nc && rk[sI] < rtake) atomicOr((unsigned*)(MB + qs * 256 + (myi[sI] >> 5)), 1u << (myi[sI] & 31u)); }
        }
    }
#undef IX_BIN
    __syncthreads();
    if (CC[4] != 0u) { __syncthreads(); ix_radix_fallback(S, H, MASK, t0, L, tid); return; }
    { const int qi = tid >> 7, w2 = (tid & 127) * 2;
      *(u32x2*)(MASK + (size_t)(t0 + qi) * 256 + w2) = *(const LAS u32x2*)(MB + qi * 256 + w2); }
    __syncthreads();
}

constexpr int NA_IDX = 0, NA_LG = 1024, NA_SCAN = 1024 + 8192;
__device__ __forceinline__ void attn_gather_unit(const Args& a, int tok, LAS unsigned char* lds, int tid) {
    unsigned char* ws = a.ws;
    const int lane = tid & 63, wave = __builtin_amdgcn_readfirstlane(tid >> 6);
    const int b = tok >> 13, qpos = tok & (SEQ - 1), c = qpos >> 6, L = 64 * (c + 1), nsel = L < 256 ? L : 256;
    const unsigned* MASK = (const unsigned*)(ws + WS_MASK);
    LAS int* idxs = (LAS int*)(lds + NA_IDX); LAS float* lg = (LAS float*)(lds + NA_LG) + wave * 256; LAS int* wsum = (LAS int*)(lds + NA_SCAN);
    unsigned w = 0u; int cnt = 0;
    if (tid < 256) { w = MASK[(size_t)tok * 256 + tid]; cnt = __popc(w); }
    int incl = cnt;
#pragma unroll
    for (int o = 1; o < 64; o <<= 1) { const int v = __shfl_up(incl, o); if (lane >= o) incl += v; }
    if (lane == 63) wsum[wave] = incl;
    __syncthreads();
    if (tid < 256) { int off = incl - cnt; for (int ww = 0; ww < wave; ++ww) off += wsum[ww];
        while (w) { const int bit = __ffs(w) - 1; w &= w - 1; if (off < 256) idxs[off] = tid * 32 + bit; ++off; } }
    __syncthreads();
    const int h = wave;
    const bf16_t* BQ = (const bf16_t*)(ws + WS_BQ); const bf16_t* BK = (const bf16_t*)(ws + WS_BK); const bf16_t* BV = (const bf16_t*)(ws + WS_BV);
    const float slope = exp2f(-(float)(h + 1));
    float qv[8];
    { const u32x4 qw = *(const u32x4*)(BQ + (size_t)tok * 1024 + h * 128 + 8 * (lane & 15));
      qv[0] = __uint_as_float(qw.x << 16); qv[1] = __uint_as_float(qw.x & 0xffff0000u); qv[2] = __uint_as_float(qw.y << 16); qv[3] = __uint_as_float(qw.y & 0xffff0000u);
      qv[4] = __uint_as_float(qw.z << 16); qv[5] = __uint_as_float(qw.z & 0xffff0000u); qv[6] = __uint_as_float(qw.w << 16); qv[7] = __uint_as_float(qw.w & 0xffff0000u); }
    for (int it = 0; it < nsel / 4; ++it) {
        const int key = idxs[4 * it + (lane >> 4)];
        const u32x4 kw = *(const u32x4*)(BK + (size_t)(b * SEQ + key) * 1024 + h * 128 + 8 * (lane & 15));
        float s = qv[0] * __uint_as_float(kw.x << 16) + qv[1] * __uint_as_float(kw.x & 0xffff0000u) + qv[2] * __uint_as_float(kw.y << 16) + qv[3] * __uint_as_float(kw.y & 0xffff0000u)
                + qv[4] * __uint_as_float(kw.z << 16) + qv[5] * __uint_as_float(kw.z & 0xffff0000u) + qv[6] * __uint_as_float(kw.w << 16) + qv[7] * __uint_as_float(kw.w & 0xffff0000u);
        s += __shfl_xor(s, 1); s += __shfl_xor(s, 2); s += __shfl_xor(s, 4); s += __shfl_xor(s, 8);
        const float dist = fabsf((float)(qpos - key));
        if ((lane & 15) == 0) lg[4 * it + (lane >> 4)] = s * 0.08838834764831845f - slope * dist;
    }
    LDS_WAIT();
    float mx = -3.0e38f;
    for (int k = lane; k < nsel; k += 64) mx = fmaxf(mx, lg[k]);
#pragma unroll
    for (int o = 1; o < 64; o <<= 1) mx = fmaxf(mx, __shfl_xor(mx, o));
    float sm = 0.f;
    for (int k = lane; k < nsel; k += 64) { const float e = __expf(lg[k] - mx); lg[k] = e; sm += e; }
    sm = wave_sum(sm);
    const float rs = 1.0f / sm;
    LDS_WAIT();
    float o0 = 0.f, o1 = 0.f;
    for (int k = 0; k < nsel; k += 4) {
        unsigned vw[4]; float pp[4];
#pragma unroll
        for (int j = 0; j < 4; ++j) { const int key = idxs[k + j]; pp[j] = lg[k + j]; vw[j] = *(const unsigned*)(BV + (size_t)(b * SEQ + key) * 1024 + h * 128 + 2 * lane); }
#pragma unroll
        for (int j = 0; j < 4; ++j) { o0 += pp[j] * __uint_as_float(vw[j] << 16); o1 += pp[j] * __uint_as_float(vw[j] & 0xffff0000u); }
    }
    *(unsigned*)((bf16_t*)(ws + WS_BRB) + (size_t)tok * 1024 + h * 128 + 2 * lane) = cvt_pk(o0 * rs, o1 * rs);
    __syncthreads();
}

constexpr int RT_BLK = 148, RT_BUF = 64 * RT_BLK * 4;
constexpr int RT_SCR = 2 * RT_BUF;
__device__ __forceinline__ void phase8_router_expw(const Args& a, LAS unsigned char* lds, int tid, int G, bool route, bool do_expw) {
    unsigned char* ws = a.ws; const int wave = __builtin_amdgcn_readfirstlane(tid >> 6);
    const int npass = MT / 8;
    if (wave < 4) {
        __syncthreads();
        int cbuf = 0;
        for (int ps = blockIdx.x; ps < npass; ps += G) {
            int lane = tid & 63; asm volatile("" : "+v"(lane));
            f32x4 v[2][8];
#pragma unroll
            for (int r = 0; r < 2; ++r) { const int row = ps * 8 + wave * 2 + r;
                const bf16_t* pre = (const bf16_t*)(ws + WS_PRE1) + (size_t)row * DM; float s = 0.f;
#pragma unroll
                for (int i = 0; i < 8; ++i) { const u32x2 pw = *(const u32x2*)(pre + 256 * i + 4 * lane);
                    v[r][i] = (f32x4){__uint_as_float(pw.x << 16), __uint_as_float(pw.x & 0xffff0000u), __uint_as_float(pw.y << 16), __uint_as_float(pw.y & 0xffff0000u)};
                    s += (v[r][i][0] + v[r][i][1]) + (v[r][i][2] + v[r][i][3]); }
                const float mean = wave_sum(s) * (1.0f / DM); float s2 = 0.f;
#pragma unroll
                for (int i = 0; i < 8; ++i) { v[r][i] = v[r][i] - mean; s2 += (v[r][i][0] * v[r][i][0] + v[r][i][1] * v[r][i][1]) + (v[r][i][2] * v[r][i][2] + v[r][i][3] * v[r][i][3]); }
                const float rstd = 1.0f / sqrtf(wave_sum(s2) * (1.0f / DM) + LN_EPS);
                bf16_t* H1B = (bf16_t*)(ws + WS_H1B) + (size_t)row * DM;
#pragma unroll
                for (int i = 0; i < 8; ++i) { const f32x4 gg = *(const f32x4*)(a.in[I_LN1G] + 256 * i + 4 * lane), bb = *(const f32x4*)(a.in[I_LN1B] + 256 * i + 4 * lane);
                    v[r][i] = v[r][i] * rstd * gg + bb;
                    *(u32x2*)(H1B + 256 * i + 4 * lane) = (u32x2){cvt_pk(v[r][i][0], v[r][i][1]), cvt_pk(v[r][i][2], v[r][i][3])}; } }
            f32x2 acc2[36];
#pragma unroll
            for (int j = 0; j < 36; ++j) acc2[j] = (f32x2){0.f, 0.f};
#pragma unroll
            for (int i = 0; i < 8; ++i) {
                int lq = lane; asm volatile("" : "+v"(lq));
                const LAS float* blk = (const LAS float*)(lds + cbuf * RT_BUF) + lq * RT_BLK;
#pragma unroll
                for (int kk = 0; kk < 4; ++kk) {
                    __builtin_amdgcn_sched_barrier(0);
                    const f32x2 hv = (f32x2){v[0][i][kk], v[1][i][kk]};
#pragma unroll
                    for (int q = 0; q < 9; ++q) { const f32x4 w4 = *(const LAS f32x4*)(blk + kk * 36 + 4 * q);
                        acc2[4 * q + 0] += hv * (f32x2){w4[0], w4[0]}; acc2[4 * q + 1] += hv * (f32x2){w4[1], w4[1]};
                        acc2[4 * q + 2] += hv * (f32x2){w4[2], w4[2]}; acc2[4 * q + 3] += hv * (f32x2){w4[3], w4[3]}; } }
                __syncthreads();
                cbuf ^= 1;
            }
#pragma unroll
            for (int r = 0; r < 2; ++r) {
                const int row = ps * 8 + wave * 2 + r;
                float lgt[36];
#pragma unroll
                for (int j = 0; j < 36; ++j) lgt[j] = wave_sum(r == 0 ? acc2[j][0] : acc2[j][1]);
                float gl[4]; float gm = -3.0e38f; int gt = 0;
#pragma unroll
                for (int j = 0; j < 4; ++j) { gl[j] = lgt[j] + a.in[I_BGRP][j]; if (gl[j] > gm) { gm = gl[j]; gt = j; } }
                float gs = 0.f;
#pragma unroll
                for (int j = 0; j < 4; ++j) gs += __expf(gl[j] - gm);
                const float gp = 1.0f / gs;
                float e1 = -3.0e38f, e2 = -3.0e38f; int i1 = 0, i2 = 0;
#pragma unroll
                for (int j = 0; j < 8; ++j) { float ev = 0.f;
#pragma unroll
                    for (int gq = 0; gq < 4; ++gq) if (gq == gt) ev = lgt[4 + 8 * gq + j] + a.in[I_BRT][8 * gq + j];
                    if (ev > e1) { e2 = e1; i2 = i1; e1 = ev; i1 = j; } else if (ev > e2) { e2 = ev; i2 = j; } }
                const float x2 = __expf(e2 - e1), w1 = gp / (1.0f + x2), w2 = gp * x2 / (1.0f + x2);
                if (lane == 0 && route) {
                    unsigned* ctl = (unsigned*)(ws + WS_CTL);
                    int* rows = (int*)(ws + WS_ROWS); int* slot_e = (int*)(ws + WS_SLOT); int* slot_p = slot_e + 2 * MT; float* slot_w = (float*)(slot_p + 2 * MT);
                    const int ea = gt * 8 + i1, eb = gt * 8 + i2;
                    const int pa = (int)atomicAdd(ctl + CW_CNT + 64 * ea, 1u), pb = (int)atomicAdd(ctl + CW_CNT + 64 * eb, 1u);
                    rows[ea * MT + pa] = row; rows[eb * MT + pb] = row;
                    slot_e[2 * row] = ea; slot_e[2 * row + 1] = eb; slot_p[2 * row] = pa; slot_p[2 * row + 1] = pb; slot_w[2 * row] = w1; slot_w[2 * row + 1] = w2;
                }
            }
        }
    } else {
        const int lane = tid & 63, te = tid - 256;
        const float* wg = a.in[I_WGRP]; const float* wr = a.in[I_WRT];
        LAS float* scr = (LAS float*)(lds + RT_SCR + (wave - 4) * 8704);
        f32x4 sa[9], sb[9];
#define RT_LOADW(dst, chunk) do { const int k_ = (chunk) * 256 + te; dst[0] = *(const f32x4*)(wg + (size_t)k_ * 4); _Pragma("unroll") for (int j_ = 0; j_ < 8; ++j_) dst[1 + j_] = *(const f32x4*)(wr + (size_t)k_ * 32 + 4 * j_); } while (0)
#define RT_WRITEW(src, buf) do { LAS float* p_ = (LAS float*)(buf) + (te >> 2) * RT_BLK + (te & 3) * 36; _Pragma("unroll") for (int j_ = 0; j_ < 9; ++j_) *(LAS f32x4*)(p_ + 4 * j_) = src[j_]; } while (0)
        RT_LOADW(sa, 0); RT_WRITEW(sa, lds); RT_LOADW(sb, 1);
        const int ge = blockIdx.x * 4 + (wave - 4), NGE = G * 4, NIT = do_expw ? NEXP * EW_E : 0;
        int it = ge; f32x4 e0[8], e1[8], e2[8];
#define EW_LOAD(dst, item) do { if ((item) < NIT) { size_t ldw_; const float* p_ = ew_src(a, (item), lane, ldw_); _Pragma("unroll") for (int i_ = 0; i_ < 8; ++i_) dst[i_] = __builtin_nontemporal_load((const f32x4*)(p_ + (size_t)(8 * i_) * ldw_)); } } while (0)
#define EW_STEPX(cur, fre) do { if (it < NIT) { EW_LOAD(fre, it + 2 * NGE); ew_store(a, it, cur, scr, lane); it += NGE; } } while (0)
        EW_LOAD(e0, it); EW_LOAD(e1, it + NGE);
        __syncthreads();
        int cbuf = 0;
        for (int ps = blockIdx.x; ps < npass; ps += G) {
#pragma unroll
            for (int i = 0; i < 8; ++i) {
                if (i & 1) { RT_LOADW(sb, (i + 2) & 7); RT_WRITEW(sa, lds + (cbuf ^ 1) * RT_BUF); }
                else { RT_LOADW(sa, (i + 2) & 7); RT_WRITEW(sb, lds + (cbuf ^ 1) * RT_BUF); }
                if (i == 0) { EW_STEPX(e0, e2); EW_STEPX(e1, e0); } else if (i == 1) { EW_STEPX(e2, e1); } else if (i == 2) { EW_STEPX(e0, e2); EW_STEPX(e1, e0); } else if (i == 3) { EW_STEPX(e2, e1); }
                else if (i == 4) { EW_STEPX(e0, e2); EW_STEPX(e1, e0); } else if (i == 5) { EW_STEPX(e2, e1); } else if (i == 6) { EW_STEPX(e0, e2); EW_STEPX(e1, e0); } else { EW_STEPX(e2, e1); }
                __syncthreads();
                cbuf ^= 1;
            }
        }
        while (it < NIT) { EW_STEPX(e0, e2); EW_STEPX(e1, e0); EW_STEPX(e2, e1); }
#undef RT_LOADW
#undef RT_WRITEW
#undef EW_STEPX
#undef EW_LOAD
    }
    __syncthreads();
}

__device__ __forceinline__ void load_tile_base(const Args& a, LAS int* tb, int tid) {
    const unsigned* ctl = (const unsigned*)(a.ws + WS_CTL);
    if (tid == 0) { int acc = 0; for (int e = 0; e < NEXP; ++e) { tb[e] = acc; acc += ((int)ctl[CW_CNT + 64 * e] + 255) >> 8; } tb[NEXP] = acc; }
    __syncthreads();
}

__device__ __forceinline__ void phase_gather(const Args& a, LAS unsigned char* lds, int tid, int G) {
    unsigned char* ws = a.ws; const int lane = tid & 63, wave = tid >> 6;
    LAS int* tb = (LAS int*)lds;
    load_tile_base(a, tb, tid);
    unsigned* ctl = (unsigned*)(ws + WS_CTL);
    const int NT = tb[NEXP];
    if (blockIdx.x == 0) { if (tid == 0) ctl[CW_NT] = (unsigned)NT;
        if (tid < NEXP) for (int t = tb[tid]; t < tb[tid + 1]; ++t) ctl[CW_TILEE + t] = (unsigned)tid;
        if (tid <= NEXP) ctl[CW_TBASE + tid] = (unsigned)tb[tid]; }
    const int* rows = (const int*)(ws + WS_ROWS); const bf16_t* H1B = (const bf16_t*)(ws + WS_H1B); bf16_t* XG = (bf16_t*)(ws + WS_XG);
    for (int r = blockIdx.x * NWAVES + wave; r < NT * 256; r += G * NWAVES) {
        const int tile = r >> 8; int e = 0;
        for (int j = 1; j < NEXP; ++j) if (tb[j] <= tile) e = j;
        const int pos = r - tb[e] * 256; const int cnt = (int)ctl[CW_CNT + 64 * e];
        u32x4 v[4];
        if (pos < cnt) { const int tok = rows[e * MT + pos];
#pragma unroll
            for (int i = 0; i < 4; ++i) v[i] = *(const u32x4*)(H1B + (size_t)tok * DM + 512 * i + 8 * lane); }
        else {
#pragma unroll
            for (int i = 0; i < 4; ++i) v[i] = (u32x4){0u, 0u, 0u, 0u}; }
#pragma unroll
        for (int i = 0; i < 4; ++i) *(u32x4*)(XG + (size_t)r * DM + 512 * i + 8 * lane) = v[i];
    }
}

struct FinSlots { int r0, r1; float w0, w1; };
__device__ __forceinline__ void fin_slots(const Args& a, int row, const LAS int* tb, FinSlots& S) {
    unsigned char* ws = a.ws;
    const int* slot_e = (const int*)(ws + WS_SLOT); const int* slot_p = slot_e + 2 * MT; const float* slot_w = (const float*)(slot_p + 2 * MT);
    const int e0 = slot_e[2 * row], e1 = slot_e[2 * row + 1];
    S.r0 = tb[e0] * 256 + slot_p[2 * row]; S.r1 = tb[e1] * 256 + slot_p[2 * row + 1]; S.w0 = slot_w[2 * row]; S.w1 = slot_w[2 * row + 1];
}
__device__ __forceinline__ void fin_data(const Args& a, int row, int lane, const FinSlots& S, u32x2 (&hw)[8], u32x2 (&ya)[8], u32x2 (&yb)[8]) {
    unsigned char* ws = a.ws;
    const bf16_t* H1B = (const bf16_t*)(ws + WS_H1B) + (size_t)row * DM; const bf16_t* Y = (const bf16_t*)(ws + WS_Y);
#pragma unroll
    for (int i = 0; i < 8; ++i) { hw[i] = *(const u32x2*)(H1B + 256 * i + 4 * lane); ya[i] = *(const u32x2*)(Y + (size_t)S.r0 * DM + 256 * i + 4 * lane); yb[i] = *(const u32x2*)(Y + (size_t)S.r1 * DM + 256 * i + 4 * lane); }
}
__device__ __forceinline__ void fin_compute(const Args& a, int row, int lane, float w0, float w1, const u32x2 (&hw)[8], const u32x2 (&ya)[8], const u32x2 (&yb)[8]) {
    f32x4 v[8]; float s = 0.f;
#pragma unroll
    for (int i = 0; i < 8; ++i) {
        const f32x4 hv = {__uint_as_float(hw[i].x << 16), __uint_as_float(hw[i].x & 0xffff0000u), __uint_as_float(hw[i].y << 16), __uint_as_float(hw[i].y & 0xffff0000u)};
        const f32x4 fa = {__uint_as_float(ya[i].x << 16), __uint_as_float(ya[i].x & 0xffff0000u), __uint_as_float(ya[i].y << 16), __uint_as_float(ya[i].y & 0xffff0000u)};
        const f32x4 fb = {__uint_as_float(yb[i].x << 16), __uint_as_float(yb[i].x & 0xffff0000u), __uint_as_float(yb[i].y << 16), __uint_as_float(yb[i].y & 0xffff0000u)};
        v[i] = hv * DN_ALPHA + fa * w0 + fb * w1; s += (v[i][0] + v[i][1]) + (v[i][2] + v[i][3]); }
    const float mean = wave_sum(s) * (1.0f / DM); float s2 = 0.f;
#pragma unroll
    for (int i = 0; i < 8; ++i) { v[i] = v[i] - mean; s2 += (v[i][0] * v[i][0] + v[i][1] * v[i][1]) + (v[i][2] * v[i][2] + v[i][3] * v[i][3]); }
    const float rstd = 1.0f / sqrtf(wave_sum(s2) * (1.0f / DM) + LN_EPS);
    float* O = a.out + (size_t)row * DM;
#pragma unroll
    for (int i = 0; i < 8; ++i) { const f32x4 g = *(const f32x4*)(a.in[I_LN2G] + 256 * i + 4 * lane), bb = *(const f32x4*)(a.in[I_LN2B] + 256 * i + 4 * lane);
        *(f32x4*)(O + 256 * i + 4 * lane) = v[i] * rstd * g + bb; }
}
__device__ __forceinline__ void phase_final(const Args& a, int tid, int G, const LAS int* tb) {
    const int lane = tid & 63, wave = tid >> 6, gw = blockIdx.x * NWAVES + wave, NGW = G * NWAVES;
    if (gw >= MT) return;
    FinSlots SA, SB; u32x2 hA[8], aA[8], bA[8], hB[8], aB[8], bB[8];
    int row = gw;
    fin_slots(a, row, tb, SA); fin_data(a, row, lane, SA, hA, aA, bA);
    if (row + NGW < MT) fin_slots(a, row + NGW, tb, SB);
    for (;;) {
        const int r1 = row + NGW, r2 = row + 2 * NGW;
        if (r1 < MT) fin_data(a, r1, lane, SB, hB, aB, bB);
        const float w0 = SA.w0, w1 = SA.w1;
        if (r2 < MT) fin_slots(a, r2, tb, SA);
        fin_compute(a, row, lane, w0, w1, hA, aA, bA);
        if (r1 >= MT) break;
        const int r3 = row + 3 * NGW;
        if (r2 < MT) fin_data(a, r2, lane, SA, hA, aA, bA);
        const float x0 = SB.w0, x1 = SB.w1;
        if (r3 < MT) fin_slots(a, r3, tb, SB);
        fin_compute(a, r1, lane, x0, x1, hB, aB, bB);
        if (r2 >= MT) break;
        row = r2;
    }
}

namespace fa {
constexpr int D = 128, NW = 8, QBLK = 32, KVBLK = 64, LDX = 1024;
constexpr float SCALE = 0.088388347648318440f, THR = 8.f;
constexpr size_t SHM_V = KVBLK * D * 2, SHM_K = KVBLK * D * 2, SHM_ATTN = 2 * SHM_V + 2 * SHM_K + NW * 64 * 4;
using s16x4 = __attribute__((ext_vector_type(4))) short;
#define KSWZ(row, colB) ((row) * 256 + ((colB) ^ (((row) & 7) << 4)))
#define SBAR() __builtin_amdgcn_sched_barrier(0)
__device__ __forceinline__ int crow(int r, int hi) { return (r & 3) + 8 * (r >> 2) + 4 * hi; }

__device__ __forceinline__ void partialSM(f32x16& p0, f32x16& p1, float& m_reg, float& mn, float& alpha) {
  constexpr float C = SCALE * 1.4426950408889634f;
  float pmax = p0[0];
#pragma unroll
  for (int r = 1; r < 16; ++r) pmax = fmaxf(pmax, p0[r]);
#pragma unroll
  for (int r = 0; r < 16; ++r) pmax = fmaxf(pmax, p1[r]);
  { auto rr = __builtin_amdgcn_permlane32_swap(__float_as_uint(pmax), __float_as_uint(pmax), false, false);
    pmax = fmaxf(__uint_as_float(rr[0]), __uint_as_float(rr[1])); }
  if (__builtin_expect(__all(pmax - m_reg <= THR / SCALE), 1)) { mn = m_reg; alpha = 1.f; }
  else { mn = fmaxf(m_reg, pmax); alpha = __builtin_amdgcn_exp2f((m_reg - mn) * C); m_reg = mn; }
  float mnC = -mn * C;
#pragma unroll
  for (int r = 0; r < 16; ++r) p0[r] = fmaf(p0[r], C, mnC);
#pragma unroll
  for (int r = 0; r < 16; ++r) p1[r] = fmaf(p1[r], C, mnC);
#pragma unroll
  for (int r = 0; r < 16; ++r) p0[r] = __builtin_amdgcn_exp2f(p0[r]);
}
__device__ __forceinline__ void finishSM(f32x16& p0, f32x16& p1, float alpha, float& l_reg, bf16x8& pa0, bf16x8& pa1, bf16x8& pa2, bf16x8& pa3) {
#pragma unroll
  for (int r = 0; r < 16; ++r) p1[r] = __builtin_amdgcn_exp2f(p1[r]);
  float ps = 0;
#pragma unroll
  for (int r = 0; r < 16; ++r) ps += p0[r];
#pragma unroll
  for (int r = 0; r < 16; ++r) ps += p1[r];
  { auto rr = __builtin_amdgcn_permlane32_swap(__float_as_uint(ps), __float_as_uint(ps), false, false);
    ps = __uint_as_float(rr[0]) + __uint_as_float(rr[1]); }
  l_reg = l_reg * alpha + ps;
#define PK4(P, BASE, OUT) do { unsigned a0 = cvt_pk(P[BASE + 0], P[BASE + 1]), a1 = cvt_pk(P[BASE + 2], P[BASE + 3]);   \
    unsigned b0 = cvt_pk(P[BASE + 4], P[BASE + 5]), b1 = cvt_pk(P[BASE + 6], P[BASE + 7]);                              \
    auto r0 = __builtin_amdgcn_permlane32_swap(a0, b0, false, false); auto r1 = __builtin_amdgcn_permlane32_swap(a1, b1, false, false); \
    u32x4 w = {r0[0], r1[0], r0[1], r1[1]}; OUT = *reinterpret_cast<bf16x8*>(&w); } while (0)
  PK4(p0, 0, pa0); PK4(p0, 8, pa1); PK4(p1, 0, pa2); PK4(p1, 8, pa3);
#undef PK4
}
__device__ __forceinline__ void qkt(f32x16& p0, f32x16& p1, const char* Ks, const bf16x8* qr, int r32, int hi) {
  p0 = f32x16{}; p1 = f32x16{};
#pragma unroll
  for (int d0 = 0; d0 < 8; ++d0) { int cb = (d0 * 16 + hi * 8) * 2;
    bf16x8 b0 = *reinterpret_cast<const bf16x8*>(Ks + KSWZ(r32, cb));
    bf16x8 b1 = *reinterpret_cast<const bf16x8*>(Ks + KSWZ(32 + r32, cb));
    p0 = __builtin_amdgcn_mfma_f32_32x32x16_bf16(b0, qr[d0], p0, 0, 0, 0);
    p1 = __builtin_amdgcn_mfma_f32_32x32x16_bf16(b1, qr[d0], p1, 0, 0, 0); }
}
__device__ __forceinline__ void mask_bias(f32x16& p0, f32x16& p1, u32x2 mw, float dq, float slr, int hi) {
  const unsigned w0 = mw.x >> (4 * hi), w1 = mw.y >> (4 * hi);
  const unsigned NEG = 0xf149f2cau;
#pragma unroll
  for (int r = 0; r < 16; ++r) { const int c = (r & 3) + 8 * (r >> 2);
    const float d0 = dq - (float)c, d1 = dq - (float)(32 + c);
    const float s0 = fmaf(-slr, fabsf(d0), p0[r]), s1 = fmaf(-slr, fabsf(d1), p1[r]);
    const unsigned t0 = (unsigned)(((int)(w0 << (31 - c))) >> 31), t1 = (unsigned)(((int)(w1 << (31 - c))) >> 31);
    p0[r] = __uint_as_float((__float_as_uint(s0) & t0) | (NEG & ~t0));
    p1[r] = __uint_as_float((__float_as_uint(s1) & t1) | (NEG & ~t1)); }
}
__device__ __forceinline__ int v_st(int k, int c) { const int kk = (k & ~0xC) | ((k & 4) << 1) | ((k & 8) >> 1); return ((kk >> 3) * 4 + (c >> 5)) * 512 + ((kk & 7) * 32 + (c & 31)) * 2; }
__device__ __forceinline__ int v_rd_base(int lane) { return ((lane & 3) << 3) | (((lane >> 2) & 3) << 6) | (((lane >> 4) & 1) << 5) | (((lane >> 5) & 1) << 8); }
constexpr int v_rd_off(int d0, int ks, int half) { return d0 * 512 + ks * 4096 + half * 2048; }
template <int OFF> __device__ __forceinline__ s16x4 tr_read(int vb) {
  s16x4 r; asm volatile("ds_read_b64_tr_b16 %0, %1 offset:%2" : "=&v"(r) : "v"(vb), "i"(OFF) : "memory"); return r;
}
template <int D0> __device__ __forceinline__ void pv_one(f32x16& od, int vb, bf16x8 pa0, bf16x8 pa1, bf16x8 pa2, bf16x8 pa3) {
  const s16x4 l0 = tr_read<v_rd_off(D0, 0, 0)>(vb), h0 = tr_read<v_rd_off(D0, 0, 1)>(vb), l1 = tr_read<v_rd_off(D0, 1, 0)>(vb), h1 = tr_read<v_rd_off(D0, 1, 1)>(vb);
  const s16x4 l2 = tr_read<v_rd_off(D0, 2, 0)>(vb), h2 = tr_read<v_rd_off(D0, 2, 1)>(vb), l3 = tr_read<v_rd_off(D0, 3, 0)>(vb), h3 = tr_read<v_rd_off(D0, 3, 1)>(vb);
  asm volatile("s_waitcnt lgkmcnt(0)" ::: "memory"); SBAR();
#define PK(L, H) (bf16x8){L[0], L[1], L[2], L[3], H[0], H[1], H[2], H[3]}
  od = __builtin_amdgcn_mfma_f32_32x32x16_bf16(pa0, PK(l0, h0), od, 0, 0, 0);
  od = __builtin_amdgcn_mfma_f32_32x32x16_bf16(pa1, PK(l1, h1), od, 0, 0, 0);
  od = __builtin_amdgcn_mfma_f32_32x32x16_bf16(pa2, PK(l2, h2), od, 0, 0, 0);
  od = __builtin_amdgcn_mfma_f32_32x32x16_bf16(pa3, PK(l3, h3), od, 0, 0, 0);
#undef PK
}
__device__ __forceinline__ void pv_d0(f32x16* o, int vb, bf16x8 pa0, bf16x8 pa1, bf16x8 pa2, bf16x8 pa3) {
  pv_one<0>(o[0], vb, pa0, pa1, pa2, pa3); pv_one<1>(o[1], vb, pa0, pa1, pa2, pa3); pv_one<2>(o[2], vb, pa0, pa1, pa2, pa3); pv_one<3>(o[3], vb, pa0, pa1, pa2, pa3);
}

#define FA_GAS __attribute__((address_space(1)))
__device__ __forceinline__ void attn_block(const bf16_t* Qb_, const bf16_t* Kh_, const bf16_t* Vh_, const unsigned* maskrow_,
                                           bf16_t* Ob_, int NT, int qpos0, float slr, char* lds) {
  const FA_GAS bf16_t* Qb = (const FA_GAS bf16_t*)Qb_; const FA_GAS bf16_t* Kh = (const FA_GAS bf16_t*)Kh_; const FA_GAS bf16_t* Vh = (const FA_GAS bf16_t*)Vh_;
  const FA_GAS unsigned* maskrow = (const FA_GAS unsigned*)maskrow_; FA_GAS bf16_t* Ob = (FA_GAS bf16_t*)Ob_;
  int tid_ = threadIdx.x; asm volatile("" : "+v"(tid_));
  const int tid = tid_, wid = tid >> 6, lane = tid & 63, r32 = lane & 31, hi = lane >> 5;
  char* V_lds = lds; char* K_lds = lds + 2 * SHM_V;
  float* wsm = (float*)(lds + 2 * SHM_V + 2 * SHM_K) + wid * 64; float* li_l = wsm; float* al_l = wsm + 32;
  float m_reg = -1e30f, l_reg = 0; f32x16 o[4] = {}; bf16x8 qr[8];
  const FA_GAS bf16_t* Qw = Qb + (long)(wid * QBLK + r32) * LDX + hi * 8;
#pragma unroll
  for (int d0 = 0; d0 < 8; ++d0) qr[d0] = *reinterpret_cast<const FA_GAS bf16x8*>(Qw + d0 * 16);
  const unsigned moff = (unsigned)(wid * QBLK + r32) * 256u;
  const float qposf = (float)(qpos0 + wid * QBLK + r32 - 4 * hi);
  const int sr = tid >> 4, sc = (tid & 15) * 8, vst0 = v_st(sr, sc), vst1 = v_st(32 + sr, sc);
  const int vb0 = (int)(uintptr_t)V_lds + v_rd_base(lane);
  constexpr int SDEPTH = 1;
  struct { bf16x8 vs0, vs1, ks0, ks1; } sr_[SDEPTH];
#define KOFF(j) ((NT - 1 - (j)) * KVBLK)
#define SLOAD(i, k0) do { sr_[i].vs0 = *reinterpret_cast<const FA_GAS bf16x8*>(&Vh[(long)((k0) + sr) * LDX + sc]); sr_[i].vs1 = *reinterpret_cast<const FA_GAS bf16x8*>(&Vh[(long)((k0) + 32 + sr) * LDX + sc]); \
    sr_[i].ks0 = *reinterpret_cast<const FA_GAS bf16x8*>(&Kh[(long)((k0) + sr) * LDX + sc]); sr_[i].ks1 = *reinterpret_cast<const FA_GAS bf16x8*>(&Kh[(long)((k0) + 32 + sr) * LDX + sc]); } while (0)
#define SWRITE(b, i) do { *(bf16x8*)(V_lds + (b) * SHM_V + vst0) = sr_[i].vs0;          \
    *(bf16x8*)(V_lds + (b) * SHM_V + vst1) = sr_[i].vs1; int kc = sc * 2;               \
    *(bf16x8*)(K_lds + (b) * SHM_K + KSWZ(sr, kc)) = sr_[i].ks0;                       \
    *(bf16x8*)(K_lds + (b) * SHM_K + KSWZ(32 + sr, kc)) = sr_[i].ks1; } while (0)
#define SWAIT() do { if constexpr (SDEPTH == 2) asm volatile("s_waitcnt vmcnt(4)" ::: "memory"); else asm volatile("s_waitcnt vmcnt(0)" ::: "memory"); } while (0)
#define RESC(a) do { if (__any((a) < 1.f)) { if (hi == 0) al_l[r32] = (a); asm volatile("s_waitcnt lgkmcnt(0)" ::: "memory"); \
    _Pragma("unroll") for (int d = 0; d < 4; ++d) _Pragma("unroll") for (int r = 0; r < 16; ++r) o[d][r] *= al_l[crow(r, hi)]; } } while (0)
#define MASKW(j) (*reinterpret_cast<const FA_GAS u32x2*>(maskrow + (moff + 2u * (unsigned)(NT - 1 - (j)))))
#define MB(P0, P1, j, MW) mask_bias(P0, P1, MW, qposf - (float)KOFF(j), slr, hi)
  f32x16 pA0, pA1, pB0, pB1; float mnA, mnB, alA, alB; bf16x8 pa0, pa1, pa2, pa3;
  constexpr int SE = 0, SO = SDEPTH - 1;
  SLOAD(SE, KOFF(0)); asm volatile("s_waitcnt vmcnt(0)" ::: "memory"); SWRITE(0, SE); __syncthreads();
  u32x2 mA = MASKW(0), mB = MASKW(1);
  { qkt(pA0, pA1, K_lds, qr, r32, hi); MB(pA0, pA1, 0, mA); } partialSM(pA0, pA1, m_reg, mnA, alA);
  SLOAD(SO, KOFF(1)); if constexpr (SDEPTH == 2) { if (2 < NT) SLOAD(SE, KOFF(2)); }
  SWAIT(); SWRITE(1, SO); __syncthreads();
  for (int j = 1; j + 1 < NT; j += 2) {
    SBAR(); mA = MASKW(j + 1); { qkt(pB0, pB1, K_lds + SHM_K, qr, r32, hi); MB(pB0, pB1, j, mB); }
    finishSM(pA0, pA1, alA, l_reg, pa0, pa1, pa2, pa3); SBAR();
    SLOAD(SO, KOFF(j + SDEPTH)); SBAR();
    pv_d0(o, vb0, pa0, pa1, pa2, pa3); partialSM(pB0, pB1, m_reg, mnB, alB);
    __syncthreads(); SWAIT(); SWRITE(0, SE);
    RESC(alB); __syncthreads();
    SBAR(); mB = MASKW(j + 2); { qkt(pA0, pA1, K_lds, qr, r32, hi); MB(pA0, pA1, j + 1, mA); }
    finishSM(pB0, pB1, alB, l_reg, pa0, pa1, pa2, pa3); SBAR();
    if (SDEPTH == 1 || j + 3 < NT) SLOAD(SE, KOFF(j + 1 + SDEPTH)); SBAR();
    pv_d0(o, vb0 + (int)SHM_V, pa0, pa1, pa2, pa3); partialSM(pA0, pA1, m_reg, mnA, alA);
    __syncthreads(); SWAIT(); SWRITE(1, SO);
    RESC(alA); __syncthreads();
  }
  SBAR(); { qkt(pB0, pB1, K_lds + SHM_K, qr, r32, hi); MB(pB0, pB1, NT - 1, mB); }
  finishSM(pA0, pA1, alA, l_reg, pa0, pa1, pa2, pa3); SBAR();
  pv_d0(o, vb0, pa0, pa1, pa2, pa3); partialSM(pB0, pB1, m_reg, mnB, alB);
  __syncthreads(); RESC(alB);
  finishSM(pB0, pB1, alB, l_reg, pa0, pa1, pa2, pa3); SBAR();
  pv_d0(o, vb0 + (int)SHM_V, pa0, pa1, pa2, pa3);
  if (hi == 0) li_l[r32] = l_reg; asm volatile("s_waitcnt lgkmcnt(0)" ::: "memory");
  float rli[16];
#pragma unroll
  for (int r = 0; r < 16; ++r) rli[r] = __builtin_amdgcn_rcpf(li_l[crow(r, hi)]);
  FA_GAS bf16_t* Ow = Ob + (long)(wid * QBLK) * LDX;
#pragma unroll
  for (int r = 0; r < 16; ++r) { int orow = crow(r, hi);
#pragma unroll
    for (int d0 = 0; d0 < 4; ++d0) Ow[(long)orow * LDX + d0 * 32 + r32] = (bf16_t)(cvt_pk(o[d0][r] * rli[r], 0.f) & 0xffffu); }
  __syncthreads();
#undef KOFF
#undef SLOAD
#undef SWRITE
#undef SWAIT
#undef RESC
#undef MASKW
#undef MB
}
#undef KSWZ
#undef SBAR
}

__device__ __forceinline__ void phase_attention(const Args& a, char* lds, int G, int bid) {
    unsigned char* ws = uni_ptr(a.ws);
    const bf16_t* BQ = (const bf16_t*)(ws + WS_BQ); const bf16_t* BK = (const bf16_t*)(ws + WS_BK); const bf16_t* BV = (const bf16_t*)(ws + WS_BV);
    const unsigned* MASK = (const unsigned*)(ws + WS_MASK); bf16_t* BRB = (bf16_t*)(ws + WS_BRB);
    const int bx = bid; const int vcu = (G % 8 == 0) ? (bx % 8) * (G / 8) + bx / 8 : bx;
    for (int p0 = vcu; p0 < 256; p0 += G) { const int p = __builtin_amdgcn_readfirstlane(p0);
        const int b = p >> 7, h = (p >> 4) & 7, x = p & 15;
        const float slr = uni_f((1.0f / fa::SCALE) / (float)(2 << h));
#pragma unroll 1
        for (int half = 0; half < 2; ++half) { const int qb = half ? 31 - x : x; const size_t row0 = (size_t)b * SEQ + qb * 256;
            fa::attn_block(uni_ptr(BQ + row0 * 1024 + h * 128), uni_ptr(BK + (size_t)b * SEQ * 1024 + h * 128), uni_ptr(BV + (size_t)b * SEQ * 1024 + h * 128),
                           uni_ptr(MASK + row0 * 256), uni_ptr(BRB + row0 * 1024 + h * 128), 4 * (qb + 1), qb * 256, slr, lds); }
    }
}


constexpr int NPH = 13;
#ifndef REPS
#define REPS 1,1,1,1,1,1,1,1,1,1,1,1,1,1,1,1
#endif
constexpr int REP[16] = {REPS};
__global__ void __launch_bounds__(NTHR, 2) mk_fwd(Args a) {
    extern __shared__ __attribute__((aligned(16))) unsigned char lds_raw[];
    LAS unsigned char* lds = (LAS unsigned char*)lds_raw;
    cg::grid_group grid = cg::this_grid();
    const int G = gridDim.x;
#define FRESH_TID() int tid = threadIdx.x; asm volatile("" : "+v"(tid)); const int lane = tid & 63, wave = tid >> 6; (void)lane; (void)wave

    unsigned char* ws = a.ws;
    const int lo = a.ph_lo, hi = a.ph_hi;
#define IN(k) (lo <= (k) && (k) < hi)
    if (threadIdx.x == 0) { ((volatile LAS unsigned*)(lds + LDS_BARST))[0] = 0u; ((volatile LAS unsigned*)(lds + LDS_BARST))[1] = 0u; }
    __syncthreads();
    (void)xcd_barrier_post((unsigned*)(ws + WS_CTL) + CW_BAR, (volatile LAS unsigned*)(lds + LDS_BARST));
    int bid = blockIdx.x;
    if (lo == 0 && hi == NPH && (G % 8) == 0) {
        if (threadIdx.x == 0) { const unsigned x = xb_xcc_id(); const unsigned r = atomicAdd((unsigned*)(ws + WS_CTL) + CW_TICKET + 64 * x, 1u); ((volatile LAS unsigned*)(lds + LDS_BARST))[2] = r * 8u + (x & 7u); }
    }
#define SEAM(k) do { if (IN(k) && IN((k) + 1)) { if (lo < 0) grid.sync();   else { XcdBarrier b_; b_.bar = (unsigned*)(a.ws + WS_CTL) + CW_BAR; b_.x = xb_xcc_id(); b_.st = (volatile LAS unsigned*)(lds + LDS_BARST); xcd_barrier(b_); } } } while (0)

    if (IN(0)) { FRESH_TID(); for (int rp = 0; rp < REP[0]; ++rp) { phase_prologue(a, lds, tid, G); __syncthreads(); } }
    SEAM(0);
    if (lo == 0 && hi == NPH && (G % 8) == 0) {
        const unsigned* bw = (const unsigned*)(ws + WS_CTL) + CW_BAR; bool ok = true;
        for (int j = 0; j < 8; ++j) ok = ok && (__hip_atomic_load(bw + XB_XCNT(j), __ATOMIC_RELAXED, __HIP_MEMORY_SCOPE_AGENT) == (unsigned)(G / 8));
        if (ok) bid = __builtin_amdgcn_readfirstlane((int)((volatile LAS unsigned*)(lds + LDS_BARST))[2]);
    }
    if (IN(1)) { FRESH_TID(); pg8::Gemm g{(const bf16_t*)(ws + WS_XB), (const bf16_t*)(ws + WS_WIN), MT, NPROJ_PAD, DM}; pg8::StaticOrder S; S.init(MT, NPROJ_PAD, G, bid);
        for (int c8 = tid; c8 < NPROJ_PAD / 2; c8 += NTHR) { const int c = 2 * c8; float b0 = 0.f, b1 = 0.f;
            if (c < 7752) { b0 = a.in[I_BIN][c]; b1 = a.in[I_BIN][c + 1]; } else if (c >= 7936) { b0 = a.in[I_BIN][c - 184]; b1 = a.in[I_BIN][c - 183]; }
            *(LAS unsigned*)(lds + LDS_BIAS + c * 2) = cvt_pk(b0, b1); }
        __syncthreads();
        pg8::EpiProj E{ws, lds + LDS_BIAS};
        for (int rp = 0; rp < REP[1]; ++rp) pg8::gemm_phase<pg8::EpiProj, pg8::StaticOrder, true, true>(lds, g, S, E); }
    SEAM(1);
    if (IN(2)) { FRESH_TID(); hg_fill_lb(a, lds, tid);
        for (int rp = 0; rp < REP[2]; ++rp) for (int u = blockIdx.x; u < 2048; u += G) hgrn1_unit(a, u, lds, tid);
        for (int rp = 0; rp < REP[3]; ++rp) for (int k = 0; k * G < MT / 4; ++k) { const int u = k * G + ((k & 1) ? (G - 1 - (int)blockIdx.x) : (int)blockIdx.x); if (u < MT / 4) indexer_unit(a, u, lds, tid); } }
    SEAM(2);
    if (IN(3)) { FRESH_TID(); for (int rp = 0; rp < REP[4]; ++rp) hgrn_scan(a, tid, G);
        for (int rp = 0; rp < REP[5]; ++rp) phase_attention(a, (char*)lds_raw, G, bid); }
    SEAM(3);
    if (IN(4)) { FRESH_TID(); for (int rp = 0; rp < REP[6]; ++rp) { float z[16]; unsigned qq[16], vv[16]; u32x4 stp[4]; u32x2 gwn[4];
            if ((int)blockIdx.x < 2048) hg3_load(a, blockIdx.x, tid, z, qq, vv, stp, gwn);
            hg_fill_lb(a, lds, tid);
            for (int u = blockIdx.x; u < 2048; u += G) hgrn3_unit(a, u, (u + G < 2048) ? u + G : -1, lds, tid, z, qq, vv, stp, gwn); } }
    SEAM(4);
    if (IN(5)) { FRESH_TID(); for (int rp = 0; rp < REP[7]; ++rp) {
        { pg8::Gemm g{(const bf16_t*)(ws + WS_BRA), (const bf16_t*)(ws + WS_WA), MT, DM, 1024}; pg8::StaticOrder S; S.init(MT, DM, G, bid);
          pg8::EpiBranch<0> E{(bf16_t*)(ws + WS_MERGED), (const bf16_t*)(ws + WS_GATES)};
          pg8::gemm_phase<pg8::EpiBranch<0>, pg8::StaticOrder, true, true>(lds, g, S, E); }
        { pg8::Gemm g{(const bf16_t*)(ws + WS_BRB), (const bf16_t*)(ws + WS_WB), MT, DM, 1024}; pg8::StaticOrder S; S.init(MT, DM, G, bid);
          pg8::EpiBranch<1> E{(bf16_t*)(ws + WS_MERGED), (const bf16_t*)(ws + WS_GATES)};
          pg8::gemm_phase<pg8::EpiBranch<1>, pg8::StaticOrder, true, true>(lds, g, S, E); } } }
    SEAM(6);
    if (IN(7)) { FRESH_TID(); pg8::Gemm g{(const bf16_t*)(ws + WS_MERGED), (const bf16_t*)(ws + WS_WOUT), MT, DM, DM}; pg8::StaticOrder S; S.init(MT, DM, G, bid);
        pg8::EpiResBf16 E{(bf16_t*)(ws + WS_PRE1), a.in[I_X], DN_ALPHA};
        for (int rp = 0; rp < REP[8]; ++rp) pg8::gemm_phase<pg8::EpiResBf16, pg8::StaticOrder, true, true>(lds, g, S, E); }
    SEAM(7);
    if (IN(8)) { FRESH_TID(); for (int rp = 0; rp < REP[9]; ++rp) phase8_router_expw(a, lds, tid, G, rp == 0, rp == 0);
        for (int rp = 1; rp < REP[10]; ++rp) phase_expert_weights(a, lds, tid, G); }
    if (IN(8) && IN(10)) { XcdBarrier b_; b_.bar = (unsigned*)(a.ws + WS_CTL) + CW_BAR; b_.x = xb_xcc_id(); b_.st = (volatile LAS unsigned*)(lds + LDS_BARST); xcd_barrier(b_); }
    if (IN(10)) { FRESH_TID(); const unsigned* ctl = (const unsigned*)(ws + WS_CTL);
        LAS int* tb = (LAS int*)(lds + LDS_MOE_TB); LAS unsigned* TE = (LAS unsigned*)(lds + LDS_MOE_TE); LAS unsigned* TOK = (LAS unsigned*)(lds + LDS_MOE_TOK);
        __syncthreads(); load_tile_base(a, tb, tid);
        if (tid < NEXP) for (int t = tb[tid]; t < tb[tid + 1]; ++t) TE[t] = (unsigned)tid;
        __syncthreads();
        const int NT = tb[NEXP];
        pg8::GroupedOrder<true> S; S.init(NT, 8, G, bid, TE, TOK);
        { const int* rows = (const int*)(ws + WS_ROWS);
          for (int i = 0; i < 8; ++i) { pg8::Unit u; if (!S.next(i, u)) break;
              if (tid < 256) { const int e = (int)TE[u.pm], pos = (u.pm - tb[e]) * 256 + tid, cnt = (int)ctl[CW_CNT + 64 * e];
                  TOK[i * 256 + tid] = (pos < cnt) ? (unsigned)rows[e * MT + pos] * (unsigned)(DM * 2) : 0u; } } }
        __syncthreads();
        pg8::Gemm g{(const bf16_t*)(ws + WS_H1B), (const bf16_t*)(ws + WS_WGU), NT * 256, 2048, DM};
        pg8::EpiGateUp E{(bf16_t*)(ws + WS_HH)};
        for (int rp = 0; rp < REP[12]; ++rp) pg8::gemm_phase<pg8::EpiGateUp, pg8::GroupedOrder<true>, true, true>(lds, g, S, E); }
    SEAM(10);
    if (IN(11)) { FRESH_TID();
        LAS int* tb = (LAS int*)(lds + LDS_MOE_TB); LAS unsigned* TE = (LAS unsigned*)(lds + LDS_MOE_TE);
        __syncthreads(); load_tile_base(a, tb, tid);
        if (tid < NEXP) for (int t = tb[tid]; t < tb[tid + 1]; ++t) TE[t] = (unsigned)tid;
        __syncthreads();
        const int NT = tb[NEXP];
        pg8::Gemm g{(const bf16_t*)(ws + WS_HH), (const bf16_t*)(ws + WS_WD), NT * 256, 2048, DFF}; pg8::GroupedOrder<false> S; S.init(NT, 8, G, bid, TE, nullptr);
        pg8::EpiStoreBf16 E{(bf16_t*)(ws + WS_Y), DM, uni_f((float)(G > 0))};
        for (int rp = 0; rp < REP[13]; ++rp) pg8::gemm_phase<pg8::EpiStoreBf16, pg8::GroupedOrder<false>, true, true>(lds, g, S, E); }
    SEAM(11);
    if (IN(12)) { FRESH_TID(); LAS int* tb = (LAS int*)lds; __syncthreads(); load_tile_base(a, tb, tid);
        for (int rp = 0; rp < REP[14]; ++rp) phase_final(a, tid, G, tb); }
#undef IN
#undef SEAM
}

#ifndef MK_SPLIT
#define MK_SPLIT 0
#endif
extern "C" void kernel_launch(void* const* d_in, const int* in_sizes, int n_in, void* d_out, int out_size, void* d_ws, size_t ws_size, hipStream_t stream) {
    static int grid = 0;
    if (grid == 0) {
        int dev = 0, cus = 0, per_cu = 0;
        if (n_in != 19 || out_size != MT * DM || ws_size < WS_END) { fprintf(stderr, "kernel_launch: unexpected shapes: n_in %d out %d ws %zu (need %zu)\n", n_in, out_size, ws_size, (size_t)WS_END); grid = -1; return; }
        if (hipGetDevice(&dev) != hipSuccess || hipDeviceGetAttribute(&cus, hipDeviceAttributeMultiprocessorCount, dev) != hipSuccess) { grid = -1; return; }
        if (hipFuncSetAttribute((const void*)mk_fwd, hipFuncAttributeMaxDynamicSharedMemorySize, LDS_BYTES) != hipSuccess) { fprintf(stderr, "kernel_launch: hipFuncSetAttribute failed\n"); grid = -1; return; }
        if (hipOccupancyMaxActiveBlocksPerMultiprocessor(&per_cu, (const void*)mk_fwd, NTHR, LDS_BYTES) != hipSuccess || per_cu < 1) { fprintf(stderr, "kernel_launch: occupancy query says %d blocks/CU\n", per_cu); grid = -1; return; }
        grid = cus;
    }
    if (grid < 0) return;
    (void)hipMemsetAsync((char*)d_ws + WS_CTL, 0, 1 * MiB, stream);
    Args a{};
    for (int i = 0; i < 19; ++i) a.in[i] = (const float*)d_in[i];
    a.out = (float*)d_out; a.ws = (unsigned char*)d_ws;
#if MK_SPLIT
#ifndef MK_DUP
#define MK_DUP -1
#endif
    for (int p2 = 0; p2 < NPH + (MK_DUP >= 0 ? 1 : 0); ++p2) { const int p = (MK_DUP >= 0 && p2 > MK_DUP) ? p2 - 1 : p2;
        a.ph_lo = p; a.ph_hi = p + 1; void* args[] = {&a};
        hipError_t e = hipLaunchCooperativeKernel((const void*)mk_fwd, dim3(grid), dim3(NTHR), args, LDS_BYTES, stream);
        if (e != hipSuccess) { fprintf(stderr, "cooperative launch (phase %d) failed: %s (grid %d)\n", p, hipGetErrorString(e), grid); break; } }
#else
    a.ph_lo = 0; a.ph_hi = NPH; void* args[] = {&a};
    hipError_t e = hipLaunchCooperativeKernel((const void*)mk_fwd, dim3(grid), dim3(NTHR), args, LDS_BYTES, stream);
    if (e != hipSuccess) fprintf(stderr, "cooperative launch failed: %s (grid %d)\n", hipGetErrorString(e), grid);
#endif
}
```

```cpp
#include <hip/hip_runtime.h>
#include <hip/hip_cooperative_groups.h>
#include <cstdio>
#include <cstdint>
namespace cg = cooperative_groups;

#define LAS __attribute__((address_space(3)))
typedef unsigned short bf16_t;
typedef short bf16x8 __attribute__((ext_vector_type(8)));
typedef float f32x4 __attribute__((ext_vector_type(4)));
typedef float f32x2 __attribute__((ext_vector_type(2)));
typedef float f32x16 __attribute__((ext_vector_type(16)));
typedef unsigned u32x4 __attribute__((ext_vector_type(4)));
typedef unsigned u32x2 __attribute__((ext_vector_type(2)));

constexpr int MT = 16384, SEQ = 8192, DM = 2048, NHEAD = 8, HD = 128, NPROJ = 11848, NPROJ_PAD = 12032;
constexpr int NEXP = 32, DFF = 1024, MAXROWS = 40960;
constexpr float DN_ALPHA = 1.189207115002721f;
constexpr float LN_EPS = 1e-5f, RMS_EPS = 1e-6f;
constexpr int NWAVES = 8, NTHR = 512;
constexpr int LDS_BYTES = 163840;

constexpr size_t MiB = 1u << 20;
constexpr size_t WS_CTL = 0;
constexpr size_t WS_WIN = 1 * MiB;
constexpr size_t WS_WA = 48 * MiB, WS_WB = 52 * MiB, WS_WOUT = 56 * MiB;
constexpr size_t WS_XB = 64 * MiB;
constexpr size_t WS_MERGED = 64 * MiB;
constexpr size_t WS_AQ = 128 * MiB, WS_AI = 160 * MiB, WS_AG = 192 * MiB, WS_BQ = 224 * MiB, WS_BK = 256 * MiB, WS_BV = 288 * MiB;
constexpr size_t WS_AF = 320 * MiB;
constexpr size_t WS_IQ = 384 * MiB;
constexpr size_t WS_IKW = 400 * MiB;
constexpr size_t WS_GATES = 408 * MiB;
constexpr size_t WS_WGU = 128 * MiB;
constexpr size_t WS_WD = 384 * MiB;
constexpr size_t WS_H1F8 = 256 * MiB;
constexpr size_t WS_MASK = 536 * MiB;
constexpr size_t WS_KV = 552 * MiB;
constexpr size_t WS_PRE1 = 552 * MiB;
constexpr size_t WS_ST = 680 * MiB;
constexpr size_t WS_H1B = 680 * MiB;
constexpr size_t WS_DECAY = 744 * MiB;
constexpr size_t WS_ROWS = 745 * MiB;
constexpr size_t WS_SLOT = 747 * MiB;
constexpr size_t WS_BRA = 750 * MiB, WS_BRB = 782 * MiB;
constexpr size_t WS_IK2 = 814 * MiB;
constexpr size_t WS_HH = 750 * MiB;
constexpr size_t WS_XG = 830 * MiB;
constexpr size_t WS_Y = 830 * MiB;
constexpr size_t WS_END = 990 * MiB;
constexpr int CW_CNT = 1024;
constexpr int CW_NT = 4096;
constexpr int CW_TILEE = 4160;
constexpr int CW_TBASE = 4400;
constexpr int CW_BAR = 8192;
constexpr int CW_TICKET = 12288;
constexpr int LDS_BIAS = 131072;
constexpr int LDS_MOE_TB = 131072, LDS_MOE_TE = 131072 + 256, LDS_MOE_TOK = 131072 + 1024;
constexpr int LDS_BARST = LDS_BYTES - 64;
constexpr int LDS_WTAB = LDS_BYTES - 128;

__device__ __forceinline__ float bf2f(unsigned h) { return __uint_as_float(h << 16); }
__device__ __forceinline__ unsigned cvt_pk(float lo, float hi) { unsigned r; asm volatile("v_cvt_pk_bf16_f32 %0, %1, %2" : "=v"(r) : "v"(lo), "v"(hi)); return r; }
__device__ __forceinline__ unsigned cvt_pk_mfma(float lo, float hi) { unsigned r; asm volatile("s_nop 15\n\ts_nop 3\n\tv_cvt_pk_bf16_f32 %0, %1, %2" : "=v"(r) : "v"(lo), "v"(hi)); return r; }
__device__ __forceinline__ unsigned cvt_pk_to_mfma(float lo, float hi) { unsigned r; asm volatile("v_cvt_pk_bf16_f32 %0, %1, %2\n\ts_nop 1" : "=v"(r) : "v"(lo), "v"(hi)); return r; }
__device__ __forceinline__ unsigned cvt4_fp8(float a, float b, float c, float d, float s) {
    a = __builtin_amdgcn_fmed3f(a * s, -448.f, 448.f); b = __builtin_amdgcn_fmed3f(b * s, -448.f, 448.f); c = __builtin_amdgcn_fmed3f(c * s, -448.f, 448.f); d = __builtin_amdgcn_fmed3f(d * s, -448.f, 448.f);
    int w = 0; w = __builtin_amdgcn_cvt_pk_fp8_f32(a, b, w, false); w = __builtin_amdgcn_cvt_pk_fp8_f32(c, d, w, true); return (unsigned)w; }
__device__ __forceinline__ unsigned cvt4_fp8_nc(float a, float b, float c, float d, float s) {
    int w = 0; w = __builtin_amdgcn_cvt_pk_fp8_f32(a * s, b * s, w, false); w = __builtin_amdgcn_cvt_pk_fp8_f32(c * s, d * s, w, true); return (unsigned)w; }
constexpr float F8_WSCALE = 1024.f, F8_ASCALE = 8.f, F8_UNSCALE = 1.0f / 8192.f;
__device__ __forceinline__ float wave_sum(float v) {
#pragma unroll
    for (int o = 1; o < 64; o <<= 1) v += __shfl_xor(v, o);
    return v;
}
__device__ __forceinline__ float fast_exp(float x) { return __builtin_amdgcn_exp2f(x * 1.4426950408889634f); }
__device__ __forceinline__ float sigmoidf_(float x) { return __builtin_amdgcn_rcpf(1.0f + __expf(-x)); }
#define LDS_WAIT() asm volatile("s_waitcnt lgkmcnt(0)" ::: "memory")
template <typename T> __device__ __forceinline__ T* uni_ptr(T* p) { const unsigned long long v = (unsigned long long)p; const unsigned lo = __builtin_amdgcn_readfirstlane((unsigned)v), hi = __builtin_amdgcn_readfirstlane((unsigned)(v >> 32)); return (T*)(((unsigned long long)hi << 32) | lo); }
__device__ __forceinline__ int cur_tid(const LAS unsigned char* lds0) {
    const unsigned slot = (unsigned)__builtin_amdgcn_s_getreg((5 << 11) | 4) & 63u;
    const unsigned w = __builtin_amdgcn_readfirstlane((unsigned)((const volatile LAS unsigned char*)(lds0 + LDS_WTAB))[slot]);
    return (int)((w << 6) | __builtin_amdgcn_mbcnt_hi(~0u, __builtin_amdgcn_mbcnt_lo(~0u, 0u)));
}
__device__ __forceinline__ float uni_f(float x) { return __uint_as_float(__builtin_amdgcn_readfirstlane(__float_as_uint(x))); }

namespace pg8 {
#define PG8_LAS __attribute__((address_space(3)))
typedef unsigned short bf16_t;
typedef short bf16x8 __attribute__((ext_vector_type(8)));
typedef float f32x4 __attribute__((ext_vector_type(4)));
typedef unsigned u32x4 __attribute__((ext_vector_type(4)));
constexpr int BM = 256, BK = 64, HALF = 128, HTB = HALF * BK * 2  , STAGE_BYTES = 8 * HTB, NXCD = 8, WGM = 8;

__host__ __device__ __forceinline__ int lds_byte(int r, int c) { const int st = (r >> 4) * 2 + (c >> 5), rr = r & 15, cc = c & 31, ob = rr * 64 + cc * 2; return st * 1024 + (ob ^ (((ob >> 9) & 1) << 5)); }
__host__ __device__ __forceinline__ void stage_rc(int b, int& R, int& C) { const int st = b / 1024, sb = b % 1024, swz = sb ^ (((sb >> 9) & 1) << 5); R = (st >> 1) * 16 + swz / 64; C = (st & 1) * 32 + (swz % 64) / 2; }
__host__ __device__ __forceinline__ int perm32(int rho) { const int n = rho >> 4, i = rho & 15; return 8 * (i >> 2) + 4 * n + (i & 3); }

typedef int i32x8 __attribute__((ext_vector_type(8)));
typedef int i32x4_ __attribute__((ext_vector_type(4)));
template <bool F8> struct OperandT { typedef bf16x8 T; };
template <> struct OperandT<true> { typedef i32x8 T; };
__device__ __forceinline__ i32x8 ld_f8(const PG8_LAS unsigned char* p) { const i32x4_ lo = *(const PG8_LAS i32x4_*)p, hi = *(const PG8_LAS i32x4_*)(p + 1024); return __builtin_shufflevector(lo, hi, 0, 1, 2, 3, 4, 5, 6, 7); }
__device__ __forceinline__ f32x4 mma_f8(const i32x8 b, const i32x8 a, const f32x4 c) { return __builtin_amdgcn_mfma_scale_f32_16x16x128_f8f6f4(b, a, c, 0, 0, 0, 0, 0, 0); }
__device__ __forceinline__ f32x4 mma_f8(const bf16x8, const bf16x8, const f32x4 c) { return c; }
struct Unit { int pm, pn, pb; };
struct Gemm { const bf16_t* A; const bf16_t* Bt; int M, N, K; };

struct StaticOrder {
    static constexpr bool GATHER = false, F8 = false; __device__ __forceinline__ unsigned row_off(int, int) const { return 0u; }
    int nM, nN, nwg, G, c;
    __host__ __device__ void init(int M, int N, int G_, int c_) { nM = M / BM; nN = N / BM; nwg = nM * nN; G = G_; c = c_; }
    __host__ __device__ bool next(int i, Unit& u) const {
        const long L = (long)i * G + c; if (L >= nwg) return false;
        int wgid = (int)L; { const int q = nwg / NXCD, r = nwg % NXCD, xcd = wgid % NXCD, off = wgid / NXCD; wgid = (xcd < r ? xcd * (q + 1) : r * (q + 1) + (xcd - r) * q) + off; }
        const int nig = WGM * nN, gid = wgid / nig, fm = gid * WGM, gsz = (nM - fm) < WGM ? (nM - fm) : WGM;
        u.pm = fm + ((wgid % nig) % gsz); u.pn = (wgid % nig) / gsz; u.pb = u.pn; return true;
    }
    __device__ __forceinline__ void a_ready(const Unit&) const {}
    __device__ __forceinline__ void done(const Unit&) const {}
};


__device__ __forceinline__ unsigned cvt_pk_bf16(float lo, float hi) { unsigned r; asm volatile("v_cvt_pk_bf16_f32 %0, %1, %2" : "=v"(r) : "v"(lo), "v"(hi)); return r; }
__device__ __forceinline__ float sigm(float x) { return __builtin_amdgcn_rcpf(1.0f + __expf(-x)); }

struct EpiProj {
    static constexpr bool PERM = true, AFTER_DRAIN = false;
    unsigned char* ws; const PG8_LAS unsigned char* lbias;
    __device__ __forceinline__ void operator()(const f32x4 (&acc)[2][2][4][2], const Unit& u, int wr, int wc, int fr, int fq) const {
        const int pn = u.pn, row0 = u.pm * BM + wr * 64 + fr, lc0 = wc * 32 + 8 * fq;
        f32x4 bv[2][2];
#pragma unroll
        for (int bj = 0; bj < 2; ++bj) { const u32x4 bw = *(const PG8_LAS u32x4*)(lbias + (size_t)(pn * 256 + lc0 + bj * HALF) * 2);
            bv[bj][0] = (f32x4){__uint_as_float(bw.x << 16), __uint_as_float(bw.x & 0xffff0000u), __uint_as_float(bw.y << 16), __uint_as_float(bw.y & 0xffff0000u)};
            bv[bj][1] = (f32x4){__uint_as_float(bw.z << 16), __uint_as_float(bw.z & 0xffff0000u), __uint_as_float(bw.w << 16), __uint_as_float(bw.w & 0xffff0000u)}; }
        if (pn >= 4 && pn < 8) {
            float* base = (float*)(ws + WS_AF);
#pragma unroll
            for (int ai = 0; ai < 2; ++ai)
#pragma unroll
                for (int m = 0; m < 4; ++m) { float* rowp = base + (size_t)(row0 + ai * HALF + m * 16) * 1024 + (pn - 4) * 256 + lc0;
#pragma unroll
                    for (int bj = 0; bj < 2; ++bj) { *(f32x4*)(rowp + bj * HALF) = acc[ai][bj][m][0] + bv[bj][0]; *(f32x4*)(rowp + bj * HALF + 4) = acc[ai][bj][m][1] + bv[bj][1]; } }
            return;
        }
        bf16_t* base; int ldc, colt; bool sg = false;
        if (pn < 28) { const int s = pn >> 2, idx = (s == 0) ? 0 : s - 1; base = (bf16_t*)(ws + WS_AQ + (size_t)idx * (32 * MiB)); ldc = 1024; colt = (pn & 3) * 256; }
        else if (pn < 30) { base = (bf16_t*)(ws + WS_IQ); ldc = 512; colt = (pn - 28) * 256; }
        else if (pn == 30) { base = (bf16_t*)(ws + WS_IKW); ldc = 256; colt = 0; }
        else { base = (bf16_t*)(ws + WS_GATES); ldc = 4096; colt = (pn - 31) * 256; sg = true; }
#pragma unroll
        for (int ai = 0; ai < 2; ++ai)
#pragma unroll
            for (int m = 0; m < 4; ++m) { bf16_t* rowp = base + (size_t)(row0 + ai * HALF + m * 16) * ldc + colt + lc0;
#pragma unroll
                for (int bj = 0; bj < 2; ++bj) { f32x4 v0 = acc[ai][bj][m][0] + bv[bj][0], v1 = acc[ai][bj][m][1] + bv[bj][1];
                    if (sg) { v0 = (f32x4){sigm(v0[0]), sigm(v0[1]), sigm(v0[2]), sigm(v0[3])}; v1 = (f32x4){sigm(v1[0]), sigm(v1[1]), sigm(v1[2]), sigm(v1[3])}; }
                    u32x4 w; w.x = cvt_pk_bf16(v0[0], v0[1]); w.y = cvt_pk_bf16(v0[2], v0[3]); w.z = cvt_pk_bf16(v1[0], v1[1]); w.w = cvt_pk_bf16(v1[2], v1[3]);
                    *(u32x4*)(rowp + bj * HALF) = w;
                    if (pn == 30 && bj == 0 && lc0 < 64) {
                        const int tok = row0 + ai * HALF + m * 16;
                        *(u32x4*)((bf16_t*)(ws + WS_IK2) + ((size_t)((tok >> 5) * 4 + (lc0 >> 4)) * 64 + ((lc0 >> 3) & 1) * 32 + (tok & 31)) * 8) = w; } } }
    }
};

__device__ __forceinline__ f32x4 bf4lo(u32x4 w) { return (f32x4){__uint_as_float(w.x << 16), __uint_as_float(w.x & 0xffff0000u), __uint_as_float(w.y << 16), __uint_as_float(w.y & 0xffff0000u)}; }
__device__ __forceinline__ f32x4 bf4hi(u32x4 w) { return (f32x4){__uint_as_float(w.z << 16), __uint_as_float(w.z & 0xffff0000u), __uint_as_float(w.w << 16), __uint_as_float(w.w & 0xffff0000u)}; }

template <int MODE> struct EpiBranch {
    static constexpr bool PERM = true, AFTER_DRAIN = false;
    bf16_t* merged; const bf16_t* gates;
    __device__ __forceinline__ void operator()(const f32x4 (&acc)[2][2][4][2], const Unit& u, int wr, int wc, int fr, int fq) const {
        const int row0 = u.pm * BM + wr * 64 + fr, col0 = u.pn * BM + wc * 32 + 8 * fq;
#pragma unroll
        for (int ai = 0; ai < 2; ++ai)
#pragma unroll
            for (int m = 0; m < 4; ++m) { const size_t r = (size_t)(row0 + ai * HALF + m * 16);
#pragma unroll
                for (int bj = 0; bj < 2; ++bj) { const int c = col0 + bj * HALF;
                    const u32x4 gw = *(const u32x4*)(gates + r * 4096 + MODE * 2048 + c);
                    f32x4 v0 = acc[ai][bj][m][0] * bf4lo(gw), v1 = acc[ai][bj][m][1] * bf4hi(gw);
                    if (MODE == 1) { const u32x4 pw = *(const u32x4*)(merged + r * 2048 + c); v0 = v0 + bf4lo(pw); v1 = v1 + bf4hi(pw); }
                    u32x4 w; w.x = cvt_pk_bf16(v0[0], v0[1]); w.y = cvt_pk_bf16(v0[2], v0[3]); w.z = cvt_pk_bf16(v1[0], v1[1]); w.w = cvt_pk_bf16(v1[2], v1[3]);
                    *(u32x4*)(merged + r * 2048 + c) = w; } }
    }
};

struct EpiResBf16 {
    static constexpr bool PERM = true, AFTER_DRAIN = false;
    bf16_t* C; const float* x; float alpha;
    __device__ __forceinline__ void operator()(const f32x4 (&acc)[2][2][4][2], const Unit& u, int wr, int wc, int fr, int fq) const {
        const int row0 = u.pm * BM + wr * 64 + fr, col0 = u.pn * BM + wc * 32 + 8 * fq;
#pragma unroll
        for (int ai = 0; ai < 2; ++ai)
#pragma unroll
            for (int m = 0; m < 4; ++m) { const size_t off = (size_t)(row0 + ai * HALF + m * 16) * 2048 + col0;
#pragma unroll
                for (int bj = 0; bj < 2; ++bj) { const f32x4 x0 = *(const f32x4*)(x + off + bj * HALF), x1 = *(const f32x4*)(x + off + bj * HALF + 4);
                    const f32x4 v0 = x0 * alpha + acc[ai][bj][m][0], v1 = x1 * alpha + acc[ai][bj][m][1];
                    u32x4 w; w.x = cvt_pk_bf16(v0[0], v0[1]); w.y = cvt_pk_bf16(v0[2], v0[3]); w.z = cvt_pk_bf16(v1[0], v1[1]); w.w = cvt_pk_bf16(v1[2], v1[3]);
                    *(u32x4*)(C + off + bj * HALF) = w; } }
    }
};

struct EpiGateUp {
    static constexpr bool PERM = true, AFTER_DRAIN = false;
    unsigned char* H;
    __device__ __forceinline__ void operator()(const f32x4 (&acc)[2][2][4][2], const Unit& u, int wr, int wc, int fr, int fq) const {
        const int row0 = u.pm * BM + wr * 64 + fr, hc0 = u.pn * 128 + wc * 16 + 4 * fq;
#pragma unroll
        for (int ai = 0; ai < 2; ++ai)
#pragma unroll
            for (int m = 0; m < 4; ++m) { unsigned char* rowp = H + (size_t)(row0 + ai * HALF + m * 16) * 1024 + hc0;
#pragma unroll
                for (int bj = 0; bj < 2; ++bj) { const f32x4 g = acc[ai][bj][m][0], up = acc[ai][bj][m][1];
                    f32x4 h;
#pragma unroll
                    for (int j = 0; j < 4; ++j) { const float gj = g[j] * F8_UNSCALE; h[j] = gj * sigm(gj) * (up[j] * F8_UNSCALE); }
                    *(unsigned*)(rowp + bj * 64) = cvt4_fp8(h[0], h[1], h[2], h[3], F8_ASCALE); } }
    }
};

struct EpiStoreBf16 {
    static constexpr bool PERM = true, AFTER_DRAIN = false;
    bf16_t* O; int ldc; float one;
    __device__ __forceinline__ void operator()(const f32x4 (&acc)[2][2][4][2], const Unit& u, int wr, int wc, int fr, int fq) const {
        const int row0 = u.pm * BM + wr * 64 + fr, col0 = u.pn * BM + wc * 32 + 8 * fq;
#pragma unroll
        for (int ai = 0; ai < 2; ++ai)
#pragma unroll
            for (int m = 0; m < 4; ++m) { bf16_t* rowp = O + (size_t)(row0 + ai * HALF + m * 16) * ldc + col0;
#pragma unroll
                for (int bj = 0; bj < 2; ++bj) { const f32x4 v0 = acc[ai][bj][m][0] * one, v1 = acc[ai][bj][m][1] * one;
                    u32x4 w; w.x = cvt_pk_bf16(v0[0], v0[1]); w.y = cvt_pk_bf16(v0[2], v0[3]); w.z = cvt_pk_bf16(v1[0], v1[1]); w.w = cvt_pk_bf16(v1[2], v1[3]);
                    *(u32x4*)(rowp + bj * HALF) = w; } }
    }
};

template <bool GATH> struct GroupedOrder {
    static constexpr bool GATHER = GATH, F8 = true;
    int nM, nN, nwg, G, c; const PG8_LAS unsigned* tile_e; const PG8_LAS unsigned* tokoff;
    __device__ __forceinline__ void init(int nT, int nN_, int G_, int c_, const PG8_LAS unsigned* te, const PG8_LAS unsigned* to) { nM = nT; nN = nN_; nwg = nM * nN; G = G_; c = c_; tile_e = te; tokoff = to; }
    __device__ __forceinline__ bool next(int i, Unit& u) const {
        const long L = (long)i * G + c; if (L >= nwg) return false;
        int wgid = (int)L; { const int q = nwg / NXCD, r = nwg % NXCD, xcd = wgid % NXCD, off = wgid / NXCD; wgid = (xcd < r ? xcd * (q + 1) : r * (q + 1) + (xcd - r) * q) + off; }
        const int nig = WGM * nN, gid = wgid / nig, fm = gid * WGM, gsz = (nM - fm) < WGM ? (nM - fm) : WGM;
        u.pm = fm + ((wgid % nig) % gsz); u.pn = (wgid % nig) / gsz; u.pb = (int)tile_e[u.pm] * nN + u.pn; return true;
    }
    __device__ __forceinline__ unsigned row_off(int ui, int r) const { return tokoff[ui * 256 + r]; }
    __device__ __forceinline__ void a_ready(const Unit&) const {}
    __device__ __forceinline__ void done(const Unit&) const {}
};

template <class Epi, class Sched, bool ALIGN_EPI = false, bool SP2 = false>
__device__ __forceinline__ void gemm_phase(PG8_LAS unsigned char* lds, const Gemm g, const Sched& S, const Epi& E) {
    int tid_ = cur_tid((const LAS unsigned char*)lds); asm volatile("" : "+v"(tid_));
    const int tid = tid_, wid = __builtin_amdgcn_readfirstlane(tid >> 6), lane = tid & 63, wr = wid >> 2, wc = wid & 3, fr = lane & 15, fq = lane >> 4;
    const int K = g.K, nt = K / BK;
    constexpr bool F8 = Sched::F8;
    constexpr bool GATHER = Sched::GATHER;
    unsigned voffA[2], voffB[2], cAoff[2]; int rA[2];
#pragma unroll
    for (int i = 0; i < 2; ++i) { int R, C; stage_rc(tid * 16 + i * 8192, R, C); const int Rb = Epi::PERM ? ((R & ~31) + perm32(R & 31)) : R;
        voffA[i] = (unsigned)(R * K + C) * 2u; voffB[i] = (unsigned)(Rb * K + C) * 2u; cAoff[i] = (unsigned)C * 2u; rA[i] = R; }
    const size_t kstep = (size_t)(BK * 2);
    const size_t hstep = (size_t)HALF * K * 2;
    const size_t tstep = 2 * hstep;
    const unsigned ldsw = (unsigned)wid * 1024u;
    const int aoff = lds_byte(wr * 64 + fr, fq * 8), boff = lds_byte(wc * 32 + fr, fq * 8);
#define PG8_SA(b, h) (((b) * 2 + (h)) * HTB)
#define PG8_SB(b, h) ((4 + (b) * 2 + (h)) * HTB)
#define PG8_GLDS(gbase, vo, ldsoff) do { if constexpr (F8) asm volatile("s_mov_b32 m0, %2\n\ts_nop 0\n\tglobal_load_lds_dwordx4 %0, %1" :: "v"(vo), "s"((const char*)(gbase)), "s"((unsigned)(uintptr_t)(lds + (ldsoff))) : "memory", "m0"); \
        else __builtin_amdgcn_global_load_lds((const unsigned*)((const char*)(gbase) + (vo)), (PG8_LAS unsigned*)(lds + (ldsoff)), 16, 0, 0); } while (0)
#define PG8_STAGE(bufoff, gbase, voff) do { _Pragma("unroll") for (int _i = 0; _i < 2; ++_i) PG8_GLDS(gbase, (voff)[_i], (bufoff) + ldsw + _i * 8192); } while (0)
#define PG8_STAGE_A(bufoff, gbase, h, nx) do { _Pragma("unroll") for (int _i = 0; _i < 2; ++_i) { const unsigned vo_ = GATHER ? (((nx) && has_next) ? PG8_GOFF(ui + 1, h, _i) : vAc[h][_i]) : voffA[_i]; \
        PG8_GLDS(gbase, vo_, (bufoff) + ldsw + _i * 8192); } } while (0)
#define PG8_LDA(dst, b, h) do { _Pragma("unroll") for (int m = 0; m < 4; ++m) { if constexpr (F8) dst[m][0] = ld_f8(lds + PG8_SA(b, h) + aoff + m * 2048); \
        else { _Pragma("unroll") for (int k = 0; k < 2; ++k) dst[m][k] = *(const PG8_LAS OpT*)(lds + PG8_SA(b, h) + aoff + m * 2048 + k * 1024); } } } while (0)
#define PG8_LDB(dst, b, h) do { _Pragma("unroll") for (int n = 0; n < 2; ++n) { if constexpr (F8) dst[n][0] = ld_f8(lds + PG8_SB(b, h) + boff + n * 2048); \
        else { _Pragma("unroll") for (int k = 0; k < 2; ++k) dst[n][k] = *(const PG8_LAS OpT*)(lds + PG8_SB(b, h) + boff + n * 2048 + k * 1024); } } } while (0)
#define PG8_MMA(ai, bj, At, Bt) do { if constexpr (F8) __builtin_amdgcn_sched_barrier(0); __builtin_amdgcn_s_setprio(1); _Pragma("unroll") for (int m = 0; m < 4; ++m) _Pragma("unroll") for (int n = 0; n < 2; ++n) { \
        if constexpr (F8) acc[ai][bj][m][n] = mma_f8(Bt[n][0], At[m][0], acc[ai][bj][m][n]); \
        else { _Pragma("unroll") for (int k = 0; k < 2; ++k) acc[ai][bj][m][n] = __builtin_amdgcn_mfma_f32_16x16x32_bf16(Bt[n][k], At[m][k], acc[ai][bj][m][n], 0, 0, 0); } } \
        __builtin_amdgcn_s_setprio(0); if constexpr (F8) __builtin_amdgcn_sched_barrier(0); } while (0)
#define PG8_WAIT_V(n) asm volatile("s_waitcnt vmcnt(" #n ")" ::: "memory")
#define PG8_WAIT_L(n) asm volatile("s_waitcnt lgkmcnt(" #n ")" ::: "memory")
#define PG8_BAR __builtin_amdgcn_s_barrier()
#define PG8_SCHED __builtin_amdgcn_sched_barrier(0)
    Unit cur, nxt; int ui = 0;
    if (!S.next(0, cur)) return;
    f32x4 acc[2][2][4][2];
#pragma unroll
    for (int a = 0; a < 2; ++a)
#pragma unroll
        for (int b = 0; b < 2; ++b)
#pragma unroll
            for (int m = 0; m < 4; ++m)
#pragma unroll
                for (int n = 0; n < 2; ++n) acc[a][b][m][n] = (f32x4){0.f, 0.f, 0.f, 0.f};
    using OpT = typename OperandT<F8>::T; constexpr int NK = F8 ? 1 : 2;
    OpT At[4][NK], B0[2][NK], B1[2][NK];
    const size_t hstepA = GATHER ? 0 : hstep;
#define PG8_GOFF(ui_, h, i) (S.row_off((ui_), (h) * HALF + rA[i]) + cAoff[i])
    unsigned vAc[2][2]; bool has_next = false;
#pragma unroll
    for (int h = 0; h < 2; ++h)
#pragma unroll
        for (int i = 0; i < 2; ++i) vAc[h][i] = GATHER ? PG8_GOFF(0, h, i) : 0u;
    const char* cA = (const char*)g.A + (GATHER ? (size_t)0 : (size_t)cur.pm * tstep); const char* cB = (const char*)g.Bt + (size_t)cur.pb * tstep;
    S.a_ready(cur);
    if constexpr (SP2) {
        PG8_STAGE(PG8_SB(0, 0), cB, voffB); PG8_STAGE(PG8_SB(0, 1), cB + hstep, voffB); PG8_STAGE_A(PG8_SA(0, 0), cA, 0, false); PG8_STAGE_A(PG8_SA(0, 1), cA + hstepA, 1, false);
        if (wr == 1) PG8_BAR;
        PG8_WAIT_V(2); PG8_BAR;
        PG8_STAGE(PG8_SB(1, 0), cB + kstep, voffB); PG8_STAGE_A(PG8_SA(1, 0), cA + kstep, 0, false); PG8_STAGE(PG8_SB(1, 1), cB + hstep + kstep, voffB);
        PG8_WAIT_V(6); PG8_BAR;
    } else {
        PG8_STAGE(PG8_SB(0, 0), cB, voffB); PG8_STAGE_A(PG8_SA(0, 0), cA, 0, false); PG8_STAGE(PG8_SB(0, 1), cB + hstep, voffB); PG8_STAGE_A(PG8_SA(0, 1), cA + hstepA, 1, false);
        if (wr == 1) PG8_BAR;
        PG8_WAIT_V(4); PG8_BAR;
        PG8_STAGE(PG8_SB(1, 0), cB + kstep, voffB); PG8_STAGE_A(PG8_SA(1, 0), cA + kstep, 0, false); PG8_STAGE(PG8_SB(1, 1), cB + hstep + kstep, voffB);
        PG8_WAIT_V(6); PG8_BAR;
    }
    for (;;) {
        has_next = S.next(ui + 1, nxt);
        const char* nA = has_next ? (const char*)g.A + (GATHER ? (size_t)0 : (size_t)nxt.pm * tstep) : cA; const char* nB = has_next ? (const char*)g.Bt + (size_t)nxt.pb * tstep : cB;
        for (int t = 0; t < nt; t += 2) {
            const bool last = (t == nt - 2);
            const char* a1 = cA + (size_t)(t + 1) * kstep;
            const char* a2 = last ? nA : cA + (size_t)(t + 2) * kstep; const char* b2 = last ? nB : cB + (size_t)(t + 2) * kstep;
            const char* a3 = a2 + kstep; const char* b3 = b2 + kstep;
            if (last && has_next) S.a_ready(nxt);
            if constexpr (SP2) {
            PG8_LDB(B0, 0, 0); PG8_LDB(B1, 0, 1); PG8_SCHED; PG8_LDA(At, 0, 0); PG8_STAGE_A(PG8_SA(1, 1), a1 + hstepA, 1, false);
            PG8_WAIT_V(8); PG8_WAIT_L(0); PG8_BAR; PG8_MMA(0, 0, At, B0); PG8_MMA(0, 1, At, B1); PG8_BAR; PG8_SCHED;
            PG8_LDA(At, 0, 1); PG8_STAGE(PG8_SB(0, 0), b2, voffB); PG8_STAGE(PG8_SB(0, 1), b2 + hstep, voffB); PG8_STAGE_A(PG8_SA(0, 0), a2, 0, last);
            PG8_WAIT_V(8); PG8_WAIT_L(0); PG8_BAR; PG8_MMA(1, 0, At, B0); PG8_MMA(1, 1, At, B1); PG8_BAR; PG8_SCHED;
            PG8_LDB(B0, 1, 0); PG8_LDB(B1, 1, 1); PG8_SCHED; PG8_LDA(At, 1, 0); PG8_STAGE_A(PG8_SA(0, 1), a2 + hstepA, 1, last);
            PG8_WAIT_V(8); PG8_WAIT_L(0); PG8_BAR; PG8_MMA(0, 0, At, B0); PG8_MMA(0, 1, At, B1); PG8_BAR; PG8_SCHED;
            PG8_LDA(At, 1, 1); PG8_STAGE(PG8_SB(1, 0), b3, voffB); PG8_STAGE(PG8_SB(1, 1), b3 + hstep, voffB); PG8_STAGE_A(PG8_SA(1, 0), a3, 0, last);
            PG8_WAIT_V(8); PG8_WAIT_L(0); PG8_BAR; PG8_MMA(1, 0, At, B0); PG8_MMA(1, 1, At, B1); PG8_BAR; PG8_SCHED;
            } else {
            PG8_LDB(B0, 0, 0); PG8_SCHED; PG8_LDA(At, 0, 0); PG8_STAGE_A(PG8_SA(1, 1), a1 + hstepA, 1, false);
            PG8_WAIT_L(8); PG8_BAR; PG8_WAIT_L(0); PG8_MMA(0, 0, At, B0); PG8_BAR; PG8_SCHED;
            PG8_LDB(B1, 0, 1); PG8_STAGE(PG8_SB(0, 0), b2, voffB);
            PG8_BAR; PG8_WAIT_L(0); PG8_MMA(0, 1, At, B1); PG8_BAR;
            PG8_LDA(At, 0, 1); PG8_STAGE_A(PG8_SA(0, 0), a2, 0, last);
            PG8_BAR; PG8_WAIT_L(0); PG8_MMA(1, 0, At, B0); PG8_BAR; PG8_SCHED;
            PG8_STAGE(PG8_SB(0, 1), b2 + hstep, voffB);
            PG8_WAIT_V(6); PG8_BAR; PG8_MMA(1, 1, At, B1); PG8_BAR;
            PG8_LDB(B0, 1, 0); PG8_SCHED; PG8_LDA(At, 1, 0); PG8_STAGE_A(PG8_SA(0, 1), a2 + hstepA, 1, last);
            PG8_WAIT_L(8); PG8_BAR; PG8_WAIT_L(0); PG8_MMA(0, 0, At, B0); PG8_BAR; PG8_SCHED;
            PG8_LDB(B1, 1, 1); PG8_STAGE(PG8_SB(1, 0), b3, voffB);
            PG8_BAR; PG8_WAIT_L(0); PG8_MMA(0, 1, At, B1); PG8_BAR;
            PG8_LDA(At, 1, 1); PG8_STAGE_A(PG8_SA(1, 0), a3, 0, last);
            PG8_BAR; PG8_WAIT_L(0); PG8_MMA(1, 0, At, B0); PG8_BAR; PG8_SCHED;
            PG8_STAGE(PG8_SB(1, 1), b3 + hstep, voffB);
            PG8_WAIT_V(6); PG8_BAR; PG8_MMA(1, 1, At, B1); PG8_BAR;
            }
        }
        if constexpr (ALIGN_EPI) { if (wr == 0) PG8_BAR; }
        if constexpr (!Epi::AFTER_DRAIN) { E(acc, cur, wr, wc, fr, fq); S.done(cur); }
        if (!has_next) break;
#pragma unroll
        for (int a = 0; a < 2; ++a)
#pragma unroll
            for (int b = 0; b < 2; ++b)
#pragma unroll
                for (int m = 0; m < 4; ++m)
#pragma unroll
                    for (int n = 0; n < 2; ++n) acc[a][b][m][n] = (f32x4){0.f, 0.f, 0.f, 0.f};
        cur = nxt; cA = nA; cB = nB; ++ui;
#pragma unroll
        for (int h = 0; h < 2; ++h)
#pragma unroll
            for (int i = 0; i < 2; ++i) if (GATHER) vAc[h][i] = PG8_GOFF(ui, h, i);
        if constexpr (ALIGN_EPI) { if (wr == 1) PG8_BAR; }
    }
    PG8_WAIT_V(0);
    if constexpr (!ALIGN_EPI) { if (wr == 0) PG8_BAR; }
    PG8_BAR;
    if constexpr (Epi::AFTER_DRAIN) { E.fused(acc, cur, wr, wc, fr, fq, lds, wid, lane); S.done(cur); }
#undef PG8_SA
#undef PG8_SB
#undef PG8_STAGE
#undef PG8_STAGE_A
#undef PG8_GOFF
#undef PG8_LDA
#undef PG8_LDB
#undef PG8_MMA
#undef PG8_WAIT_V
#undef PG8_WAIT_L
#undef PG8_BAR
#undef PG8_SCHED
}
}
#define XB_TMO      128
#define XB_XCNT(j)  (256  + 64 * (j))
#define XB_XSUB(j)  (1280 + 64 * (j))
#define XB_XGEN(j)  (2304 + 64 * (j))
#define XB_TOP      3328
#define XB_TOPGEN   3392
#define XCD_BAR_WORDS 3456
#define XB_SPIN_CAP (1u << 18)

__device__ __forceinline__ unsigned xb_ld(unsigned* p)              { return __hip_atomic_load(p, __ATOMIC_RELAXED, __HIP_MEMORY_SCOPE_AGENT); }
__device__ __forceinline__ unsigned xb_add(unsigned* p, unsigned v) { return __hip_atomic_fetch_add(p, v, __ATOMIC_RELAXED, __HIP_MEMORY_SCOPE_AGENT); }
__device__ __forceinline__ unsigned xb_xcc_id() { return (unsigned)__builtin_amdgcn_s_getreg((3 << 11) | 20) & 0xFu; }
#define XB_SPIN(cond, bar) do { unsigned _sp = 0; while (cond) { __builtin_amdgcn_s_sleep(1); \
    if ((++_sp & 255u) == 0u) { if (xb_ld(&(bar)[XB_TMO])) break; if (_sp > XB_SPIN_CAP) { atomicAdd(&(bar)[XB_TMO], 1u); break; } } } } while (0)

struct XcdBarrier {
    unsigned* bar; unsigned x;
    volatile LAS unsigned* st;
};

__device__ __forceinline__ XcdBarrier xcd_barrier_post(unsigned* bar, volatile LAS unsigned* st) {
    XcdBarrier b; b.bar = bar; b.x = xb_xcc_id(); b.st = st;
    if (threadIdx.x == 0) (void)xb_add(&bar[XB_XCNT(b.x)], 1u);
    return b;
}
__device__ __forceinline__ void xcd_barrier_complete(unsigned* bar, unsigned x, unsigned& nloc, unsigned& nx) {
    const unsigned G = gridDim.x * gridDim.y * gridDim.z;
    unsigned sum, cnt, mine, sp = 0u;
    for (;;) {
        sum = 0u; cnt = 0u; mine = 0u;
#pragma unroll
        for (unsigned j = 0; j < 16; ++j) { const unsigned c = xb_ld(&bar[XB_XCNT(j)]); sum += c; cnt += (c > 0u) ? 1u : 0u; mine = (j == x) ? c : mine; }
        if (sum == G) break;
        __builtin_amdgcn_s_sleep(1);
        if ((++sp & 255u) == 0u) { if (xb_ld(&bar[XB_TMO])) break; if (sp > XB_SPIN_CAP) { atomicAdd(&bar[XB_TMO], 1u); break; } }
    }
    nloc = mine > 0u ? mine : 1u; nx = cnt > 0u ? cnt : 1u;
}

__device__ __forceinline__ void xcd_barrier(const XcdBarrier& b) {
    asm volatile("s_waitcnt vmcnt(0)" ::: "memory");
    __syncthreads();
    if (cur_tid((const LAS unsigned char*)b.st - LDS_BARST) == 0) {
        unsigned* bar = b.bar;
        __builtin_amdgcn_s_waitcnt(0);
        unsigned nloc = b.st[0], nx = b.st[1];
        if (nloc == 0u) { xcd_barrier_complete(bar, b.x, nloc, nx); b.st[0] = nloc; b.st[1] = nx; }
        const unsigned old = xb_add(&bar[XB_XSUB(b.x)], 1u);
        const unsigned gen = old / nloc;
        if (old + 1u == (gen + 1u) * nloc) {
            __builtin_amdgcn_fence(__ATOMIC_RELEASE, "agent");
            asm volatile("s_waitcnt vmcnt(0)" ::: "memory");
            const unsigned og = xb_add(&bar[XB_TOP], 1u);
            const unsigned tg = og / nx;
            if (og + 1u == (tg + 1u) * nx) xb_add(&bar[XB_TOPGEN], 1u);
            else XB_SPIN(xb_ld(&bar[XB_TOPGEN]) == tg, bar);
            __builtin_amdgcn_fence(__ATOMIC_ACQUIRE, "agent");
            xb_add(&bar[XB_XGEN(b.x)], 1u);
            asm volatile("s_waitcnt vmcnt(0)" ::: "memory");
        } else {
            XB_SPIN(xb_ld(&bar[XB_XGEN(b.x)]) == gen, bar);
            __builtin_amdgcn_fence(__ATOMIC_ACQUIRE, "agent");
            asm volatile("s_waitcnt vmcnt(0)" ::: "memory");
        }
    }
    __syncthreads();
}

struct Args { const float* in[19]; float* out; unsigned char* ws; int ph_lo, ph_hi; };
enum { I_X = 0, I_WIN, I_BIN, I_LB, I_HGNG, I_WA, I_WB, I_WOUT, I_LN1G, I_LN1B, I_WGRP, I_BGRP, I_WRT, I_BRT, I_WGATE, I_WUP, I_WDOWN, I_LN2G, I_LN2B };

__device__ __forceinline__ void transpose_item(const float* src4, size_t ldw, bf16_t* WT, size_t K, int dest_row0, int k0, LAS float* scr, int lane) {
    f32x4 v[8];
#pragma unroll
    for (int i = 0; i < 8; ++i) v[i] = src4 ? __builtin_nontemporal_load((const f32x4*)(src4 + (size_t)(8 * i) * ldw)) : (f32x4){0.f, 0.f, 0.f, 0.f};
#pragma unroll
    for (int i = 0; i < 8; ++i) { const int k = 8 * i + (lane >> 3), n4 = (lane & 7) * 4;
        scr[k * 33 + n4 + 0] = v[i][0]; scr[k * 33 + n4 + 1] = v[i][1]; scr[k * 33 + n4 + 2] = v[i][2]; scr[k * 33 + n4 + 3] = v[i][3]; }
    LDS_WAIT(); asm volatile("" ::: "memory");
    const int c = lane & 7;
#pragma unroll
    for (int j = 0; j < 4; ++j) { const int n = (lane >> 3) + 8 * j; const LAS float* s = scr + (8 * c) * 33 + n;
        u32x4 o; o.x = cvt_pk(s[0 * 33], s[1 * 33]); o.y = cvt_pk(s[2 * 33], s[3 * 33]); o.z = cvt_pk(s[4 * 33], s[5 * 33]); o.w = cvt_pk(s[6 * 33], s[7 * 33]);
        *(u32x4*)(WT + (size_t)(dest_row0 + n) * K + k0 + 8 * c) = o; }
    LDS_WAIT(); asm volatile("" ::: "memory");
}

__device__ __forceinline__ void phase_prologue(const Args& a, LAS unsigned char* lds, int tid, int G) {
    unsigned char* ws = a.ws;
    { const float* x = a.in[I_X]; bf16_t* xb = (bf16_t*)(ws + WS_XB); const size_t n8 = (size_t)MT * DM / 8;
#pragma unroll 4
      for (size_t i = (size_t)blockIdx.x * NTHR + tid; i < n8; i += (size_t)G * NTHR) {
          const f32x4 p = __builtin_nontemporal_load((const f32x4*)(x + i * 8)), q = __builtin_nontemporal_load((const f32x4*)(x + i * 8 + 4));
          u32x4 o; o.x = cvt_pk(p[0], p[1]); o.y = cvt_pk(p[2], p[3]); o.z = cvt_pk(q[0], q[1]); o.w = cvt_pk(q[2], q[3]);
          *(u32x4*)(xb + i * 8) = o; } }
    asm volatile("" : "+v"(tid));
    const int lane = tid & 63, wave = tid >> 6;
    LAS float* scr = (LAS float*)(lds + wave * 8704);
    const int gw = blockIdx.x * NWAVES + wave, NGW = G * NWAVES;
    constexpr int IT_IN = (NPROJ_PAD / 32) * (DM / 64);
    constexpr int IT_A = (DM / 32) * (1024 / 64);
    constexpr int IT_OUT = (DM / 32) * (DM / 64);
    constexpr int NIT = IT_IN + 2 * IT_A + IT_OUT;
    for (int it = gw; it < NIT; it += NGW) {
        int r = it;
        if (r < IT_IN) { const int kb = r / (NPROJ_PAD / 32), rb = r % (NPROJ_PAD / 32); const int n = rb * 32 + (lane & 7) * 4;
            int src = -1; if (n < 7752) src = n; else if (n >= 7936) src = n - 184;
            const float* p = (src >= 0) ? a.in[I_WIN] + (size_t)(kb * 64 + (lane >> 3)) * NPROJ + src : nullptr;
            transpose_item(p, NPROJ, (bf16_t*)(ws + WS_WIN), DM, rb * 32, kb * 64, scr, lane); continue; }
        r -= IT_IN;
        if (r < 2 * IT_A) { const int which = r / IT_A; r %= IT_A; const int kb = r / 64, rb = r % 64; const int n = rb * 32 + (lane & 7) * 4;
            const float* p = a.in[which ? I_WB : I_WA] + (size_t)(kb * 64 + (lane >> 3)) * DM + n;
            transpose_item(p, DM, (bf16_t*)(ws + (which ? WS_WB : WS_WA)), 1024, rb * 32, kb * 64, scr, lane); continue; }
        r -= 2 * IT_A;
        { const int kb = r / 64, rb = r % 64; const int n = rb * 32 + (lane & 7) * 4;
          const float* p = a.in[I_WOUT] + (size_t)(kb * 64 + (lane >> 3)) * DM + n;
          transpose_item(p, DM, (bf16_t*)(ws + WS_WOUT), DM, rb * 32, kb * 64, scr, lane); }
    }
}

constexpr int EW_GU = 64 * 32, EW_D = 64 * 16, EW_E = EW_GU + EW_D;
__device__ __forceinline__ const float* ew_src(const Args& a, int it, int lane, size_t& ldw) {
    const int e = it / EW_E; int r = it % EW_E;
    if (r < EW_GU) { const int kb = r / 64, rb = r % 64; const int n = rb * 32 + (lane & 7) * 4; const int j = n >> 3, up = (n >> 2) & 1; ldw = DFF;
        return a.in[up ? I_WUP : I_WGATE] + (size_t)e * DM * DFF + (size_t)(kb * 64 + (lane >> 3)) * DFF + 4 * j; }
    r -= EW_GU; const int kb = r / 64, rb = r % 64; const int n = rb * 32 + (lane & 7) * 4; ldw = DM;
    return a.in[I_WDOWN] + (size_t)e * DFF * DM + (size_t)(kb * 64 + (lane >> 3)) * DM + n;
}
__device__ __forceinline__ void ew_store(const Args& a, int it, const f32x4 (&v)[8], LAS float* scr, int lane) {
    const int e = it / EW_E; int r = it % EW_E; unsigned char* WT; size_t K; int rb, kb;
    if (r < EW_GU) { kb = r / 64; rb = r % 64; WT = a.ws + WS_WGU + (size_t)e * 2048 * 2048; K = 2048; }
    else { r -= EW_GU; kb = r / 64; rb = r % 64; WT = a.ws + WS_WD + (size_t)e * 2048 * 1024; K = 1024; }
#pragma unroll
    for (int i = 0; i < 8; ++i) { const int k = 8 * i + (lane >> 3), n4 = (lane & 7) * 4;
        scr[k * 33 + n4 + 0] = v[i][0]; scr[k * 33 + n4 + 1] = v[i][1]; scr[k * 33 + n4 + 2] = v[i][2]; scr[k * 33 + n4 + 3] = v[i][3]; }
    LDS_WAIT(); asm volatile("" ::: "memory");
    const int c = lane & 3;
#pragma unroll
    for (int j = 0; j < 2; ++j) { const int n = (lane >> 2) + 16 * j; const LAS float* s = scr + (16 * c) * 33 + n;
        u32x4 o;
#pragma unroll
        for (int q = 0; q < 4; ++q) o[q] = cvt4_fp8_nc(s[(4 * q) * 33], s[(4 * q + 1) * 33], s[(4 * q + 2) * 33], s[(4 * q + 3) * 33], F8_WSCALE);
        *(u32x4*)(WT + (size_t)(rb * 32 + n) * K + kb * 64 + 16 * c) = o; }
    LDS_WAIT(); asm volatile("" ::: "memory");
}
__device__ __forceinline__ void phase_expert_weights(const Args& a, LAS unsigned char* lds, int tid, int G) {
    const int lane = tid & 63, wave = tid >> 6;
    LAS float* scr = (LAS float*)(lds + wave * 8704);
    const int gw = blockIdx.x * NWAVES + wave, NGW = G * NWAVES, NIT = NEXP * EW_E;
    int it = gw; if (it >= NIT) return;
    f32x4 v[8]; { size_t ldw; const float* p = ew_src(a, it, lane, ldw);
#pragma unroll
        for (int i = 0; i < 8; ++i) v[i] = *(const f32x4*)(p + (size_t)(8 * i) * ldw); }
    for (;;) {
        const int nx = it + NGW; const bool has = nx < NIT;
        f32x4 vn[8];
        if (has) { size_t ldw; const float* p = ew_src(a, nx, lane, ldw);
#pragma unroll
            for (int i = 0; i < 8; ++i) vn[i] = *(const f32x4*)(p + (size_t)(8 * i) * ldw); }
        ew_store(a, it, v, scr, lane);
        if (!has) break;
#pragma unroll
        for (int i = 0; i < 8; ++i) v[i] = vn[i];
        it = nx;
    }
}

constexpr int HG_QD = 0, HG_KD = 17408, HG_P = 34816, HG_VT = 44032, HG_SEG = 62464, HG_RED = 64512;
constexpr int HG_LBT = 66560;
constexpr int HG_NGT = 70656;
constexpr int HG_ST = 74752, HG_STLD = 136;
constexpr int HG_LD128 = 136, HG_LD64 = 72;

struct HgPrep { float cum[16]; float kh[16]; float tot; };
__device__ __forceinline__ void hg_fill_lb(const Args& a, LAS unsigned char* lds, int tid) {
    for (int i = tid; i < 1024; i += NTHR) { const float l0 = a.in[I_LB][i], l1 = a.in[I_LB][1024 + i]; *(LAS float*)(lds + HG_LBT + i * 4) = 1.0f / (1.0f + __expf(l1 - l0)); *(LAS float*)(lds + HG_NGT + i * 4) = a.in[I_HGNG][i]; }
    __syncthreads();
}
__device__ __forceinline__ void hg_prep(HgPrep& P, const float (&z)[16], float lb, int d, int seg, LAS unsigned char* lds) {
    float run = 0.f;
#pragma unroll
    for (int j = 0; j < 16; ++j) { const float sg = sigmoidf_(z[j]); const float f = lb + (1.0f - lb) * sg; run += __logf(f); P.cum[j] = run; P.kh[j] = (1.0f - lb) * (1.0f - sg); }
    LAS float* segs = (LAS float*)(lds + HG_SEG);
    segs[seg * 128 + d] = run;
    __syncthreads();
    float off = 0.f, tot = 0.f;
#pragma unroll
    for (int s = 0; s < 4; ++s) { const float v = segs[s * 128 + d]; tot += v; if (s < seg) off += v; }
#pragma unroll
    for (int j = 0; j < 16; ++j) P.cum[j] += off;
    P.tot = tot;
}
__device__ __forceinline__ void hg_write_vt(const unsigned (&vv)[16], int d, int seg, LAS unsigned char* lds) {
    u32x4 w0, w1;
    w0.x = vv[0] | (vv[1] << 16); w0.y = vv[2] | (vv[3] << 16); w0.z = vv[4] | (vv[5] << 16); w0.w = vv[6] | (vv[7] << 16);
    w1.x = vv[8] | (vv[9] << 16); w1.y = vv[10] | (vv[11] << 16); w1.z = vv[12] | (vv[13] << 16); w1.w = vv[14] | (vv[15] << 16);
    LAS unsigned char* p = lds + HG_VT + d * (HG_LD64 * 2) + seg * 32;
    *(LAS u32x4*)p = w0; *(LAS u32x4*)(p + 16) = w1;
}

__device__ __forceinline__ void hgrn1_unit(const Args& a, int unit, LAS unsigned char* lds, int tid) {
    unsigned char* ws = a.ws;
    const int lane = tid & 63, wave = tid >> 6, d = tid & 127, seg = tid >> 7;
    const int b = unit >> 10, h = (unit >> 7) & 7, n = unit & 127, tok0 = b * SEQ + n * 64;
    float z[16]; unsigned vv[16];
    { const float* AF = (const float*)(ws + WS_AF); const bf16_t* AI = (const bf16_t*)(ws + WS_AI);
#pragma unroll
      for (int j = 0; j < 16; ++j) z[j] = AF[(size_t)(tok0 + seg * 16 + j) * 1024 + h * 128 + d];
#pragma unroll
      for (int j = 0; j < 16; ++j) vv[j] = AI[(size_t)(tok0 + seg * 16 + j) * 1024 + h * 128 + d]; }
    const float lbv = *(const LAS float*)(lds + HG_LBT + (h * 128 + d) * 4);
    HgPrep P;
    hg_prep(P, z, lbv, d, seg, lds);
    { unsigned pk[8];
#pragma unroll
      for (int j = 0; j < 8; ++j) pk[j] = cvt_pk(P.kh[2 * j] * __expf(P.tot - P.cum[2 * j]), P.kh[2 * j + 1] * __expf(P.tot - P.cum[2 * j + 1]));
      LAS unsigned char* p = lds + HG_KD + d * (HG_LD64 * 2) + seg * 32;
      *(LAS u32x4*)p = (u32x4){pk[0], pk[1], pk[2], pk[3]}; *(LAS u32x4*)(p + 16) = (u32x4){pk[4], pk[5], pk[6], pk[7]}; }
    if (seg == 0) ((float*)(ws + WS_DECAY))[(size_t)unit * 128 + d] = __expf(P.tot);
    hg_write_vt(vv, d, seg, lds);
    __syncthreads();
    const int fr = lane & 15, fq = lane >> 4;
    bf16x8 af[2];
#pragma unroll
    for (int ks = 0; ks < 2; ++ks) af[ks] = *(const LAS bf16x8*)(lds + HG_KD + (16 * wave + fr) * (HG_LD64 * 2) + (32 * ks + 8 * fq) * 2);
    float* kvo = (float*)(ws + WS_KV) + (size_t)unit * 16384;
#pragma unroll
    for (int vb = 0; vb < 8; ++vb) {
        f32x4 acc = {0.f, 0.f, 0.f, 0.f};
#pragma unroll
        for (int ks = 0; ks < 2; ++ks) { const bf16x8 bfr = *(const LAS bf16x8*)(lds + HG_VT + (16 * vb + fr) * (HG_LD64 * 2) + (32 * ks + 8 * fq) * 2);
            acc = __builtin_amdgcn_mfma_f32_16x16x32_bf16(af[ks], bfr, acc, 0, 0, 0); }
        *(f32x4*)(kvo + (size_t)(16 * vb + fr) * 128 + 16 * wave + 4 * fq) = acc;
    }
    __syncthreads();
}

__device__ __forceinline__ void hgrn_scan(const Args& a, int tid, int G) {
    unsigned char* ws = a.ws;
    const float* KV = (const float*)(ws + WS_KV); const float* DEC = (const float*)(ws + WS_DECAY); unsigned* ST = (unsigned*)(ws + WS_ST);
    for (int g = blockIdx.x * NTHR + tid; g < 16 * 8192; g += G * NTHR) {
        const int bh = g >> 13, rem = g & 8191, v = rem >> 6, d2 = (rem & 63) * 2;
        float s0 = 0.f, s1 = 0.f;
        for (int n0 = 0; n0 < 128; n0 += 8) {
            f32x2 kv[8], dc[8];
#pragma unroll
            for (int j = 0; j < 8; ++j) { const size_t unit = (size_t)bh * 128 + n0 + j; kv[j] = *(const f32x2*)(KV + unit * 16384 + v * 128 + d2); dc[j] = *(const f32x2*)(DEC + unit * 128 + d2); }
#pragma unroll
            for (int j = 0; j < 8; ++j) { const size_t unit = (size_t)bh * 128 + n0 + j; ST[(unit * 16384 + v * 128 + d2) >> 1] = cvt_pk(s0, s1);
                s0 = dc[j][0] * s0 + kv[j][0]; s1 = dc[j][1] * s1 + kv[j][1]; }
        }
    }
}

__device__ __forceinline__ void hg3_load(const Args& a, int unit, int tid, float (&z)[16], unsigned (&qq)[16], unsigned (&vv)[16], u32x4 (&stp)[4], u32x2 (&gwv)[4]) {
    unsigned char* ws = a.ws; const int d = tid & 127, seg = tid >> 7;
    const int b = unit >> 10, h = (unit >> 7) & 7, n = unit & 127, tok0 = b * SEQ + n * 64;
    const float* AF = (const float*)(ws + WS_AF); const bf16_t* AI = (const bf16_t*)(ws + WS_AI); const bf16_t* AQ = (const bf16_t*)(ws + WS_AQ);
#pragma unroll
    for (int j = 0; j < 16; ++j) z[j] = AF[(size_t)(tok0 + seg * 16 + j) * 1024 + h * 128 + d];
#pragma unroll
    for (int j = 0; j < 16; ++j) qq[j] = AQ[(size_t)(tok0 + seg * 16 + j) * 1024 + h * 128 + d];
#pragma unroll
    for (int j = 0; j < 16; ++j) vv[j] = AI[(size_t)(tok0 + seg * 16 + j) * 1024 + h * 128 + d];
    { const bf16_t* ST = (const bf16_t*)(ws + WS_ST) + (size_t)unit * 16384;
#pragma unroll
      for (int i = 0; i < 4; ++i) stp[i] = *(const u32x4*)(ST + (size_t)(tid + NTHR * i) * 8); }
    { const int lane = tid & 63, wave = tid >> 6, t_ = 16 * (wave & 3) + (lane & 15); const bf16_t* AG = (const bf16_t*)(ws + WS_AG);
#pragma unroll
      for (int vi = 0; vi < 4; ++vi) gwv[vi] = *(const u32x2*)(AG + (size_t)(tok0 + t_) * 1024 + h * 128 + 16 * (4 * (wave >> 2) + vi) + 4 * (lane >> 4)); }
}
__device__ __forceinline__ void hgrn3_unit(const Args& a, int unit, int next_unit, LAS unsigned char* lds, int tid, float (&z)[16], unsigned (&qq)[16], unsigned (&vv)[16], u32x4 (&stp)[4], u32x2 (&gwn)[4]) {
    unsigned char* ws = a.ws;
    const int lane = tid & 63, wave = tid >> 6, d = tid & 127, seg = tid >> 7;
    const int b = unit >> 10, h = (unit >> 7) & 7, n = unit & 127, tok0 = b * SEQ + n * 64;
    const float lbv = *(const LAS float*)(lds + HG_LBT + (h * 128 + d) * 4);
    u32x2 gwv[4];
#pragma unroll
    for (int vi = 0; vi < 4; ++vi) gwv[vi] = gwn[vi];
#ifndef HG3_RA
#define HG3_RA 1
#define HG3_RB 1
#define HG3_RC 1
#endif
    for (int ra = 0; ra < HG3_RA; ++ra) {
    HgPrep P;
    hg_prep(P, z, lbv, d, seg, lds);
    {
#pragma unroll
      for (int j = 0; j < 16; ++j) { const float q = bf2f(qq[j]); const float qs = q * sigmoidf_(q);
          const float qd = qs * __expf(P.cum[j]), kd = P.kh[j] * __expf(-P.cum[j]);
          const int t = seg * 16 + j;
          *(LAS bf16_t*)(lds + HG_QD + (t * HG_LD128 + d) * 2) = (bf16_t)(cvt_pk(qd, 0.f) & 0xffffu);
          *(LAS bf16_t*)(lds + HG_KD + (t * HG_LD128 + d) * 2) = (bf16_t)(cvt_pk(kd, 0.f) & 0xffffu); } }
    hg_write_vt(vv, d, seg, lds);
#pragma unroll
    for (int i = 0; i < 4; ++i) { const int id = tid + NTHR * i; *(LAS u32x4*)(lds + HG_ST + (id >> 4) * (HG_STLD * 2) + (id & 15) * 16) = stp[i]; }
    __syncthreads();
    }
    if (next_unit >= 0) hg3_load(a, next_unit, tid, z, qq, vv, stp, gwn);
    const int fr = lane & 15, fq = lane >> 4;
    for (int rb = 0; rb < HG3_RB; ++rb) {
    { const int tb = wave & 3;
      bf16x8 bq[4];
#pragma unroll
      for (int ks = 0; ks < 4; ++ks) bq[ks] = *(const LAS bf16x8*)(lds + HG_QD + ((16 * tb + fr) * HG_LD128 + 32 * ks + 8 * fq) * 2);
#pragma unroll
      for (int si = 0; si < 2; ++si) { const int sb = 2 * (wave >> 2) + si;
          f32x4 acc = {0.f, 0.f, 0.f, 0.f};
#pragma unroll
          for (int ks = 0; ks < 4; ++ks) { const bf16x8 ak = *(const LAS bf16x8*)(lds + HG_KD + ((16 * sb + fr) * HG_LD128 + 32 * ks + 8 * fq) * 2);
              acc = __builtin_amdgcn_mfma_f32_16x16x32_bf16(ak, bq[ks], acc, 0, 0, 0); }
          const int t = 16 * tb + fr, s0 = 16 * sb + 4 * fq;
          float p[4];
#pragma unroll
          for (int r = 0; r < 4; ++r) p[r] = (s0 + r <= t) ? acc[r] : 0.f;
          *(LAS u32x2*)(lds + HG_P + (t * HG_LD64 + s0) * 2) = (u32x2){cvt_pk(p[0], p[1]), cvt_pk(p[2], p[3])}; } }
    __syncthreads();
    }
    for (int rc = 0; rc < HG3_RC; ++rc) {
    const int tb = wave & 3, t = 16 * tb + fr;
    f32x4 o[4];
    { bf16x8 bp[2], bq[4];
#pragma unroll
      for (int ks = 0; ks < 2; ++ks) bp[ks] = *(const LAS bf16x8*)(lds + HG_P + ((16 * tb + fr) * HG_LD64 + 32 * ks + 8 * fq) * 2);
#pragma unroll
      for (int ks = 0; ks < 4; ++ks) bq[ks] = *(const LAS bf16x8*)(lds + HG_QD + ((16 * tb + fr) * HG_LD128 + 32 * ks + 8 * fq) * 2);
#pragma unroll
      for (int vi = 0; vi < 4; ++vi) { const int vb = 4 * (wave >> 2) + vi;
          f32x4 acc = {0.f, 0.f, 0.f, 0.f};
#pragma unroll
          for (int ks = 0; ks < 2; ++ks) { const bf16x8 av = *(const LAS bf16x8*)(lds + HG_VT + ((16 * vb + fr) * HG_LD64 + 32 * ks + 8 * fq) * 2);
              acc = __builtin_amdgcn_mfma_f32_16x16x32_bf16(av, bp[ks], acc, 0, 0, 0); }
#pragma unroll
          for (int ks = 0; ks < 4; ++ks) { const bf16x8 as = *(const LAS bf16x8*)(lds + HG_ST + ((16 * vb + fr) * HG_STLD + 32 * ks + 8 * fq) * 2);
              acc = __builtin_amdgcn_mfma_f32_16x16x32_bf16(as, bq[ks], acc, 0, 0, 0); }
          o[vi] = acc; } }
    float ss = 0.f;
#pragma unroll
    for (int vi = 0; vi < 4; ++vi) ss += (o[vi][0] * o[vi][0] + o[vi][1] * o[vi][1]) + (o[vi][2] * o[vi][2] + o[vi][3] * o[vi][3]);
    ss += __shfl_xor(ss, 16); ss += __shfl_xor(ss, 32);
    LAS float* red = (LAS float*)(lds + HG_RED);
    if (fq == 0) red[(wave >> 2) * 64 + t] = ss;
    __syncthreads();
    const float tot = red[t] + red[64 + t];
    const float rinv = 1.0f / sqrtf(tot * (1.0f / 128.0f) + RMS_EPS);
    bf16_t* BRA = (bf16_t*)(ws + WS_BRA);
#pragma unroll
    for (int vi = 0; vi < 4; ++vi) { const int v0 = 16 * (4 * (wave >> 2) + vi) + 4 * fq; const size_t off = (size_t)(tok0 + t) * 1024 + h * 128 + v0;
        const u32x2 gw = gwv[vi]; const f32x4 gn = *(const LAS f32x4*)(lds + HG_NGT + (h * 128 + v0) * 4);
        const float g0 = __uint_as_float(gw.x << 16), g1 = __uint_as_float(gw.x & 0xffff0000u), g2 = __uint_as_float(gw.y << 16), g3 = __uint_as_float(gw.y & 0xffff0000u);
        const float r0 = o[vi][0] * rinv * gn[0] * (g0 * sigmoidf_(g0)), r1 = o[vi][1] * rinv * gn[1] * (g1 * sigmoidf_(g1));
        const float r2 = o[vi][2] * rinv * gn[2] * (g2 * sigmoidf_(g2)), r3 = o[vi][3] * rinv * gn[3] * (g3 * sigmoidf_(g3));
        *(u32x2*)(BRA + off) = (u32x2){cvt_pk(r0, r1), cvt_pk(r2, r3)}; }
    __syncthreads();
    }
}


constexpr int IX_S = 0, IX_H = 131072, IX_L = 147456, IX_M = 155648, IX_C = 159744;
constexpr int IX_CAP = 512;
__device__ __forceinline__ unsigned ix_sortable(unsigned u) { return (u & 0x80000000u) ? ~u : (u | 0x80000000u); }

__device__ __forceinline__ void ix_radix_fallback(LAS unsigned* S, LAS unsigned* H, unsigned* MASK, int t0, int L, int tid) {
    const int lane = tid & 63, wave = __builtin_amdgcn_readfirstlane(tid >> 6);
    for (int q = 0; q < 4; ++q) for (int i = tid; i < L; i += NTHR) S[q * 8192 + i] = ix_sortable(S[q * 8192 + i]);
    for (int i = tid; i < 2048; i += NTHR) H[i] = 0u;
    __syncthreads();
    const int qs = wave >> 1, half = wave & 1;
    unsigned prefix = 0u; int kth = 256;
    for (int p = 0; p < 4; ++p) {
        const int shift = 24 - 8 * p;
        LAS unsigned* hist = H + (p & 1) * 1024 + qs * 256;
        for (int i = half * 64 + lane; i < L; i += 128) { const unsigned k = S[qs * 8192 + i];
            const bool in = (p == 0) || ((k >> (shift + 8)) == prefix);
            if (in) atomicAdd((unsigned*)(hist + ((k >> shift) & 255u)), 1u); }
        __syncthreads();
        const unsigned c0 = hist[255 - 4 * lane], c1 = hist[254 - 4 * lane], c2 = hist[253 - 4 * lane], c3 = hist[252 - 4 * lane];
        const int tot = (int)(c0 + c1 + c2 + c3);
        int incl = tot;
#pragma unroll
        for (int o = 1; o < 64; o <<= 1) { const int v = __shfl_up(incl, o); if (lane >= o) incl += v; }
        const unsigned long long bal = __ballot(incl >= kth);
        const int fl = __ffsll((long long)bal) - 1;
        const int rem = kth - (incl - tot);
        int dig, nk;
        if (rem <= (int)c0) { dig = 255 - 4 * lane; nk = rem; }
        else if (rem <= (int)(c0 + c1)) { dig = 254 - 4 * lane; nk = rem - (int)c0; }
        else if (rem <= (int)(c0 + c1 + c2)) { dig = 253 - 4 * lane; nk = rem - (int)(c0 + c1); }
        else { dig = 252 - 4 * lane; nk = rem - (int)(c0 + c1 + c2); }
        dig = __shfl(dig, fl); nk = __shfl(nk, fl);
        prefix = (prefix << 8) | (unsigned)dig; kth = nk;
        __syncthreads();
        if (p < 2) for (int i = tid; i < 1024; i += NTHR) H[(p & 1) * 1024 + i] = 0u;
    }
    const unsigned T = prefix;
    const int NG = L / 64;
    int tie_before = 0;
    if (half == 1) for (int g = 0; g < 64 && g < NG; ++g) { const unsigned k = S[qs * 8192 + 64 * g + lane]; tie_before += __popcll(__ballot(k == T)); }
    unsigned mlo = 0u, mhi = 0u;
    const unsigned long long lt = (1ull << lane) - 1ull;
    for (int g = 64 * half; g < NG && g < 64 * half + 64; ++g) {
        const unsigned k = S[qs * 8192 + 64 * g + lane];
        const bool eq = (k == T);
        const unsigned long long eqm = __ballot(eq);
        const int rank = tie_before + __popcll(eqm & lt);
        const bool sel = (k > T) || (eq && rank < kth);
        const unsigned long long m = __ballot(sel);
        if (lane == g - 64 * half) { mlo = (unsigned)m; mhi = (unsigned)(m >> 32); }
        tie_before += __popcll(eqm);
    }
    *(u32x2*)(MASK + (size_t)(t0 + qs) * 256 + 2 * (64 * half + lane)) = (u32x2){mlo, mhi};
    __syncthreads();
}

__device__ __forceinline__ void indexer_unit(const Args& a, int unit, LAS unsigned char* lds, int tid) {
    unsigned char* ws = a.ws;
    const int lane = tid & 63, wave = __builtin_amdgcn_readfirstlane(tid >> 6);
    const int t0 = unit * 4, b = t0 >> 13, qpos0 = t0 & (SEQ - 1), c = qpos0 >> 6, L = 64 * (c + 1);
    unsigned* MASK = (unsigned*)(ws + WS_MASK);
    if (c < 4) {
        const int qi = tid >> 7, w2 = (tid & 127) * 2;
        const unsigned m0 = (w2 * 32 < L) ? 0xffffffffu : 0u, m1 = ((w2 + 1) * 32 < L) ? 0xffffffffu : 0u;
        *(u32x2*)(MASK + (size_t)(t0 + qi) * 256 + w2) = (u32x2){m0, m1};
        return;
    }
    const bf16_t* IQ = (const bf16_t*)(ws + WS_IQ); const bf16_t* IKW = (const bf16_t*)(ws + WS_IKW);
    LAS unsigned* S = (LAS unsigned*)(lds + IX_S); LAS unsigned* H = (LAS unsigned*)(lds + IX_H); LAS unsigned* LST = (LAS unsigned*)(lds + IX_L);
    LAS unsigned* MB = (LAS unsigned*)(lds + IX_M); LAS float* MM = (LAS float*)(lds + IX_C); LAS unsigned* CC = (LAS unsigned*)(lds + IX_C + 256);
    const int r32 = lane & 31, hh = lane >> 5;
    for (int i = tid; i < 4096; i += NTHR) H[i] = 0u;
    for (int i = tid; i < 1024; i += NTHR) MB[i] = 0u;
    if (tid < 8) CC[tid] = 0u;
    bf16x8 af[4];
#pragma unroll
    for (int ks = 0; ks < 4; ++ks) af[ks] = *(const bf16x8*)(IQ + (size_t)(t0 + (r32 >> 3)) * 512 + (r32 & 7) * 64 + 16 * ks + 8 * hh);
    bf16x8 a2[2];
#pragma unroll
    for (int sI = 0; sI < 2; ++sI)
#pragma unroll
        for (int j = 0; j < 8; ++j) { const int qm = 2 * sI + (j >> 2), hm = 4 * hh + (j & 3);
            a2[sI][j] = (r32 == qm) ? (short)IKW[(size_t)(t0 + qm) * 256 + 64 + hm] : (short)0; }
    float mn[4], mx[4];
#pragma unroll
    for (int qi = 0; qi < 4; ++qi) { mn[qi] = 3.0e38f; mx[qi] = -3.0e38f; }
    const int NT32 = L / 32;
    const bf16_t* kbase = (const bf16_t*)(ws + WS_IK2) + (size_t)b * (SEQ / 32) * 2048 + lane * 8;
#define IX_LOADT(dst, kt_) do { const bf16_t* kp_ = kbase + (size_t)(kt_) * 2048; _Pragma("unroll") for (int ks = 0; ks < 4; ++ks) dst[ks] = *(const bf16x8*)(kp_ + 512 * ks); } while (0)
#define IX_MM(acc, bt) do { acc = f32x16{}; _Pragma("unroll") for (int ks = 0; ks < 4; ++ks) acc = __builtin_amdgcn_mfma_f32_32x32x16_bf16(af[ks], bt[ks], acc, 0, 0, 0); } while (0)
#define IX_HS(y_, acc) do { unsigned pk_[8]; _Pragma("unroll") for (int i = 0; i < 8; ++i) { const float x0_ = __builtin_amdgcn_fmed3f(acc[2 * i], 0.0f, 3.0e38f), x1_ = __builtin_amdgcn_fmed3f(acc[2 * i + 1], 0.0f, 3.0e38f); pk_[i] = cvt_pk_to_mfma(x0_, x1_); } \
        const u32x4 f0_ = {pk_[0], pk_[1], pk_[2], pk_[3]}, f1_ = {pk_[4], pk_[5], pk_[6], pk_[7]}; \
        y_ = f32x16{}; y_ = __builtin_amdgcn_mfma_f32_32x32x16_bf16(a2[0], *(const bf16x8*)&f0_, y_, 0, 0, 0); y_ = __builtin_amdgcn_mfma_f32_32x32x16_bf16(a2[1], *(const bf16x8*)&f1_, y_, 0, 0, 0); } while (0)
#define IX_ST(y_, kt_) do { const int key = (kt_) * 32 + r32; \
        if (hh == 0) { _Pragma("unroll") for (int qi = 0; qi < 4; ++qi) { const float s = y_[qi] + 0.0f; mn[qi] = fminf(mn[qi], s); mx[qi] = fmaxf(mx[qi], s); S[qi * 8192 + key] = __float_as_uint(s); } } } while (0)
#ifndef IX_REP_S1
#define IX_REP_S1 1
#endif
    for (int rp1 = 0; rp1 < IX_REP_S1; ++rp1) {
    bf16x8 bA[4], bB[4], bC[4];
    { const int kt = wave; if (kt < NT32) IX_LOADT(bA, kt); if (kt + 8 < NT32) IX_LOADT(bB, kt + 8); if (kt + 16 < NT32) IX_LOADT(bC, kt + 16); }
    for (int kt = wave; kt < NT32; kt += 3 * NWAVES) {
        const int kn = kt + 3 * NWAVES;
        bf16x8 nA[4], nB[4], nC[4];
        if (kn < NT32) IX_LOADT(nA, kn); if (kn + 8 < NT32) IX_LOADT(nB, kn + 8); if (kn + 16 < NT32) IX_LOADT(nC, kn + 16);
        const bool hB = kt + 8 < NT32, hC = kt + 16 < NT32;
#ifndef IX_REP_C
#define IX_REP_C 1
#endif
        for (int rc_ = 0; rc_ < IX_REP_C; ++rc_) {
        f32x16 xA, xB, xC;
        IX_MM(xA, bA); if (hB) IX_MM(xB, bB); if (hC) IX_MM(xC, bC);
        { f32x16 yy; IX_HS(yy, xA); IX_ST(yy, kt); }
        if (hB) { f32x16 yy; IX_HS(yy, xB); IX_ST(yy, kt + 8); }
        if (hC) { f32x16 yy; IX_HS(yy, xC); IX_ST(yy, kt + 16); }
        }
#pragma unroll
        for (int ks = 0; ks < 4; ++ks) { bA[ks] = nA[ks]; bB[ks] = nB[ks]; bC[ks] = nC[ks]; }
    }
    }
#undef IX_LOADT
#undef IX_MM
#undef IX_HS
#undef IX_ST
#pragma unroll
    for (int qi = 0; qi < 4; ++qi) {
#pragma unroll
        for (int o = 1; o < 32; o <<= 1) { mn[qi] = fminf(mn[qi], __shfl_xor(mn[qi], o)); mx[qi] = fmaxf(mx[qi], __shfl_xor(mx[qi], o)); }
        if (lane == 0) { MM[(wave * 4 + qi) * 2] = mn[qi]; MM[(wave * 4 + qi) * 2 + 1] = mx[qi]; } }
    __syncthreads();
    const int qs = wave >> 1, half = wave & 1;
    float mnq = 3.0e38f, mxq = -3.0e38f;
#pragma unroll
    for (int w = 0; w < NWAVES; ++w) { mnq = fminf(mnq, MM[(w * 4 + qs) * 2]); mxq = fmaxf(mxq, MM[(w * 4 + qs) * 2 + 1]); }
    const float scl = (mxq > mnq) ? 1023.0f / (mxq - mnq) : 0.0f;
#define IX_BIN(sbits) min((int)((__uint_as_float(sbits) - mnq) * scl), 1023)
    { LAS unsigned* hist = H + qs * 1024;
      int i = half * 64 + lane;
      for (; i + 384 < L; i += 512) { const unsigned s0 = S[qs * 8192 + i], s1 = S[qs * 8192 + i + 128], s2 = S[qs * 8192 + i + 256], s3 = S[qs * 8192 + i + 384];
          const int b0 = IX_BIN(s0), b1 = IX_BIN(s1), b2 = IX_BIN(s2), b3 = IX_BIN(s3);
          atomicAdd((unsigned*)(hist + b0), 1u); atomicAdd((unsigned*)(hist + b1), 1u); atomicAdd((unsigned*)(hist + b2), 1u); atomicAdd((unsigned*)(hist + b3), 1u); }
      for (; i < L; i += 128) { const int bin = IX_BIN(S[qs * 8192 + i]); atomicAdd((unsigned*)(hist + bin), 1u); } }
    __syncthreads();
    int bstar, rtake, cntb;
    { const LAS u32x4* hp = (const LAS u32x4*)(H + qs * 1024 + 1008 - 16 * lane);
      const u32x4 h0 = hp[0], h1 = hp[1], h2 = hp[2], h3 = hp[3];
      const unsigned cb[16] = {h0.x, h0.y, h0.z, h0.w, h1.x, h1.y, h1.z, h1.w, h2.x, h2.y, h2.z, h2.w, h3.x, h3.y, h3.z, h3.w};
      int tot = 0;
#pragma unroll
      for (int j = 0; j < 16; ++j) tot += (int)cb[j];
      int incl = tot;
#pragma unroll
      for (int o = 1; o < 64; o <<= 1) { const int v = __shfl_up(incl, o); if (lane >= o) incl += v; }
      const unsigned long long bal = __ballot(incl >= 256);
      const int fl = __ffsll((long long)bal) - 1;
      const int rem = 256 - (incl - tot);
      int cum = 0, bs = 0, rt = 0, cn = 0; bool found = false;
#pragma unroll
      for (int j = 15; j >= 0; --j) { const int cj = (int)cb[j]; if (!found && cum + cj >= rem) { bs = 1008 - 16 * lane + j; rt = rem - cum; cn = cj; found = true; } cum += cj; }
      bstar = __shfl(bs, fl); rtake = __shfl(rt, fl); cntb = __shfl(cn, fl); }
    const int NG = L / 64;
    const bool all_eq = (cntb == rtake);
    const unsigned long long lt = (1ull << lane) - 1ull;
    { unsigned mlo = 0u, mhi = 0u;
      const int gh = (NG + 1) >> 1, gbeg = half ? gh : 0, gend = half ? NG : gh;
      const float tge = (float)bstar, tgt = (bstar >= 1023) ? 3.0e38f : (float)(bstar + 1);
      unsigned sv[4] = {0u, 0u, 0u, 0u};
      for (int g = gbeg; g < gend; ++g) {
          const int gi = (g - gbeg) & 3;
          if (gi == 0) {
#pragma unroll
              for (int j = 0; j < 4; ++j) if (g + j < gend) sv[j] = S[qs * 8192 + 64 * (g + j) + lane]; }
          const unsigned sb = (gi == 0) ? sv[0] : (gi == 1) ? sv[1] : (gi == 2) ? sv[2] : sv[3];
          const float tq = (__uint_as_float(sb) - mnq) * scl;
          unsigned long long m = __ballot(tq >= tgt);
          const unsigned long long eqm = __ballot(tq >= tge) & ~m;
          if (all_eq) m |= eqm;
          else if (eqm != 0ull) {
              unsigned base = 0u;
              if (lane == 0) base = atomicAdd((unsigned*)(CC + qs), (unsigned)__popcll(eqm));
              base = __builtin_amdgcn_readfirstlane(base);
              const unsigned pos = base + (unsigned)__popcll(eqm & lt);
              if (((eqm >> lane) & 1ull) && pos < (unsigned)IX_CAP) LST[qs * IX_CAP + pos] = (unsigned)(64 * g + lane); }
          if (lane == g - gbeg) { mlo = (unsigned)m; mhi = (unsigned)(m >> 32); }
      }
      if (lane < gend - gbeg) *(LAS u32x2*)(MB + qs * 256 + 2 * (gbeg + lane)) = (u32x2){mlo, mhi}; }
    __syncthreads();
    if (half == 0 && !all_eq) {
        const int nc = cntb;
        if (nc > IX_CAP) { if (lane == 0) CC[4] = 1u; }
        else {
            unsigned myk[8], myi[8]; int rk[8];
#pragma unroll
            for (int sI = 0; sI < 8; ++sI) { const int j = sI * 64 + lane; rk[sI] = 0; myi[sI] = 0u; myk[sI] = 0u;
                if (sI * 64 < nc && j < nc) { myi[sI] = LST[qs * IX_CAP + j]; myk[sI] = ix_sortable(S[qs * 8192 + myi[sI]]); } }
            for (int t = 0; t < nc; ++t) { const unsigned it = LST[qs * IX_CAP + t]; const unsigned kt_ = ix_sortable(S[qs * 8192 + it]);
#pragma unroll
                for (int sI = 0; sI < 8; ++sI) if (sI * 64 < nc) rk[sI] += (kt_ > myk[sI] || (kt_ == myk[sI] && it < myi[sI])) ? 1 : 0; }
#pragma unroll
            for (int sI = 0; sI < 8; ++sI) { const int j = sI * 64 + lane;
                if (sI * 64 < nc && j < nc && rk[sI] < rtake) atomicOr((unsigned*)(MB + qs * 256 + (myi[sI] >> 5)), 1u << (myi[sI] & 31u)); }
        }
    }
#undef IX_BIN
    __syncthreads();
    if (CC[4] != 0u) { __syncthreads(); ix_radix_fallback(S, H, MASK, t0, L, tid); return; }
    { const int qi = tid >> 7, w2 = (tid & 127) * 2;
      *(u32x2*)(MASK + (size_t)(t0 + qi) * 256 + w2) = *(const LAS u32x2*)(MB + qi * 256 + w2); }
    __syncthreads();
}

constexpr int NA_IDX = 0, NA_LG = 1024, NA_SCAN = 1024 + 8192;
__device__ __forceinline__ void attn_gather_unit(const Args& a, int tok, LAS unsigned char* lds, int tid) {
    unsigned char* ws = a.ws;
    const int lane = tid & 63, wave = __builtin_amdgcn_readfirstlane(tid >> 6);
    const int b = tok >> 13, qpos = tok & (SEQ - 1), c = qpos >> 6, L = 64 * (c + 1), nsel = L < 256 ? L : 256;
    const unsigned* MASK = (const unsigned*)(ws + WS_MASK);
    LAS int* idxs = (LAS int*)(lds + NA_IDX); LAS float* lg = (LAS float*)(lds + NA_LG) + wave * 256; LAS int* wsum = (LAS int*)(lds + NA_SCAN);
    unsigned w = 0u; int cnt = 0;
    if (tid < 256) { w = MASK[(size_t)tok * 256 + tid]; cnt = __popc(w); }
    int incl = cnt;
#pragma unroll
    for (int o = 1; o < 64; o <<= 1) { const int v = __shfl_up(incl, o); if (lane >= o) incl += v; }
    if (lane == 63) wsum[wave] = incl;
    __syncthreads();
    if (tid < 256) { int off = incl - cnt; for (int ww = 0; ww < wave; ++ww) off += wsum[ww];
        while (w) { const int bit = __ffs(w) - 1; w &= w - 1; if (off < 256) idxs[off] = tid * 32 + bit; ++off; } }
    __syncthreads();
    const int h = wave;
    const bf16_t* BQ = (const bf16_t*)(ws + WS_BQ); const bf16_t* BK = (const bf16_t*)(ws + WS_BK); const bf16_t* BV = (const bf16_t*)(ws + WS_BV);
    const float slope = exp2f(-(float)(h + 1));
    float qv[8];
    { const u32x4 qw = *(const u32x4*)(BQ + (size_t)tok * 1024 + h * 128 + 8 * (lane & 15));
      qv[0] = __uint_as_float(qw.x << 16); qv[1] = __uint_as_float(qw.x & 0xffff0000u); qv[2] = __uint_as_float(qw.y << 16); qv[3] = __uint_as_float(qw.y & 0xffff0000u);
      qv[4] = __uint_as_float(qw.z << 16); qv[5] = __uint_as_float(qw.z & 0xffff0000u); qv[6] = __uint_as_float(qw.w << 16); qv[7] = __uint_as_float(qw.w & 0xffff0000u); }
    for (int it = 0; it < nsel / 4; ++it) {
        const int key = idxs[4 * it + (lane >> 4)];
        const u32x4 kw = *(const u32x4*)(BK + (size_t)(b * SEQ + key) * 1024 + h * 128 + 8 * (lane & 15));
        float s = qv[0] * __uint_as_float(kw.x << 16) + qv[1] * __uint_as_float(kw.x & 0xffff0000u) + qv[2] * __uint_as_float(kw.y << 16) + qv[3] * __uint_as_float(kw.y & 0xffff0000u)
                + qv[4] * __uint_as_float(kw.z << 16) + qv[5] * __uint_as_float(kw.z & 0xffff0000u) + qv[6] * __uint_as_float(kw.w << 16) + qv[7] * __uint_as_float(kw.w & 0xffff0000u);
        s += __shfl_xor(s, 1); s += __shfl_xor(s, 2); s += __shfl_xor(s, 4); s += __shfl_xor(s, 8);
        const float dist = fabsf((float)(qpos - key));
        if ((lane & 15) == 0) lg[4 * it + (lane >> 4)] = s * 0.08838834764831845f - slope * dist;
    }
    LDS_WAIT();
    float mx = -3.0e38f;
    for (int k = lane; k < nsel; k += 64) mx = fmaxf(mx, lg[k]);
#pragma unroll
    for (int o = 1; o < 64; o <<= 1) mx = fmaxf(mx, __shfl_xor(mx, o));
    float sm = 0.f;
    for (int k = lane; k < nsel; k += 64) { const float e = __expf(lg[k] - mx); lg[k] = e; sm += e; }
    sm = wave_sum(sm);
    const float rs = 1.0f / sm;
    LDS_WAIT();
    float o0 = 0.f, o1 = 0.f;
    for (int k = 0; k < nsel; k += 4) {
        unsigned vw[4]; float pp[4];
#pragma unroll
        for (int j = 0; j < 4; ++j) { const int key = idxs[k + j]; pp[j] = lg[k + j]; vw[j] = *(const unsigned*)(BV + (size_t)(b * SEQ + key) * 1024 + h * 128 + 2 * lane); }
#pragma unroll
        for (int j = 0; j < 4; ++j) { o0 += pp[j] * __uint_as_float(vw[j] << 16); o1 += pp[j] * __uint_as_float(vw[j] & 0xffff0000u); }
    }
    *(unsigned*)((bf16_t*)(ws + WS_BRB) + (size_t)tok * 1024 + h * 128 + 2 * lane) = cvt_pk(o0 * rs, o1 * rs);
    __syncthreads();
}

constexpr int RT_BLK = 148, RT_BUF = 64 * RT_BLK * 4;
constexpr int RT_SCR = 2 * RT_BUF;
__device__ __forceinline__ void phase8_router_expw(const Args& a, LAS unsigned char* lds, int tid, int G, bool route, bool do_expw) {
    unsigned char* ws = a.ws; const int wave = __builtin_amdgcn_readfirstlane(tid >> 6);
    const int npass = MT / 8;
    if (wave < 4) {
        __syncthreads();
        int cbuf = 0;
        for (int ps = blockIdx.x; ps < npass; ps += G) {
            int lane = tid & 63; asm volatile("" : "+v"(lane));
            f32x4 v[2][8];
#pragma unroll
            for (int r = 0; r < 2; ++r) { const int row = ps * 8 + wave * 2 + r;
                const unsigned ro = (unsigned)row * (unsigned)(DM * 2) + 8u * (unsigned)lane; float s = 0.f;
#pragma unroll
                for (int i = 0; i < 8; ++i) { const u32x2 pw = *(const u32x2*)(ws + (size_t)((unsigned)WS_PRE1 + ro + 512u * i));
                    v[r][i] = (f32x4){__uint_as_float(pw.x << 16), __uint_as_float(pw.x & 0xffff0000u), __uint_as_float(pw.y << 16), __uint_as_float(pw.y & 0xffff0000u)};
                    s += (v[r][i][0] + v[r][i][1]) + (v[r][i][2] + v[r][i][3]); }
                const float mean = wave_sum(s) * (1.0f / DM); float s2 = 0.f;
#pragma unroll
                for (int i = 0; i < 8; ++i) { v[r][i] = v[r][i] - mean; s2 += (v[r][i][0] * v[r][i][0] + v[r][i][1] * v[r][i][1]) + (v[r][i][2] * v[r][i][2] + v[r][i][3] * v[r][i][3]); }
                const float rstd = 1.0f / sqrtf(wave_sum(s2) * (1.0f / DM) + LN_EPS);
#pragma unroll
                for (int i = 0; i < 8; ++i) { const f32x4 gg = *(const f32x4*)(a.in[I_LN1G] + 256 * i + 4 * lane), bb = *(const f32x4*)(a.in[I_LN1B] + 256 * i + 4 * lane);
                    v[r][i] = v[r][i] * rstd * gg + bb;
                    *(u32x2*)(ws + (size_t)((unsigned)WS_H1B + ro + 512u * i)) = (u32x2){cvt_pk(v[r][i][0], v[r][i][1]), cvt_pk(v[r][i][2], v[r][i][3])};
                    *(unsigned*)(ws + (size_t)((unsigned)WS_H1F8 + (ro >> 1) + 256u * i)) = cvt4_fp8_nc(v[r][i][0], v[r][i][1], v[r][i][2], v[r][i][3], F8_ASCALE); } }
            f32x2 acc2[36];
#pragma unroll
            for (int j = 0; j < 36; ++j) acc2[j] = (f32x2){0.f, 0.f};
#pragma unroll
            for (int i = 0; i < 8; ++i) {
                int lq = lane; asm volatile("" : "+v"(lq));
                const LAS float* blk = (const LAS float*)(lds + cbuf * RT_BUF) + lq * RT_BLK;
#pragma unroll
                for (int kk = 0; kk < 4; ++kk) {
                    __builtin_amdgcn_sched_barrier(0);
                    const f32x2 hv = (f32x2){v[0][i][kk], v[1][i][kk]};
#pragma unroll
                    for (int q = 0; q < 9; ++q) { const f32x4 w4 = *(const LAS f32x4*)(blk + kk * 36 + 4 * q);
                        acc2[4 * q + 0] += hv * (f32x2){w4[0], w4[0]}; acc2[4 * q + 1] += hv * (f32x2){w4[1], w4[1]};
                        acc2[4 * q + 2] += hv * (f32x2){w4[2], w4[2]}; acc2[4 * q + 3] += hv * (f32x2){w4[3], w4[3]}; } }
                __syncthreads();
                cbuf ^= 1;
            }
#pragma unroll
            for (int r = 0; r < 2; ++r) {
                const int row = ps * 8 + wave * 2 + r;
                float lgt[36];
#pragma unroll
                for (int j = 0; j < 36; ++j) lgt[j] = wave_sum(r == 0 ? acc2[j][0] : acc2[j][1]);
                float gl[4]; float gm = -3.0e38f; int gt = 0;
#pragma unroll
                for (int j = 0; j < 4; ++j) { gl[j] = lgt[j] + a.in[I_BGRP][j]; if (gl[j] > gm) { gm = gl[j]; gt = j; } }
                float gs = 0.f;
#pragma unroll
                for (int j = 0; j < 4; ++j) gs += __expf(gl[j] - gm);
                const float gp = 1.0f / gs;
                float e1 = -3.0e38f, e2 = -3.0e38f; int i1 = 0, i2 = 0;
#pragma unroll
                for (int j = 0; j < 8; ++j) { float ev = 0.f;
#pragma unroll
                    for (int gq = 0; gq < 4; ++gq) if (gq == gt) ev = lgt[4 + 8 * gq + j] + a.in[I_BRT][8 * gq + j];
                    if (ev > e1) { e2 = e1; i2 = i1; e1 = ev; i1 = j; } else if (ev > e2) { e2 = ev; i2 = j; } }
                const float x2 = __expf(e2 - e1), w1 = gp / (1.0f + x2), w2 = gp * x2 / (1.0f + x2);
                if (lane == 0 && route) {
                    unsigned* ctl = (unsigned*)(ws + WS_CTL);
                    int* rows = (int*)(ws + WS_ROWS); int* slot_e = (int*)(ws + WS_SLOT); int* slot_p = slot_e + 2 * MT; float* slot_w = (float*)(slot_p + 2 * MT);
                    const int ea = gt * 8 + i1, eb = gt * 8 + i2;
                    const int pa = (int)atomicAdd(ctl + CW_CNT + 64 * ea, 1u), pb = (int)atomicAdd(ctl + CW_CNT + 64 * eb, 1u);
                    rows[ea * MT + pa] = row; rows[eb * MT + pb] = row;
                    slot_e[2 * row] = ea; slot_e[2 * row + 1] = eb; slot_p[2 * row] = pa; slot_p[2 * row + 1] = pb; slot_w[2 * row] = w1; slot_w[2 * row + 1] = w2;
                }
            }
        }
    } else {
        const int lane = tid & 63, te = tid - 256;
        const float* wg = a.in[I_WGRP]; const float* wr = a.in[I_WRT];
        LAS float* scr = (LAS float*)(lds + RT_SCR + (wave - 4) * 8704);
        f32x4 sa[9], sb[9];
#define RT_LOADW(dst, chunk) do { const int k_ = (chunk) * 256 + te; dst[0] = *(const f32x4*)(wg + (size_t)k_ * 4); _Pragma("unroll") for (int j_ = 0; j_ < 8; ++j_) dst[1 + j_] = *(const f32x4*)(wr + (size_t)k_ * 32 + 4 * j_); } while (0)
#define RT_WRITEW(src, buf) do { LAS float* p_ = (LAS float*)(buf) + (te >> 2) * RT_BLK + (te & 3) * 36; _Pragma("unroll") for (int j_ = 0; j_ < 9; ++j_) *(LAS f32x4*)(p_ + 4 * j_) = src[j_]; } while (0)
        RT_LOADW(sa, 0); RT_WRITEW(sa, lds); RT_LOADW(sb, 1);
        const int ge = blockIdx.x * 4 + (wave - 4), NGE = G * 4, NIT = do_expw ? NEXP * EW_E : 0;
        int it = ge; f32x4 e0[8], e1[8];
#define EW_LOAD(dst, item) do { if ((item) < NIT) { size_t ldw_; const float* p_ = ew_src(a, (item), lane, ldw_); _Pragma("unroll") for (int i_ = 0; i_ < 8; ++i_) dst[i_] = __builtin_nontemporal_load((const f32x4*)(p_ + (size_t)(8 * i_) * ldw_)); } } while (0)
#define EW_STEPX(cur, fre) do { if (it < NIT) { EW_LOAD(fre, it + NGE); ew_store(a, it, cur, scr, lane); it += NGE; } } while (0)
        EW_LOAD(e0, it);
        __syncthreads();
        int cbuf = 0;
        for (int ps = blockIdx.x; ps < npass; ps += G) {
#pragma unroll
            for (int i = 0; i < 8; ++i) {
                if (i & 1) { RT_LOADW(sb, (i + 2) & 7); RT_WRITEW(sa, lds + (cbuf ^ 1) * RT_BUF); }
                else { RT_LOADW(sa, (i + 2) & 7); RT_WRITEW(sb, lds + (cbuf ^ 1) * RT_BUF); }
                if (i == 0) { EW_STEPX(e0, e1); EW_STEPX(e1, e0); } else if (i == 1) { EW_STEPX(e0, e1); } else if (i == 2) { EW_STEPX(e1, e0); EW_STEPX(e0, e1); } else if (i == 3) { EW_STEPX(e1, e0); }
                else if (i == 4) { EW_STEPX(e0, e1); EW_STEPX(e1, e0); } else if (i == 5) { EW_STEPX(e0, e1); } else if (i == 6) { EW_STEPX(e1, e0); EW_STEPX(e0, e1); } else { EW_STEPX(e1, e0); }
                __syncthreads();
                cbuf ^= 1;
            }
        }
        while (it < NIT) { EW_STEPX(e0, e1); EW_STEPX(e1, e0); }
#undef RT_LOADW
#undef RT_WRITEW
#undef EW_STEPX
#undef EW_LOAD
    }
    __syncthreads();
}

__device__ __forceinline__ void load_tile_base(const Args& a, LAS int* tb, int tid) {
    const unsigned* ctl = (const unsigned*)(a.ws + WS_CTL);
    if (tid == 0) { int acc = 0; for (int e = 0; e < NEXP; ++e) { tb[e] = acc; acc += ((int)ctl[CW_CNT + 64 * e] + 255) >> 8; } tb[NEXP] = acc; }
    __syncthreads();
}

__device__ __forceinline__ void phase_gather(const Args& a, LAS unsigned char* lds, int tid, int G) {
    unsigned char* ws = a.ws; const int lane = tid & 63, wave = tid >> 6;
    LAS int* tb = (LAS int*)lds;
    load_tile_base(a, tb, tid);
    unsigned* ctl = (unsigned*)(ws + WS_CTL);
    const int NT = tb[NEXP];
    if (blockIdx.x == 0) { if (tid == 0) ctl[CW_NT] = (unsigned)NT;
        if (tid < NEXP) for (int t = tb[tid]; t < tb[tid + 1]; ++t) ctl[CW_TILEE + t] = (unsigned)tid;
        if (tid <= NEXP) ctl[CW_TBASE + tid] = (unsigned)tb[tid]; }
    const int* rows = (const int*)(ws + WS_ROWS); const bf16_t* H1B = (const bf16_t*)(ws + WS_H1B); bf16_t* XG = (bf16_t*)(ws + WS_XG);
    for (int r = blockIdx.x * NWAVES + wave; r < NT * 256; r += G * NWAVES) {
        const int tile = r >> 8; int e = 0;
        for (int j = 1; j < NEXP; ++j) if (tb[j] <= tile) e = j;
        const int pos = r - tb[e] * 256; const int cnt = (int)ctl[CW_CNT + 64 * e];
        u32x4 v[4];
        if (pos < cnt) { const int tok = rows[e * MT + pos];
#pragma unroll
            for (int i = 0; i < 4; ++i) v[i] = *(const u32x4*)(H1B + (size_t)tok * DM + 512 * i + 8 * lane); }
        else {
#pragma unroll
            for (int i = 0; i < 4; ++i) v[i] = (u32x4){0u, 0u, 0u, 0u}; }
#pragma unroll
        for (int i = 0; i < 4; ++i) *(u32x4*)(XG + (size_t)r * DM + 512 * i + 8 * lane) = v[i];
    }
}

struct FinSlots { int r0, r1; float w0, w1; };
__device__ __forceinline__ void fin_slots(const Args& a, int row, const LAS int* tb, FinSlots& S) {
    unsigned char* ws = a.ws;
    const int* slot_e = (const int*)(ws + WS_SLOT); const int* slot_p = slot_e + 2 * MT; const float* slot_w = (const float*)(slot_p + 2 * MT);
    const int e0 = slot_e[2 * row], e1 = slot_e[2 * row + 1];
    S.r0 = tb[e0] * 256 + slot_p[2 * row]; S.r1 = tb[e1] * 256 + slot_p[2 * row + 1]; S.w0 = slot_w[2 * row]; S.w1 = slot_w[2 * row + 1];
}
__device__ __forceinline__ void fin_data(const Args& a, int row, int lane, const FinSlots& S, u32x2 (&hw)[8], u32x2 (&ya)[8], u32x2 (&yb)[8]) {
    unsigned char* ws = a.ws;
    const bf16_t* H1B = (const bf16_t*)(ws + WS_H1B) + (size_t)row * DM; const bf16_t* Y = (const bf16_t*)(ws + WS_Y);
#pragma unroll
    for (int i = 0; i < 8; ++i) { hw[i] = *(const u32x2*)(H1B + 256 * i + 4 * lane); ya[i] = *(const u32x2*)(Y + (size_t)S.r0 * DM + 256 * i + 4 * lane); yb[i] = *(const u32x2*)(Y + (size_t)S.r1 * DM + 256 * i + 4 * lane); }
}
__device__ __forceinline__ void fin_compute(const Args& a, int row, int lane, float w0, float w1, const u32x2 (&hw)[8], const u32x2 (&ya)[8], const u32x2 (&yb)[8]) {
    f32x4 v[8]; float s = 0.f;
#pragma unroll
    for (int i = 0; i < 8; ++i) {
        const f32x4 hv = {__uint_as_float(hw[i].x << 16), __uint_as_float(hw[i].x & 0xffff0000u), __uint_as_float(hw[i].y << 16), __uint_as_float(hw[i].y & 0xffff0000u)};
        const f32x4 fa = {__uint_as_float(ya[i].x << 16), __uint_as_float(ya[i].x & 0xffff0000u), __uint_as_float(ya[i].y << 16), __uint_as_float(ya[i].y & 0xffff0000u)};
        const f32x4 fb = {__uint_as_float(yb[i].x << 16), __uint_as_float(yb[i].x & 0xffff0000u), __uint_as_float(yb[i].y << 16), __uint_as_float(yb[i].y & 0xffff0000u)};
        v[i] = hv * DN_ALPHA + fa * w0 + fb * w1; s += (v[i][0] + v[i][1]) + (v[i][2] + v[i][3]); }
    const float mean = wave_sum(s) * (1.0f / DM); float s2 = 0.f;
#pragma unroll
    for (int i = 0; i < 8; ++i) { v[i] = v[i] - mean; s2 += (v[i][0] * v[i][0] + v[i][1] * v[i][1]) + (v[i][2] * v[i][2] + v[i][3] * v[i][3]); }
    const float rstd = 1.0f / sqrtf(wave_sum(s2) * (1.0f / DM) + LN_EPS);
    float* O = a.out + (size_t)row * DM;
#pragma unroll
    for (int i = 0; i < 8; ++i) { const f32x4 g = *(const f32x4*)(a.in[I_LN2G] + 256 * i + 4 * lane), bb = *(const f32x4*)(a.in[I_LN2B] + 256 * i + 4 * lane);
        *(f32x4*)(O + 256 * i + 4 * lane) = v[i] * rstd * g + bb; }
}
__device__ __forceinline__ void phase_final(const Args& a, int tid, int G, const LAS int* tb) {
    const int lane = tid & 63, wave = tid >> 6, gw = blockIdx.x * NWAVES + wave, NGW = G * NWAVES;
    if (gw >= MT) return;
    FinSlots SA, SB; u32x2 hA[8], aA[8], bA[8], hB[8], aB[8], bB[8];
    int row = gw;
    fin_slots(a, row, tb, SA); fin_data(a, row, lane, SA, hA, aA, bA);
    if (row + NGW < MT) fin_slots(a, row + NGW, tb, SB);
    for (;;) {
        const int r1 = row + NGW, r2 = row + 2 * NGW;
        if (r1 < MT) fin_data(a, r1, lane, SB, hB, aB, bB);
        const float w0 = SA.w0, w1 = SA.w1;
        if (r2 < MT) fin_slots(a, r2, tb, SA);
        fin_compute(a, row, lane, w0, w1, hA, aA, bA);
        if (r1 >= MT) break;
        const int r3 = row + 3 * NGW;
        if (r2 < MT) fin_data(a, r2, lane, SA, hA, aA, bA);
        const float x0 = SB.w0, x1 = SB.w1;
        if (r3 < MT) fin_slots(a, r3, tb, SB);
        fin_compute(a, r1, lane, x0, x1, hB, aB, bB);
        if (r2 >= MT) break;
        row = r2;
    }
}

namespace fa {
constexpr int D = 128, NW = 8, QBLK = 32, KVBLK = 64, LDX = 1024;
constexpr float SCALE = 0.088388347648318440f, THR = 8.f;
constexpr size_t SHM_V = KVBLK * D * 2, SHM_K = KVBLK * D * 2, SHM_ATTN = 2 * SHM_V + 2 * SHM_K + NW * 64 * 4;
using s16x4 = __attribute__((ext_vector_type(4))) short;
#define KSWZ(row, colB) ((row) * 256 + ((colB) ^ (((row) & 7) << 4)))
#define SBAR() __builtin_amdgcn_sched_barrier(0)
__device__ __forceinline__ int crow(int r, int hi) { return (r & 3) + 8 * (r >> 2) + 4 * hi; }

__device__ __forceinline__ void partialSM(f32x16& p0, f32x16& p1, float& m_reg, float& mn, float& alpha) {
  constexpr float C = SCALE * 1.4426950408889634f;
  float pmax = p0[0];
#pragma unroll
  for (int r = 1; r < 16; ++r) pmax = fmaxf(pmax, p0[r]);
#pragma unroll
  for (int r = 0; r < 16; ++r) pmax = fmaxf(pmax, p1[r]);
  { auto rr = __builtin_amdgcn_permlane32_swap(__float_as_uint(pmax), __float_as_uint(pmax), false, false);
    pmax = fmaxf(__uint_as_float(rr[0]), __uint_as_float(rr[1])); }
  if (__builtin_expect(__all(pmax - m_reg <= THR / SCALE), 1)) { mn = m_reg; alpha = 1.f; }
  else { mn = fmaxf(m_reg, pmax); alpha = __builtin_amdgcn_exp2f((m_reg - mn) * C); m_reg = mn; }
  float mnC = -mn * C;
#pragma unroll
  for (int r = 0; r < 16; ++r) p0[r] = fmaf(p0[r], C, mnC);
#pragma unroll
  for (int r = 0; r < 16; ++r) p1[r] = fmaf(p1[r], C, mnC);
#pragma unroll
  for (int r = 0; r < 16; ++r) p0[r] = __builtin_amdgcn_exp2f(p0[r]);
}
__device__ __forceinline__ void finishSM(f32x16& p0, f32x16& p1, float alpha, float& l_reg, bf16x8& pa0, bf16x8& pa1, bf16x8& pa2, bf16x8& pa3) {
#pragma unroll
  for (int r = 0; r < 16; ++r) p1[r] = __builtin_amdgcn_exp2f(p1[r]);
  float ps = 0;
#pragma unroll
  for (int r = 0; r < 16; ++r) ps += p0[r];
#pragma unroll
  for (int r = 0; r < 16; ++r) ps += p1[r];
  { auto rr = __builtin_amdgcn_permlane32_swap(__float_as_uint(ps), __float_as_uint(ps), false, false);
    ps = __uint_as_float(rr[0]) + __uint_as_float(rr[1]); }
  l_reg = l_reg * alpha + ps;
#define PK4(P, BASE, OUT) do { unsigned a0 = cvt_pk(P[BASE + 0], P[BASE + 1]), a1 = cvt_pk(P[BASE + 2], P[BASE + 3]);   \
    unsigned b0 = cvt_pk(P[BASE + 4], P[BASE + 5]), b1 = cvt_pk(P[BASE + 6], P[BASE + 7]);                              \
    auto r0 = __builtin_amdgcn_permlane32_swap(a0, b0, false, false); auto r1 = __builtin_amdgcn_permlane32_swap(a1, b1, false, false); \
    u32x4 w = {r0[0], r1[0], r0[1], r1[1]}; OUT = *reinterpret_cast<bf16x8*>(&w); } while (0)
  PK4(p0, 0, pa0); PK4(p0, 8, pa1); PK4(p1, 0, pa2); PK4(p1, 8, pa3);
#undef PK4
}
__device__ __forceinline__ void qkt(f32x16& p0, f32x16& p1, const char* Ks, const bf16x8* qr, int r32, int hi) {
  p0 = f32x16{}; p1 = f32x16{};
#pragma unroll
  for (int d0 = 0; d0 < 8; ++d0) { int cb = (d0 * 16 + hi * 8) * 2;
    bf16x8 b0 = *reinterpret_cast<const bf16x8*>(Ks + KSWZ(r32, cb));
    bf16x8 b1 = *reinterpret_cast<const bf16x8*>(Ks + KSWZ(32 + r32, cb));
    p0 = __builtin_amdgcn_mfma_f32_32x32x16_bf16(b0, qr[d0], p0, 0, 0, 0);
    p1 = __builtin_amdgcn_mfma_f32_32x32x16_bf16(b1, qr[d0], p1, 0, 0, 0); }
}
__device__ __forceinline__ void mask_bias(f32x16& p0, f32x16& p1, u32x2 mw, float dq, float slr, int hi) {
  const unsigned w0 = mw.x >> (4 * hi), w1 = mw.y >> (4 * hi);
  const unsigned NEG = 0xf149f2cau;
#pragma unroll
  for (int r = 0; r < 16; ++r) { const int c = (r & 3) + 8 * (r >> 2);
    const float d0 = dq - (float)c, d1 = dq - (float)(32 + c);
    const float s0 = fmaf(-slr, fabsf(d0), p0[r]), s1 = fmaf(-slr, fabsf(d1), p1[r]);
    const unsigned t0 = (unsigned)(((int)(w0 << (31 - c))) >> 31), t1 = (unsigned)(((int)(w1 << (31 - c))) >> 31);
    p0[r] = __uint_as_float((__float_as_uint(s0) & t0) | (NEG & ~t0));
    p1[r] = __uint_as_float((__float_as_uint(s1) & t1) | (NEG & ~t1)); }
}
__device__ __forceinline__ int v_st(int k, int c) { const int kk = (k & ~0xC) | ((k & 4) << 1) | ((k & 8) >> 1); return ((kk >> 3) * 4 + (c >> 5)) * 512 + ((kk & 7) * 32 + (c & 31)) * 2; }
__device__ __forceinline__ int v_rd_base(int lane) { return ((lane & 3) << 3) | (((lane >> 2) & 3) << 6) | (((lane >> 4) & 1) << 5) | (((lane >> 5) & 1) << 8); }
constexpr int v_rd_off(int d0, int ks, int half) { return d0 * 512 + ks * 4096 + half * 2048; }
template <int OFF> __device__ __forceinline__ s16x4 tr_read(int vb) {
  s16x4 r; asm volatile("ds_read_b64_tr_b16 %0, %1 offset:%2" : "=&v"(r) : "v"(vb), "i"(OFF) : "memory"); return r;
}
template <int D0> __device__ __forceinline__ void pv_one(f32x16& od, int vb, bf16x8 pa0, bf16x8 pa1, bf16x8 pa2, bf16x8 pa3) {
  const s16x4 l0 = tr_read<v_rd_off(D0, 0, 0)>(vb), h0 = tr_read<v_rd_off(D0, 0, 1)>(vb), l1 = tr_read<v_rd_off(D0, 1, 0)>(vb), h1 = tr_read<v_rd_off(D0, 1, 1)>(vb);
  const s16x4 l2 = tr_read<v_rd_off(D0, 2, 0)>(vb), h2 = tr_read<v_rd_off(D0, 2, 1)>(vb), l3 = tr_read<v_rd_off(D0, 3, 0)>(vb), h3 = tr_read<v_rd_off(D0, 3, 1)>(vb);
  asm volatile("s_waitcnt lgkmcnt(0)" ::: "memory"); SBAR();
#define PK(L, H) (bf16x8){L[0], L[1], L[2], L[3], H[0], H[1], H[2], H[3]}
  od = __builtin_amdgcn_mfma_f32_32x32x16_bf16(pa0, PK(l0, h0), od, 0, 0, 0);
  od = __builtin_amdgcn_mfma_f32_32x32x16_bf16(pa1, PK(l1, h1), od, 0, 0, 0);
  od = __builtin_amdgcn_mfma_f32_32x32x16_bf16(pa2, PK(l2, h2), od, 0, 0, 0);
  od = __builtin_amdgcn_mfma_f32_32x32x16_bf16(pa3, PK(l3, h3), od, 0, 0, 0);
#undef PK
}
__device__ __forceinline__ void pv_d0(f32x16* o, int vb, bf16x8 pa0, bf16x8 pa1, bf16x8 pa2, bf16x8 pa3) {
  pv_one<0>(o[0], vb, pa0, pa1, pa2, pa3); pv_one<1>(o[1], vb, pa0, pa1, pa2, pa3); pv_one<2>(o[2], vb, pa0, pa1, pa2, pa3); pv_one<3>(o[3], vb, pa0, pa1, pa2, pa3);
}

#define FA_GAS __attribute__((address_space(1)))
__device__ __forceinline__ void attn_block(const bf16_t* Qb_, const bf16_t* Kh_, const bf16_t* Vh_, const unsigned* maskrow_,
                                           bf16_t* Ob_, int NT, int qpos0, float slr, char* lds) {
  const FA_GAS bf16_t* Qb = (const FA_GAS bf16_t*)Qb_; const FA_GAS bf16_t* Kh = (const FA_GAS bf16_t*)Kh_; const FA_GAS bf16_t* Vh = (const FA_GAS bf16_t*)Vh_;
  const FA_GAS unsigned* maskrow = (const FA_GAS unsigned*)maskrow_; FA_GAS bf16_t* Ob = (FA_GAS bf16_t*)Ob_;
  int tid_ = cur_tid((const LAS unsigned char*)lds); asm volatile("" : "+v"(tid_));
  const int tid = tid_, wid = tid >> 6, lane = tid & 63, r32 = lane & 31, hi = lane >> 5;
  char* V_lds = lds; char* K_lds = lds + 2 * SHM_V;
  float* wsm = (float*)(lds + 2 * SHM_V + 2 * SHM_K) + wid * 64; float* li_l = wsm; float* al_l = wsm + 32;
  float m_reg = -1e30f, l_reg = 0; f32x16 o[4] = {}; bf16x8 qr[8];
  const FA_GAS bf16_t* Qw = Qb + (long)(wid * QBLK + r32) * LDX + hi * 8;
#pragma unroll
  for (int d0 = 0; d0 < 8; ++d0) qr[d0] = *reinterpret_cast<const FA_GAS bf16x8*>(Qw + d0 * 16);
  const unsigned moff = (unsigned)(wid * QBLK + r32) * 256u;
  const float qposf = (float)(qpos0 + wid * QBLK + r32 - 4 * hi);
  const int sr = tid >> 4, sc = (tid & 15) * 8, vst0 = v_st(sr, sc), vst1 = v_st(32 + sr, sc);
  const int vb0 = (int)(uintptr_t)V_lds + v_rd_base(lane);
  constexpr int SDEPTH = 1;
  struct { bf16x8 vs0, vs1, ks0, ks1; } sr_[SDEPTH];
#define KOFF(j) ((NT - 1 - (j)) * KVBLK)
#define SLOAD(i, k0) do { sr_[i].vs0 = *reinterpret_cast<const FA_GAS bf16x8*>(&Vh[(long)((k0) + sr) * LDX + sc]); sr_[i].vs1 = *reinterpret_cast<const FA_GAS bf16x8*>(&Vh[(long)((k0) + 32 + sr) * LDX + sc]); \
    sr_[i].ks0 = *reinterpret_cast<const FA_GAS bf16x8*>(&Kh[(long)((k0) + sr) * LDX + sc]); sr_[i].ks1 = *reinterpret_cast<const FA_GAS bf16x8*>(&Kh[(long)((k0) + 32 + sr) * LDX + sc]); } while (0)
#define SWRITE(b, i) do { *(bf16x8*)(V_lds + (b) * SHM_V + vst0) = sr_[i].vs0;          \
    *(bf16x8*)(V_lds + (b) * SHM_V + vst1) = sr_[i].vs1; int kc = sc * 2;               \
    *(bf16x8*)(K_lds + (b) * SHM_K + KSWZ(sr, kc)) = sr_[i].ks0;                       \
    *(bf16x8*)(K_lds + (b) * SHM_K + KSWZ(32 + sr, kc)) = sr_[i].ks1; } while (0)
#define SWAIT() do { if constexpr (SDEPTH == 2) asm volatile("s_waitcnt vmcnt(4)" ::: "memory"); else asm volatile("s_waitcnt vmcnt(0)" ::: "memory"); } while (0)
#define RESC(a) do { if (__any((a) < 1.f)) { if (hi == 0) al_l[r32] = (a); asm volatile("s_waitcnt lgkmcnt(0)" ::: "memory"); \
    _Pragma("unroll") for (int d = 0; d < 4; ++d) _Pragma("unroll") for (int r = 0; r < 16; ++r) o[d][r] *= al_l[crow(r, hi)]; } } while (0)
#define MASKW(j) (*reinterpret_cast<const FA_GAS u32x2*>(maskrow + (moff + 2u * (unsigned)(NT - 1 - (j)))))
#define MB(P0, P1, j, MW) mask_bias(P0, P1, MW, qposf - (float)KOFF(j), slr, hi)
  f32x16 pA0, pA1, pB0, pB1; float mnA, mnB, alA, alB; bf16x8 pa0, pa1, pa2, pa3;
  constexpr int SE = 0, SO = SDEPTH - 1;
  SLOAD(SE, KOFF(0)); asm volatile("s_waitcnt vmcnt(0)" ::: "memory"); SWRITE(0, SE); __syncthreads();
  { qkt(pA0, pA1, K_lds, qr, r32, hi); MB(pA0, pA1, 0, MASKW(0)); } partialSM(pA0, pA1, m_reg, mnA, alA);
  SLOAD(SO, KOFF(1)); if constexpr (SDEPTH == 2) { if (2 < NT) SLOAD(SE, KOFF(2)); }
  SWAIT(); SWRITE(1, SO); __syncthreads();
  for (int j = 1; j + 1 < NT; j += 2) {
    SBAR(); { qkt(pB0, pB1, K_lds + SHM_K, qr, r32, hi); MB(pB0, pB1, j, MASKW(j)); }
    finishSM(pA0, pA1, alA, l_reg, pa0, pa1, pa2, pa3); SBAR();
    SLOAD(SO, KOFF(j + SDEPTH)); SBAR();
    pv_d0(o, vb0, pa0, pa1, pa2, pa3); partialSM(pB0, pB1, m_reg, mnB, alB);
    __syncthreads(); SWAIT(); SWRITE(0, SE);
    RESC(alB); __syncthreads();
    SBAR(); { qkt(pA0, pA1, K_lds, qr, r32, hi); MB(pA0, pA1, j + 1, MASKW(j + 1)); }
    finishSM(pB0, pB1, alB, l_reg, pa0, pa1, pa2, pa3); SBAR();
    if (SDEPTH == 1 || j + 3 < NT) SLOAD(SE, KOFF(j + 1 + SDEPTH)); SBAR();
    pv_d0(o, vb0 + (int)SHM_V, pa0, pa1, pa2, pa3); partialSM(pA0, pA1, m_reg, mnA, alA);
    __syncthreads(); SWAIT(); SWRITE(1, SO);
    RESC(alA); __syncthreads();
  }
  SBAR(); { qkt(pB0, pB1, K_lds + SHM_K, qr, r32, hi); MB(pB0, pB1, NT - 1, MASKW(NT - 1)); }
  finishSM(pA0, pA1, alA, l_reg, pa0, pa1, pa2, pa3); SBAR();
  pv_d0(o, vb0, pa0, pa1, pa2, pa3); partialSM(pB0, pB1, m_reg, mnB, alB);
  __syncthreads(); RESC(alB);
  finishSM(pB0, pB1, alB, l_reg, pa0, pa1, pa2, pa3); SBAR();
  pv_d0(o, vb0 + (int)SHM_V, pa0, pa1, pa2, pa3);
  if (hi == 0) li_l[r32] = l_reg; asm volatile("s_waitcnt lgkmcnt(0)" ::: "memory");
  float rli[16];
#pragma unroll
  for (int r = 0; r < 16; ++r) rli[r] = __builtin_amdgcn_rcpf(li_l[crow(r, hi)]);
  FA_GAS bf16_t* Ow = Ob + (long)(wid * QBLK) * LDX;
#pragma unroll
  for (int r = 0; r < 16; ++r) { int orow = crow(r, hi);
#pragma unroll
    for (int d0 = 0; d0 < 4; ++d0) Ow[(long)orow * LDX + d0 * 32 + r32] = (bf16_t)(cvt_pk(o[d0][r] * rli[r], 0.f) & 0xffffu); }
  __syncthreads();
#undef KOFF
#undef SLOAD
#undef SWRITE
#undef SWAIT
#undef RESC
#undef MASKW
#undef MB
}
#undef KSWZ
#undef SBAR
}

__device__ __forceinline__ void phase_attention(const Args& a, char* lds, int G, int bid) {
    unsigned char* ws = uni_ptr(a.ws);
    const bf16_t* BQ = (const bf16_t*)(ws + WS_BQ); const bf16_t* BK = (const bf16_t*)(ws + WS_BK); const bf16_t* BV = (const bf16_t*)(ws + WS_BV);
    const unsigned* MASK = (const unsigned*)(ws + WS_MASK); bf16_t* BRB = (bf16_t*)(ws + WS_BRB);
    const int bx = bid; const int vcu = (G % 8 == 0) ? (bx % 8) * (G / 8) + bx / 8 : bx;
    for (int p0 = vcu; p0 < 256; p0 += G) { const int p = __builtin_amdgcn_readfirstlane(p0);
        const int b = p >> 7, h = (p >> 4) & 7, x = p & 15;
        const float slr = uni_f((1.0f / fa::SCALE) / (float)(2 << h));
#pragma unroll 1
        for (int half = 0; half < 2; ++half) { const int qb = half ? 31 - x : x; const size_t row0 = (size_t)b * SEQ + qb * 256;
            fa::attn_block(uni_ptr(BQ + row0 * 1024 + h * 128), uni_ptr(BK + (size_t)b * SEQ * 1024 + h * 128), uni_ptr(BV + (size_t)b * SEQ * 1024 + h * 128),
                           uni_ptr(MASK + row0 * 256), uni_ptr(BRB + row0 * 1024 + h * 128), 4 * (qb + 1), qb * 256, slr, lds); }
    }
}


constexpr int NPH = 13;
#ifndef REPS
#define REPS 1,1,1,1,1,1,1,1,1,1,1,1,1,1,1,1
#endif
constexpr int REP[16] = {REPS};
__global__ void __launch_bounds__(NTHR, 2) mk_fwd(Args a) {
    extern __shared__ __attribute__((aligned(16))) unsigned char lds_raw[];
    LAS unsigned char* lds = (LAS unsigned char*)lds_raw;
    cg::grid_group grid = cg::this_grid();
    const int G = gridDim.x;
#define FRESH_TID() int tid = cur_tid(lds); asm volatile("" : "+v"(tid)); const int lane = tid & 63, wave = tid >> 6; (void)lane; (void)wave

    unsigned char* ws = a.ws;
    const int lo = a.ph_lo, hi = a.ph_hi;
#define IN(k) (lo <= (k) && (k) < hi)
    if (lo < 0) grid.sync();
    if (threadIdx.x == 0) { ((volatile LAS unsigned*)(lds + LDS_BARST))[0] = 0u; ((volatile LAS unsigned*)(lds + LDS_BARST))[1] = 0u; }
    if ((threadIdx.x & 63) == 0) ((volatile LAS unsigned char*)(lds + LDS_WTAB))[(unsigned)__builtin_amdgcn_s_getreg((5 << 11) | 4) & 63u] = (unsigned char)(threadIdx.x >> 6);
    __syncthreads();
    (void)xcd_barrier_post((unsigned*)(ws + WS_CTL) + CW_BAR, (volatile LAS unsigned*)(lds + LDS_BARST));
    int bid = blockIdx.x;
    if (lo == 0 && hi == NPH && (G % 8) == 0) {
        if (threadIdx.x == 0) { const unsigned x = xb_xcc_id(); const unsigned r = atomicAdd((unsigned*)(ws + WS_CTL) + CW_TICKET + 64 * x, 1u); ((volatile LAS unsigned*)(lds + LDS_BARST))[2] = r * 8u + (x & 7u); }
    }
#define SEAM(k) do { if (IN(k) && IN((k) + 1)) { { XcdBarrier b_; b_.bar = (unsigned*)(a.ws + WS_CTL) + CW_BAR; b_.x = xb_xcc_id(); b_.st = (volatile LAS unsigned*)(lds + LDS_BARST); xcd_barrier(b_); } } } while (0)

    if (IN(0)) { FRESH_TID(); for (int rp = 0; rp < REP[0]; ++rp) { phase_prologue(a, lds, tid, G); __syncthreads(); } }
    SEAM(0);
    if (lo == 0 && hi == NPH && (G % 8) == 0) {
        const unsigned* bw = (const unsigned*)(ws + WS_CTL) + CW_BAR; bool ok = true;
        for (int j = 0; j < 8; ++j) ok = ok && (__hip_atomic_load(bw + XB_XCNT(j), __ATOMIC_RELAXED, __HIP_MEMORY_SCOPE_AGENT) == (unsigned)(G / 8));
        if (ok) bid = __builtin_amdgcn_readfirstlane((int)((volatile LAS unsigned*)(lds + LDS_BARST))[2]);
    }
    if (IN(1)) { FRESH_TID(); pg8::Gemm g{(const bf16_t*)(ws + WS_XB), (const bf16_t*)(ws + WS_WIN), MT, NPROJ_PAD, DM}; pg8::StaticOrder S; S.init(MT, NPROJ_PAD, G, bid);
        for (int c8 = tid; c8 < NPROJ_PAD / 2; c8 += NTHR) { const int c = 2 * c8; float b0 = 0.f, b1 = 0.f;
            if (c < 7752) { b0 = a.in[I_BIN][c]; b1 = a.in[I_BIN][c + 1]; } else if (c >= 7936) { b0 = a.in[I_BIN][c - 184]; b1 = a.in[I_BIN][c - 183]; }
            *(LAS unsigned*)(lds + LDS_BIAS + c * 2) = cvt_pk(b0, b1); }
        __syncthreads();
        pg8::EpiProj E{ws, lds + LDS_BIAS};
        for (int rp = 0; rp < REP[1]; ++rp) pg8::gemm_phase<pg8::EpiProj, pg8::StaticOrder, true, true>(lds, g, S, E); }
    SEAM(1);
    if (IN(2)) { FRESH_TID(); hg_fill_lb(a, lds, tid);
        for (int rp = 0; rp < REP[2]; ++rp) for (int u = blockIdx.x; u < 2048; u += G) hgrn1_unit(a, u, lds, tid);
        { int tix = tid; asm volatile("" : "+v"(tix));
        for (int rp = 0; rp < REP[3]; ++rp) for (int k = 0; k * G < MT / 4; ++k) { const int u = k * G + ((k & 1) ? (G - 1 - (int)blockIdx.x) : (int)blockIdx.x); if (u < MT / 4) indexer_unit(a, u, lds, tix); } } }
    SEAM(2);
    if (IN(3)) { FRESH_TID(); for (int rp = 0; rp < REP[4]; ++rp) hgrn_scan(a, tid, G);
        for (int rp = 0; rp < REP[5]; ++rp) phase_attention(a, (char*)lds_raw, G, bid); }
    SEAM(3);
    if (IN(4)) { FRESH_TID(); for (int rp = 0; rp < REP[6]; ++rp) { float z[16]; unsigned qq[16], vv[16]; u32x4 stp[4]; u32x2 gwn[4];
            if ((int)blockIdx.x < 2048) hg3_load(a, blockIdx.x, tid, z, qq, vv, stp, gwn);
            hg_fill_lb(a, lds, tid);
            for (int u = blockIdx.x; u < 2048; u += G) hgrn3_unit(a, u, (u + G < 2048) ? u + G : -1, lds, tid, z, qq, vv, stp, gwn); } }
    SEAM(4);
    if (IN(5)) { FRESH_TID(); for (int rp = 0; rp < REP[7]; ++rp) {
        { pg8::Gemm g{(const bf16_t*)(ws + WS_BRA), (const bf16_t*)(ws + WS_WA), MT, DM, 1024}; pg8::StaticOrder S; S.init(MT, DM, G, bid);
          pg8::EpiBranch<0> E{(bf16_t*)(ws + WS_MERGED), (const bf16_t*)(ws + WS_GATES)};
          pg8::gemm_phase<pg8::EpiBranch<0>, pg8::StaticOrder, true, true>(lds, g, S, E); }
        { pg8::Gemm g{(const bf16_t*)(ws + WS_BRB), (const bf16_t*)(ws + WS_WB), MT, DM, 1024}; pg8::StaticOrder S; S.init(MT, DM, G, bid);
          pg8::EpiBranch<1> E{(bf16_t*)(ws + WS_MERGED), (const bf16_t*)(ws + WS_GATES)};
          pg8::gemm_phase<pg8::EpiBranch<1>, pg8::StaticOrder, true, true>(lds, g, S, E); } } }
    SEAM(6);
    if (IN(7)) { FRESH_TID(); pg8::Gemm g{(const bf16_t*)(ws + WS_MERGED), (const bf16_t*)(ws + WS_WOUT), MT, DM, DM}; pg8::StaticOrder S; S.init(MT, DM, G, bid);
        pg8::EpiResBf16 E{(bf16_t*)(ws + WS_PRE1), a.in[I_X], DN_ALPHA};
        for (int rp = 0; rp < REP[8]; ++rp) pg8::gemm_phase<pg8::EpiResBf16, pg8::StaticOrder, true, true>(lds, g, S, E); }
    SEAM(7);
    if (IN(8)) { FRESH_TID(); for (int rp = 0; rp < REP[9]; ++rp) phase8_router_expw(a, lds, tid, G, rp == 0, rp == 0);
        for (int rp = 1; rp < REP[10]; ++rp) phase_expert_weights(a, lds, tid, G); }
    if (IN(8) && IN(10)) { XcdBarrier b_; b_.bar = (unsigned*)(a.ws + WS_CTL) + CW_BAR; b_.x = xb_xcc_id(); b_.st = (volatile LAS unsigned*)(lds + LDS_BARST); xcd_barrier(b_); }
    if (IN(10)) { FRESH_TID(); const unsigned* ctl = (const unsigned*)(ws + WS_CTL);
        LAS int* tb = (LAS int*)(lds + LDS_MOE_TB); LAS unsigned* TE = (LAS unsigned*)(lds + LDS_MOE_TE); LAS unsigned* TOK = (LAS unsigned*)(lds + LDS_MOE_TOK);
        __syncthreads(); load_tile_base(a, tb, tid);
        if (tid < NEXP) for (int t = tb[tid]; t < tb[tid + 1]; ++t) TE[t] = (unsigned)tid;
        __syncthreads();
        const int NT = tb[NEXP];
        pg8::GroupedOrder<true> S; S.init(NT, 8, G, bid, TE, TOK);
        { const int* rows = (const int*)(ws + WS_ROWS);
          for (int i = 0; i < 8; ++i) { pg8::Unit u; if (!S.next(i, u)) break;
              if (tid < 256) { const int e = (int)TE[u.pm], pos = (u.pm - tb[e]) * 256 + tid, cnt = (int)ctl[CW_CNT + 64 * e];
                  TOK[i * 256 + tid] = (pos < cnt) ? (unsigned)rows[e * MT + pos] * (unsigned)DM : 0u; } } }
        __syncthreads();
        pg8::Gemm g{(const bf16_t*)(ws + WS_H1F8), (const bf16_t*)(ws + WS_WGU), NT * 256, 2048, DM / 2};
        pg8::EpiGateUp E{ws + WS_HH};
        for (int rp = 0; rp < REP[12]; ++rp) pg8::gemm_phase<pg8::EpiGateUp, pg8::GroupedOrder<true>, true, true>(lds, g, S, E); }
    SEAM(10);
    if (IN(11)) { FRESH_TID();
        LAS int* tb = (LAS int*)(lds + LDS_MOE_TB); LAS unsigned* TE = (LAS unsigned*)(lds + LDS_MOE_TE);
        __syncthreads(); load_tile_base(a, tb, tid);
        if (tid < NEXP) for (int t = tb[tid]; t < tb[tid + 1]; ++t) TE[t] = (unsigned)tid;
        __syncthreads();
        const int NT = tb[NEXP];
        int kd = DFF / 2; asm volatile("" : "+s"(kd));
        pg8::Gemm g{(const bf16_t*)(ws + WS_HH), (const bf16_t*)(ws + WS_WD), NT * 256, 2048, kd}; pg8::GroupedOrder<false> S; S.init(NT, 8, G, bid, TE, nullptr);
        pg8::EpiStoreBf16 E{(bf16_t*)(ws + WS_Y), DM, uni_f(G > 0 ? F8_UNSCALE : 0.f)};
        for (int rp = 0; rp < REP[13]; ++rp) pg8::gemm_phase<pg8::EpiStoreBf16, pg8::GroupedOrder<false>, true, true>(lds, g, S, E); }
    SEAM(11);
    if (IN(12)) { FRESH_TID(); LAS int* tb = (LAS int*)lds; __syncthreads(); load_tile_base(a, tb, tid);
        for (int rp = 0; rp < REP[14]; ++rp) phase_final(a, tid, G, tb); }
#undef IN
#undef SEAM
}

#ifndef MK_SPLIT
#define MK_SPLIT 0
#endif
extern "C" void kernel_launch(void* const* d_in, const int* in_sizes, int n_in, void* d_out, int out_size, void* d_ws, size_t ws_size, hipStream_t stream) {
    static int grid = 0;
    if (grid == 0) {
        int dev = 0, cus = 0, per_cu = 0;
        if (n_in != 19 || out_size != MT * DM || ws_size < WS_END) { fprintf(stderr, "kernel_launch: unexpected shapes: n_in %d out %d ws %zu (need %zu)\n", n_in, out_size, ws_size, (size_t)WS_END); grid = -1; return; }
        if (hipGetDevice(&dev) != hipSuccess || hipDeviceGetAttribute(&cus, hipDeviceAttributeMultiprocessorCount, dev) != hipSuccess) { grid = -1; return; }
        if (hipFuncSetAttribute((const void*)mk_fwd, hipFuncAttributeMaxDynamicSharedMemorySize, LDS_BYTES) != hipSuccess) { fprintf(stderr, "kernel_launch: hipFuncSetAttribute failed\n"); grid = -1; return; }
        if (hipOccupancyMaxActiveBlocksPerMultiprocessor(&per_cu, (const void*)mk_fwd, NTHR, LDS_BYTES) != hipSuccess || per_cu < 1) { fprintf(stderr, "kernel_launch: occupancy query says %d blocks/CU\n", per_cu); grid = -1; return; }
        grid = cus;
    }
    if (grid < 0) return;
    (void)hipMemsetAsync((char*)d_ws + WS_CTL, 0, 1 * MiB, stream);
    Args a{};
    for (int i = 0; i < 19; ++i) a.in[i] = (const float*)d_in[i];
    a.out = (float*)d_out; a.ws = (unsigned char*)d_ws;
#if MK_SPLIT
#ifndef MK_DUP
#define MK_DUP -1
#endif
    for (int p2 = 0; p2 < NPH + (MK_DUP >= 0 ? 1 : 0); ++p2) { const int p = (MK_DUP >= 0 && p2 > MK_DUP) ? p2 - 1 : p2;
        a.ph_lo = p; a.ph_hi = p + 1; void* args[] = {&a};
        hipError_t e = hipLaunchCooperativeKernel((const void*)mk_fwd, dim3(grid), dim3(NTHR), args, LDS_BYTES, stream);
        if (e != hipSuccess) { fprintf(stderr, "cooperative launch (phase %d) failed: %s (grid %d)\n", p, hipGetErrorString(e), grid); break; } }
#else
    a.ph_lo = 0; a.ph_hi = NPH; void* args[] = {&a};
    hipError_t e = hipLaunchCooperativeKernel((const void*)mk_fwd, dim3(grid), dim3(NTHR), args, LDS_BYTES, stream);
    if (e != hipSuccess) fprintf(stderr, "cooperative launch failed: %s (grid %d)\n", hipGetErrorString(e), grid);
#endif
}
```

```cpp
#include <hip/hip_runtime.h>
#include <hip/hip_cooperative_groups.h>
#include <cstdio>
#include <cstdint>
namespace cg = cooperative_groups;

#define LAS __attribute__((address_space(3)))
typedef unsigned short bf16_t;
typedef short bf16x8 __attribute__((ext_vector_type(8)));
typedef float f32x4 __attribute__((ext_vector_type(4)));
typedef float f32x2 __attribute__((ext_vector_type(2)));
typedef float f32x16 __attribute__((ext_vector_type(16)));
typedef unsigned u32x4 __attribute__((ext_vector_type(4)));
typedef unsigned u32x2 __attribute__((ext_vector_type(2)));

constexpr int MT = 16384, SEQ = 8192, DM = 2048, NHEAD = 8, HD = 128, NPROJ = 11848, NPROJ_PAD = 12032;
constexpr int NEXP = 32, DFF = 1024, MAXROWS = 40960;
constexpr float DN_ALPHA = 1.189207115002721f;
constexpr float LN_EPS = 1e-5f, RMS_EPS = 1e-6f;
constexpr int NWAVES = 8, NTHR = 512;
constexpr int LDS_BYTES = 163840;

constexpr size_t MiB = 1u << 20;
constexpr size_t WS_CTL = 0;
constexpr size_t WS_WIN = 1 * MiB;
constexpr size_t WS_WA = 48 * MiB, WS_WB = 52 * MiB, WS_WOUT = 56 * MiB;
constexpr size_t WS_XB = 64 * MiB;
constexpr size_t WS_MERGED = 64 * MiB;
constexpr size_t WS_AQ = 128 * MiB, WS_AI = 160 * MiB, WS_AG = 192 * MiB, WS_BQ = 224 * MiB, WS_BK = 256 * MiB, WS_BV = 288 * MiB;
constexpr size_t WS_AF = 320 * MiB;
constexpr size_t WS_IQ = 384 * MiB;
constexpr size_t WS_IKW = 400 * MiB;
constexpr size_t WS_GATES = 408 * MiB;
constexpr size_t WS_WGU = 128 * MiB;
constexpr size_t WS_WD = 384 * MiB;
constexpr size_t WS_H1F8 = 256 * MiB;
constexpr size_t WS_MASK = 536 * MiB;
constexpr size_t WS_KV = 552 * MiB;
constexpr size_t WS_PRE1 = 552 * MiB;
constexpr size_t WS_ST = 680 * MiB;
constexpr size_t WS_H1B = 680 * MiB;
constexpr size_t WS_DECAY = 744 * MiB;
constexpr size_t WS_ROWS = 745 * MiB;
constexpr size_t WS_SLOT = 747 * MiB;
constexpr size_t WS_BRA = 750 * MiB, WS_BRB = 782 * MiB;
constexpr size_t WS_MERGED8 = 616 * MiB;
constexpr size_t WS_IK2 = 814 * MiB;
constexpr size_t WS_HH = 750 * MiB;
constexpr size_t WS_XG = 830 * MiB;
constexpr size_t WS_Y = 830 * MiB;
constexpr size_t WS_END = 990 * MiB;
constexpr int CW_CNT = 1024;
constexpr int CW_NT = 4096;
constexpr int CW_TILEE = 4160;
constexpr int CW_TBASE = 4400;
constexpr int CW_BAR = 8192;
constexpr int CW_TICKET = 12288;
constexpr int LDS_BIAS = 131072;
constexpr int LDS_MOE_TB = 131072, LDS_MOE_TE = 131072 + 256, LDS_MOE_TOK = 131072 + 1024;
constexpr int LDS_BARST = LDS_BYTES - 64;
constexpr int LDS_WTAB = LDS_BYTES - 128;

__device__ __forceinline__ float bf2f(unsigned h) { return __uint_as_float(h << 16); }
__device__ __forceinline__ unsigned cvt_pk(float lo, float hi) { unsigned r; asm volatile("v_cvt_pk_bf16_f32 %0, %1, %2" : "=v"(r) : "v"(lo), "v"(hi)); return r; }
__device__ __forceinline__ unsigned cvt_pk_mfma(float lo, float hi) { unsigned r; asm volatile("s_nop 15\n\ts_nop 3\n\tv_cvt_pk_bf16_f32 %0, %1, %2" : "=v"(r) : "v"(lo), "v"(hi)); return r; }
__device__ __forceinline__ unsigned cvt_pk_to_mfma(float lo, float hi) { unsigned r; asm volatile("v_cvt_pk_bf16_f32 %0, %1, %2\n\ts_nop 1" : "=v"(r) : "v"(lo), "v"(hi)); return r; }
__device__ __forceinline__ unsigned cvt4_fp8(float a, float b, float c, float d, float s) {
    a = __builtin_amdgcn_fmed3f(a * s, -448.f, 448.f); b = __builtin_amdgcn_fmed3f(b * s, -448.f, 448.f); c = __builtin_amdgcn_fmed3f(c * s, -448.f, 448.f); d = __builtin_amdgcn_fmed3f(d * s, -448.f, 448.f);
    int w = 0; w = __builtin_amdgcn_cvt_pk_fp8_f32(a, b, w, false); w = __builtin_amdgcn_cvt_pk_fp8_f32(c, d, w, true); return (unsigned)w; }
__device__ __forceinline__ unsigned cvt1_fp8(float a, float s) { a = __builtin_amdgcn_fmed3f(a * s, -448.f, 448.f); return (unsigned)__builtin_amdgcn_cvt_pk_fp8_f32(a, a, 0, false) & 0xffu; }
__device__ __forceinline__ unsigned cvt4_fp8_nc(float a, float b, float c, float d, float s) {
    int w = 0; w = __builtin_amdgcn_cvt_pk_fp8_f32(a * s, b * s, w, false); w = __builtin_amdgcn_cvt_pk_fp8_f32(c * s, d * s, w, true); return (unsigned)w; }
constexpr float F8_WSCALE = 1024.f, F8_ASCALE = 8.f, F8_UNSCALE = 1.0f / 8192.f;
__device__ __forceinline__ float wave_sum(float v) {
#pragma unroll
    for (int o = 1; o < 64; o <<= 1) v += __shfl_xor(v, o);
    return v;
}
__device__ __forceinline__ float fast_exp(float x) { return __builtin_amdgcn_exp2f(x * 1.4426950408889634f); }
__device__ __forceinline__ float sigmoidf_(float x) { return __builtin_amdgcn_rcpf(1.0f + __expf(-x)); }
#define LDS_WAIT() asm volatile("s_waitcnt lgkmcnt(0)" ::: "memory")
template <typename T> __device__ __forceinline__ T* uni_ptr(T* p) { const unsigned long long v = (unsigned long long)p; const unsigned lo = __builtin_amdgcn_readfirstlane((unsigned)v), hi = __builtin_amdgcn_readfirstlane((unsigned)(v >> 32)); return (T*)(((unsigned long long)hi << 32) | lo); }
__device__ __forceinline__ int cur_tid(const LAS unsigned char* lds0) {
    const unsigned slot = (unsigned)__builtin_amdgcn_s_getreg((5 << 11) | 4) & 63u;
    const unsigned w = __builtin_amdgcn_readfirstlane((unsigned)((const volatile LAS unsigned char*)(lds0 + LDS_WTAB))[slot]);
    return (int)((w << 6) | __builtin_amdgcn_mbcnt_hi(~0u, __builtin_amdgcn_mbcnt_lo(~0u, 0u)));
}
__device__ __forceinline__ float uni_f(float x) { return __uint_as_float(__builtin_amdgcn_readfirstlane(__float_as_uint(x))); }

namespace pg8 {
#define PG8_LAS __attribute__((address_space(3)))
typedef unsigned short bf16_t;
typedef short bf16x8 __attribute__((ext_vector_type(8)));
typedef float f32x4 __attribute__((ext_vector_type(4)));
typedef unsigned u32x4 __attribute__((ext_vector_type(4)));
constexpr int BM = 256, BK = 64, HALF = 128, HTB = HALF * BK * 2  , STAGE_BYTES = 8 * HTB, NXCD = 8, WGM = 8;

__host__ __device__ __forceinline__ int lds_byte(int r, int c) { const int st = (r >> 4) * 2 + (c >> 5), rr = r & 15, cc = c & 31, ob = rr * 64 + cc * 2; return st * 1024 + (ob ^ (((ob >> 9) & 1) << 5)); }
__host__ __device__ __forceinline__ void stage_rc(int b, int& R, int& C) { const int st = b / 1024, sb = b % 1024, swz = sb ^ (((sb >> 9) & 1) << 5); R = (st >> 1) * 16 + swz / 64; C = (st & 1) * 32 + (swz % 64) / 2; }
__host__ __device__ __forceinline__ int perm32(int rho) { const int n = rho >> 4, i = rho & 15; return 8 * (i >> 2) + 4 * n + (i & 3); }

typedef int i32x8 __attribute__((ext_vector_type(8)));
typedef int i32x4_ __attribute__((ext_vector_type(4)));
template <bool F8> struct OperandT { typedef bf16x8 T; };
template <> struct OperandT<true> { typedef i32x8 T; };
__device__ __forceinline__ i32x8 ld_f8(const PG8_LAS unsigned char* p) { const i32x4_ lo = *(const PG8_LAS i32x4_*)p, hi = *(const PG8_LAS i32x4_*)(p + 1024); return __builtin_shufflevector(lo, hi, 0, 1, 2, 3, 4, 5, 6, 7); }
__device__ __forceinline__ f32x4 mma_f8(const i32x8 b, const i32x8 a, const f32x4 c) { return __builtin_amdgcn_mfma_scale_f32_16x16x128_f8f6f4(b, a, c, 0, 0, 0, 0, 0, 0); }
__device__ __forceinline__ f32x4 mma_f8(const bf16x8, const bf16x8, const f32x4 c) { return c; }
struct Unit { int pm, pn, pb; };
struct Gemm { const bf16_t* A; const bf16_t* Bt; int M, N, K; };

template <bool F8_> struct StaticOrderT {
    static constexpr bool GATHER = false, F8 = F8_; __device__ __forceinline__ unsigned row_off(int, int) const { return 0u; }
    int nM, nN, nwg, G, c;
    __host__ __device__ void init(int M, int N, int G_, int c_) { nM = M / BM; nN = N / BM; nwg = nM * nN; G = G_; c = c_; }
    __host__ __device__ bool next(int i, Unit& u) const {
        const long L = (long)i * G + c; if (L >= nwg) return false;
        int wgid = (int)L; { const int q = nwg / NXCD, r = nwg % NXCD, xcd = wgid % NXCD, off = wgid / NXCD; wgid = (xcd < r ? xcd * (q + 1) : r * (q + 1) + (xcd - r) * q) + off; }
        const int nig = WGM * nN, gid = wgid / nig, fm = gid * WGM, gsz = (nM - fm) < WGM ? (nM - fm) : WGM;
        u.pm = fm + ((wgid % nig) % gsz); u.pn = (wgid % nig) / gsz; u.pb = u.pn; return true;
    }
    __device__ __forceinline__ void a_ready(const Unit&) const {}
    __device__ __forceinline__ void done(const Unit&) const {}
};
typedef StaticOrderT<false> StaticOrder;
typedef StaticOrderT<true> StaticOrderF8;


__device__ __forceinline__ unsigned cvt_pk_bf16(float lo, float hi) { unsigned r; asm volatile("v_cvt_pk_bf16_f32 %0, %1, %2" : "=v"(r) : "v"(lo), "v"(hi)); return r; }
__device__ __forceinline__ float sigm(float x) { return __builtin_amdgcn_rcpf(1.0f + __expf(-x)); }

struct EpiProj {
    static constexpr bool PERM = true, AFTER_DRAIN = false;
    unsigned char* ws; const PG8_LAS unsigned char* lbias;
    __device__ __forceinline__ void operator()(const f32x4 (&acc)[2][2][4][2], const Unit& u, int wr, int wc, int fr, int fq) const {
        const int pn = u.pn, row0 = u.pm * BM + wr * 64 + fr, lc0 = wc * 32 + 8 * fq;
        f32x4 bv[2][2];
#pragma unroll
        for (int bj = 0; bj < 2; ++bj) { const u32x4 bw = *(const PG8_LAS u32x4*)(lbias + (size_t)(pn * 256 + lc0 + bj * HALF) * 2);
            bv[bj][0] = (f32x4){__uint_as_float(bw.x << 16), __uint_as_float(bw.x & 0xffff0000u), __uint_as_float(bw.y << 16), __uint_as_float(bw.y & 0xffff0000u)};
            bv[bj][1] = (f32x4){__uint_as_float(bw.z << 16), __uint_as_float(bw.z & 0xffff0000u), __uint_as_float(bw.w << 16), __uint_as_float(bw.w & 0xffff0000u)}; }
        if (pn >= 4 && pn < 8) {
            float* base = (float*)(ws + WS_AF);
#pragma unroll
            for (int ai = 0; ai < 2; ++ai)
#pragma unroll
                for (int m = 0; m < 4; ++m) { float* rowp = base + (size_t)(row0 + ai * HALF + m * 16) * 1024 + (pn - 4) * 256 + lc0;
#pragma unroll
                    for (int bj = 0; bj < 2; ++bj) { *(f32x4*)(rowp + bj * HALF) = acc[ai][bj][m][0] + bv[bj][0]; *(f32x4*)(rowp + bj * HALF + 4) = acc[ai][bj][m][1] + bv[bj][1]; } }
            return;
        }
        bf16_t* base; int ldc, colt; bool sg = false;
        if (pn < 28) { const int s = pn >> 2, idx = (s == 0) ? 0 : s - 1; base = (bf16_t*)(ws + WS_AQ + (size_t)idx * (32 * MiB)); ldc = 1024; colt = (pn & 3) * 256; }
        else if (pn < 30) { base = (bf16_t*)(ws + WS_IQ); ldc = 512; colt = (pn - 28) * 256; }
        else if (pn == 30) { base = (bf16_t*)(ws + WS_IKW); ldc = 256; colt = 0; }
        else { base = (bf16_t*)(ws + WS_GATES); ldc = 4096; colt = (pn - 31) * 256; sg = true; }
#pragma unroll
        for (int ai = 0; ai < 2; ++ai)
#pragma unroll
            for (int m = 0; m < 4; ++m) { bf16_t* rowp = base + (size_t)(row0 + ai * HALF + m * 16) * ldc + colt + lc0;
#pragma unroll
                for (int bj = 0; bj < 2; ++bj) { f32x4 v0 = acc[ai][bj][m][0] + bv[bj][0], v1 = acc[ai][bj][m][1] + bv[bj][1];
                    if (sg) { v0 = (f32x4){sigm(v0[0]), sigm(v0[1]), sigm(v0[2]), sigm(v0[3])}; v1 = (f32x4){sigm(v1[0]), sigm(v1[1]), sigm(v1[2]), sigm(v1[3])}; }
                    u32x4 w; w.x = cvt_pk_bf16(v0[0], v0[1]); w.y = cvt_pk_bf16(v0[2], v0[3]); w.z = cvt_pk_bf16(v1[0], v1[1]); w.w = cvt_pk_bf16(v1[2], v1[3]);
                    *(u32x4*)(rowp + bj * HALF) = w;
                    if (pn == 30 && bj == 0 && lc0 < 64) {
                        const int tok = row0 + ai * HALF + m * 16;
                        *(u32x4*)((bf16_t*)(ws + WS_IK2) + ((size_t)((tok >> 5) * 4 + (lc0 >> 4)) * 64 + ((lc0 >> 3) & 1) * 32 + (tok & 31)) * 8) = w; } } }
    }
};

__device__ __forceinline__ f32x4 bf4lo(u32x4 w) { return (f32x4){__uint_as_float(w.x << 16), __uint_as_float(w.x & 0xffff0000u), __uint_as_float(w.y << 16), __uint_as_float(w.y & 0xffff0000u)}; }
__device__ __forceinline__ f32x4 bf4hi(u32x4 w) { return (f32x4){__uint_as_float(w.z << 16), __uint_as_float(w.z & 0xffff0000u), __uint_as_float(w.w << 16), __uint_as_float(w.w & 0xffff0000u)}; }

template <int MODE> struct EpiBranch {
    static constexpr bool PERM = true, AFTER_DRAIN = false;
    bf16_t* merged; const bf16_t* gates; unsigned char* merged8;
    __device__ __forceinline__ void operator()(const f32x4 (&acc)[2][2][4][2], const Unit& u, int wr, int wc, int fr, int fq) const {
        const int row0 = u.pm * BM + wr * 64 + fr, col0 = u.pn * BM + wc * 32 + 8 * fq;
#pragma unroll
        for (int ai = 0; ai < 2; ++ai)
#pragma unroll
            for (int m = 0; m < 4; ++m) { const size_t r = (size_t)(row0 + ai * HALF + m * 16);
#pragma unroll
                for (int bj = 0; bj < 2; ++bj) { const int c = col0 + bj * HALF;
                    const u32x4 gw = *(const u32x4*)(gates + r * 4096 + MODE * 2048 + c);
                    f32x4 v0 = acc[ai][bj][m][0] * (bf4lo(gw) * F8_UNSCALE), v1 = acc[ai][bj][m][1] * (bf4hi(gw) * F8_UNSCALE);
                    if (MODE == 1) { const u32x4 pw = *(const u32x4*)(merged + r * 2048 + c); v0 = v0 + bf4lo(pw); v1 = v1 + bf4hi(pw);
                        *(u32x2*)(merged8 + r * 2048 + c) = (u32x2){cvt4_fp8(v0[0], v0[1], v0[2], v0[3], F8_ASCALE), cvt4_fp8(v1[0], v1[1], v1[2], v1[3], F8_ASCALE)}; }
                    else { u32x4 w; w.x = cvt_pk_bf16(v0[0], v0[1]); w.y = cvt_pk_bf16(v0[2], v0[3]); w.z = cvt_pk_bf16(v1[0], v1[1]); w.w = cvt_pk_bf16(v1[2], v1[3]);
                        *(u32x4*)(merged + r * 2048 + c) = w; } } }
    }
};

struct EpiResBf16 {
    static constexpr bool PERM = true, AFTER_DRAIN = false;
    bf16_t* C; const float* x; float alpha;
    __device__ __forceinline__ void operator()(const f32x4 (&acc)[2][2][4][2], const Unit& u, int wr, int wc, int fr, int fq) const {
        const int row0 = u.pm * BM + wr * 64 + fr, col0 = u.pn * BM + wc * 32 + 8 * fq;
#pragma unroll
        for (int ai = 0; ai < 2; ++ai)
#pragma unroll
            for (int m = 0; m < 4; ++m) { const size_t off = (size_t)(row0 + ai * HALF + m * 16) * 2048 + col0;
#pragma unroll
                for (int bj = 0; bj < 2; ++bj) { const f32x4 x0 = *(const f32x4*)(x + off + bj * HALF), x1 = *(const f32x4*)(x + off + bj * HALF + 4);
                    const f32x4 v0 = x0 * alpha + acc[ai][bj][m][0] * F8_UNSCALE, v1 = x1 * alpha + acc[ai][bj][m][1] * F8_UNSCALE;
                    u32x4 w; w.x = cvt_pk_bf16(v0[0], v0[1]); w.y = cvt_pk_bf16(v0[2], v0[3]); w.z = cvt_pk_bf16(v1[0], v1[1]); w.w = cvt_pk_bf16(v1[2], v1[3]);
                    *(u32x4*)(C + off + bj * HALF) = w; } }
    }
};

struct EpiGateUp {
    static constexpr bool PERM = true, AFTER_DRAIN = false;
    unsigned char* H;
    __device__ __forceinline__ void operator()(const f32x4 (&acc)[2][2][4][2], const Unit& u, int wr, int wc, int fr, int fq) const {
        const int row0 = u.pm * BM + wr * 64 + fr, hc0 = u.pn * 128 + wc * 16 + 4 * fq;
#pragma unroll
        for (int ai = 0; ai < 2; ++ai)
#pragma unroll
            for (int m = 0; m < 4; ++m) { unsigned char* rowp = H + (size_t)(row0 + ai * HALF + m * 16) * 1024 + hc0;
#pragma unroll
                for (int bj = 0; bj < 2; ++bj) { const f32x4 g = acc[ai][bj][m][0], up = acc[ai][bj][m][1];
                    f32x4 h;
#pragma unroll
                    for (int j = 0; j < 4; ++j) { const float gj = g[j] * F8_UNSCALE; h[j] = gj * sigm(gj) * (up[j] * F8_UNSCALE); }
                    *(unsigned*)(rowp + bj * 64) = cvt4_fp8(h[0], h[1], h[2], h[3], F8_ASCALE); } }
    }
};

struct EpiStoreBf16 {
    static constexpr bool PERM = true, AFTER_DRAIN = false;
    bf16_t* O; int ldc; float one;
    __device__ __forceinline__ void operator()(const f32x4 (&acc)[2][2][4][2], const Unit& u, int wr, int wc, int fr, int fq) const {
        const int row0 = u.pm * BM + wr * 64 + fr, col0 = u.pn * BM + wc * 32 + 8 * fq;
#pragma unroll
        for (int ai = 0; ai < 2; ++ai)
#pragma unroll
            for (int m = 0; m < 4; ++m) { bf16_t* rowp = O + (size_t)(row0 + ai * HALF + m * 16) * ldc + col0;
#pragma unroll
                for (int bj = 0; bj < 2; ++bj) { const f32x4 v0 = acc[ai][bj][m][0] * one, v1 = acc[ai][bj][m][1] * one;
                    u32x4 w; w.x = cvt_pk_bf16(v0[0], v0[1]); w.y = cvt_pk_bf16(v0[2], v0[3]); w.z = cvt_pk_bf16(v1[0], v1[1]); w.w = cvt_pk_bf16(v1[2], v1[3]);
                    *(u32x4*)(rowp + bj * HALF) = w; } }
    }
};

template <bool GATH> struct GroupedOrder {
    static constexpr bool GATHER = GATH, F8 = true;
    int nM, nN, nwg, G, c; const PG8_LAS unsigned* tile_e; const PG8_LAS unsigned* tokoff;
    __device__ __forceinline__ void init(int nT, int nN_, int G_, int c_, const PG8_LAS unsigned* te, const PG8_LAS unsigned* to) { nM = nT; nN = nN_; nwg = nM * nN; G = G_; c = c_; tile_e = te; tokoff = to; }
    __device__ __forceinline__ bool next(int i, Unit& u) const {
        const long L = (long)i * G + c; if (L >= nwg) return false;
        int wgid = (int)L; { const int q = nwg / NXCD, r = nwg % NXCD, xcd = wgid % NXCD, off = wgid / NXCD; wgid = (xcd < r ? xcd * (q + 1) : r * (q + 1) + (xcd - r) * q) + off; }
        const int nig = WGM * nN, gid = wgid / nig, fm = gid * WGM, gsz = (nM - fm) < WGM ? (nM - fm) : WGM;
        u.pm = fm + ((wgid % nig) % gsz); u.pn = (wgid % nig) / gsz; u.pb = (int)tile_e[u.pm] * nN + u.pn; return true;
    }
    __device__ __forceinline__ unsigned row_off(int ui, int r) const { return tokoff[ui * 256 + r]; }
    __device__ __forceinline__ void a_ready(const Unit&) const {}
    __device__ __forceinline__ void done(const Unit&) const {}
};

template <class Epi, class Sched, bool ALIGN_EPI = false, bool SP2 = false>
__device__ __forceinline__ void gemm_phase(PG8_LAS unsigned char* lds, const Gemm g, const Sched& S, const Epi& E) {
    int tid_ = cur_tid((const LAS unsigned char*)lds); asm volatile("" : "+v"(tid_));
    const int tid = tid_, wid = __builtin_amdgcn_readfirstlane(tid >> 6), lane = tid & 63, wr = wid >> 2, wc = wid & 3, fr = lane & 15, fq = lane >> 4;
    const int K = g.K, nt = K / BK;
    constexpr bool F8 = Sched::F8;
    constexpr bool GATHER = Sched::GATHER;
    unsigned voffA[2], voffB[2], cAoff[2]; int rA[2];
#pragma unroll
    for (int i = 0; i < 2; ++i) { int R, C; stage_rc(tid * 16 + i * 8192, R, C); const int Rb = Epi::PERM ? ((R & ~31) + perm32(R & 31)) : R;
        voffA[i] = (unsigned)(R * K + C) * 2u; voffB[i] = (unsigned)(Rb * K + C) * 2u; cAoff[i] = (unsigned)C * 2u; rA[i] = R; }
    const size_t kstep = (size_t)(BK * 2);
    const size_t hstep = (size_t)HALF * K * 2;
    const size_t tstep = 2 * hstep;
    const unsigned ldsw = (unsigned)wid * 1024u;
    const int aoff = lds_byte(wr * 64 + fr, fq * 8), boff = lds_byte(wc * 32 + fr, fq * 8);
#define PG8_SA(b, h) (((b) * 2 + (h)) * HTB)
#define PG8_SB(b, h) ((4 + (b) * 2 + (h)) * HTB)
#define PG8_GLDS(gbase, vo, ldsoff) do { if constexpr (F8) asm volatile("s_mov_b32 m0, %2\n\ts_nop 0\n\tglobal_load_lds_dwordx4 %0, %1" :: "v"(vo), "s"((const char*)(gbase)), "s"((unsigned)(uintptr_t)(lds + (ldsoff))) : "memory", "m0"); \
        else __builtin_amdgcn_global_load_lds((const unsigned*)((const char*)(gbase) + (vo)), (PG8_LAS unsigned*)(lds + (ldsoff)), 16, 0, 0); } while (0)
#define PG8_STAGE(bufoff, gbase, voff) do { _Pragma("unroll") for (int _i = 0; _i < 2; ++_i) PG8_GLDS(gbase, (voff)[_i], (bufoff) + ldsw + _i * 8192); } while (0)
#define PG8_STAGE_A(bufoff, gbase, h, nx) do { _Pragma("unroll") for (int _i = 0; _i < 2; ++_i) { const unsigned vo_ = GATHER ? (((nx) && has_next) ? PG8_GOFF(ui + 1, h, _i) : vAc[h][_i]) : voffA[_i]; \
        PG8_GLDS(gbase, vo_, (bufoff) + ldsw + _i * 8192); } } while (0)
#define PG8_LDA(dst, b, h) do { _Pragma("unroll") for (int m = 0; m < 4; ++m) { if constexpr (F8) dst[m][0] = ld_f8(lds + PG8_SA(b, h) + aoff + m * 2048); \
        else { _Pragma("unroll") for (int k = 0; k < 2; ++k) dst[m][k] = *(const PG8_LAS OpT*)(lds + PG8_SA(b, h) + aoff + m * 2048 + k * 1024); } } } while (0)
#define PG8_LDB(dst, b, h) do { _Pragma("unroll") for (int n = 0; n < 2; ++n) { if constexpr (F8) dst[n][0] = ld_f8(lds + PG8_SB(b, h) + boff + n * 2048); \
        else { _Pragma("unroll") for (int k = 0; k < 2; ++k) dst[n][k] = *(const PG8_LAS OpT*)(lds + PG8_SB(b, h) + boff + n * 2048 + k * 1024); } } } while (0)
#define PG8_MMA(ai, bj, At, Bt) do { if constexpr (F8) __builtin_amdgcn_sched_barrier(0); __builtin_amdgcn_s_setprio(1); _Pragma("unroll") for (int m = 0; m < 4; ++m) _Pragma("unroll") for (int n = 0; n < 2; ++n) { \
        if constexpr (F8) acc[ai][bj][m][n] = mma_f8(Bt[n][0], At[m][0], acc[ai][bj][m][n]); \
        else { _Pragma("unroll") for (int k = 0; k < 2; ++k) acc[ai][bj][m][n] = __builtin_amdgcn_mfma_f32_16x16x32_bf16(Bt[n][k], At[m][k], acc[ai][bj][m][n], 0, 0, 0); } } \
        __builtin_amdgcn_s_setprio(0); if constexpr (F8) __builtin_amdgcn_sched_barrier(0); } while (0)
#define PG8_WAIT_V(n) asm volatile("s_waitcnt vmcnt(" #n ")" ::: "memory")
#define PG8_WAIT_L(n) asm volatile("s_waitcnt lgkmcnt(" #n ")" ::: "memory")
#define PG8_BAR __builtin_amdgcn_s_barrier()
#define PG8_SCHED __builtin_amdgcn_sched_barrier(0)
    Unit cur, nxt; int ui = 0;
    if (!S.next(0, cur)) return;
    f32x4 acc[2][2][4][2];
#pragma unroll
    for (int a = 0; a < 2; ++a)
#pragma unroll
        for (int b = 0; b < 2; ++b)
#pragma unroll
            for (int m = 0; m < 4; ++m)
#pragma unroll
                for (int n = 0; n < 2; ++n) acc[a][b][m][n] = (f32x4){0.f, 0.f, 0.f, 0.f};
    using OpT = typename OperandT<F8>::T; constexpr int NK = F8 ? 1 : 2;
    OpT At[4][NK], B0[2][NK], B1[2][NK];
    const size_t hstepA = GATHER ? 0 : hstep;
#define PG8_GOFF(ui_, h, i) (S.row_off((ui_), (h) * HALF + rA[i]) + cAoff[i])
    unsigned vAc[2][2]; bool has_next = false;
#pragma unroll
    for (int h = 0; h < 2; ++h)
#pragma unroll
        for (int i = 0; i < 2; ++i) vAc[h][i] = GATHER ? PG8_GOFF(0, h, i) : 0u;
    const char* cA = (const char*)g.A + (GATHER ? (size_t)0 : (size_t)cur.pm * tstep); const char* cB = (const char*)g.Bt + (size_t)cur.pb * tstep;
    S.a_ready(cur);
    if constexpr (SP2) {
        PG8_STAGE(PG8_SB(0, 0), cB, voffB); PG8_STAGE(PG8_SB(0, 1), cB + hstep, voffB); PG8_STAGE_A(PG8_SA(0, 0), cA, 0, false); PG8_STAGE_A(PG8_SA(0, 1), cA + hstepA, 1, false);
        if (wr == 1) PG8_BAR;
        PG8_WAIT_V(2); PG8_BAR;
        PG8_STAGE(PG8_SB(1, 0), cB + kstep, voffB); PG8_STAGE_A(PG8_SA(1, 0), cA + kstep, 0, false); PG8_STAGE(PG8_SB(1, 1), cB + hstep + kstep, voffB);
        PG8_WAIT_V(6); PG8_BAR;
    } else {
        PG8_STAGE(PG8_SB(0, 0), cB, voffB); PG8_STAGE_A(PG8_SA(0, 0), cA, 0, false); PG8_STAGE(PG8_SB(0, 1), cB + hstep, voffB); PG8_STAGE_A(PG8_SA(0, 1), cA + hstepA, 1, false);
        if (wr == 1) PG8_BAR;
        PG8_WAIT_V(4); PG8_BAR;
        PG8_STAGE(PG8_SB(1, 0), cB + kstep, voffB); PG8_STAGE_A(PG8_SA(1, 0), cA + kstep, 0, false); PG8_STAGE(PG8_SB(1, 1), cB + hstep + kstep, voffB);
        PG8_WAIT_V(6); PG8_BAR;
    }
    for (;;) {
        has_next = S.next(ui + 1, nxt);
        const char* nA = has_next ? (const char*)g.A + (GATHER ? (size_t)0 : (size_t)nxt.pm * tstep) : cA; const char* nB = has_next ? (const char*)g.Bt + (size_t)nxt.pb * tstep : cB;
        for (int t = 0; t < nt; t += 2) {
            const bool last = (t == nt - 2);
            const char* a1 = cA + (size_t)(t + 1) * kstep;
            const char* a2 = last ? nA : cA + (size_t)(t + 2) * kstep; const char* b2 = last ? nB : cB + (size_t)(t + 2) * kstep;
            const char* a3 = a2 + kstep; const char* b3 = b2 + kstep;
            if (last && has_next) S.a_ready(nxt);
            if constexpr (SP2) {
            PG8_LDB(B0, 0, 0); PG8_LDB(B1, 0, 1); PG8_SCHED; PG8_LDA(At, 0, 0); PG8_STAGE_A(PG8_SA(1, 1), a1 + hstepA, 1, false);
            PG8_WAIT_V(8); PG8_WAIT_L(0); PG8_BAR; PG8_MMA(0, 0, At, B0); PG8_MMA(0, 1, At, B1); PG8_BAR; PG8_SCHED;
            PG8_LDA(At, 0, 1); PG8_STAGE(PG8_SB(0, 0), b2, voffB); PG8_STAGE(PG8_SB(0, 1), b2 + hstep, voffB); PG8_STAGE_A(PG8_SA(0, 0), a2, 0, last);
            PG8_WAIT_V(8); PG8_WAIT_L(0); PG8_BAR; PG8_MMA(1, 0, At, B0); PG8_MMA(1, 1, At, B1); PG8_BAR; PG8_SCHED;
            PG8_LDB(B0, 1, 0); PG8_LDB(B1, 1, 1); PG8_SCHED; PG8_LDA(At, 1, 0); PG8_STAGE_A(PG8_SA(0, 1), a2 + hstepA, 1, last);
            PG8_WAIT_V(8); PG8_WAIT_L(0); PG8_BAR; PG8_MMA(0, 0, At, B0); PG8_MMA(0, 1, At, B1); PG8_BAR; PG8_SCHED;
            PG8_LDA(At, 1, 1); PG8_STAGE(PG8_SB(1, 0), b3, voffB); PG8_STAGE(PG8_SB(1, 1), b3 + hstep, voffB); PG8_STAGE_A(PG8_SA(1, 0), a3, 0, last);
            PG8_WAIT_V(8); PG8_WAIT_L(0); PG8_BAR; PG8_MMA(1, 0, At, B0); PG8_MMA(1, 1, At, B1); PG8_BAR; PG8_SCHED;
            } else {
            PG8_LDB(B0, 0, 0); PG8_SCHED; PG8_LDA(At, 0, 0); PG8_STAGE_A(PG8_SA(1, 1), a1 + hstepA, 1, false);
            PG8_WAIT_L(8); PG8_BAR; PG8_WAIT_L(0); PG8_MMA(0, 0, At, B0); PG8_BAR; PG8_SCHED;
            PG8_LDB(B1, 0, 1); PG8_STAGE(PG8_SB(0, 0), b2, voffB);
            PG8_BAR; PG8_WAIT_L(0); PG8_MMA(0, 1, At, B1); PG8_BAR;
            PG8_LDA(At, 0, 1); PG8_STAGE_A(PG8_SA(0, 0), a2, 0, last);
            PG8_BAR; PG8_WAIT_L(0); PG8_MMA(1, 0, At, B0); PG8_BAR; PG8_SCHED;
            PG8_STAGE(PG8_SB(0, 1), b2 + hstep, voffB);
            PG8_WAIT_V(6); PG8_BAR; PG8_MMA(1, 1, At, B1); PG8_BAR;
            PG8_LDB(B0, 1, 0); PG8_SCHED; PG8_LDA(At, 1, 0); PG8_STAGE_A(PG8_SA(0, 1), a2 + hstepA, 1, last);
            PG8_WAIT_L(8); PG8_BAR; PG8_WAIT_L(0); PG8_MMA(0, 0, At, B0); PG8_BAR; PG8_SCHED;
            PG8_LDB(B1, 1, 1); PG8_STAGE(PG8_SB(1, 0), b3, voffB);
            PG8_BAR; PG8_WAIT_L(0); PG8_MMA(0, 1, At, B1); PG8_BAR;
            PG8_LDA(At, 1, 1); PG8_STAGE_A(PG8_SA(1, 0), a3, 0, last);
            PG8_BAR; PG8_WAIT_L(0); PG8_MMA(1, 0, At, B0); PG8_BAR; PG8_SCHED;
            PG8_STAGE(PG8_SB(1, 1), b3 + hstep, voffB);
            PG8_WAIT_V(6); PG8_BAR; PG8_MMA(1, 1, At, B1); PG8_BAR;
            }
        }
        if constexpr (ALIGN_EPI) { if (wr == 0) PG8_BAR; }
        if constexpr (!Epi::AFTER_DRAIN) { E(acc, cur, wr, wc, fr, fq); S.done(cur); }
        if (!has_next) break;
#pragma unroll
        for (int a = 0; a < 2; ++a)
#pragma unroll
            for (int b = 0; b < 2; ++b)
#pragma unroll
                for (int m = 0; m < 4; ++m)
#pragma unroll
                    for (int n = 0; n < 2; ++n) acc[a][b][m][n] = (f32x4){0.f, 0.f, 0.f, 0.f};
        cur = nxt; cA = nA; cB = nB; ++ui;
#pragma unroll
        for (int h = 0; h < 2; ++h)
#pragma unroll
            for (int i = 0; i < 2; ++i) if (GATHER) vAc[h][i] = PG8_GOFF(ui, h, i);
        if constexpr (ALIGN_EPI) { if (wr == 1) PG8_BAR; }
    }
    PG8_WAIT_V(0);
    if constexpr (!ALIGN_EPI) { if (wr == 0) PG8_BAR; }
    PG8_BAR;
    if constexpr (Epi::AFTER_DRAIN) { E.fused(acc, cur, wr, wc, fr, fq, lds, wid, lane); S.done(cur); }
#undef PG8_SA
#undef PG8_SB
#undef PG8_STAGE
#undef PG8_STAGE_A
#undef PG8_GOFF
#undef PG8_LDA
#undef PG8_LDB
#undef PG8_MMA
#undef PG8_WAIT_V
#undef PG8_WAIT_L
#undef PG8_BAR
#undef PG8_SCHED
}
}
#define XB_TMO      128
#define XB_XCNT(j)  (256  + 64 * (j))
#define XB_XSUB(j)  (1280 + 64 * (j))
#define XB_XGEN(j)  (2304 + 64 * (j))
#define XB_TOP      3328
#define XB_TOPGEN   3392
#define XCD_BAR_WORDS 3456
#define XB_SPIN_CAP (1u << 18)

__device__ __forceinline__ unsigned xb_ld(unsigned* p)              { return __hip_atomic_load(p, __ATOMIC_RELAXED, __HIP_MEMORY_SCOPE_AGENT); }
__device__ __forceinline__ unsigned xb_add(unsigned* p, unsigned v) { return __hip_atomic_fetch_add(p, v, __ATOMIC_RELAXED, __HIP_MEMORY_SCOPE_AGENT); }
__device__ __forceinline__ unsigned xb_xcc_id() { return (unsigned)__builtin_amdgcn_s_getreg((3 << 11) | 20) & 0xFu; }
#define XB_SPIN(cond, bar) do { unsigned _sp = 0; while (cond) { __builtin_amdgcn_s_sleep(1); \
    if ((++_sp & 255u) == 0u) { if (xb_ld(&(bar)[XB_TMO])) break; if (_sp > XB_SPIN_CAP) { atomicAdd(&(bar)[XB_TMO], 1u); break; } } } } while (0)

struct XcdBarrier {
    unsigned* bar; unsigned x;
    volatile LAS unsigned* st;
};

__device__ __forceinline__ XcdBarrier xcd_barrier_post(unsigned* bar, volatile LAS unsigned* st) {
    XcdBarrier b; b.bar = bar; b.x = xb_xcc_id(); b.st = st;
    if (threadIdx.x == 0) (void)xb_add(&bar[XB_XCNT(b.x)], 1u);
    return b;
}
__device__ __forceinline__ void xcd_barrier_complete(unsigned* bar, unsigned x, unsigned& nloc, unsigned& nx) {
    const unsigned G = gridDim.x * gridDim.y * gridDim.z;
    unsigned sum, cnt, mine, sp = 0u;
    for (;;) {
        sum = 0u; cnt = 0u; mine = 0u;
#pragma unroll
        for (unsigned j = 0; j < 16; ++j) { const unsigned c = xb_ld(&bar[XB_XCNT(j)]); sum += c; cnt += (c > 0u) ? 1u : 0u; mine = (j == x) ? c : mine; }
        if (sum == G) break;
        __builtin_amdgcn_s_sleep(1);
        if ((++sp & 255u) == 0u) { if (xb_ld(&bar[XB_TMO])) break; if (sp > XB_SPIN_CAP) { atomicAdd(&bar[XB_TMO], 1u); break; } }
    }
    nloc = mine > 0u ? mine : 1u; nx = cnt > 0u ? cnt : 1u;
}

__device__ __forceinline__ void xcd_barrier(const XcdBarrier& b) {
    asm volatile("s_waitcnt vmcnt(0)" ::: "memory");
    __syncthreads();
    if (cur_tid((const LAS unsigned char*)b.st - LDS_BARST) == 0) {
        unsigned* bar = b.bar;
        __builtin_amdgcn_s_waitcnt(0);
        unsigned nloc = b.st[0], nx = b.st[1];
        if (nloc == 0u) { xcd_barrier_complete(bar, b.x, nloc, nx); b.st[0] = nloc; b.st[1] = nx; }
        const unsigned old = xb_add(&bar[XB_XSUB(b.x)], 1u);
        const unsigned gen = old / nloc;
        if (old + 1u == (gen + 1u) * nloc) {
            __builtin_amdgcn_fence(__ATOMIC_RELEASE, "agent");
            asm volatile("s_waitcnt vmcnt(0)" ::: "memory");
            const unsigned og = xb_add(&bar[XB_TOP], 1u);
            const unsigned tg = og / nx;
            if (og + 1u == (tg + 1u) * nx) xb_add(&bar[XB_TOPGEN], 1u);
            else XB_SPIN(xb_ld(&bar[XB_TOPGEN]) == tg, bar);
            __builtin_amdgcn_fence(__ATOMIC_ACQUIRE, "agent");
            xb_add(&bar[XB_XGEN(b.x)], 1u);
            asm volatile("s_waitcnt vmcnt(0)" ::: "memory");
        } else {
            XB_SPIN(xb_ld(&bar[XB_XGEN(b.x)]) == gen, bar);
            __builtin_amdgcn_fence(__ATOMIC_ACQUIRE, "agent");
            asm volatile("s_waitcnt vmcnt(0)" ::: "memory");
        }
    }
    __syncthreads();
}

struct Args { const float* in[19]; float* out; unsigned char* ws; int ph_lo, ph_hi; };
enum { I_X = 0, I_WIN, I_BIN, I_LB, I_HGNG, I_WA, I_WB, I_WOUT, I_LN1G, I_LN1B, I_WGRP, I_BGRP, I_WRT, I_BRT, I_WGATE, I_WUP, I_WDOWN, I_LN2G, I_LN2B };

__device__ __forceinline__ void transpose_item(const float* src4, size_t ldw, bf16_t* WT, size_t K, int dest_row0, int k0, LAS float* scr, int lane) {
    f32x4 v[8];
#pragma unroll
    for (int i = 0; i < 8; ++i) v[i] = src4 ? __builtin_nontemporal_load((const f32x4*)(src4 + (size_t)(8 * i) * ldw)) : (f32x4){0.f, 0.f, 0.f, 0.f};
#pragma unroll
    for (int i = 0; i < 8; ++i) { const int k = 8 * i + (lane >> 3), n4 = (lane & 7) * 4;
        scr[k * 33 + n4 + 0] = v[i][0]; scr[k * 33 + n4 + 1] = v[i][1]; scr[k * 33 + n4 + 2] = v[i][2]; scr[k * 33 + n4 + 3] = v[i][3]; }
    LDS_WAIT(); asm volatile("" ::: "memory");
    const int c = lane & 7;
#pragma unroll
    for (int j = 0; j < 4; ++j) { const int n = (lane >> 3) + 8 * j; const LAS float* s = scr + (8 * c) * 33 + n;
        u32x4 o; o.x = cvt_pk(s[0 * 33], s[1 * 33]); o.y = cvt_pk(s[2 * 33], s[3 * 33]); o.z = cvt_pk(s[4 * 33], s[5 * 33]); o.w = cvt_pk(s[6 * 33], s[7 * 33]);
        *(u32x4*)(WT + (size_t)(dest_row0 + n) * K + k0 + 8 * c) = o; }
    LDS_WAIT(); asm volatile("" ::: "memory");
}

__device__ __forceinline__ void transpose_item_f8(const float* src4, size_t ldw, unsigned char* WT, size_t K, int dest_row0, int k0, LAS float* scr, int lane) {
    f32x4 v[8];
#pragma unroll
    for (int i = 0; i < 8; ++i) v[i] = __builtin_nontemporal_load((const f32x4*)(src4 + (size_t)(8 * i) * ldw));
#pragma unroll
    for (int i = 0; i < 8; ++i) { const int k = 8 * i + (lane >> 3), n4 = (lane & 7) * 4;
        scr[k * 33 + n4 + 0] = v[i][0]; scr[k * 33 + n4 + 1] = v[i][1]; scr[k * 33 + n4 + 2] = v[i][2]; scr[k * 33 + n4 + 3] = v[i][3]; }
    LDS_WAIT(); asm volatile("" ::: "memory");
    const int c = lane & 3;
#pragma unroll
    for (int j = 0; j < 2; ++j) { const int n = (lane >> 2) + 16 * j; const LAS float* s = scr + (16 * c) * 33 + n;
        u32x4 o;
#pragma unroll
        for (int q = 0; q < 4; ++q) o[q] = cvt4_fp8_nc(s[(4 * q) * 33], s[(4 * q + 1) * 33], s[(4 * q + 2) * 33], s[(4 * q + 3) * 33], F8_WSCALE);
        *(u32x4*)(WT + (size_t)(dest_row0 + n) * K + k0 + 16 * c) = o; }
    LDS_WAIT(); asm volatile("" ::: "memory");
}
__device__ __forceinline__ void phase_prologue(const Args& a, LAS unsigned char* lds, int tid, int G) {
    unsigned char* ws = a.ws;
    { const float* x = a.in[I_X]; bf16_t* xb = (bf16_t*)(ws + WS_XB); const size_t n8 = (size_t)MT * DM / 8;
#pragma unroll 4
      for (size_t i = (size_t)blockIdx.x * NTHR + tid; i < n8; i += (size_t)G * NTHR) {
          const f32x4 p = __builtin_nontemporal_load((const f32x4*)(x + i * 8)), q = __builtin_nontemporal_load((const f32x4*)(x + i * 8 + 4));
          u32x4 o; o.x = cvt_pk(p[0], p[1]); o.y = cvt_pk(p[2], p[3]); o.z = cvt_pk(q[0], q[1]); o.w = cvt_pk(q[2], q[3]);
          *(u32x4*)(xb + i * 8) = o; } }
    asm volatile("" : "+v"(tid));
    const int lane = tid & 63, wave = tid >> 6;
    LAS float* scr = (LAS float*)(lds + wave * 8704);
    const int gw = blockIdx.x * NWAVES + wave, NGW = G * NWAVES;
    constexpr int IT_IN = (NPROJ_PAD / 32) * (DM / 64);
    constexpr int IT_A = (DM / 32) * (1024 / 64);
    constexpr int IT_OUT = (DM / 32) * (DM / 64);
    constexpr int NIT = IT_IN + 2 * IT_A + IT_OUT;
    for (int it = gw; it < NIT; it += NGW) {
        int r = it;
        if (r < IT_IN) { const int kb = r / (NPROJ_PAD / 32), rb = r % (NPROJ_PAD / 32); const int n = rb * 32 + (lane & 7) * 4;
            int src = -1; if (n < 7752) src = n; else if (n >= 7936) src = n - 184;
            const float* p = (src >= 0) ? a.in[I_WIN] + (size_t)(kb * 64 + (lane >> 3)) * NPROJ + src : nullptr;
            transpose_item(p, NPROJ, (bf16_t*)(ws + WS_WIN), DM, rb * 32, kb * 64, scr, lane); continue; }
        r -= IT_IN;
        if (r < 2 * IT_A) { const int which = r / IT_A; r %= IT_A; const int kb = r / 64, rb = r % 64; const int n = rb * 32 + (lane & 7) * 4;
            const float* p = a.in[which ? I_WB : I_WA] + (size_t)(kb * 64 + (lane >> 3)) * DM + n;
            transpose_item_f8(p, DM, ws + (which ? WS_WB : WS_WA), 1024, rb * 32, kb * 64, scr, lane); continue; }
        r -= 2 * IT_A;
        { const int kb = r / 64, rb = r % 64; const int n = rb * 32 + (lane & 7) * 4;
          const float* p = a.in[I_WOUT] + (size_t)(kb * 64 + (lane >> 3)) * DM + n;
          transpose_item_f8(p, DM, ws + WS_WOUT, DM, rb * 32, kb * 64, scr, lane); }
    }
}

constexpr int EW_GU = 64 * 32, EW_D = 64 * 16, EW_E = EW_GU + EW_D;
__device__ __forceinline__ const float* ew_src(const Args& a, int it, int lane, size_t& ldw) {
    const int e = it / EW_E; int r = it % EW_E;
    if (r < EW_GU) { const int kb = r / 64, rb = r % 64; const int n = rb * 32 + (lane & 7) * 4; const int j = n >> 3, up = (n >> 2) & 1; ldw = DFF;
        return a.in[up ? I_WUP : I_WGATE] + (size_t)e * DM * DFF + (size_t)(kb * 64 + (lane >> 3)) * DFF + 4 * j; }
    r -= EW_GU; const int kb = r / 64, rb = r % 64; const int n = rb * 32 + (lane & 7) * 4; ldw = DM;
    return a.in[I_WDOWN] + (size_t)e * DFF * DM + (size_t)(kb * 64 + (lane >> 3)) * DM + n;
}
__device__ __forceinline__ void ew_store(const Args& a, int it, const f32x4 (&v)[8], LAS float* scr, int lane) {
    const int e = it / EW_E; int r = it % EW_E; unsigned char* WT; size_t K; int rb, kb;
    if (r < EW_GU) { kb = r / 64; rb = r % 64; WT = a.ws + WS_WGU + (size_t)e * 2048 * 2048; K = 2048; }
    else { r -= EW_GU; kb = r / 64; rb = r % 64; WT = a.ws + WS_WD + (size_t)e * 2048 * 1024; K = 1024; }
#pragma unroll
    for (int i = 0; i < 8; ++i) { const int k = 8 * i + (lane >> 3), n4 = (lane & 7) * 4;
        scr[k * 33 + n4 + 0] = v[i][0]; scr[k * 33 + n4 + 1] = v[i][1]; scr[k * 33 + n4 + 2] = v[i][2]; scr[k * 33 + n4 + 3] = v[i][3]; }
    LDS_WAIT(); asm volatile("" ::: "memory");
    const int c = lane & 3;
#pragma unroll
    for (int j = 0; j < 2; ++j) { const int n = (lane >> 2) + 16 * j; const LAS float* s = scr + (16 * c) * 33 + n;
        u32x4 o;
#pragma unroll
        for (int q = 0; q < 4; ++q) o[q] = cvt4_fp8_nc(s[(4 * q) * 33], s[(4 * q + 1) * 33], s[(4 * q + 2) * 33], s[(4 * q + 3) * 33], F8_WSCALE);
        *(u32x4*)(WT + (size_t)(rb * 32 + n) * K + kb * 64 + 16 * c) = o; }
    LDS_WAIT(); asm volatile("" ::: "memory");
}
__device__ __forceinline__ void phase_expert_weights(const Args& a, LAS unsigned char* lds, int tid, int G) {
    const int lane = tid & 63, wave = tid >> 6;
    LAS float* scr = (LAS float*)(lds + wave * 8704);
    const int gw = blockIdx.x * NWAVES + wave, NGW = G * NWAVES, NIT = NEXP * EW_E;
    int it = gw; if (it >= NIT) return;
    f32x4 v[8]; { size_t ldw; const float* p = ew_src(a, it, lane, ldw);
#pragma unroll
        for (int i = 0; i < 8; ++i) v[i] = *(const f32x4*)(p + (size_t)(8 * i) * ldw); }
    for (;;) {
        const int nx = it + NGW; const bool has = nx < NIT;
        f32x4 vn[8];
        if (has) { size_t ldw; const float* p = ew_src(a, nx, lane, ldw);
#pragma unroll
            for (int i = 0; i < 8; ++i) vn[i] = *(const f32x4*)(p + (size_t)(8 * i) * ldw); }
        ew_store(a, it, v, scr, lane);
        if (!has) break;
#pragma unroll
        for (int i = 0; i < 8; ++i) v[i] = vn[i];
        it = nx;
    }
}

constexpr int HG_QD = 0, HG_KD = 17408, HG_P = 34816, HG_VT = 44032, HG_SEG = 62464, HG_RED = 64512;
constexpr int HG_LBT = 66560;
constexpr int HG_NGT = 70656;
constexpr int HG_ST = 74752, HG_STLD = 136;
constexpr int HG_LD128 = 136, HG_LD64 = 72;

struct HgPrep { float cum[16]; float kh[16]; float tot; };
__device__ __forceinline__ void hg_fill_lb(const Args& a, LAS unsigned char* lds, int tid) {
    for (int i = tid; i < 1024; i += NTHR) { const float l0 = a.in[I_LB][i], l1 = a.in[I_LB][1024 + i]; *(LAS float*)(lds + HG_LBT + i * 4) = 1.0f / (1.0f + __expf(l1 - l0)); *(LAS float*)(lds + HG_NGT + i * 4) = a.in[I_HGNG][i]; }
    __syncthreads();
}
__device__ __forceinline__ void hg_prep(HgPrep& P, const float (&z)[16], float lb, int d, int seg, LAS unsigned char* lds) {
    float run = 0.f;
#pragma unroll
    for (int j = 0; j < 16; ++j) { const float sg = sigmoidf_(z[j]); const float f = lb + (1.0f - lb) * sg; run += __logf(f); P.cum[j] = run; P.kh[j] = (1.0f - lb) * (1.0f - sg); }
    LAS float* segs = (LAS float*)(lds + HG_SEG);
    segs[seg * 128 + d] = run;
    __syncthreads();
    float off = 0.f, tot = 0.f;
#pragma unroll
    for (int s = 0; s < 4; ++s) { const float v = segs[s * 128 + d]; tot += v; if (s < seg) off += v; }
#pragma unroll
    for (int j = 0; j < 16; ++j) P.cum[j] += off;
    P.tot = tot;
}
__device__ __forceinline__ void hg_write_vt(const unsigned (&vv)[16], int d, int seg, LAS unsigned char* lds) {
    u32x4 w0, w1;
    w0.x = vv[0] | (vv[1] << 16); w0.y = vv[2] | (vv[3] << 16); w0.z = vv[4] | (vv[5] << 16); w0.w = vv[6] | (vv[7] << 16);
    w1.x = vv[8] | (vv[9] << 16); w1.y = vv[10] | (vv[11] << 16); w1.z = vv[12] | (vv[13] << 16); w1.w = vv[14] | (vv[15] << 16);
    LAS unsigned char* p = lds + HG_VT + d * (HG_LD64 * 2) + seg * 32;
    *(LAS u32x4*)p = w0; *(LAS u32x4*)(p + 16) = w1;
}

__device__ __forceinline__ void hgrn1_unit(const Args& a, int unit, LAS unsigned char* lds, int tid) {
    unsigned char* ws = a.ws;
    const int lane = tid & 63, wave = tid >> 6, d = tid & 127, seg = tid >> 7;
    const int b = unit >> 10, h = (unit >> 7) & 7, n = unit & 127, tok0 = b * SEQ + n * 64;
    float z[16]; unsigned vv[16];
    { const float* AF = (const float*)(ws + WS_AF); const bf16_t* AI = (const bf16_t*)(ws + WS_AI);
#pragma unroll
      for (int j = 0; j < 16; ++j) z[j] = AF[(size_t)(tok0 + seg * 16 + j) * 1024 + h * 128 + d];
#pragma unroll
      for (int j = 0; j < 16; ++j) vv[j] = AI[(size_t)(tok0 + seg * 16 + j) * 1024 + h * 128 + d]; }
    const float lbv = *(const LAS float*)(lds + HG_LBT + (h * 128 + d) * 4);
    HgPrep P;
    hg_prep(P, z, lbv, d, seg, lds);
    { unsigned pk[8];
#pragma unroll
      for (int j = 0; j < 8; ++j) pk[j] = cvt_pk(P.kh[2 * j] * __expf(P.tot - P.cum[2 * j]), P.kh[2 * j + 1] * __expf(P.tot - P.cum[2 * j + 1]));
      LAS unsigned char* p = lds + HG_KD + d * (HG_LD64 * 2) + seg * 32;
      *(LAS u32x4*)p = (u32x4){pk[0], pk[1], pk[2], pk[3]}; *(LAS u32x4*)(p + 16) = (u32x4){pk[4], pk[5], pk[6], pk[7]}; }
    if (seg == 0) ((float*)(ws + WS_DECAY))[(size_t)unit * 128 + d] = __expf(P.tot);
    hg_write_vt(vv, d, seg, lds);
    __syncthreads();
    const int fr = lane & 15, fq = lane >> 4;
    bf16x8 af[2];
#pragma unroll
    for (int ks = 0; ks < 2; ++ks) af[ks] = *(const LAS bf16x8*)(lds + HG_KD + (16 * wave + fr) * (HG_LD64 * 2) + (32 * ks + 8 * fq) * 2);
    float* kvo = (float*)(ws + WS_KV) + (size_t)unit * 16384;
#pragma unroll
    for (int vb = 0; vb < 8; ++vb) {
        f32x4 acc = {0.f, 0.f, 0.f, 0.f};
#pragma unroll
        for (int ks = 0; ks < 2; ++ks) { const bf16x8 bfr = *(const LAS bf16x8*)(lds + HG_VT + (16 * vb + fr) * (HG_LD64 * 2) + (32 * ks + 8 * fq) * 2);
            acc = __builtin_amdgcn_mfma_f32_16x16x32_bf16(af[ks], bfr, acc, 0, 0, 0); }
        *(f32x4*)(kvo + (size_t)(16 * vb + fr) * 128 + 16 * wave + 4 * fq) = acc;
    }
    __syncthreads();
}

__device__ __forceinline__ void hgrn_scan(const Args& a, int tid, int G) {
    unsigned char* ws = a.ws;
    const float* KV = (const float*)(ws + WS_KV); const float* DEC = (const float*)(ws + WS_DECAY); unsigned* ST = (unsigned*)(ws + WS_ST);
    for (int g = blockIdx.x * NTHR + tid; g < 16 * 8192; g += G * NTHR) {
        const int bh = g >> 13, rem = g & 8191, v = rem >> 6, d2 = (rem & 63) * 2;
        float s0 = 0.f, s1 = 0.f;
        for (int n0 = 0; n0 < 128; n0 += 8) {
            f32x2 kv[8], dc[8];
#pragma unroll
            for (int j = 0; j < 8; ++j) { const size_t unit = (size_t)bh * 128 + n0 + j; kv[j] = *(const f32x2*)(KV + unit * 16384 + v * 128 + d2); dc[j] = *(const f32x2*)(DEC + unit * 128 + d2); }
#pragma unroll
            for (int j = 0; j < 8; ++j) { const size_t unit = (size_t)bh * 128 + n0 + j; ST[(unit * 16384 + v * 128 + d2) >> 1] = cvt_pk(s0, s1);
                s0 = dc[j][0] * s0 + kv[j][0]; s1 = dc[j][1] * s1 + kv[j][1]; }
        }
    }
}

__device__ __forceinline__ void hg3_load(const Args& a, int unit, int tid, float (&z)[16], unsigned (&qq)[16], unsigned (&vv)[16], u32x4 (&stp)[4], u32x2 (&gwv)[4]) {
    unsigned char* ws = a.ws; const int d = tid & 127, seg = tid >> 7;
    const int b = unit >> 10, h = (unit >> 7) & 7, n = unit & 127, tok0 = b * SEQ + n * 64;
    const float* AF = (const float*)(ws + WS_AF); const bf16_t* AI = (const bf16_t*)(ws + WS_AI); const bf16_t* AQ = (const bf16_t*)(ws + WS_AQ);
#pragma unroll
    for (int j = 0; j < 16; ++j) z[j] = AF[(size_t)(tok0 + seg * 16 + j) * 1024 + h * 128 + d];
#pragma unroll
    for (int j = 0; j < 16; ++j) qq[j] = AQ[(size_t)(tok0 + seg * 16 + j) * 1024 + h * 128 + d];
#pragma unroll
    for (int j = 0; j < 16; ++j) vv[j] = AI[(size_t)(tok0 + seg * 16 + j) * 1024 + h * 128 + d];
    { const bf16_t* ST = (const bf16_t*)(ws + WS_ST) + (size_t)unit * 16384;
#pragma unroll
      for (int i = 0; i < 4; ++i) stp[i] = *(const u32x4*)(ST + (size_t)(tid + NTHR * i) * 8); }
    { const int lane = tid & 63, wave = tid >> 6, t_ = 16 * (wave & 3) + (lane & 15); const bf16_t* AG = (const bf16_t*)(ws + WS_AG);
#pragma unroll
      for (int vi = 0; vi < 4; ++vi) gwv[vi] = *(const u32x2*)(AG + (size_t)(tok0 + t_) * 1024 + h * 128 + 16 * (4 * (wave >> 2) + vi) + 4 * (lane >> 4)); }
}
__device__ __forceinline__ void hgrn3_unit(const Args& a, int unit, int next_unit, LAS unsigned char* lds, int tid, float (&z)[16], unsigned (&qq)[16], unsigned (&vv)[16], u32x4 (&stp)[4], u32x2 (&gwn)[4]) {
    unsigned char* ws = a.ws;
    const int lane = tid & 63, wave = tid >> 6, d = tid & 127, seg = tid >> 7;
    const int b = unit >> 10, h = (unit >> 7) & 7, n = unit & 127, tok0 = b * SEQ + n * 64;
    const float lbv = *(const LAS float*)(lds + HG_LBT + (h * 128 + d) * 4);
    u32x2 gwv[4];
#pragma unroll
    for (int vi = 0; vi < 4; ++vi) gwv[vi] = gwn[vi];
#ifndef HG3_RA
#define HG3_RA 1
#define HG3_RB 1
#define HG3_RC 1
#endif
    for (int ra = 0; ra < HG3_RA; ++ra) {
    HgPrep P;
    hg_prep(P, z, lbv, d, seg, lds);
    {
#pragma unroll
      for (int j = 0; j < 16; ++j) { const float q = bf2f(qq[j]); const float qs = q * sigmoidf_(q);
          const float qd = qs * __expf(P.cum[j]), kd = P.kh[j] * __expf(-P.cum[j]);
          const int t = seg * 16 + j;
          *(LAS bf16_t*)(lds + HG_QD + (t * HG_LD128 + d) * 2) = (bf16_t)(cvt_pk(qd, 0.f) & 0xffffu);
          *(LAS bf16_t*)(lds + HG_KD + (t * HG_LD128 + d) * 2) = (bf16_t)(cvt_pk(kd, 0.f) & 0xffffu); } }
    hg_write_vt(vv, d, seg, lds);
#pragma unroll
    for (int i = 0; i < 4; ++i) { const int id = tid + NTHR * i; *(LAS u32x4*)(lds + HG_ST + (id >> 4) * (HG_STLD * 2) + (id & 15) * 16) = stp[i]; }
    __syncthreads();
    }
    if (next_unit >= 0) hg3_load(a, next_unit, tid, z, qq, vv, stp, gwn);
    const int fr = lane & 15, fq = lane >> 4;
    for (int rb = 0; rb < HG3_RB; ++rb) {
    { const int tb = wave & 3;
      bf16x8 bq[4];
#pragma unroll
      for (int ks = 0; ks < 4; ++ks) bq[ks] = *(const LAS bf16x8*)(lds + HG_QD + ((16 * tb + fr) * HG_LD128 + 32 * ks + 8 * fq) * 2);
#pragma unroll
      for (int si = 0; si < 2; ++si) { const int sb = 2 * (wave >> 2) + si;
          f32x4 acc = {0.f, 0.f, 0.f, 0.f};
#pragma unroll
          for (int ks = 0; ks < 4; ++ks) { const bf16x8 ak = *(const LAS bf16x8*)(lds + HG_KD + ((16 * sb + fr) * HG_LD128 + 32 * ks + 8 * fq) * 2);
              acc = __builtin_amdgcn_mfma_f32_16x16x32_bf16(ak, bq[ks], acc, 0, 0, 0); }
          const int t = 16 * tb + fr, s0 = 16 * sb + 4 * fq;
          float p[4];
#pragma unroll
          for (int r = 0; r < 4; ++r) p[r] = (s0 + r <= t) ? acc[r] : 0.f;
          *(LAS u32x2*)(lds + HG_P + (t * HG_LD64 + s0) * 2) = (u32x2){cvt_pk(p[0], p[1]), cvt_pk(p[2], p[3])}; } }
    __syncthreads();
    }
    for (int rc = 0; rc < HG3_RC; ++rc) {
    const int tb = wave & 3, t = 16 * tb + fr;
    f32x4 o[4];
    { bf16x8 bp[2], bq[4];
#pragma unroll
      for (int ks = 0; ks < 2; ++ks) bp[ks] = *(const LAS bf16x8*)(lds + HG_P + ((16 * tb + fr) * HG_LD64 + 32 * ks + 8 * fq) * 2);
#pragma unroll
      for (int ks = 0; ks < 4; ++ks) bq[ks] = *(const LAS bf16x8*)(lds + HG_QD + ((16 * tb + fr) * HG_LD128 + 32 * ks + 8 * fq) * 2);
#pragma unroll
      for (int vi = 0; vi < 4; ++vi) { const int vb = 4 * (wave >> 2) + vi;
          f32x4 acc = {0.f, 0.f, 0.f, 0.f};
#pragma unroll
          for (int ks = 0; ks < 2; ++ks) { const bf16x8 av = *(const LAS bf16x8*)(lds + HG_VT + ((16 * vb + fr) * HG_LD64 + 32 * ks + 8 * fq) * 2);
              acc = __builtin_amdgcn_mfma_f32_16x16x32_bf16(av, bp[ks], acc, 0, 0, 0); }
#pragma unroll
          for (int ks = 0; ks < 4; ++ks) { const bf16x8 as = *(const LAS bf16x8*)(lds + HG_ST + ((16 * vb + fr) * HG_STLD + 32 * ks + 8 * fq) * 2);
              acc = __builtin_amdgcn_mfma_f32_16x16x32_bf16(as, bq[ks], acc, 0, 0, 0); }
          o[vi] = acc; } }
    float ss = 0.f;
#pragma unroll
    for (int vi = 0; vi < 4; ++vi) ss += (o[vi][0] * o[vi][0] + o[vi][1] * o[vi][1]) + (o[vi][2] * o[vi][2] + o[vi][3] * o[vi][3]);
    ss += __shfl_xor(ss, 16); ss += __shfl_xor(ss, 32);
    LAS float* red = (LAS float*)(lds + HG_RED);
    if (fq == 0) red[(wave >> 2) * 64 + t] = ss;
    __syncthreads();
    const float tot = red[t] + red[64 + t];
    const float rinv = 1.0f / sqrtf(tot * (1.0f / 128.0f) + RMS_EPS);
    unsigned char* BRA = ws + WS_BRA;
#pragma unroll
    for (int vi = 0; vi < 4; ++vi) { const int v0 = 16 * (4 * (wave >> 2) + vi) + 4 * fq; const size_t off = (size_t)(tok0 + t) * 1024 + h * 128 + v0;
        const u32x2 gw = gwv[vi]; const f32x4 gn = *(const LAS f32x4*)(lds + HG_NGT + (h * 128 + v0) * 4);
        const float g0 = __uint_as_float(gw.x << 16), g1 = __uint_as_float(gw.x & 0xffff0000u), g2 = __uint_as_float(gw.y << 16), g3 = __uint_as_float(gw.y & 0xffff0000u);
        const float r0 = o[vi][0] * rinv * gn[0] * (g0 * sigmoidf_(g0)), r1 = o[vi][1] * rinv * gn[1] * (g1 * sigmoidf_(g1));
        const float r2 = o[vi][2] * rinv * gn[2] * (g2 * sigmoidf_(g2)), r3 = o[vi][3] * rinv * gn[3] * (g3 * sigmoidf_(g3));
        *(unsigned*)(BRA + off) = cvt4_fp8(r0, r1, r2, r3, F8_ASCALE); }
    __syncthreads();
    }
}


constexpr int IX_S = 0, IX_H = 131072, IX_L = 147456, IX_M = 155648, IX_C = 159744;
constexpr int IX_CAP = 512;
__device__ __forceinline__ unsigned ix_sortable(unsigned u) { return (u & 0x80000000u) ? ~u : (u | 0x80000000u); }

__device__ __forceinline__ void ix_radix_fallback(LAS unsigned* S, LAS unsigned* H, unsigned* MASK, int t0, int L, int tid) {
    const int lane = tid & 63, wave = __builtin_amdgcn_readfirstlane(tid >> 6);
    for (int q = 0; q < 4; ++q) for (int i = tid; i < L; i += NTHR) S[q * 8192 + i] = ix_sortable(S[q * 8192 + i]);
    for (int i = tid; i < 2048; i += NTHR) H[i] = 0u;
    __syncthreads();
    const int qs = wave >> 1, half = wave & 1;
    unsigned prefix = 0u; int kth = 256;
    for (int p = 0; p < 4; ++p) {
        const int shift = 24 - 8 * p;
        LAS unsigned* hist = H + (p & 1) * 1024 + qs * 256;
        for (int i = half * 64 + lane; i < L; i += 128) { const unsigned k = S[qs * 8192 + i];
            const bool in = (p == 0) || ((k >> (shift + 8)) == prefix);
            if (in) atomicAdd((unsigned*)(hist + ((k >> shift) & 255u)), 1u); }
        __syncthreads();
        const unsigned c0 = hist[255 - 4 * lane], c1 = hist[254 - 4 * lane], c2 = hist[253 - 4 * lane], c3 = hist[252 - 4 * lane];
        const int tot = (int)(c0 + c1 + c2 + c3);
        int incl = tot;
#pragma unroll
        for (int o = 1; o < 64; o <<= 1) { const int v = __shfl_up(incl, o); if (lane >= o) incl += v; }
        const unsigned long long bal = __ballot(incl >= kth);
        const int fl = __ffsll((long long)bal) - 1;
        const int rem = kth - (incl - tot);
        int dig, nk;
        if (rem <= (int)c0) { dig = 255 - 4 * lane; nk = rem; }
        else if (rem <= (int)(c0 + c1)) { dig = 254 - 4 * lane; nk = rem - (int)c0; }
        else if (rem <= (int)(c0 + c1 + c2)) { dig = 253 - 4 * lane; nk = rem - (int)(c0 + c1); }
        else { dig = 252 - 4 * lane; nk = rem - (int)(c0 + c1 + c2); }
        dig = __shfl(dig, fl); nk = __shfl(nk, fl);
        prefix = (prefix << 8) | (unsigned)dig; kth = nk;
        __syncthreads();
        if (p < 2) for (int i = tid; i < 1024; i += NTHR) H[(p & 1) * 1024 + i] = 0u;
    }
    const unsigned T = prefix;
    const int NG = L / 64;
    int tie_before = 0;
    if (half == 1) for (int g = 0; g < 64 && g < NG; ++g) { const unsigned k = S[qs * 8192 + 64 * g + lane]; tie_before += __popcll(__ballot(k == T)); }
    unsigned mlo = 0u, mhi = 0u;
    const unsigned long long lt = (1ull << lane) - 1ull;
    for (int g = 64 * half; g < NG && g < 64 * half + 64; ++g) {
        const unsigned k = S[qs * 8192 + 64 * g + lane];
        const bool eq = (k == T);
        const unsigned long long eqm = __ballot(eq);
        const int rank = tie_before + __popcll(eqm & lt);
        const bool sel = (k > T) || (eq && rank < kth);
        const unsigned long long m = __ballot(sel);
        if (lane == g - 64 * half) { mlo = (unsigned)m; mhi = (unsigned)(m >> 32); }
        tie_before += __popcll(eqm);
    }
    *(u32x2*)(MASK + (size_t)(t0 + qs) * 256 + 2 * (64 * half + lane)) = (u32x2){mlo, mhi};
    __syncthreads();
}

__device__ __forceinline__ void indexer_unit(const Args& a, int unit, LAS unsigned char* lds, int tid) {
    unsigned char* ws = a.ws;
    const int lane = tid & 63, wave = __builtin_amdgcn_readfirstlane(tid >> 6);
    const int t0 = unit * 4, b = t0 >> 13, qpos0 = t0 & (SEQ - 1), c = qpos0 >> 6, L = 64 * (c + 1);
    unsigned* MASK = (unsigned*)(ws + WS_MASK);
    if (c < 4) {
        const int qi = tid >> 7, w2 = (tid & 127) * 2;
        const unsigned m0 = (w2 * 32 < L) ? 0xffffffffu : 0u, m1 = ((w2 + 1) * 32 < L) ? 0xffffffffu : 0u;
        *(u32x2*)(MASK + (size_t)(t0 + qi) * 256 + w2) = (u32x2){m0, m1};
        return;
    }
    const bf16_t* IQ = (const bf16_t*)(ws + WS_IQ); const bf16_t* IKW = (const bf16_t*)(ws + WS_IKW);
    LAS unsigned* S = (LAS unsigned*)(lds + IX_S); LAS unsigned* H = (LAS unsigned*)(lds + IX_H); LAS unsigned* LST = (LAS unsigned*)(lds + IX_L);
    LAS unsigned* MB = (LAS unsigned*)(lds + IX_M); LAS float* MM = (LAS float*)(lds + IX_C); LAS unsigned* CC = (LAS unsigned*)(lds + IX_C + 256);
    const int r32 = lane & 31, hh = lane >> 5;
    for (int i = tid; i < 4096; i += NTHR) H[i] = 0u;
    for (int i = tid; i < 1024; i += NTHR) MB[i] = 0u;
    if (tid < 8) CC[tid] = 0u;
    bf16x8 af[4];
#pragma unroll
    for (int ks = 0; ks < 4; ++ks) af[ks] = *(const bf16x8*)(IQ + (size_t)(t0 + (r32 >> 3)) * 512 + (r32 & 7) * 64 + 16 * ks + 8 * hh);
    bf16x8 a2[2];
#pragma unroll
    for (int sI = 0; sI < 2; ++sI)
#pragma unroll
        for (int j = 0; j < 8; ++j) { const int qm = 2 * sI + (j >> 2), hm = 4 * hh + (j & 3);
            a2[sI][j] = (r32 == qm) ? (short)IKW[(size_t)(t0 + qm) * 256 + 64 + hm] : (short)0; }
    float mn[4], mx[4];
#pragma unroll
    for (int qi = 0; qi < 4; ++qi) { mn[qi] = 3.0e38f; mx[qi] = -3.0e38f; }
    const int NT32 = L / 32;
    const bf16_t* kbase = (const bf16_t*)(ws + WS_IK2) + (size_t)b * (SEQ / 32) * 2048 + lane * 8;
#define IX_LOADT(dst, kt_) do { const bf16_t* kp_ = kbase + (size_t)(kt_) * 2048; _Pragma("unroll") for (int ks = 0; ks < 4; ++ks) dst[ks] = *(const bf16x8*)(kp_ + 512 * ks); } while (0)
#define IX_MM(acc, bt) do { acc = f32x16{}; _Pragma("unroll") for (int ks = 0; ks < 4; ++ks) acc = __builtin_amdgcn_mfma_f32_32x32x16_bf16(af[ks], bt[ks], acc, 0, 0, 0); } while (0)
#define IX_HS(y_, acc) do { unsigned pk_[8]; _Pragma("unroll") for (int i = 0; i < 8; ++i) { const float x0_ = __builtin_amdgcn_fmed3f(acc[2 * i], 0.0f, 3.0e38f), x1_ = __builtin_amdgcn_fmed3f(acc[2 * i + 1], 0.0f, 3.0e38f); pk_[i] = cvt_pk_to_mfma(x0_, x1_); } \
        const u32x4 f0_ = {pk_[0], pk_[1], pk_[2], pk_[3]}, f1_ = {pk_[4], pk_[5], pk_[6], pk_[7]}; \
        y_ = f32x16{}; y_ = __builtin_amdgcn_mfma_f32_32x32x16_bf16(a2[0], *(const bf16x8*)&f0_, y_, 0, 0, 0); y_ = __builtin_amdgcn_mfma_f32_32x32x16_bf16(a2[1], *(const bf16x8*)&f1_, y_, 0, 0, 0); } while (0)
#define IX_ST(y_, kt_) do { const int key = (kt_) * 32 + r32; \
        if (hh == 0) { _Pragma("unroll") for (int qi = 0; qi < 4; ++qi) { const float s = y_[qi] + 0.0f; mn[qi] = fminf(mn[qi], s); mx[qi] = fmaxf(mx[qi], s); S[qi * 8192 + key] = __float_as_uint(s); } } } while (0)
#ifndef IX_REP_S1
#define IX_REP_S1 1
#endif
    for (int rp1 = 0; rp1 < IX_REP_S1; ++rp1) {
    bf16x8 bA[4], bB[4], bC[4];
    { const int kt = wave; if (kt < NT32) IX_LOADT(bA, kt); if (kt + 8 < NT32) IX_LOADT(bB, kt + 8); if (kt + 16 < NT32) IX_LOADT(bC, kt + 16); }
    for (int kt = wave; kt < NT32; kt += 3 * NWAVES) {
        const int kn = kt + 3 * NWAVES;
        bf16x8 nA[4], nB[4], nC[4];
        if (kn < NT32) IX_LOADT(nA, kn); if (kn + 8 < NT32) IX_LOADT(nB, kn + 8); if (kn + 16 < NT32) IX_LOADT(nC, kn + 16);
        const bool hB = kt + 8 < NT32, hC = kt + 16 < NT32;
#ifndef IX_REP_C
#define IX_REP_C 1
#endif
        for (int rc_ = 0; rc_ < IX_REP_C; ++rc_) {
        f32x16 xA, xB, xC;
        IX_MM(xA, bA); if (hB) IX_MM(xB, bB); if (hC) IX_MM(xC, bC);
        { f32x16 yy; IX_HS(yy, xA); IX_ST(yy, kt); }
        if (hB) { f32x16 yy; IX_HS(yy, xB); IX_ST(yy, kt + 8); }
        if (hC) { f32x16 yy; IX_HS(yy, xC); IX_ST(yy, kt + 16); }
        }
#pragma unroll
        for (int ks = 0; ks < 4; ++ks) { bA[ks] = nA[ks]; bB[ks] = nB[ks]; bC[ks] = nC[ks]; }
    }
    }
#undef IX_LOADT
#undef IX_MM
#undef IX_HS
#undef IX_ST
#pragma unroll
    for (int qi = 0; qi < 4; ++qi) {
#pragma unroll
        for (int o = 1; o < 32; o <<= 1) { mn[qi] = fminf(mn[qi], __shfl_xor(mn[qi], o)); mx[qi] = fmaxf(mx[qi], __shfl_xor(mx[qi], o)); }
        if (lane == 0) { MM[(wave * 4 + qi) * 2] = mn[qi]; MM[(wave * 4 + qi) * 2 + 1] = mx[qi]; } }
    __syncthreads();
    const int qs = wave >> 1, half = wave & 1;
    float mnq = 3.0e38f, mxq = -3.0e38f;
#pragma unroll
    for (int w = 0; w < NWAVES; ++w) { mnq = fminf(mnq, MM[(w * 4 + qs) * 2]); mxq = fmaxf(mxq, MM[(w * 4 + qs) * 2 + 1]); }
    const float scl = (mxq > mnq) ? 1023.0f / (mxq - mnq) : 0.0f;
#define IX_BIN(sbits) min((int)((__uint_as_float(sbits) - mnq) * scl), 1023)
    { LAS unsigned* hist = H + qs * 1024;
      int i = half * 64 + lane;
      for (; i + 384 < L; i += 512) { const unsigned s0 = S[qs * 8192 + i], s1 = S[qs * 8192 + i + 128], s2 = S[qs * 8192 + i + 256], s3 = S[qs * 8192 + i + 384];
          const int b0 = IX_BIN(s0), b1 = IX_BIN(s1), b2 = IX_BIN(s2), b3 = IX_BIN(s3);
          atomicAdd((unsigned*)(hist + b0), 1u); atomicAdd((unsigned*)(hist + b1), 1u); atomicAdd((unsigned*)(hist + b2), 1u); atomicAdd((unsigned*)(hist + b3), 1u); }
      for (; i < L; i += 128) { const int bin = IX_BIN(S[qs * 8192 + i]); atomicAdd((unsigned*)(hist + bin), 1u); } }
    __syncthreads();
    int bstar, rtake, cntb;
    { const LAS u32x4* hp = (const LAS u32x4*)(H + qs * 1024 + 1008 - 16 * lane);
      const u32x4 h0 = hp[0], h1 = hp[1], h2 = hp[2], h3 = hp[3];
      const unsigned cb[16] = {h0.x, h0.y, h0.z, h0.w, h1.x, h1.y, h1.z, h1.w, h2.x, h2.y, h2.z, h2.w, h3.x, h3.y, h3.z, h3.w};
      int tot = 0;
#pragma unroll
      for (int j = 0; j < 16; ++j) tot += (int)cb[j];
      int incl = tot;
#pragma unroll
      for (int o = 1; o < 64; o <<= 1) { const int v = __shfl_up(incl, o); if (lane >= o) incl += v; }
      const unsigned long long bal = __ballot(incl >= 256);
      const int fl = __ffsll((long long)bal) - 1;
      const int rem = 256 - (incl - tot);
      int cum = 0, bs = 0, rt = 0, cn = 0; bool found = false;
#pragma unroll
      for (int j = 15; j >= 0; --j) { const int cj = (int)cb[j]; if (!found && cum + cj >= rem) { bs = 1008 - 16 * lane + j; rt = rem - cum; cn = cj; found = true; } cum += cj; }
      bstar = __shfl(bs, fl); rtake = __shfl(rt, fl); cntb = __shfl(cn, fl); }
    const int NG = L / 64;
    const bool all_eq = (cntb == rtake);
    const unsigned long long lt = (1ull << lane) - 1ull;
    { unsigned mlo = 0u, mhi = 0u;
      const int gh = (NG + 1) >> 1, gbeg = half ? gh : 0, gend = half ? NG : gh;
      const float tge = (float)bstar, tgt = (bstar >= 1023) ? 3.0e38f : (float)(bstar + 1);
      unsigned sv[4] = {0u, 0u, 0u, 0u};
      for (int g = gbeg; g < gend; ++g) {
          const int gi = (g - gbeg) & 3;
          if (gi == 0) {
#pragma unroll
              for (int j = 0; j < 4; ++j) if (g + j < gend) sv[j] = S[qs * 8192 + 64 * (g + j) + lane]; }
          const unsigned sb = (gi == 0) ? sv[0] : (gi == 1) ? sv[1] : (gi == 2) ? sv[2] : sv[3];
          const float tq = (__uint_as_float(sb) - mnq) * scl;
          unsigned long long m = __ballot(tq >= tgt);
          const unsigned long long eqm = __ballot(tq >= tge) & ~m;
          if (all_eq) m |= eqm;
          else if (eqm != 0ull) {
              unsigned base = 0u;
              if (lane == 0) base = atomicAdd((unsigned*)(CC + qs), (unsigned)__popcll(eqm));
              base = __builtin_amdgcn_readfirstlane(base);
              const unsigned pos = base + (unsigned)__popcll(eqm & lt);
              if (((eqm >> lane) & 1ull) && pos < (unsigned)IX_CAP) LST[qs * IX_CAP + pos] = (unsigned)(64 * g + lane); }
          if (lane == g - gbeg) { mlo = (unsigned)m; mhi = (unsigned)(m >> 32); }
      }
      if (lane < gend - gbeg) *(LAS u32x2*)(MB + qs * 256 + 2 * (gbeg + lane)) = (u32x2){mlo, mhi}; }
    __syncthreads();
    if (half == 0 && !all_eq) {
        const int nc = cntb;
        if (nc > IX_CAP) { if (lane == 0) CC[4] = 1u; }
        else {
            unsigned myk[8], myi[8]; int rk[8];
#pragma unroll
            for (int sI = 0; sI < 8; ++sI) { const int j = sI * 64 + lane; rk[sI] = 0; myi[sI] = 0u; myk[sI] = 0u;
                if (sI * 64 < nc && j < nc) { myi[sI] = LST[qs * IX_CAP + j]; myk[sI] = ix_sortable(S[qs * 8192 + myi[sI]]); } }
            for (int t = 0; t < nc; ++t) { const unsigned it = LST[qs * IX_CAP + t]; const unsigned kt_ = ix_sortable(S[qs * 8192 + it]);
#pragma unroll
                for (int sI = 0; sI < 8; ++sI) if (sI * 64 < nc) rk[sI] += (kt_ > myk[sI] || (kt_ == myk[sI] && it < myi[sI])) ? 1 : 0; }
#pragma unroll
            for (int sI = 0; sI < 8; ++sI) { const int j = sI * 64 + lane;
                if (sI * 64 < nc && j < nc && rk[sI] < rtake) atomicOr((unsigned*)(MB + qs * 256 + (myi[sI] >> 5)), 1u << (myi[sI] & 31u)); }
        }
    }
#undef IX_BIN
    __syncthreads();
    if (CC[4] != 0u) { __syncthreads(); ix_radix_fallback(S, H, MASK, t0, L, tid); return; }
    { const int qi = tid >> 7, w2 = (tid & 127) * 2;
      *(u32x2*)(MASK + (size_t)(t0 + qi) * 256 + w2) = *(const LAS u32x2*)(MB + qi * 256 + w2); }
    __syncthreads();
}

constexpr int NA_IDX = 0, NA_LG = 1024, NA_SCAN = 1024 + 8192;
__device__ __forceinline__ void attn_gather_unit(const Args& a, int tok, LAS unsigned char* lds, int tid) {
    unsigned char* ws = a.ws;
    const int lane = tid & 63, wave = __builtin_amdgcn_readfirstlane(tid >> 6);
    const int b = tok >> 13, qpos = tok & (SEQ - 1), c = qpos >> 6, L = 64 * (c + 1), nsel = L < 256 ? L : 256;
    const unsigned* MASK = (const unsigned*)(ws + WS_MASK);
    LAS int* idxs = (LAS int*)(lds + NA_IDX); LAS float* lg = (LAS float*)(lds + NA_LG) + wave * 256; LAS int* wsum = (LAS int*)(lds + NA_SCAN);
    unsigned w = 0u; int cnt = 0;
    if (tid < 256) { w = MASK[(size_t)tok * 256 + tid]; cnt = __popc(w); }
    int incl = cnt;
#pragma unroll
    for (int o = 1; o < 64; o <<= 1) { const int v = __shfl_up(incl, o); if (lane >= o) incl += v; }
    if (lane == 63) wsum[wave] = incl;
    __syncthreads();
    if (tid < 256) { int off = incl - cnt; for (int ww = 0; ww < wave; ++ww) off += wsum[ww];
        while (w) { const int bit = __ffs(w) - 1; w &= w - 1; if (off < 256) idxs[off] = tid * 32 + bit; ++off; } }
    __syncthreads();
    const int h = wave;
    const bf16_t* BQ = (const bf16_t*)(ws + WS_BQ); const bf16_t* BK = (const bf16_t*)(ws + WS_BK); const bf16_t* BV = (const bf16_t*)(ws + WS_BV);
    const float slope = exp2f(-(float)(h + 1));
    float qv[8];
    { const u32x4 qw = *(const u32x4*)(BQ + (size_t)tok * 1024 + h * 128 + 8 * (lane & 15));
      qv[0] = __uint_as_float(qw.x << 16); qv[1] = __uint_as_float(qw.x & 0xffff0000u); qv[2] = __uint_as_float(qw.y << 16); qv[3] = __uint_as_float(qw.y & 0xffff0000u);
      qv[4] = __uint_as_float(qw.z << 16); qv[5] = __uint_as_float(qw.z & 0xffff0000u); qv[6] = __uint_as_float(qw.w << 16); qv[7] = __uint_as_float(qw.w & 0xffff0000u); }
    for (int it = 0; it < nsel / 4; ++it) {
        const int key = idxs[4 * it + (lane >> 4)];
        const u32x4 kw = *(const u32x4*)(BK + (size_t)(b * SEQ + key) * 1024 + h * 128 + 8 * (lane & 15));
        float s = qv[0] * __uint_as_float(kw.x << 16) + qv[1] * __uint_as_float(kw.x & 0xffff0000u) + qv[2] * __uint_as_float(kw.y << 16) + qv[3] * __uint_as_float(kw.y & 0xffff0000u)
                + qv[4] * __uint_as_float(kw.z << 16) + qv[5] * __uint_as_float(kw.z & 0xffff0000u) + qv[6] * __uint_as_float(kw.w << 16) + qv[7] * __uint_as_float(kw.w & 0xffff0000u);
        s += __shfl_xor(s, 1); s += __shfl_xor(s, 2); s += __shfl_xor(s, 4); s += __shfl_xor(s, 8);
        const float dist = fabsf((float)(qpos - key));
        if ((lane & 15) == 0) lg[4 * it + (lane >> 4)] = s * 0.08838834764831845f - slope * dist;
    }
    LDS_WAIT();
    float mx = -3.0e38f;
    for (int k = lane; k < nsel; k += 64) mx = fmaxf(mx, lg[k]);
#pragma unroll
    for (int o = 1; o < 64; o <<= 1) mx = fmaxf(mx, __shfl_xor(mx, o));
    float sm = 0.f;
    for (int k = lane; k < nsel; k += 64) { const float e = __expf(lg[k] - mx); lg[k] = e; sm += e; }
    sm = wave_sum(sm);
    const float rs = 1.0f / sm;
    LDS_WAIT();
    float o0 = 0.f, o1 = 0.f;
    for (int k = 0; k < nsel; k += 4) {
        unsigned vw[4]; float pp[4];
#pragma unroll
        for (int j = 0; j < 4; ++j) { const int key = idxs[k + j]; pp[j] = lg[k + j]; vw[j] = *(const unsigned*)(BV + (size_t)(b * SEQ + key) * 1024 + h * 128 + 2 * lane); }
#pragma unroll
        for (int j = 0; j < 4; ++j) { o0 += pp[j] * __uint_as_float(vw[j] << 16); o1 += pp[j] * __uint_as_float(vw[j] & 0xffff0000u); }
    }
    *(unsigned*)((bf16_t*)(ws + WS_BRB) + (size_t)tok * 1024 + h * 128 + 2 * lane) = cvt_pk(o0 * rs, o1 * rs);
    __syncthreads();
}

constexpr int RT_BLK = 148, RT_BUF = 64 * RT_BLK * 4;
constexpr int RT_SCR = 2 * RT_BUF;
__device__ __forceinline__ void phase8_router_expw(const Args& a, LAS unsigned char* lds, int tid, int G, bool route, bool do_expw) {
    unsigned char* ws = a.ws; const int wave = __builtin_amdgcn_readfirstlane(tid >> 6);
    const int npass = MT / 8;
    if (wave < 4) {
        __syncthreads();
        int cbuf = 0;
        for (int ps = blockIdx.x; ps < npass; ps += G) {
            int lane = tid & 63; asm volatile("" : "+v"(lane));
            f32x4 v[2][8];
#pragma unroll
            for (int r = 0; r < 2; ++r) { const int row = ps * 8 + wave * 2 + r;
                const unsigned ro = (unsigned)row * (unsigned)(DM * 2) + 8u * (unsigned)lane; float s = 0.f;
#pragma unroll
                for (int i = 0; i < 8; ++i) { const u32x2 pw = *(const u32x2*)(ws + (size_t)((unsigned)WS_PRE1 + ro + 512u * i));
                    v[r][i] = (f32x4){__uint_as_float(pw.x << 16), __uint_as_float(pw.x & 0xffff0000u), __uint_as_float(pw.y << 16), __uint_as_float(pw.y & 0xffff0000u)};
                    s += (v[r][i][0] + v[r][i][1]) + (v[r][i][2] + v[r][i][3]); }
                const float mean = wave_sum(s) * (1.0f / DM); float s2 = 0.f;
#pragma unroll
                for (int i = 0; i < 8; ++i) { v[r][i] = v[r][i] - mean; s2 += (v[r][i][0] * v[r][i][0] + v[r][i][1] * v[r][i][1]) + (v[r][i][2] * v[r][i][2] + v[r][i][3] * v[r][i][3]); }
                const float rstd = 1.0f / sqrtf(wave_sum(s2) * (1.0f / DM) + LN_EPS);
#pragma unroll
                for (int i = 0; i < 8; ++i) { const f32x4 gg = *(const f32x4*)(a.in[I_LN1G] + 256 * i + 4 * lane), bb = *(const f32x4*)(a.in[I_LN1B] + 256 * i + 4 * lane);
                    v[r][i] = v[r][i] * rstd * gg + bb;
                    *(u32x2*)(ws + (size_t)((unsigned)WS_H1B + ro + 512u * i)) = (u32x2){cvt_pk(v[r][i][0], v[r][i][1]), cvt_pk(v[r][i][2], v[r][i][3])};
                    *(unsigned*)(ws + (size_t)((unsigned)WS_H1F8 + (ro >> 1) + 256u * i)) = cvt4_fp8_nc(v[r][i][0], v[r][i][1], v[r][i][2], v[r][i][3], F8_ASCALE); } }
            f32x2 acc2[36];
#pragma unroll
            for (int j = 0; j < 36; ++j) acc2[j] = (f32x2){0.f, 0.f};
#pragma unroll
            for (int i = 0; i < 8; ++i) {
                int lq = lane; asm volatile("" : "+v"(lq));
                const LAS float* blk = (const LAS float*)(lds + cbuf * RT_BUF) + lq * RT_BLK;
#pragma unroll
                for (int kk = 0; kk < 4; ++kk) {
                    __builtin_amdgcn_sched_barrier(0);
                    const f32x2 hv = (f32x2){v[0][i][kk], v[1][i][kk]};
#pragma unroll
                    for (int q = 0; q < 9; ++q) { const f32x4 w4 = *(const LAS f32x4*)(blk + kk * 36 + 4 * q);
                        acc2[4 * q + 0] += hv * (f32x2){w4[0], w4[0]}; acc2[4 * q + 1] += hv * (f32x2){w4[1], w4[1]};
                        acc2[4 * q + 2] += hv * (f32x2){w4[2], w4[2]}; acc2[4 * q + 3] += hv * (f32x2){w4[3], w4[3]}; } }
                __syncthreads();
                cbuf ^= 1;
            }
#pragma unroll
            for (int r = 0; r < 2; ++r) {
                const int row = ps * 8 + wave * 2 + r;
                float lgt[36];
#pragma unroll
                for (int j = 0; j < 36; ++j) lgt[j] = wave_sum(r == 0 ? acc2[j][0] : acc2[j][1]);
                float gl[4]; float gm = -3.0e38f; int gt = 0;
#pragma unroll
                for (int j = 0; j < 4; ++j) { gl[j] = lgt[j] + a.in[I_BGRP][j]; if (gl[j] > gm) { gm = gl[j]; gt = j; } }
                float gs = 0.f;
#pragma unroll
                for (int j = 0; j < 4; ++j) gs += __expf(gl[j] - gm);
                const float gp = 1.0f / gs;
                float e1 = -3.0e38f, e2 = -3.0e38f; int i1 = 0, i2 = 0;
#pragma unroll
                for (int j = 0; j < 8; ++j) { float ev = 0.f;
#pragma unroll
                    for (int gq = 0; gq < 4; ++gq) if (gq == gt) ev = lgt[4 + 8 * gq + j] + a.in[I_BRT][8 * gq + j];
                    if (ev > e1) { e2 = e1; i2 = i1; e1 = ev; i1 = j; } else if (ev > e2) { e2 = ev; i2 = j; } }
                const float x2 = __expf(e2 - e1), w1 = gp / (1.0f + x2), w2 = gp * x2 / (1.0f + x2);
                if (lane == 0 && route) {
                    unsigned* ctl = (unsigned*)(ws + WS_CTL);
                    int* rows = (int*)(ws + WS_ROWS); int* slot_e = (int*)(ws + WS_SLOT); int* slot_p = slot_e + 2 * MT; float* slot_w = (float*)(slot_p + 2 * MT);
                    const int ea = gt * 8 + i1, eb = gt * 8 + i2;
                    const int pa = (int)atomicAdd(ctl + CW_CNT + 64 * ea, 1u), pb = (int)atomicAdd(ctl + CW_CNT + 64 * eb, 1u);
                    rows[ea * MT + pa] = row; rows[eb * MT + pb] = row;
                    slot_e[2 * row] = ea; slot_e[2 * row + 1] = eb; slot_p[2 * row] = pa; slot_p[2 * row + 1] = pb; slot_w[2 * row] = w1; slot_w[2 * row + 1] = w2;
                }
            }
        }
    } else {
        const int lane = tid & 63, te = tid - 256;
        const float* wg = a.in[I_WGRP]; const float* wr = a.in[I_WRT];
        LAS float* scr = (LAS float*)(lds + RT_SCR + (wave - 4) * 8704);
        f32x4 sa[9], sb[9];
#define RT_LOADW(dst, chunk) do { const int k_ = (chunk) * 256 + te; dst[0] = *(const f32x4*)(wg + (size_t)k_ * 4); _Pragma("unroll") for (int j_ = 0; j_ < 8; ++j_) dst[1 + j_] = *(const f32x4*)(wr + (size_t)k_ * 32 + 4 * j_); } while (0)
#define RT_WRITEW(src, buf) do { LAS float* p_ = (LAS float*)(buf) + (te >> 2) * RT_BLK + (te & 3) * 36; _Pragma("unroll") for (int j_ = 0; j_ < 9; ++j_) *(LAS f32x4*)(p_ + 4 * j_) = src[j_]; } while (0)
        RT_LOADW(sa, 0); RT_WRITEW(sa, lds); RT_LOADW(sb, 1);
        const int ge = blockIdx.x * 4 + (wave - 4), NGE = G * 4, NIT = do_expw ? NEXP * EW_E : 0;
        int it = ge; f32x4 e0[8], e1[8];
#define EW_LOAD(dst, item) do { if ((item) < NIT) { size_t ldw_; const float* p_ = ew_src(a, (item), lane, ldw_); _Pragma("unroll") for (int i_ = 0; i_ < 8; ++i_) dst[i_] = __builtin_nontemporal_load((const f32x4*)(p_ + (size_t)(8 * i_) * ldw_)); } } while (0)
#define EW_STEPX(cur, fre) do { if (it < NIT) { EW_LOAD(fre, it + NGE); ew_store(a, it, cur, scr, lane); it += NGE; } } while (0)
        EW_LOAD(e0, it);
        __syncthreads();
        int cbuf = 0;
        for (int ps = blockIdx.x; ps < npass; ps += G) {
#pragma unroll
            for (int i = 0; i < 8; ++i) {
                if (i & 1) { RT_LOADW(sb, (i + 2) & 7); RT_WRITEW(sa, lds + (cbuf ^ 1) * RT_BUF); }
                else { RT_LOADW(sa, (i + 2) & 7); RT_WRITEW(sb, lds + (cbuf ^ 1) * RT_BUF); }
                if (i == 0) { EW_STEPX(e0, e1); EW_STEPX(e1, e0); } else if (i == 1) { EW_STEPX(e0, e1); } else if (i == 2) { EW_STEPX(e1, e0); EW_STEPX(e0, e1); } else if (i == 3) { EW_STEPX(e1, e0); }
                else if (i == 4) { EW_STEPX(e0, e1); EW_STEPX(e1, e0); } else if (i == 5) { EW_STEPX(e0, e1); } else if (i == 6) { EW_STEPX(e1, e0); EW_STEPX(e0, e1); } else { EW_STEPX(e1, e0); }
                __syncthreads();
                cbuf ^= 1;
            }
        }
        while (it < NIT) { EW_STEPX(e0, e1); EW_STEPX(e1, e0); }
#undef RT_LOADW
#undef RT_WRITEW
#undef EW_STEPX
#undef EW_LOAD
    }
    __syncthreads();
}

__device__ __forceinline__ void load_tile_base(const Args& a, LAS int* tb, int tid) {
    const unsigned* ctl = (const unsigned*)(a.ws + WS_CTL);
    if (tid == 0) { int acc = 0; for (int e = 0; e < NEXP; ++e) { tb[e] = acc; acc += ((int)ctl[CW_CNT + 64 * e] + 255) >> 8; } tb[NEXP] = acc; }
    __syncthreads();
}

__device__ __forceinline__ void phase_gather(const Args& a, LAS unsigned char* lds, int tid, int G) {
    unsigned char* ws = a.ws; const int lane = tid & 63, wave = tid >> 6;
    LAS int* tb = (LAS int*)lds;
    load_tile_base(a, tb, tid);
    unsigned* ctl = (unsigned*)(ws + WS_CTL);
    const int NT = tb[NEXP];
    if (blockIdx.x == 0) { if (tid == 0) ctl[CW_NT] = (unsigned)NT;
        if (tid < NEXP) for (int t = tb[tid]; t < tb[tid + 1]; ++t) ctl[CW_TILEE + t] = (unsigned)tid;
        if (tid <= NEXP) ctl[CW_TBASE + tid] = (unsigned)tb[tid]; }
    const int* rows = (const int*)(ws + WS_ROWS); const bf16_t* H1B = (const bf16_t*)(ws + WS_H1B); bf16_t* XG = (bf16_t*)(ws + WS_XG);
    for (int r = blockIdx.x * NWAVES + wave; r < NT * 256; r += G * NWAVES) {
        const int tile = r >> 8; int e = 0;
        for (int j = 1; j < NEXP; ++j) if (tb[j] <= tile) e = j;
        const int pos = r - tb[e] * 256; const int cnt = (int)ctl[CW_CNT + 64 * e];
        u32x4 v[4];
        if (pos < cnt) { const int tok = rows[e * MT + pos];
#pragma unroll
            for (int i = 0; i < 4; ++i) v[i] = *(const u32x4*)(H1B + (size_t)tok * DM + 512 * i + 8 * lane); }
        else {
#pragma unroll
            for (int i = 0; i < 4; ++i) v[i] = (u32x4){0u, 0u, 0u, 0u}; }
#pragma unroll
        for (int i = 0; i < 4; ++i) *(u32x4*)(XG + (size_t)r * DM + 512 * i + 8 * lane) = v[i];
    }
}

struct FinSlots { int r0, r1; float w0, w1; };
__device__ __forceinline__ void fin_slots(const Args& a, int row, const LAS int* tb, FinSlots& S) {
    unsigned char* ws = a.ws;
    const int* slot_e = (const int*)(ws + WS_SLOT); const int* slot_p = slot_e + 2 * MT; const float* slot_w = (const float*)(slot_p + 2 * MT);
    const int e0 = slot_e[2 * row], e1 = slot_e[2 * row + 1];
    S.r0 = tb[e0] * 256 + slot_p[2 * row]; S.r1 = tb[e1] * 256 + slot_p[2 * row + 1]; S.w0 = slot_w[2 * row]; S.w1 = slot_w[2 * row + 1];
}
__device__ __forceinline__ void fin_data(const Args& a, int row, int lane, const FinSlots& S, u32x2 (&hw)[8], u32x2 (&ya)[8], u32x2 (&yb)[8]) {
    unsigned char* ws = a.ws;
    const bf16_t* H1B = (const bf16_t*)(ws + WS_H1B) + (size_t)row * DM; const bf16_t* Y = (const bf16_t*)(ws + WS_Y);
#pragma unroll
    for (int i = 0; i < 8; ++i) { hw[i] = *(const u32x2*)(H1B + 256 * i + 4 * lane); ya[i] = *(const u32x2*)(Y + (size_t)S.r0 * DM + 256 * i + 4 * lane); yb[i] = *(const u32x2*)(Y + (size_t)S.r1 * DM + 256 * i + 4 * lane); }
}
__device__ __forceinline__ void fin_compute(const Args& a, int row, int lane, float w0, float w1, const u32x2 (&hw)[8], const u32x2 (&ya)[8], const u32x2 (&yb)[8]) {
    f32x4 v[8]; float s = 0.f;
#pragma unroll
    for (int i = 0; i < 8; ++i) {
        const f32x4 hv = {__uint_as_float(hw[i].x << 16), __uint_as_float(hw[i].x & 0xffff0000u), __uint_as_float(hw[i].y << 16), __uint_as_float(hw[i].y & 0xffff0000u)};
        const f32x4 fa = {__uint_as_float(ya[i].x << 16), __uint_as_float(ya[i].x & 0xffff0000u), __uint_as_float(ya[i].y << 16), __uint_as_float(ya[i].y & 0xffff0000u)};
        const f32x4 fb = {__uint_as_float(yb[i].x << 16), __uint_as_float(yb[i].x & 0xffff0000u), __uint_as_float(yb[i].y << 16), __uint_as_float(yb[i].y & 0xffff0000u)};
        v[i] = hv * DN_ALPHA + fa * w0 + fb * w1; s += (v[i][0] + v[i][1]) + (v[i][2] + v[i][3]); }
    const float mean = wave_sum(s) * (1.0f / DM); float s2 = 0.f;
#pragma unroll
    for (int i = 0; i < 8; ++i) { v[i] = v[i] - mean; s2 += (v[i][0] * v[i][0] + v[i][1] * v[i][1]) + (v[i][2] * v[i][2] + v[i][3] * v[i][3]); }
    const float rstd = 1.0f / sqrtf(wave_sum(s2) * (1.0f / DM) + LN_EPS);
    float* O = a.out + (size_t)row * DM;
#pragma unroll
    for (int i = 0; i < 8; ++i) { const f32x4 g = *(const f32x4*)(a.in[I_LN2G] + 256 * i + 4 * lane), bb = *(const f32x4*)(a.in[I_LN2B] + 256 * i + 4 * lane);
        *(f32x4*)(O + 256 * i + 4 * lane) = v[i] * rstd * g + bb; }
}
__device__ __forceinline__ void phase_final(const Args& a, int tid, int G, const LAS int* tb) {
    const int lane = tid & 63, wave = tid >> 6, gw = blockIdx.x * NWAVES + wave, NGW = G * NWAVES;
    if (gw >= MT) return;
    FinSlots SA, SB; u32x2 hA[8], aA[8], bA[8], hB[8], aB[8], bB[8];
    int row = gw;
    fin_slots(a, row, tb, SA); fin_data(a, row, lane, SA, hA, aA, bA);
    if (row + NGW < MT) fin_slots(a, row + NGW, tb, SB);
    for (;;) {
        const int r1 = row + NGW, r2 = row + 2 * NGW;
        if (r1 < MT) fin_data(a, r1, lane, SB, hB, aB, bB);
        const float w0 = SA.w0, w1 = SA.w1;
        if (r2 < MT) fin_slots(a, r2, tb, SA);
        fin_compute(a, row, lane, w0, w1, hA, aA, bA);
        if (r1 >= MT) break;
        const int r3 = row + 3 * NGW;
        if (r2 < MT) fin_data(a, r2, lane, SA, hA, aA, bA);
        const float x0 = SB.w0, x1 = SB.w1;
        if (r3 < MT) fin_slots(a, r3, tb, SB);
        fin_compute(a, r1, lane, x0, x1, hB, aB, bB);
        if (r2 >= MT) break;
        row = r2;
    }
}

namespace fa {
constexpr int D = 128, NW = 8, QBLK = 32, KVBLK = 64, LDX = 1024;
constexpr float SCALE = 0.088388347648318440f, THR = 8.f;
constexpr size_t SHM_V = KVBLK * D * 2, SHM_K = KVBLK * D * 2, SHM_ATTN = 2 * SHM_V + 2 * SHM_K + NW * 64 * 4;
using s16x4 = __attribute__((ext_vector_type(4))) short;
#define KSWZ(row, colB) ((row) * 256 + ((colB) ^ (((row) & 7) << 4)))
#define SBAR() __builtin_amdgcn_sched_barrier(0)
__device__ __forceinline__ int crow(int r, int hi) { return (r & 3) + 8 * (r >> 2) + 4 * hi; }

__device__ __forceinline__ void partialSM(f32x16& p0, f32x16& p1, float& m_reg, float& mn, float& alpha) {
  constexpr float C = SCALE * 1.4426950408889634f;
  float pmax = p0[0];
#pragma unroll
  for (int r = 1; r < 16; ++r) pmax = fmaxf(pmax, p0[r]);
#pragma unroll
  for (int r = 0; r < 16; ++r) pmax = fmaxf(pmax, p1[r]);
  { auto rr = __builtin_amdgcn_permlane32_swap(__float_as_uint(pmax), __float_as_uint(pmax), false, false);
    pmax = fmaxf(__uint_as_float(rr[0]), __uint_as_float(rr[1])); }
  if (__builtin_expect(__all(pmax - m_reg <= THR / SCALE), 1)) { mn = m_reg; alpha = 1.f; }
  else { mn = fmaxf(m_reg, pmax); alpha = __builtin_amdgcn_exp2f((m_reg - mn) * C); m_reg = mn; }
  float mnC = -mn * C;
#pragma unroll
  for (int r = 0; r < 16; ++r) p0[r] = fmaf(p0[r], C, mnC);
#pragma unroll
  for (int r = 0; r < 16; ++r) p1[r] = fmaf(p1[r], C, mnC);
#pragma unroll
  for (int r = 0; r < 16; ++r) p0[r] = __builtin_amdgcn_exp2f(p0[r]);
}
__device__ __forceinline__ void finishSM(f32x16& p0, f32x16& p1, float alpha, float& l_reg, bf16x8& pa0, bf16x8& pa1, bf16x8& pa2, bf16x8& pa3) {
#pragma unroll
  for (int r = 0; r < 16; ++r) p1[r] = __builtin_amdgcn_exp2f(p1[r]);
  float ps = 0;
#pragma unroll
  for (int r = 0; r < 16; ++r) ps += p0[r];
#pragma unroll
  for (int r = 0; r < 16; ++r) ps += p1[r];
  { auto rr = __builtin_amdgcn_permlane32_swap(__float_as_uint(ps), __float_as_uint(ps), false, false);
    ps = __uint_as_float(rr[0]) + __uint_as_float(rr[1]); }
  l_reg = l_reg * alpha + ps;
#define PK4(P, BASE, OUT) do { unsigned a0 = cvt_pk(P[BASE + 0], P[BASE + 1]), a1 = cvt_pk(P[BASE + 2], P[BASE + 3]);   \
    unsigned b0 = cvt_pk(P[BASE + 4], P[BASE + 5]), b1 = cvt_pk(P[BASE + 6], P[BASE + 7]);                              \
    auto r0 = __builtin_amdgcn_permlane32_swap(a0, b0, false, false); auto r1 = __builtin_amdgcn_permlane32_swap(a1, b1, false, false); \
    u32x4 w = {r0[0], r1[0], r0[1], r1[1]}; OUT = *reinterpret_cast<bf16x8*>(&w); } while (0)
  PK4(p0, 0, pa0); PK4(p0, 8, pa1); PK4(p1, 0, pa2); PK4(p1, 8, pa3);
#undef PK4
}
__device__ __forceinline__ void qkt(f32x16& p0, f32x16& p1, const char* Ks, const bf16x8* qr, int r32, int hi) {
  p0 = f32x16{}; p1 = f32x16{};
#pragma unroll
  for (int d0 = 0; d0 < 8; ++d0) { int cb = (d0 * 16 + hi * 8) * 2;
    bf16x8 b0 = *reinterpret_cast<const bf16x8*>(Ks + KSWZ(r32, cb));
    bf16x8 b1 = *reinterpret_cast<const bf16x8*>(Ks + KSWZ(32 + r32, cb));
    p0 = __builtin_amdgcn_mfma_f32_32x32x16_bf16(b0, qr[d0], p0, 0, 0, 0);
    p1 = __builtin_amdgcn_mfma_f32_32x32x16_bf16(b1, qr[d0], p1, 0, 0, 0); }
}
__device__ __forceinline__ void mask_bias(f32x16& p0, f32x16& p1, u32x2 mw, float dq, float slr, int hi) {
  const unsigned w0 = mw.x >> (4 * hi), w1 = mw.y >> (4 * hi);
  const unsigned NEG = 0xf149f2cau;
#pragma unroll
  for (int r = 0; r < 16; ++r) { const int c = (r & 3) + 8 * (r >> 2);
    const float d0 = dq - (float)c, d1 = dq - (float)(32 + c);
    const float s0 = fmaf(-slr, fabsf(d0), p0[r]), s1 = fmaf(-slr, fabsf(d1), p1[r]);
    const unsigned t0 = (unsigned)(((int)(w0 << (31 - c))) >> 31), t1 = (unsigned)(((int)(w1 << (31 - c))) >> 31);
    p0[r] = __uint_as_float((__float_as_uint(s0) & t0) | (NEG & ~t0));
    p1[r] = __uint_as_float((__float_as_uint(s1) & t1) | (NEG & ~t1)); }
}
__device__ __forceinline__ int v_st(int k, int c) { const int kk = (k & ~0xC) | ((k & 4) << 1) | ((k & 8) >> 1); return ((kk >> 3) * 4 + (c >> 5)) * 512 + ((kk & 7) * 32 + (c & 31)) * 2; }
__device__ __forceinline__ int v_rd_base(int lane) { return ((lane & 3) << 3) | (((lane >> 2) & 3) << 6) | (((lane >> 4) & 1) << 5) | (((lane >> 5) & 1) << 8); }
constexpr int v_rd_off(int d0, int ks, int half) { return d0 * 512 + ks * 4096 + half * 2048; }
template <int OFF> __device__ __forceinline__ s16x4 tr_read(int vb) {
  s16x4 r; asm volatile("ds_read_b64_tr_b16 %0, %1 offset:%2" : "=&v"(r) : "v"(vb), "i"(OFF) : "memory"); return r;
}
template <int D0> __device__ __forceinline__ void pv_one(f32x16& od, int vb, bf16x8 pa0, bf16x8 pa1, bf16x8 pa2, bf16x8 pa3) {
  const s16x4 l0 = tr_read<v_rd_off(D0, 0, 0)>(vb), h0 = tr_read<v_rd_off(D0, 0, 1)>(vb), l1 = tr_read<v_rd_off(D0, 1, 0)>(vb), h1 = tr_read<v_rd_off(D0, 1, 1)>(vb);
  const s16x4 l2 = tr_read<v_rd_off(D0, 2, 0)>(vb), h2 = tr_read<v_rd_off(D0, 2, 1)>(vb), l3 = tr_read<v_rd_off(D0, 3, 0)>(vb), h3 = tr_read<v_rd_off(D0, 3, 1)>(vb);
  asm volatile("s_waitcnt lgkmcnt(0)" ::: "memory"); SBAR();
#define PK(L, H) (bf16x8){L[0], L[1], L[2], L[3], H[0], H[1], H[2], H[3]}
  od = __builtin_amdgcn_mfma_f32_32x32x16_bf16(pa0, PK(l0, h0), od, 0, 0, 0);
  od = __builtin_amdgcn_mfma_f32_32x32x16_bf16(pa1, PK(l1, h1), od, 0, 0, 0);
  od = __builtin_amdgcn_mfma_f32_32x32x16_bf16(pa2, PK(l2, h2), od, 0, 0, 0);
  od = __builtin_amdgcn_mfma_f32_32x32x16_bf16(pa3, PK(l3, h3), od, 0, 0, 0);
#undef PK
}
__device__ __forceinline__ void pv_d0(f32x16* o, int vb, bf16x8 pa0, bf16x8 pa1, bf16x8 pa2, bf16x8 pa3) {
  pv_one<0>(o[0], vb, pa0, pa1, pa2, pa3); pv_one<1>(o[1], vb, pa0, pa1, pa2, pa3); pv_one<2>(o[2], vb, pa0, pa1, pa2, pa3); pv_one<3>(o[3], vb, pa0, pa1, pa2, pa3);
}

#define FA_GAS __attribute__((address_space(1)))
__device__ __forceinline__ void attn_block(const bf16_t* Qb_, const bf16_t* Kh_, const bf16_t* Vh_, const unsigned* maskrow_,
                                           bf16_t* Ob_, int NT, int qpos0, float slr, char* lds) {
  const FA_GAS bf16_t* Qb = (const FA_GAS bf16_t*)Qb_; const FA_GAS bf16_t* Kh = (const FA_GAS bf16_t*)Kh_; const FA_GAS bf16_t* Vh = (const FA_GAS bf16_t*)Vh_;
  const FA_GAS unsigned* maskrow = (const FA_GAS unsigned*)maskrow_; FA_GAS unsigned char* Ob = (FA_GAS unsigned char*)Ob_;
  int tid_ = cur_tid((const LAS unsigned char*)lds); asm volatile("" : "+v"(tid_));
  const int tid = tid_, wid = tid >> 6, lane = tid & 63, r32 = lane & 31, hi = lane >> 5;
  char* V_lds = lds; char* K_lds = lds + 2 * SHM_V;
  float* wsm = (float*)(lds + 2 * SHM_V + 2 * SHM_K) + wid * 64; float* li_l = wsm; float* al_l = wsm + 32;
  float m_reg = -1e30f, l_reg = 0; f32x16 o[4] = {}; bf16x8 qr[8];
  const FA_GAS bf16_t* Qw = Qb + (long)(wid * QBLK + r32) * LDX + hi * 8;
#pragma unroll
  for (int d0 = 0; d0 < 8; ++d0) qr[d0] = *reinterpret_cast<const FA_GAS bf16x8*>(Qw + d0 * 16);
  const unsigned moff = (unsigned)(wid * QBLK + r32) * 256u;
  const float qposf = (float)(qpos0 + wid * QBLK + r32 - 4 * hi);
  const int sr = tid >> 4, sc = (tid & 15) * 8, vst0 = v_st(sr, sc), vst1 = v_st(32 + sr, sc);
  const int vb0 = (int)(uintptr_t)V_lds + v_rd_base(lane);
  constexpr int SDEPTH = 1;
  struct { bf16x8 vs0, vs1, ks0, ks1; } sr_[SDEPTH];
#define KOFF(j) ((NT - 1 - (j)) * KVBLK)
#define SLOAD(i, k0) do { sr_[i].vs0 = *reinterpret_cast<const FA_GAS bf16x8*>(&Vh[(long)((k0) + sr) * LDX + sc]); sr_[i].vs1 = *reinterpret_cast<const FA_GAS bf16x8*>(&Vh[(long)((k0) + 32 + sr) * LDX + sc]); \
    sr_[i].ks0 = *reinterpret_cast<const FA_GAS bf16x8*>(&Kh[(long)((k0) + sr) * LDX + sc]); sr_[i].ks1 = *reinterpret_cast<const FA_GAS bf16x8*>(&Kh[(long)((k0) + 32 + sr) * LDX + sc]); } while (0)
#define SWRITE(b, i) do { *(bf16x8*)(V_lds + (b) * SHM_V + vst0) = sr_[i].vs0;          \
    *(bf16x8*)(V_lds + (b) * SHM_V + vst1) = sr_[i].vs1; int kc = sc * 2;               \
    *(bf16x8*)(K_lds + (b) * SHM_K + KSWZ(sr, kc)) = sr_[i].ks0;                       \
    *(bf16x8*)(K_lds + (b) * SHM_K + KSWZ(32 + sr, kc)) = sr_[i].ks1; } while (0)
#define SWAIT() do { if constexpr (SDEPTH == 2) asm volatile("s_waitcnt vmcnt(4)" ::: "memory"); else asm volatile("s_waitcnt vmcnt(0)" ::: "memory"); } while (0)
#define RESC(a) do { if (__any((a) < 1.f)) { if (hi == 0) al_l[r32] = (a); asm volatile("s_waitcnt lgkmcnt(0)" ::: "memory"); \
    _Pragma("unroll") for (int d = 0; d < 4; ++d) _Pragma("unroll") for (int r = 0; r < 16; ++r) o[d][r] *= al_l[crow(r, hi)]; } } while (0)
#define MASKW(j) (*reinterpret_cast<const FA_GAS u32x2*>(maskrow + (moff + 2u * (unsigned)(NT - 1 - (j)))))
#define MB(P0, P1, j, MW) mask_bias(P0, P1, MW, qposf - (float)KOFF(j), slr, hi)
  f32x16 pA0, pA1, pB0, pB1; float mnA, mnB, alA, alB; bf16x8 pa0, pa1, pa2, pa3;
  constexpr int SE = 0, SO = SDEPTH - 1;
  SLOAD(SE, KOFF(0)); asm volatile("s_waitcnt vmcnt(0)" ::: "memory"); SWRITE(0, SE); __syncthreads();
  { qkt(pA0, pA1, K_lds, qr, r32, hi); MB(pA0, pA1, 0, MASKW(0)); } partialSM(pA0, pA1, m_reg, mnA, alA);
  SLOAD(SO, KOFF(1)); if constexpr (SDEPTH == 2) { if (2 < NT) SLOAD(SE, KOFF(2)); }
  SWAIT(); SWRITE(1, SO); __syncthreads();
  for (int j = 1; j + 1 < NT; j += 2) {
    SBAR(); { qkt(pB0, pB1, K_lds + SHM_K, qr, r32, hi); MB(pB0, pB1, j, MASKW(j)); }
    finishSM(pA0, pA1, alA, l_reg, pa0, pa1, pa2, pa3); SBAR();
    SLOAD(SO, KOFF(j + SDEPTH)); SBAR();
    pv_d0(o, vb0, pa0, pa1, pa2, pa3); partialSM(pB0, pB1, m_reg, mnB, alB);
    __syncthreads(); SWAIT(); SWRITE(0, SE);
    RESC(alB); __syncthreads();
    SBAR(); { qkt(pA0, pA1, K_lds, qr, r32, hi); MB(pA0, pA1, j + 1, MASKW(j + 1)); }
    finishSM(pB0, pB1, alB, l_reg, pa0, pa1, pa2, pa3); SBAR();
    if (SDEPTH == 1 || j + 3 < NT) SLOAD(SE, KOFF(j + 1 + SDEPTH)); SBAR();
    pv_d0(o, vb0 + (int)SHM_V, pa0, pa1, pa2, pa3); partialSM(pA0, pA1, m_reg, mnA, alA);
    __syncthreads(); SWAIT(); SWRITE(1, SO);
    RESC(alA); __syncthreads();
  }
  SBAR(); { qkt(pB0, pB1, K_lds + SHM_K, qr, r32, hi); MB(pB0, pB1, NT - 1, MASKW(NT - 1)); }
  finishSM(pA0, pA1, alA, l_reg, pa0, pa1, pa2, pa3); SBAR();
  pv_d0(o, vb0, pa0, pa1, pa2, pa3); partialSM(pB0, pB1, m_reg, mnB, alB);
  __syncthreads(); RESC(alB);
  finishSM(pB0, pB1, alB, l_reg, pa0, pa1, pa2, pa3); SBAR();
  pv_d0(o, vb0 + (int)SHM_V, pa0, pa1, pa2, pa3);
  if (hi == 0) li_l[r32] = l_reg; asm volatile("s_waitcnt lgkmcnt(0)" ::: "memory");
  float rli[16];
#pragma unroll
  for (int r = 0; r < 16; ++r) rli[r] = __builtin_amdgcn_rcpf(li_l[crow(r, hi)]);
  FA_GAS unsigned char* Ow = Ob + (long)(wid * QBLK) * LDX;
#pragma unroll
  for (int r = 0; r < 16; ++r) { int orow = crow(r, hi);
#pragma unroll
    for (int d0 = 0; d0 < 4; ++d0) Ow[(long)orow * LDX + d0 * 32 + r32] = (unsigned char)cvt1_fp8(o[d0][r] * rli[r], F8_ASCALE); }
  __syncthreads();
#undef KOFF
#undef SLOAD
#undef SWRITE
#undef SWAIT
#undef RESC
#undef MASKW
#undef MB
}
#undef KSWZ
#undef SBAR
}

__device__ __forceinline__ void phase_attention(const Args& a, char* lds, int G, int bid) {
    unsigned char* ws = uni_ptr(a.ws);
    const bf16_t* BQ = (const bf16_t*)(ws + WS_BQ); const bf16_t* BK = (const bf16_t*)(ws + WS_BK); const bf16_t* BV = (const bf16_t*)(ws + WS_BV);
    const unsigned* MASK = (const unsigned*)(ws + WS_MASK); unsigned char* BRB = ws + WS_BRB;
    const int bx = bid; const int vcu = (G % 8 == 0) ? (bx % 8) * (G / 8) + bx / 8 : bx;
    for (int p0 = vcu; p0 < 256; p0 += G) { const int p = __builtin_amdgcn_readfirstlane(p0);
        const int b = p >> 7, h = (p >> 4) & 7, x = p & 15;
        const float slr = uni_f((1.0f / fa::SCALE) / (float)(2 << h));
#pragma unroll 1
        for (int half = 0; half < 2; ++half) { const int qb = half ? 31 - x : x; const size_t row0 = (size_t)b * SEQ + qb * 256;
            fa::attn_block(uni_ptr(BQ + row0 * 1024 + h * 128), uni_ptr(BK + (size_t)b * SEQ * 1024 + h * 128), uni_ptr(BV + (size_t)b * SEQ * 1024 + h * 128),
                           uni_ptr(MASK + row0 * 256), (bf16_t*)uni_ptr(BRB + row0 * 1024 + h * 128), 4 * (qb + 1), qb * 256, slr, lds); }
    }
}


constexpr int NPH = 13;
#ifndef REPS
#define REPS 1,1,1,1,1,1,1,1,1,1,1,1,1,1,1,1
#endif
constexpr int REP[16] = {REPS};
__global__ void __launch_bounds__(NTHR, 2) mk_fwd(Args a) {
    extern __shared__ __attribute__((aligned(16))) unsigned char lds_raw[];
    LAS unsigned char* lds = (LAS unsigned char*)lds_raw;
    cg::grid_group grid = cg::this_grid();
    const int G = gridDim.x;
#define FRESH_TID() int tid = cur_tid(lds); asm volatile("" : "+v"(tid)); const int lane = tid & 63, wave = tid >> 6; (void)lane; (void)wave

    unsigned char* ws = a.ws;
    const int lo = a.ph_lo, hi = a.ph_hi;
#define IN(k) (lo <= (k) && (k) < hi)
    if (lo < 0) grid.sync();
    if (threadIdx.x == 0) { ((volatile LAS unsigned*)(lds + LDS_BARST))[0] = 0u; ((volatile LAS unsigned*)(lds + LDS_BARST))[1] = 0u; }
    if ((threadIdx.x & 63) == 0) ((volatile LAS unsigned char*)(lds + LDS_WTAB))[(unsigned)__builtin_amdgcn_s_getreg((5 << 11) | 4) & 63u] = (unsigned char)(threadIdx.x >> 6);
    __syncthreads();
    (void)xcd_barrier_post((unsigned*)(ws + WS_CTL) + CW_BAR, (volatile LAS unsigned*)(lds + LDS_BARST));
    int bid = blockIdx.x;
    if (lo == 0 && hi == NPH && (G % 8) == 0) {
        if (threadIdx.x == 0) { const unsigned x = xb_xcc_id(); const unsigned r = atomicAdd((unsigned*)(ws + WS_CTL) + CW_TICKET + 64 * x, 1u); ((volatile LAS unsigned*)(lds + LDS_BARST))[2] = r * 8u + (x & 7u); }
    }
#define SEAM(k) do { if (IN(k) && IN((k) + 1)) { { XcdBarrier b_; b_.bar = (unsigned*)(a.ws + WS_CTL) + CW_BAR; b_.x = xb_xcc_id(); b_.st = (volatile LAS unsigned*)(lds + LDS_BARST); xcd_barrier(b_); } } } while (0)

    if (IN(0)) { FRESH_TID(); for (int rp = 0; rp < REP[0]; ++rp) { phase_prologue(a, lds, tid, G); __syncthreads(); } }
    SEAM(0);
    if (lo == 0 && hi == NPH && (G % 8) == 0) {
        const unsigned* bw = (const unsigned*)(ws + WS_CTL) + CW_BAR; bool ok = true;
        for (int j = 0; j < 8; ++j) ok = ok && (__hip_atomic_load(bw + XB_XCNT(j), __ATOMIC_RELAXED, __HIP_MEMORY_SCOPE_AGENT) == (unsigned)(G / 8));
        if (ok) bid = __builtin_amdgcn_readfirstlane((int)((volatile LAS unsigned*)(lds + LDS_BARST))[2]);
    }
    if (IN(1)) { FRESH_TID(); pg8::Gemm g{(const bf16_t*)(ws + WS_XB), (const bf16_t*)(ws + WS_WIN), MT, NPROJ_PAD, DM}; pg8::StaticOrder S; S.init(MT, NPROJ_PAD, G, bid);
        for (int c8 = tid; c8 < NPROJ_PAD / 2; c8 += NTHR) { const int c = 2 * c8; float b0 = 0.f, b1 = 0.f;
            if (c < 7752) { b0 = a.in[I_BIN][c]; b1 = a.in[I_BIN][c + 1]; } else if (c >= 7936) { b0 = a.in[I_BIN][c - 184]; b1 = a.in[I_BIN][c - 183]; }
            *(LAS unsigned*)(lds + LDS_BIAS + c * 2) = cvt_pk(b0, b1); }
        __syncthreads();
        pg8::EpiProj E{ws, lds + LDS_BIAS};
        for (int rp = 0; rp < REP[1]; ++rp) pg8::gemm_phase<pg8::EpiProj, pg8::StaticOrder, true, true>(lds, g, S, E); }
    SEAM(1);
    if (IN(2)) { FRESH_TID(); hg_fill_lb(a, lds, tid);
        for (int rp = 0; rp < REP[2]; ++rp) for (int u = blockIdx.x; u < 2048; u += G) hgrn1_unit(a, u, lds, tid);
        { int tix = tid; asm volatile("" : "+v"(tix));
        for (int rp = 0; rp < REP[3]; ++rp) for (int k = 0; k * G < MT / 4; ++k) { const int u = k * G + ((k & 1) ? (G - 1 - (int)blockIdx.x) : (int)blockIdx.x); if (u < MT / 4) indexer_unit(a, u, lds, tix); } } }
    SEAM(2);
    if (IN(3)) { FRESH_TID(); for (int rp = 0; rp < REP[4]; ++rp) hgrn_scan(a, tid, G);
        for (int rp = 0; rp < REP[5]; ++rp) phase_attention(a, (char*)lds_raw, G, bid); }
    SEAM(3);
    if (IN(4)) { FRESH_TID(); for (int rp = 0; rp < REP[6]; ++rp) { float z[16]; unsigned qq[16], vv[16]; u32x4 stp[4]; u32x2 gwn[4];
            if ((int)blockIdx.x < 2048) hg3_load(a, blockIdx.x, tid, z, qq, vv, stp, gwn);
            hg_fill_lb(a, lds, tid);
            for (int u = blockIdx.x; u < 2048; u += G) hgrn3_unit(a, u, (u + G < 2048) ? u + G : -1, lds, tid, z, qq, vv, stp, gwn); } }
    SEAM(4);
    if (IN(5)) { FRESH_TID(); for (int rp = 0; rp < REP[7]; ++rp) {
        int kb5 = 512; asm volatile("" : "+s"(kb5));
        { pg8::Gemm g{(const bf16_t*)(ws + WS_BRA), (const bf16_t*)(ws + WS_WA), MT, DM, kb5}; pg8::StaticOrderF8 S; S.init(MT, DM, G, bid);
          pg8::EpiBranch<0> E{(bf16_t*)(ws + WS_MERGED), (const bf16_t*)(ws + WS_GATES), ws + WS_MERGED8};
          pg8::gemm_phase<pg8::EpiBranch<0>, pg8::StaticOrderF8, true, true>(lds, g, S, E); }
        { pg8::Gemm g{(const bf16_t*)(ws + WS_BRB), (const bf16_t*)(ws + WS_WB), MT, DM, kb5}; pg8::StaticOrderF8 S; S.init(MT, DM, G, bid);
          pg8::EpiBranch<1> E{(bf16_t*)(ws + WS_MERGED), (const bf16_t*)(ws + WS_GATES), ws + WS_MERGED8};
          pg8::gemm_phase<pg8::EpiBranch<1>, pg8::StaticOrderF8, true, true>(lds, g, S, E); } } }
    SEAM(6);
    if (IN(7)) { FRESH_TID(); int kb7 = DM / 2; asm volatile("" : "+s"(kb7));
        pg8::Gemm g{(const bf16_t*)(ws + WS_MERGED8), (const bf16_t*)(ws + WS_WOUT), MT, DM, kb7}; pg8::StaticOrderF8 S; S.init(MT, DM, G, bid);
        pg8::EpiResBf16 E{(bf16_t*)(ws + WS_PRE1), a.in[I_X], DN_ALPHA};
        for (int rp = 0; rp < REP[8]; ++rp) pg8::gemm_phase<pg8::EpiResBf16, pg8::StaticOrderF8, true, true>(lds, g, S, E); }
    SEAM(7);
    if (IN(8)) { FRESH_TID(); for (int rp = 0; rp < REP[9]; ++rp) phase8_router_expw(a, lds, tid, G, rp == 0, rp == 0);
        for (int rp = 1; rp < REP[10]; ++rp) phase_expert_weights(a, lds, tid, G); }
    if (IN(8) && IN(10)) { XcdBarrier b_; b_.bar = (unsigned*)(a.ws + WS_CTL) + CW_BAR; b_.x = xb_xcc_id(); b_.st = (volatile LAS unsigned*)(lds + LDS_BARST); xcd_barrier(b_); }
    if (IN(10)) { FRESH_TID(); const unsigned* ctl = (const unsigned*)(ws + WS_CTL);
        LAS int* tb = (LAS int*)(lds + LDS_MOE_TB); LAS unsigned* TE = (LAS unsigned*)(lds + LDS_MOE_TE); LAS unsigned* TOK = (LAS unsigned*)(lds + LDS_MOE_TOK);
        __syncthreads(); load_tile_base(a, tb, tid);
        if (tid < NEXP) for (int t = tb[tid]; t < tb[tid + 1]; ++t) TE[t] = (unsigned)tid;
        __syncthreads();
        const int NT = tb[NEXP];
        pg8::GroupedOrder<true> S; S.init(NT, 8, G, bid, TE, TOK);
        { const int* rows = (const int*)(ws + WS_ROWS);
          for (int i = 0; i < 8; ++i) { pg8::Unit u; if (!S.next(i, u)) break;
              if (tid < 256) { const int e = (int)TE[u.pm], pos = (u.pm - tb[e]) * 256 + tid, cnt = (int)ctl[CW_CNT + 64 * e];
                  TOK[i * 256 + tid] = (pos < cnt) ? (unsigned)rows[e * MT + pos] * (unsigned)DM : 0u; } } }
        __syncthreads();
        pg8::Gemm g{(const bf16_t*)(ws + WS_H1F8), (const bf16_t*)(ws + WS_WGU), NT * 256, 2048, DM / 2};
        pg8::EpiGateUp E{ws + WS_HH};
        for (int rp = 0; rp < REP[12]; ++rp) pg8::gemm_phase<pg8::EpiGateUp, pg8::GroupedOrder<true>, true, true>(lds, g, S, E); }
    SEAM(10);
    if (IN(11)) { FRESH_TID();
        LAS int* tb = (LAS int*)(lds + LDS_MOE_TB); LAS unsigned* TE = (LAS unsigned*)(lds + LDS_MOE_TE);
        __syncthreads(); load_tile_base(a, tb, tid);
        if (tid < NEXP) for (int t = tb[tid]; t < tb[tid + 1]; ++t) TE[t] = (unsigned)tid;
        __syncthreads();
        const int NT = tb[NEXP];
        int kd = DFF / 2; asm volatile("" : "+s"(kd));
        pg8::Gemm g{(const bf16_t*)(ws + WS_HH), (const bf16_t*)(ws + WS_WD), NT * 256, 2048, kd}; pg8::GroupedOrder<false> S; S.init(NT, 8, G, bid, TE, nullptr);
        pg8::EpiStoreBf16 E{(bf16_t*)(ws + WS_Y), DM, uni_f(G > 0 ? F8_UNSCALE : 0.f)};
        for (int rp = 0; rp < REP[13]; ++rp) pg8::gemm_phase<pg8::EpiStoreBf16, pg8::GroupedOrder<false>, true, true>(lds, g, S, E); }
    SEAM(11);
    if (IN(12)) { FRESH_TID(); LAS int* tb = (LAS int*)lds; __syncthreads(); load_tile_base(a, tb, tid);
        for (int rp = 0; rp < REP[14]; ++rp) phase_final(a, tid, G, tb); }
#undef IN
#undef SEAM
}

#ifndef MK_SPLIT
#define MK_SPLIT 0
#endif
extern "C" void kernel_launch(void* const* d_in, const int* in_sizes, int n_in, void* d_out, int out_size, void* d_ws, size_t ws_size, hipStream_t stream) {
    static int grid = 0;
    if (grid == 0) {
        int dev = 0, cus = 0, per_cu = 0;
        if (n_in != 19 || out_size != MT * DM || ws_size < WS_END) { fprintf(stderr, "kernel_launch: unexpected shapes: n_in %d out %d ws %zu (need %zu)\n", n_in, out_size, ws_size, (size_t)WS_END); grid = -1; return; }
        if (hipGetDevice(&dev) != hipSuccess || hipDeviceGetAttribute(&cus, hipDeviceAttributeMultiprocessorCount, dev) != hipSuccess) { grid = -1; return; }
        if (hipFuncSetAttribute((const void*)mk_fwd, hipFuncAttributeMaxDynamicSharedMemorySize, LDS_BYTES) != hipSuccess) { fprintf(stderr, "kernel_launch: hipFuncSetAttribute failed\n"); grid = -1; return; }
        if (hipOccupancyMaxActiveBlocksPerMultiprocessor(&per_cu, (const void*)mk_fwd, NTHR, LDS_BYTES) != hipSuccess || per_cu < 1) { fprintf(stderr, "kernel_launch: occupancy query says %d blocks/CU\n", per_cu); grid = -1; return; }
        grid = cus;
    }
    if (grid < 0) return;
    (void)hipMemsetAsync((char*)d_ws + WS_CTL, 0, 1 * MiB, stream);
    Args a{};
    for (int i = 0; i < 19; ++i) a.in[i] = (const float*)d_in[i];
    a.out = (float*)d_out; a.ws = (unsigned char*)d_ws;
#if MK_SPLIT
#ifndef MK_DUP
#define MK_DUP -1
#endif
    for (int p2 = 0; p2 < NPH + (MK_DUP >= 0 ? 1 : 0); ++p2) { const int p = (MK_DUP >= 0 && p2 > MK_DUP) ? p2 - 1 : p2;
        a.ph_lo = p; a.ph_hi = p + 1; void* args[] = {&a};
        hipError_t e = hipLaunchCooperativeKernel((const void*)mk_fwd, dim3(grid), dim3(NTHR), args, LDS_BYTES, stream);
        if (e != hipSuccess) { fprintf(stderr, "cooperative launch (phase %d) failed: %s (grid %d)\n", p, hipGetErrorString(e), grid); break; } }
#else
    a.ph_lo = 0; a.ph_hi = NPH; void* args[] = {&a};
    hipError_t e = hipLaunchCooperativeKernel((const void*)mk_fwd, dim3(grid), dim3(NTHR), args, LDS_BYTES, stream);
    if (e != hipSuccess) fprintf(stderr, "cooperative launch failed: %s (grid %d)\n", hipGetErrorString(e), grid);
#endif
}
```

```cpp
#include <hip/hip_runtime.h>
#include <hip/hip_cooperative_groups.h>
#include <cstdio>
#include <cstdint>
namespace cg = cooperative_groups;

#define LAS __attribute__((address_space(3)))
typedef unsigned short bf16_t;
typedef short bf16x8 __attribute__((ext_vector_type(8)));
typedef float f32x4 __attribute__((ext_vector_type(4)));
typedef float f32x2 __attribute__((ext_vector_type(2)));
typedef float f32x16 __attribute__((ext_vector_type(16)));
typedef unsigned u32x4 __attribute__((ext_vector_type(4)));
typedef unsigned u32x2 __attribute__((ext_vector_type(2)));

constexpr int MT = 16384, SEQ = 8192, DM = 2048, NHEAD = 8, HD = 128, NPROJ = 11848, NPROJ_PAD = 12032;
constexpr int NEXP = 32, DFF = 1024, MAXROWS = 40960;
constexpr float DN_ALPHA = 1.189207115002721f;
constexpr float LN_EPS = 1e-5f, RMS_EPS = 1e-6f;
constexpr int NWAVES = 8, NTHR = 512;
constexpr int LDS_BYTES = 163840;

constexpr size_t MiB = 1u << 20;
constexpr size_t WS_CTL = 0;
constexpr size_t WS_WIN = 1 * MiB;
constexpr size_t WS_WA = 48 * MiB, WS_WB = 52 * MiB, WS_WOUT = 56 * MiB;
constexpr size_t WS_XB = 64 * MiB;
constexpr size_t WS_MERGED = 64 * MiB;
constexpr size_t WS_AQ = 128 * MiB, WS_AI = 160 * MiB, WS_AG = 192 * MiB, WS_BQ = 224 * MiB, WS_BK = 256 * MiB, WS_BV = 288 * MiB;
constexpr size_t WS_AF = 320 * MiB;
constexpr size_t WS_IQ = 384 * MiB;
constexpr size_t WS_IKW = 400 * MiB;
constexpr size_t WS_GATES = 408 * MiB;
constexpr size_t WS_WGU = 128 * MiB;
constexpr size_t WS_WD = 384 * MiB;
constexpr size_t WS_H1F8 = 256 * MiB;
constexpr size_t WS_MASK = 536 * MiB;
constexpr size_t WS_KV = 552 * MiB;
constexpr size_t WS_PRE1 = 552 * MiB;
constexpr size_t WS_ST = 680 * MiB;
constexpr size_t WS_H1B = 680 * MiB;
constexpr size_t WS_DECAY = 744 * MiB;
constexpr size_t WS_ROWS = 745 * MiB;
constexpr size_t WS_SLOT = 747 * MiB;
constexpr size_t WS_BRA = 750 * MiB, WS_BRB = 782 * MiB;
constexpr size_t WS_MERGED8 = 616 * MiB;
constexpr size_t WS_IK2 = 814 * MiB;
constexpr size_t WS_HH = 750 * MiB;
constexpr size_t WS_XG = 830 * MiB;
constexpr size_t WS_Y = 830 * MiB;
constexpr size_t WS_WIN8 = 830 * MiB;
constexpr size_t WS_X8 = 860 * MiB;
constexpr size_t WS_END = 990 * MiB;
constexpr int CW_CNT = 1024;
constexpr int CW_NT = 4096;
constexpr int CW_TILEE = 4160;
constexpr int CW_TBASE = 4400;
constexpr int CW_BAR = 8192;
constexpr int CW_TICKET = 12288;
constexpr int LDS_BIAS = 131072;
constexpr int LDS_MOE_TB = 131072, LDS_MOE_TE = 131072 + 256, LDS_MOE_TOK = 131072 + 1024;
constexpr int LDS_BARST = LDS_BYTES - 64;
constexpr int LDS_WTAB = LDS_BYTES - 128;

__device__ __forceinline__ float bf2f(unsigned h) { return __uint_as_float(h << 16); }
__device__ __forceinline__ unsigned cvt_pk(float lo, float hi) { unsigned r; asm volatile("v_cvt_pk_bf16_f32 %0, %1, %2" : "=v"(r) : "v"(lo), "v"(hi)); return r; }
__device__ __forceinline__ unsigned cvt_pk_mfma(float lo, float hi) { unsigned r; asm volatile("s_nop 15\n\ts_nop 3\n\tv_cvt_pk_bf16_f32 %0, %1, %2" : "=v"(r) : "v"(lo), "v"(hi)); return r; }
__device__ __forceinline__ unsigned cvt_pk_to_mfma(float lo, float hi) { unsigned r; asm volatile("v_cvt_pk_bf16_f32 %0, %1, %2\n\ts_nop 1" : "=v"(r) : "v"(lo), "v"(hi)); return r; }
__device__ __forceinline__ unsigned cvt4_fp8(float a, float b, float c, float d, float s) {
    a = __builtin_amdgcn_fmed3f(a * s, -448.f, 448.f); b = __builtin_amdgcn_fmed3f(b * s, -448.f, 448.f); c = __builtin_amdgcn_fmed3f(c * s, -448.f, 448.f); d = __builtin_amdgcn_fmed3f(d * s, -448.f, 448.f);
    int w = 0; w = __builtin_amdgcn_cvt_pk_fp8_f32(a, b, w, false); w = __builtin_amdgcn_cvt_pk_fp8_f32(c, d, w, true); return (unsigned)w; }
__device__ __forceinline__ unsigned cvt1_fp8(float a, float s) { a = __builtin_amdgcn_fmed3f(a * s, -448.f, 448.f); return (unsigned)__builtin_amdgcn_cvt_pk_fp8_f32(a, a, 0, false) & 0xffu; }
__device__ __forceinline__ unsigned cvt4_fp8_nc(float a, float b, float c, float d, float s) {
    int w = 0; w = __builtin_amdgcn_cvt_pk_fp8_f32(a * s, b * s, w, false); w = __builtin_amdgcn_cvt_pk_fp8_f32(c * s, d * s, w, true); return (unsigned)w; }
constexpr float F8_WSCALE = 1024.f, F8_ASCALE = 8.f, F8_UNSCALE = 1.0f / 8192.f;
__device__ __forceinline__ float wave_sum(float v) {
#pragma unroll
    for (int o = 1; o < 64; o <<= 1) v += __shfl_xor(v, o);
    return v;
}
__device__ __forceinline__ float fast_exp(float x) { return __builtin_amdgcn_exp2f(x * 1.4426950408889634f); }
__device__ __forceinline__ float sigmoidf_(float x) { return __builtin_amdgcn_rcpf(1.0f + __expf(-x)); }
#define LDS_WAIT() asm volatile("s_waitcnt lgkmcnt(0)" ::: "memory")
template <typename T> __device__ __forceinline__ T* uni_ptr(T* p) { const unsigned long long v = (unsigned long long)p; const unsigned lo = __builtin_amdgcn_readfirstlane((unsigned)v), hi = __builtin_amdgcn_readfirstlane((unsigned)(v >> 32)); return (T*)(((unsigned long long)hi << 32) | lo); }
__device__ __forceinline__ int cur_tid(const LAS unsigned char* lds0) {
    const unsigned slot = (unsigned)__builtin_amdgcn_s_getreg((5 << 11) | 4) & 63u;
    const unsigned w = __builtin_amdgcn_readfirstlane((unsigned)((const volatile LAS unsigned char*)(lds0 + LDS_WTAB))[slot]);
    return (int)((w << 6) | __builtin_amdgcn_mbcnt_hi(~0u, __builtin_amdgcn_mbcnt_lo(~0u, 0u)));
}
__device__ __forceinline__ float uni_f(float x) { return __uint_as_float(__builtin_amdgcn_readfirstlane(__float_as_uint(x))); }

namespace pg8 {
#define PG8_LAS __attribute__((address_space(3)))
typedef unsigned short bf16_t;
typedef short bf16x8 __attribute__((ext_vector_type(8)));
typedef float f32x4 __attribute__((ext_vector_type(4)));
typedef unsigned u32x4 __attribute__((ext_vector_type(4)));
constexpr int BM = 256, BK = 64, HALF = 128, HTB = HALF * BK * 2  , STAGE_BYTES = 8 * HTB, NXCD = 8, WGM = 8;

__host__ __device__ __forceinline__ int lds_byte(int r, int c) { const int st = (r >> 4) * 2 + (c >> 5), rr = r & 15, cc = c & 31, ob = rr * 64 + cc * 2; return st * 1024 + (ob ^ (((ob >> 9) & 1) << 5)); }
__host__ __device__ __forceinline__ void stage_rc(int b, int& R, int& C) { const int st = b / 1024, sb = b % 1024, swz = sb ^ (((sb >> 9) & 1) << 5); R = (st >> 1) * 16 + swz / 64; C = (st & 1) * 32 + (swz % 64) / 2; }
__host__ __device__ __forceinline__ int perm32(int rho) { const int n = rho >> 4, i = rho & 15; return 8 * (i >> 2) + 4 * n + (i & 3); }

typedef int i32x8 __attribute__((ext_vector_type(8)));
typedef int i32x4_ __attribute__((ext_vector_type(4)));
template <bool F8> struct OperandT { typedef bf16x8 T; };
template <> struct OperandT<true> { typedef i32x8 T; };
__device__ __forceinline__ i32x8 ld_f8(const PG8_LAS unsigned char* p) { const i32x4_ lo = *(const PG8_LAS i32x4_*)p, hi = *(const PG8_LAS i32x4_*)(p + 1024); return __builtin_shufflevector(lo, hi, 0, 1, 2, 3, 4, 5, 6, 7); }
__device__ __forceinline__ f32x4 mma_f8(const i32x8 b, const i32x8 a, const f32x4 c) { return __builtin_amdgcn_mfma_scale_f32_16x16x128_f8f6f4(b, a, c, 0, 0, 0, 0, 0, 0); }
__device__ __forceinline__ f32x4 mma_f8(const bf16x8, const bf16x8, const f32x4 c) { return c; }
struct Unit { int pm, pn, pb; };
struct Gemm { const bf16_t* A; const bf16_t* Bt; int M, N, K; };

template <bool F8_, int MAP = 0> struct StaticOrderT {
    static constexpr bool GATHER = false, F8 = F8_; __device__ __forceinline__ unsigned row_off(int, int) const { return 0u; }
    int nM, nN, nwg, G, c;
    __host__ __device__ void init(int M, int N, int G_, int c_) { nM = M / BM; nN = N / BM; nwg = nM * nN; G = G_; c = c_; }
    __host__ __device__ bool next(int i, Unit& u) const {
        const long L = (long)i * G + c; if (L >= nwg) return false;
        int wgid = (int)L; { const int q = nwg / NXCD, r = nwg % NXCD, xcd = wgid % NXCD, off = wgid / NXCD; wgid = (xcd < r ? xcd * (q + 1) : r * (q + 1) + (xcd - r) * q) + off; }
        const int nig = WGM * nN, gid = wgid / nig, fm = gid * WGM, gsz = (nM - fm) < WGM ? (nM - fm) : WGM;
        u.pm = fm + ((wgid % nig) % gsz); u.pn = (wgid % nig) / gsz;
        if (MAP == 1) u.pn = u.pn < 4 ? u.pn : (u.pn < 24 ? u.pn + 4 : u.pn + 7);
        if (MAP == 2) u.pn = u.pn < 4 ? u.pn + 4 : u.pn + 24;
        u.pb = u.pn; return true;
    }
    __device__ __forceinline__ void a_ready(const Unit&) const {}
    __device__ __forceinline__ void done(const Unit&) const {}
};
typedef StaticOrderT<false> StaticOrder;
typedef StaticOrderT<true> StaticOrderF8;


__device__ __forceinline__ unsigned cvt_pk_bf16(float lo, float hi) { unsigned r; asm volatile("v_cvt_pk_bf16_f32 %0, %1, %2" : "=v"(r) : "v"(lo), "v"(hi)); return r; }
__device__ __forceinline__ float sigm(float x) { return __builtin_amdgcn_rcpf(1.0f + __expf(-x)); }

template <bool F8IN> struct EpiProjT {
    static constexpr bool PERM = true, AFTER_DRAIN = false;
    unsigned char* ws; const PG8_LAS unsigned char* lbias;
    __device__ __forceinline__ void operator()(const f32x4 (&acc)[2][2][4][2], const Unit& u, int wr, int wc, int fr, int fq) const {
        const int pn = u.pn, row0 = u.pm * BM + wr * 64 + fr, lc0 = wc * 32 + 8 * fq; constexpr float usc = F8IN ? F8_UNSCALE : 1.0f;
        f32x4 bv[2][2];
#pragma unroll
        for (int bj = 0; bj < 2; ++bj) { const u32x4 bw = *(const PG8_LAS u32x4*)(lbias + (size_t)(pn * 256 + lc0 + bj * HALF) * 2);
            bv[bj][0] = (f32x4){__uint_as_float(bw.x << 16), __uint_as_float(bw.x & 0xffff0000u), __uint_as_float(bw.y << 16), __uint_as_float(bw.y & 0xffff0000u)};
            bv[bj][1] = (f32x4){__uint_as_float(bw.z << 16), __uint_as_float(bw.z & 0xffff0000u), __uint_as_float(bw.w << 16), __uint_as_float(bw.w & 0xffff0000u)}; }
        if (pn >= 4 && pn < 8) {
            float* base = (float*)(ws + WS_AF);
#pragma unroll
            for (int ai = 0; ai < 2; ++ai)
#pragma unroll
                for (int m = 0; m < 4; ++m) { float* rowp = base + (size_t)(row0 + ai * HALF + m * 16) * 1024 + (pn - 4) * 256 + lc0;
#pragma unroll
                    for (int bj = 0; bj < 2; ++bj) { *(f32x4*)(rowp + bj * HALF) = acc[ai][bj][m][0] * usc + bv[bj][0]; *(f32x4*)(rowp + bj * HALF + 4) = acc[ai][bj][m][1] * usc + bv[bj][1]; } }
            return;
        }
        bf16_t* base; int ldc, colt; bool sg = false;
        if (pn < 28) { const int s = pn >> 2, idx = (s == 0) ? 0 : s - 1; base = (bf16_t*)(ws + WS_AQ + (size_t)idx * (32 * MiB)); ldc = 1024; colt = (pn & 3) * 256; }
        else if (pn < 30) { base = (bf16_t*)(ws + WS_IQ); ldc = 512; colt = (pn - 28) * 256; }
        else if (pn == 30) { base = (bf16_t*)(ws + WS_IKW); ldc = 256; colt = 0; }
        else { base = (bf16_t*)(ws + WS_GATES); ldc = 4096; colt = (pn - 31) * 256; sg = true; }
#pragma unroll
        for (int ai = 0; ai < 2; ++ai)
#pragma unroll
            for (int m = 0; m < 4; ++m) { bf16_t* rowp = base + (size_t)(row0 + ai * HALF + m * 16) * ldc + colt + lc0;
#pragma unroll
                for (int bj = 0; bj < 2; ++bj) { f32x4 v0 = acc[ai][bj][m][0] * usc + bv[bj][0], v1 = acc[ai][bj][m][1] * usc + bv[bj][1];
                    if (sg) { v0 = (f32x4){sigm(v0[0]), sigm(v0[1]), sigm(v0[2]), sigm(v0[3])}; v1 = (f32x4){sigm(v1[0]), sigm(v1[1]), sigm(v1[2]), sigm(v1[3])}; }
                    u32x4 w; w.x = cvt_pk_bf16(v0[0], v0[1]); w.y = cvt_pk_bf16(v0[2], v0[3]); w.z = cvt_pk_bf16(v1[0], v1[1]); w.w = cvt_pk_bf16(v1[2], v1[3]);
                    *(u32x4*)(rowp + bj * HALF) = w;
                    if (pn == 30 && bj == 0 && lc0 < 64) {
                        const int tok = row0 + ai * HALF + m * 16;
                        *(u32x4*)((bf16_t*)(ws + WS_IK2) + ((size_t)((tok >> 5) * 4 + (lc0 >> 4)) * 64 + ((lc0 >> 3) & 1) * 32 + (tok & 31)) * 8) = w; } } }
    }
};

typedef EpiProjT<false> EpiProj;
__device__ __forceinline__ f32x4 bf4lo(u32x4 w) { return (f32x4){__uint_as_float(w.x << 16), __uint_as_float(w.x & 0xffff0000u), __uint_as_float(w.y << 16), __uint_as_float(w.y & 0xffff0000u)}; }
__device__ __forceinline__ f32x4 bf4hi(u32x4 w) { return (f32x4){__uint_as_float(w.z << 16), __uint_as_float(w.z & 0xffff0000u), __uint_as_float(w.w << 16), __uint_as_float(w.w & 0xffff0000u)}; }

template <int MODE> struct EpiBranch {
    static constexpr bool PERM = true, AFTER_DRAIN = false;
    bf16_t* merged; const bf16_t* gates; unsigned char* merged8;
    __device__ __forceinline__ void operator()(const f32x4 (&acc)[2][2][4][2], const Unit& u, int wr, int wc, int fr, int fq) const {
        const int row0 = u.pm * BM + wr * 64 + fr, col0 = u.pn * BM + wc * 32 + 8 * fq;
#pragma unroll
        for (int ai = 0; ai < 2; ++ai)
#pragma unroll
            for (int m = 0; m < 4; ++m) { const size_t r = (size_t)(row0 + ai * HALF + m * 16);
#pragma unroll
                for (int bj = 0; bj < 2; ++bj) { const int c = col0 + bj * HALF;
                    const u32x4 gw = *(const u32x4*)(gates + r * 4096 + MODE * 2048 + c);
                    f32x4 v0 = acc[ai][bj][m][0] * (bf4lo(gw) * F8_UNSCALE), v1 = acc[ai][bj][m][1] * (bf4hi(gw) * F8_UNSCALE);
                    if (MODE == 1) { const u32x4 pw = *(const u32x4*)(merged + r * 2048 + c); v0 = v0 + bf4lo(pw); v1 = v1 + bf4hi(pw);
                        *(u32x2*)(merged8 + r * 2048 + c) = (u32x2){cvt4_fp8(v0[0], v0[1], v0[2], v0[3], F8_ASCALE), cvt4_fp8(v1[0], v1[1], v1[2], v1[3], F8_ASCALE)}; }
                    else { u32x4 w; w.x = cvt_pk_bf16(v0[0], v0[1]); w.y = cvt_pk_bf16(v0[2], v0[3]); w.z = cvt_pk_bf16(v1[0], v1[1]); w.w = cvt_pk_bf16(v1[2], v1[3]);
                        *(u32x4*)(merged + r * 2048 + c) = w; } } }
    }
};

struct EpiResBf16 {
    static constexpr bool PERM = true, AFTER_DRAIN = false;
    bf16_t* C; const float* x; float alpha;
    __device__ __forceinline__ void operator()(const f32x4 (&acc)[2][2][4][2], const Unit& u, int wr, int wc, int fr, int fq) const {
        const int row0 = u.pm * BM + wr * 64 + fr, col0 = u.pn * BM + wc * 32 + 8 * fq;
#pragma unroll
        for (int ai = 0; ai < 2; ++ai)
#pragma unroll
            for (int m = 0; m < 4; ++m) { const size_t off = (size_t)(row0 + ai * HALF + m * 16) * 2048 + col0;
#pragma unroll
                for (int bj = 0; bj < 2; ++bj) { const f32x4 x0 = *(const f32x4*)(x + off + bj * HALF), x1 = *(const f32x4*)(x + off + bj * HALF + 4);
                    const f32x4 v0 = x0 * alpha + acc[ai][bj][m][0] * F8_UNSCALE, v1 = x1 * alpha + acc[ai][bj][m][1] * F8_UNSCALE;
                    u32x4 w; w.x = cvt_pk_bf16(v0[0], v0[1]); w.y = cvt_pk_bf16(v0[2], v0[3]); w.z = cvt_pk_bf16(v1[0], v1[1]); w.w = cvt_pk_bf16(v1[2], v1[3]);
                    *(u32x4*)(C + off + bj * HALF) = w; } }
    }
};

struct EpiGateUp {
    static constexpr bool PERM = true, AFTER_DRAIN = false;
    unsigned char* H;
    __device__ __forceinline__ void operator()(const f32x4 (&acc)[2][2][4][2], const Unit& u, int wr, int wc, int fr, int fq) const {
        const int row0 = u.pm * BM + wr * 64 + fr, hc0 = u.pn * 128 + wc * 16 + 4 * fq;
#pragma unroll
        for (int ai = 0; ai < 2; ++ai)
#pragma unroll
            for (int m = 0; m < 4; ++m) { unsigned char* rowp = H + (size_t)(row0 + ai * HALF + m * 16) * 1024 + hc0;
#pragma unroll
                for (int bj = 0; bj < 2; ++bj) { const f32x4 g = acc[ai][bj][m][0], up = acc[ai][bj][m][1];
                    f32x4 h;
#pragma unroll
                    for (int j = 0; j < 4; ++j) { const float gj = g[j] * F8_UNSCALE; h[j] = gj * sigm(gj) * (up[j] * F8_UNSCALE); }
                    *(unsigned*)(rowp + bj * 64) = cvt4_fp8(h[0], h[1], h[2], h[3], F8_ASCALE); } }
    }
};

struct EpiStoreBf16 {
    static constexpr bool PERM = true, AFTER_DRAIN = false;
    bf16_t* O; int ldc; float one;
    __device__ __forceinline__ void operator()(const f32x4 (&acc)[2][2][4][2], const Unit& u, int wr, int wc, int fr, int fq) const {
        const int row0 = u.pm * BM + wr * 64 + fr, col0 = u.pn * BM + wc * 32 + 8 * fq;
#pragma unroll
        for (int ai = 0; ai < 2; ++ai)
#pragma unroll
            for (int m = 0; m < 4; ++m) { bf16_t* rowp = O + (size_t)(row0 + ai * HALF + m * 16) * ldc + col0;
#pragma unroll
                for (int bj = 0; bj < 2; ++bj) { const f32x4 v0 = acc[ai][bj][m][0] * one, v1 = acc[ai][bj][m][1] * one;
                    u32x4 w; w.x = cvt_pk_bf16(v0[0], v0[1]); w.y = cvt_pk_bf16(v0[2], v0[3]); w.z = cvt_pk_bf16(v1[0], v1[1]); w.w = cvt_pk_bf16(v1[2], v1[3]);
                    *(u32x4*)(rowp + bj * HALF) = w; } }
    }
};

template <bool GATH> struct GroupedOrder {
    static constexpr bool GATHER = GATH, F8 = true;
    int nM, nN, nwg, G, c; const PG8_LAS unsigned* tile_e; const PG8_LAS unsigned* tokoff;
    __device__ __forceinline__ void init(int nT, int nN_, int G_, int c_, const PG8_LAS unsigned* te, const PG8_LAS unsigned* to) { nM = nT; nN = nN_; nwg = nM * nN; G = G_; c = c_; tile_e = te; tokoff = to; }
    __device__ __forceinline__ bool next(int i, Unit& u) const {
        const long L = (long)i * G + c; if (L >= nwg) return false;
        int wgid = (int)L; { const int q = nwg / NXCD, r = nwg % NXCD, xcd = wgid % NXCD, off = wgid / NXCD; wgid = (xcd < r ? xcd * (q + 1) : r * (q + 1) + (xcd - r) * q) + off; }
        const int nig = WGM * nN, gid = wgid / nig, fm = gid * WGM, gsz = (nM - fm) < WGM ? (nM - fm) : WGM;
        u.pm = fm + ((wgid % nig) % gsz); u.pn = (wgid % nig) / gsz; u.pb = (int)tile_e[u.pm] * nN + u.pn; return true;
    }
    __device__ __forceinline__ unsigned row_off(int ui, int r) const { return tokoff[ui * 256 + r]; }
    __device__ __forceinline__ void a_ready(const Unit&) const {}
    __device__ __forceinline__ void done(const Unit&) const {}
};

template <class Epi, class Sched, bool ALIGN_EPI = false, bool SP2 = false>
__device__ __forceinline__ void gemm_phase(PG8_LAS unsigned char* lds, const Gemm g, const Sched& S, const Epi& E) {
    int tid_ = cur_tid((const LAS unsigned char*)lds); asm volatile("" : "+v"(tid_));
    const int tid = tid_, wid = __builtin_amdgcn_readfirstlane(tid >> 6), lane = tid & 63, wr = wid >> 2, wc = wid & 3, fr = lane & 15, fq = lane >> 4;
    const int K = g.K, nt = K / BK;
    constexpr bool F8 = Sched::F8;
    constexpr bool GATHER = Sched::GATHER;
    unsigned voffA[2], voffB[2], cAoff[2]; int rA[2];
#pragma unroll
    for (int i = 0; i < 2; ++i) { int R, C; stage_rc(tid * 16 + i * 8192, R, C); const int Rb = Epi::PERM ? ((R & ~31) + perm32(R & 31)) : R;
        voffA[i] = (unsigned)(R * K + C) * 2u; voffB[i] = (unsigned)(Rb * K + C) * 2u; cAoff[i] = (unsigned)C * 2u; rA[i] = R; }
    const size_t kstep = (size_t)(BK * 2);
    const size_t hstep = (size_t)HALF * K * 2;
    const size_t tstep = 2 * hstep;
    const unsigned ldsw = (unsigned)wid * 1024u;
    const int aoff = lds_byte(wr * 64 + fr, fq * 8), boff = lds_byte(wc * 32 + fr, fq * 8);
#define PG8_SA(b, h) (((b) * 2 + (h)) * HTB)
#define PG8_SB(b, h) ((4 + (b) * 2 + (h)) * HTB)
#define PG8_GLDS(gbase, vo, ldsoff) do { if constexpr (F8) asm volatile("s_mov_b32 m0, %2\n\ts_nop 0\n\tglobal_load_lds_dwordx4 %0, %1" :: "v"(vo), "s"((const char*)(gbase)), "s"((unsigned)(uintptr_t)(lds + (ldsoff))) : "memory", "m0"); \
        else __builtin_amdgcn_global_load_lds((const unsigned*)((const char*)(gbase) + (vo)), (PG8_LAS unsigned*)(lds + (ldsoff)), 16, 0, 0); } while (0)
#define PG8_STAGE(bufoff, gbase, voff) do { _Pragma("unroll") for (int _i = 0; _i < 2; ++_i) PG8_GLDS(gbase, (voff)[_i], (bufoff) + ldsw + _i * 8192); } while (0)
#define PG8_STAGE_A(bufoff, gbase, h, nx) do { _Pragma("unroll") for (int _i = 0; _i < 2; ++_i) { const unsigned vo_ = GATHER ? (((nx) && has_next) ? PG8_GOFF(ui + 1, h, _i) : vAc[h][_i]) : voffA[_i]; \
        PG8_GLDS(gbase, vo_, (bufoff) + ldsw + _i * 8192); } } while (0)
#define PG8_LDA(dst, b, h) do { _Pragma("unroll") for (int m = 0; m < 4; ++m) { if constexpr (F8) dst[m][0] = ld_f8(lds + PG8_SA(b, h) + aoff + m * 2048); \
        else { _Pragma("unroll") for (int k = 0; k < 2; ++k) dst[m][k] = *(const PG8_LAS OpT*)(lds + PG8_SA(b, h) + aoff + m * 2048 + k * 1024); } } } while (0)
#define PG8_LDB(dst, b, h) do { _Pragma("unroll") for (int n = 0; n < 2; ++n) { if constexpr (F8) dst[n][0] = ld_f8(lds + PG8_SB(b, h) + boff + n * 2048); \
        else { _Pragma("unroll") for (int k = 0; k < 2; ++k) dst[n][k] = *(const PG8_LAS OpT*)(lds + PG8_SB(b, h) + boff + n * 2048 + k * 1024); } } } while (0)
#define PG8_MMA(ai, bj, At, Bt) do { if constexpr (F8) __builtin_amdgcn_sched_barrier(0); __builtin_amdgcn_s_setprio(1); _Pragma("unroll") for (int m = 0; m < 4; ++m) _Pragma("unroll") for (int n = 0; n < 2; ++n) { \
        if constexpr (F8) acc[ai][bj][m][n] = mma_f8(Bt[n][0], At[m][0], acc[ai][bj][m][n]); \
        else { _Pragma("unroll") for (int k = 0; k < 2; ++k) acc[ai][bj][m][n] = __builtin_amdgcn_mfma_f32_16x16x32_bf16(Bt[n][k], At[m][k], acc[ai][bj][m][n], 0, 0, 0); } } \
        __builtin_amdgcn_s_setprio(0); if constexpr (F8) __builtin_amdgcn_sched_barrier(0); } while (0)
#define PG8_WAIT_V(n) asm volatile("s_waitcnt vmcnt(" #n ")" ::: "memory")
#define PG8_WAIT_L(n) asm volatile("s_waitcnt lgkmcnt(" #n ")" ::: "memory")
#define PG8_BAR __builtin_amdgcn_s_barrier()
#define PG8_SCHED __builtin_amdgcn_sched_barrier(0)
    Unit cur, nxt; int ui = 0;
    if (!S.next(0, cur)) return;
    f32x4 acc[2][2][4][2];
#pragma unroll
    for (int a = 0; a < 2; ++a)
#pragma unroll
        for (int b = 0; b < 2; ++b)
#pragma unroll
            for (int m = 0; m < 4; ++m)
#pragma unroll
                for (int n = 0; n < 2; ++n) acc[a][b][m][n] = (f32x4){0.f, 0.f, 0.f, 0.f};
    using OpT = typename OperandT<F8>::T; constexpr int NK = F8 ? 1 : 2;
    OpT At[4][NK], B0[2][NK], B1[2][NK];
    const size_t hstepA = GATHER ? 0 : hstep;
#define PG8_GOFF(ui_, h, i) (S.row_off((ui_), (h) * HALF + rA[i]) + cAoff[i])
    unsigned vAc[2][2]; bool has_next = false;
#pragma unroll
    for (int h = 0; h < 2; ++h)
#pragma unroll
        for (int i = 0; i < 2; ++i) vAc[h][i] = GATHER ? PG8_GOFF(0, h, i) : 0u;
    const char* cA = (const char*)g.A + (GATHER ? (size_t)0 : (size_t)cur.pm * tstep); const char* cB = (const char*)g.Bt + (size_t)cur.pb * tstep;
    S.a_ready(cur);
    if constexpr (SP2) {
        PG8_STAGE(PG8_SB(0, 0), cB, voffB); PG8_STAGE(PG8_SB(0, 1), cB + hstep, voffB); PG8_STAGE_A(PG8_SA(0, 0), cA, 0, false); PG8_STAGE_A(PG8_SA(0, 1), cA + hstepA, 1, false);
        if (wr == 1) PG8_BAR;
        PG8_WAIT_V(2); PG8_BAR;
        PG8_STAGE(PG8_SB(1, 0), cB + kstep, voffB); PG8_STAGE_A(PG8_SA(1, 0), cA + kstep, 0, false); PG8_STAGE(PG8_SB(1, 1), cB + hstep + kstep, voffB);
        PG8_WAIT_V(6); PG8_BAR;
    } else {
        PG8_STAGE(PG8_SB(0, 0), cB, voffB); PG8_STAGE_A(PG8_SA(0, 0), cA, 0, false); PG8_STAGE(PG8_SB(0, 1), cB + hstep, voffB); PG8_STAGE_A(PG8_SA(0, 1), cA + hstepA, 1, false);
        if (wr == 1) PG8_BAR;
        PG8_WAIT_V(4); PG8_BAR;
        PG8_STAGE(PG8_SB(1, 0), cB + kstep, voffB); PG8_STAGE_A(PG8_SA(1, 0), cA + kstep, 0, false); PG8_STAGE(PG8_SB(1, 1), cB + hstep + kstep, voffB);
        PG8_WAIT_V(6); PG8_BAR;
    }
    for (;;) {
        has_next = S.next(ui + 1, nxt);
        const char* nA = has_next ? (const char*)g.A + (GATHER ? (size_t)0 : (size_t)nxt.pm * tstep) : cA; const char* nB = has_next ? (const char*)g.Bt + (size_t)nxt.pb * tstep : cB;
        for (int t = 0; t < nt; t += 2) {
            const bool last = (t == nt - 2);
            const char* a1 = cA + (size_t)(t + 1) * kstep;
            const char* a2 = last ? nA : cA + (size_t)(t + 2) * kstep; const char* b2 = last ? nB : cB + (size_t)(t + 2) * kstep;
            const char* a3 = a2 + kstep; const char* b3 = b2 + kstep;
            if (last && has_next) S.a_ready(nxt);
            if constexpr (SP2) {
            PG8_LDB(B0, 0, 0); PG8_LDB(B1, 0, 1); PG8_SCHED; PG8_LDA(At, 0, 0); PG8_STAGE_A(PG8_SA(1, 1), a1 + hstepA, 1, false);
            PG8_WAIT_V(8); PG8_WAIT_L(0); PG8_BAR; PG8_MMA(0, 0, At, B0); PG8_MMA(0, 1, At, B1); PG8_BAR; PG8_SCHED;
            PG8_LDA(At, 0, 1); PG8_STAGE(PG8_SB(0, 0), b2, voffB); PG8_STAGE(PG8_SB(0, 1), b2 + hstep, voffB); PG8_STAGE_A(PG8_SA(0, 0), a2, 0, last);
            PG8_WAIT_V(8); PG8_WAIT_L(0); PG8_BAR; PG8_MMA(1, 0, At, B0); PG8_MMA(1, 1, At, B1); PG8_BAR; PG8_SCHED;
            PG8_LDB(B0, 1, 0); PG8_LDB(B1, 1, 1); PG8_SCHED; PG8_LDA(At, 1, 0); PG8_STAGE_A(PG8_SA(0, 1), a2 + hstepA, 1, last);
            PG8_WAIT_V(8); PG8_WAIT_L(0); PG8_BAR; PG8_MMA(0, 0, At, B0); PG8_MMA(0, 1, At, B1); PG8_BAR; PG8_SCHED;
            PG8_LDA(At, 1, 1); PG8_STAGE(PG8_SB(1, 0), b3, voffB); PG8_STAGE(PG8_SB(1, 1), b3 + hstep, voffB); PG8_STAGE_A(PG8_SA(1, 0), a3, 0, last);
            PG8_WAIT_V(8); PG8_WAIT_L(0); PG8_BAR; PG8_MMA(1, 0, At, B0); PG8_MMA(1, 1, At, B1); PG8_BAR; PG8_SCHED;
            } else {
            PG8_LDB(B0, 0, 0); PG8_SCHED; PG8_LDA(At, 0, 0); PG8_STAGE_A(PG8_SA(1, 1), a1 + hstepA, 1, false);
            PG8_WAIT_L(8); PG8_BAR; PG8_WAIT_L(0); PG8_MMA(0, 0, At, B0); PG8_BAR; PG8_SCHED;
            PG8_LDB(B1, 0, 1); PG8_STAGE(PG8_SB(0, 0), b2, voffB);
            PG8_BAR; PG8_WAIT_L(0); PG8_MMA(0, 1, At, B1); PG8_BAR;
            PG8_LDA(At, 0, 1); PG8_STAGE_A(PG8_SA(0, 0), a2, 0, last);
            PG8_BAR; PG8_WAIT_L(0); PG8_MMA(1, 0, At, B0); PG8_BAR; PG8_SCHED;
            PG8_STAGE(PG8_SB(0, 1), b2 + hstep, voffB);
            PG8_WAIT_V(6); PG8_BAR; PG8_MMA(1, 1, At, B1); PG8_BAR;
            PG8_LDB(B0, 1, 0); PG8_SCHED; PG8_LDA(At, 1, 0); PG8_STAGE_A(PG8_SA(0, 1), a2 + hstepA, 1, last);
            PG8_WAIT_L(8); PG8_BAR; PG8_WAIT_L(0); PG8_MMA(0, 0, At, B0); PG8_BAR; PG8_SCHED;
            PG8_LDB(B1, 1, 1); PG8_STAGE(PG8_SB(1, 0), b3, voffB);
            PG8_BAR; PG8_WAIT_L(0); PG8_MMA(0, 1, At, B1); PG8_BAR;
            PG8_LDA(At, 1, 1); PG8_STAGE_A(PG8_SA(1, 0), a3, 0, last);
            PG8_BAR; PG8_WAIT_L(0); PG8_MMA(1, 0, At, B0); PG8_BAR; PG8_SCHED;
            PG8_STAGE(PG8_SB(1, 1), b3 + hstep, voffB);
            PG8_WAIT_V(6); PG8_BAR; PG8_MMA(1, 1, At, B1); PG8_BAR;
            }
        }
        if constexpr (ALIGN_EPI) { if (wr == 0) PG8_BAR; }
        if constexpr (!Epi::AFTER_DRAIN) { int fr_ = fr, fq_ = fq; asm volatile("" : "+v"(fr_), "+v"(fq_));
            E(acc, cur, wr, wc, fr_, fq_); S.done(cur); }
        if (!has_next) break;
#pragma unroll
        for (int a = 0; a < 2; ++a)
#pragma unroll
            for (int b = 0; b < 2; ++b)
#pragma unroll
                for (int m = 0; m < 4; ++m)
#pragma unroll
                    for (int n = 0; n < 2; ++n) acc[a][b][m][n] = (f32x4){0.f, 0.f, 0.f, 0.f};
        cur = nxt; cA = nA; cB = nB; ++ui;
#pragma unroll
        for (int h = 0; h < 2; ++h)
#pragma unroll
            for (int i = 0; i < 2; ++i) if (GATHER) vAc[h][i] = PG8_GOFF(ui, h, i);
        if constexpr (ALIGN_EPI) { if (wr == 1) PG8_BAR; }
    }
    PG8_WAIT_V(0);
    if constexpr (!ALIGN_EPI) { if (wr == 0) PG8_BAR; }
    PG8_BAR;
    if constexpr (Epi::AFTER_DRAIN) { E.fused(acc, cur, wr, wc, fr, fq, lds, wid, lane); S.done(cur); }
#undef PG8_SA
#undef PG8_SB
#undef PG8_STAGE
#undef PG8_STAGE_A
#undef PG8_GOFF
#undef PG8_LDA
#undef PG8_LDB
#undef PG8_MMA
#undef PG8_WAIT_V
#undef PG8_WAIT_L
#undef PG8_BAR
#undef PG8_SCHED
}
}
#define XB_TMO      128
#define XB_XCNT(j)  (256  + 64 * (j))
#define XB_XSUB(j)  (1280 + 64 * (j))
#define XB_XGEN(j)  (2304 + 64 * (j))
#define XB_TOP      3328
#define XB_TOPGEN   3392
#define XCD_BAR_WORDS 3456
#define XB_SPIN_CAP (1u << 18)

__device__ __forceinline__ unsigned xb_ld(unsigned* p)              { return __hip_atomic_load(p, __ATOMIC_RELAXED, __HIP_MEMORY_SCOPE_AGENT); }
__device__ __forceinline__ unsigned xb_add(unsigned* p, unsigned v) { return __hip_atomic_fetch_add(p, v, __ATOMIC_RELAXED, __HIP_MEMORY_SCOPE_AGENT); }
__device__ __forceinline__ unsigned xb_xcc_id() { return (unsigned)__builtin_amdgcn_s_getreg((3 << 11) | 20) & 0xFu; }
#define XB_SPIN(cond, bar) do { unsigned _sp = 0; while (cond) { __builtin_amdgcn_s_sleep(1); \
    if ((++_sp & 255u) == 0u) { if (xb_ld(&(bar)[XB_TMO])) break; if (_sp > XB_SPIN_CAP) { atomicAdd(&(bar)[XB_TMO], 1u); break; } } } } while (0)

struct XcdBarrier {
    unsigned* bar; unsigned x;
    volatile LAS unsigned* st;
};

__device__ __forceinline__ XcdBarrier xcd_barrier_post(unsigned* bar, volatile LAS unsigned* st) {
    XcdBarrier b; b.bar = bar; b.x = xb_xcc_id(); b.st = st;
    if (threadIdx.x == 0) (void)xb_add(&bar[XB_XCNT(b.x)], 1u);
    return b;
}
__device__ __forceinline__ void xcd_barrier_complete(unsigned* bar, unsigned x, unsigned& nloc, unsigned& nx) {
    const unsigned G = gridDim.x * gridDim.y * gridDim.z;
    unsigned sum, cnt, mine, sp = 0u;
    for (;;) {
        sum = 0u; cnt = 0u; mine = 0u;
#pragma unroll
        for (unsigned j = 0; j < 16; ++j) { const unsigned c = xb_ld(&bar[XB_XCNT(j)]); sum += c; cnt += (c > 0u) ? 1u : 0u; mine = (j == x) ? c : mine; }
        if (sum == G) break;
        __builtin_amdgcn_s_sleep(1);
        if ((++sp & 255u) == 0u) { if (xb_ld(&bar[XB_TMO])) break; if (sp > XB_SPIN_CAP) { atomicAdd(&bar[XB_TMO], 1u); break; } }
    }
    nloc = mine > 0u ? mine : 1u; nx = cnt > 0u ? cnt : 1u;
}

__device__ __forceinline__ void xcd_barrier(const XcdBarrier& b) {
    asm volatile("s_waitcnt vmcnt(0)" ::: "memory");
    __syncthreads();
    if (cur_tid((const LAS unsigned char*)b.st - LDS_BARST) == 0) {
        unsigned* bar = b.bar;
        __builtin_amdgcn_s_waitcnt(0);
        unsigned nloc = b.st[0], nx = b.st[1];
        if (nloc == 0u) { xcd_barrier_complete(bar, b.x, nloc, nx); b.st[0] = nloc; b.st[1] = nx; }
        const unsigned old = xb_add(&bar[XB_XSUB(b.x)], 1u);
        const unsigned gen = old / nloc;
        if (old + 1u == (gen + 1u) * nloc) {
            __builtin_amdgcn_fence(__ATOMIC_RELEASE, "agent");
            asm volatile("s_waitcnt vmcnt(0)" ::: "memory");
            const unsigned og = xb_add(&bar[XB_TOP], 1u);
            const unsigned tg = og / nx;
            if (og + 1u == (tg + 1u) * nx) xb_add(&bar[XB_TOPGEN], 1u);
            else XB_SPIN(xb_ld(&bar[XB_TOPGEN]) == tg, bar);
            __builtin_amdgcn_fence(__ATOMIC_ACQUIRE, "agent");
            xb_add(&bar[XB_XGEN(b.x)], 1u);
            asm volatile("s_waitcnt vmcnt(0)" ::: "memory");
        } else {
            XB_SPIN(xb_ld(&bar[XB_XGEN(b.x)]) == gen, bar);
            __builtin_amdgcn_fence(__ATOMIC_ACQUIRE, "agent");
            asm volatile("s_waitcnt vmcnt(0)" ::: "memory");
        }
    }
    __syncthreads();
}

struct Args { const float* in[19]; float* out; unsigned char* ws; int ph_lo, ph_hi; };
enum { I_X = 0, I_WIN, I_BIN, I_LB, I_HGNG, I_WA, I_WB, I_WOUT, I_LN1G, I_LN1B, I_WGRP, I_BGRP, I_WRT, I_BRT, I_WGATE, I_WUP, I_WDOWN, I_LN2G, I_LN2B };

__device__ __forceinline__ void transpose_item(const float* src4, size_t ldw, bf16_t* WT, size_t K, int dest_row0, int k0, LAS float* scr, int lane) {
    f32x4 v[8];
#pragma unroll
    for (int i = 0; i < 8; ++i) v[i] = src4 ? __builtin_nontemporal_load((const f32x4*)(src4 + (size_t)(8 * i) * ldw)) : (f32x4){0.f, 0.f, 0.f, 0.f};
#pragma unroll
    for (int i = 0; i < 8; ++i) { const int k = 8 * i + (lane >> 3), n4 = (lane & 7) * 4;
        scr[k * 33 + n4 + 0] = v[i][0]; scr[k * 33 + n4 + 1] = v[i][1]; scr[k * 33 + n4 + 2] = v[i][2]; scr[k * 33 + n4 + 3] = v[i][3]; }
    LDS_WAIT(); asm volatile("" ::: "memory");
    const int c = lane & 7;
#pragma unroll
    for (int j = 0; j < 4; ++j) { const int n = (lane >> 3) + 8 * j; const LAS float* s = scr + (8 * c) * 33 + n;
        u32x4 o; o.x = cvt_pk(s[0 * 33], s[1 * 33]); o.y = cvt_pk(s[2 * 33], s[3 * 33]); o.z = cvt_pk(s[4 * 33], s[5 * 33]); o.w = cvt_pk(s[6 * 33], s[7 * 33]);
        *(u32x4*)(WT + (size_t)(dest_row0 + n) * K + k0 + 8 * c) = o; }
    LDS_WAIT(); asm volatile("" ::: "memory");
}

__device__ __forceinline__ void transpose_item_f8(const float* src4, size_t ldw, unsigned char* WT, size_t K, int dest_row0, int k0, LAS float* scr, int lane) {
    f32x4 v[8];
#pragma unroll
    for (int i = 0; i < 8; ++i) v[i] = src4 ? __builtin_nontemporal_load((const f32x4*)(src4 + (size_t)(8 * i) * ldw)) : (f32x4){0.f, 0.f, 0.f, 0.f};
#pragma unroll
    for (int i = 0; i < 8; ++i) { const int k = 8 * i + (lane >> 3), n4 = (lane & 7) * 4;
        scr[k * 33 + n4 + 0] = v[i][0]; scr[k * 33 + n4 + 1] = v[i][1]; scr[k * 33 + n4 + 2] = v[i][2]; scr[k * 33 + n4 + 3] = v[i][3]; }
    LDS_WAIT(); asm volatile("" ::: "memory");
    const int c = lane & 3;
#pragma unroll
    for (int j = 0; j < 2; ++j) { const int n = (lane >> 2) + 16 * j; const LAS float* s = scr + (16 * c) * 33 + n;
        u32x4 o;
#pragma unroll
        for (int q = 0; q < 4; ++q) o[q] = cvt4_fp8_nc(s[(4 * q) * 33], s[(4 * q + 1) * 33], s[(4 * q + 2) * 33], s[(4 * q + 3) * 33], F8_WSCALE);
        *(u32x4*)(WT + (size_t)(dest_row0 + n) * K + k0 + 16 * c) = o; }
    LDS_WAIT(); asm volatile("" ::: "memory");
}
__device__ __forceinline__ void phase_prologue(const Args& a, LAS unsigned char* lds, int tid, int G) {
    unsigned char* ws = a.ws;
    { const float* x = a.in[I_X]; bf16_t* xb = (bf16_t*)(ws + WS_XB); const size_t n8 = (size_t)MT * DM / 8;
#pragma unroll 4
      for (size_t i = (size_t)blockIdx.x * NTHR + tid; i < n8; i += (size_t)G * NTHR) {
          const f32x4 p = __builtin_nontemporal_load((const f32x4*)(x + i * 8)), q = __builtin_nontemporal_load((const f32x4*)(x + i * 8 + 4));
          u32x4 o; o.x = cvt_pk(p[0], p[1]); o.y = cvt_pk(p[2], p[3]); o.z = cvt_pk(q[0], q[1]); o.w = cvt_pk(q[2], q[3]);
          *(u32x4*)(xb + i * 8) = o;
          *(u32x2*)(ws + WS_X8 + i * 8) = (u32x2){cvt4_fp8(p[0], p[1], p[2], p[3], F8_ASCALE), cvt4_fp8(q[0], q[1], q[2], q[3], F8_ASCALE)}; } }
    asm volatile("" : "+v"(tid));
    const int lane = tid & 63, wave = tid >> 6;
    LAS float* scr = (LAS float*)(lds + wave * 8704);
    const int gw = blockIdx.x * NWAVES + wave, NGW = G * NWAVES;
    constexpr int IT_IN = (NPROJ_PAD / 32) * (DM / 64);
    constexpr int IT_A = (DM / 32) * (1024 / 64);
    constexpr int IT_OUT = (DM / 32) * (DM / 64);
    constexpr int NIT = IT_IN + 2 * IT_A + IT_OUT;
    for (int it = gw; it < NIT; it += NGW) {
        int r = it;
        if (r < IT_IN) { const int kb = r / (NPROJ_PAD / 32), rb = r % (NPROJ_PAD / 32); const int n = rb * 32 + (lane & 7) * 4;
            int src = -1; if (n < 7752) src = n; else if (n >= 7936) src = n - 184;
            const float* p = (src >= 0) ? a.in[I_WIN] + (size_t)(kb * 64 + (lane >> 3)) * NPROJ + src : nullptr;
            const int pn = rb >> 3;
            if ((pn >= 4 && pn < 8) || (pn >= 28 && pn < 31)) transpose_item(p, NPROJ, (bf16_t*)(ws + WS_WIN), DM, rb * 32, kb * 64, scr, lane);
            else transpose_item_f8(p, NPROJ, ws + WS_WIN8, DM, rb * 32, kb * 64, scr, lane);
            continue; }
        r -= IT_IN;
        if (r < 2 * IT_A) { const int which = r / IT_A; r %= IT_A; const int kb = r / 64, rb = r % 64; const int n = rb * 32 + (lane & 7) * 4;
            const float* p = a.in[which ? I_WB : I_WA] + (size_t)(kb * 64 + (lane >> 3)) * DM + n;
            transpose_item_f8(p, DM, ws + (which ? WS_WB : WS_WA), 1024, rb * 32, kb * 64, scr, lane); continue; }
        r -= 2 * IT_A;
        { const int kb = r / 64, rb = r % 64; const int n = rb * 32 + (lane & 7) * 4;
          const float* p = a.in[I_WOUT] + (size_t)(kb * 64 + (lane >> 3)) * DM + n;
          transpose_item_f8(p, DM, ws + WS_WOUT, DM, rb * 32, kb * 64, scr, lane); }
    }
}

constexpr int EW_GU = 64 * 32, EW_D = 64 * 16, EW_E = EW_GU + EW_D;
__device__ __forceinline__ const float* ew_src(const Args& a, int it, int lane, size_t& ldw) {
    const int e = it / EW_E; int r = it % EW_E;
    if (r < EW_GU) { const int kb = r / 64, rb = r % 64; const int n = rb * 32 + (lane & 7) * 4; const int j = n >> 3, up = (n >> 2) & 1; ldw = DFF;
        return a.in[up ? I_WUP : I_WGATE] + (size_t)e * DM * DFF + (size_t)(kb * 64 + (lane >> 3)) * DFF + 4 * j; }
    r -= EW_GU; const int kb = r / 64, rb = r % 64; const int n = rb * 32 + (lane & 7) * 4; ldw = DM;
    return a.in[I_WDOWN] + (size_t)e * DFF * DM + (size_t)(kb * 64 + (lane >> 3)) * DM + n;
}
__device__ __forceinline__ void ew_store(const Args& a, int it, const f32x4 (&v)[8], LAS float* scr, int lane) {
    const int e = it / EW_E; int r = it % EW_E; unsigned char* WT; size_t K; int rb, kb;
    if (r < EW_GU) { kb = r / 64; rb = r % 64; WT = a.ws + WS_WGU + (size_t)e * 2048 * 2048; K = 2048; }
    else { r -= EW_GU; kb = r / 64; rb = r % 64; WT = a.ws + WS_WD + (size_t)e * 2048 * 1024; K = 1024; }
#pragma unroll
    for (int i = 0; i < 8; ++i) { const int k = 8 * i + (lane >> 3), n4 = (lane & 7) * 4;
        scr[k * 33 + n4 + 0] = v[i][0]; scr[k * 33 + n4 + 1] = v[i][1]; scr[k * 33 + n4 + 2] = v[i][2]; scr[k * 33 + n4 + 3] = v[i][3]; }
    LDS_WAIT(); asm volatile("" ::: "memory");
    const int c = lane & 3;
#pragma unroll
    for (int j = 0; j < 2; ++j) { const int n = (lane >> 2) + 16 * j; const LAS float* s = scr + (16 * c) * 33 + n;
        u32x4 o;
#pragma unroll
        for (int q = 0; q < 4; ++q) o[q] = cvt4_fp8_nc(s[(4 * q) * 33], s[(4 * q + 1) * 33], s[(4 * q + 2) * 33], s[(4 * q + 3) * 33], F8_WSCALE);
        *(u32x4*)(WT + (size_t)(rb * 32 + n) * K + kb * 64 + 16 * c) = o; }
    LDS_WAIT(); asm volatile("" ::: "memory");
}
__device__ __forceinline__ void phase_expert_weights(const Args& a, LAS unsigned char* lds, int tid, int G) {
    const int lane = tid & 63, wave = tid >> 6;
    LAS float* scr = (LAS float*)(lds + wave * 8704);
    const int gw = blockIdx.x * NWAVES + wave, NGW = G * NWAVES, NIT = NEXP * EW_E;
    int it = gw; if (it >= NIT) return;
    f32x4 v[8]; { size_t ldw; const float* p = ew_src(a, it, lane, ldw);
#pragma unroll
        for (int i = 0; i < 8; ++i) v[i] = *(const f32x4*)(p + (size_t)(8 * i) * ldw); }
    for (;;) {
        const int nx = it + NGW; const bool has = nx < NIT;
        f32x4 vn[8];
        if (has) { size_t ldw; const float* p = ew_src(a, nx, lane, ldw);
#pragma unroll
            for (int i = 0; i < 8; ++i) vn[i] = *(const f32x4*)(p + (size_t)(8 * i) * ldw); }
        ew_store(a, it, v, scr, lane);
        if (!has) break;
#pragma unroll
        for (int i = 0; i < 8; ++i) v[i] = vn[i];
        it = nx;
    }
}

constexpr int HG_QD = 0, HG_KD = 17408, HG_P = 34816, HG_VT = 44032, HG_SEG = 62464, HG_RED = 64512;
constexpr int HG_LBT = 66560;
constexpr int HG_NGT = 70656;
constexpr int HG_ST = 74752, HG_STLD = 136;
constexpr int HG_LD128 = 136, HG_LD64 = 72;

struct HgPrep { float cum[16]; float kh[16]; float tot; };
__device__ __forceinline__ void hg_fill_lb(const Args& a, LAS unsigned char* lds, int tid) {
    for (int i = tid; i < 1024; i += NTHR) { const float l0 = a.in[I_LB][i], l1 = a.in[I_LB][1024 + i]; *(LAS float*)(lds + HG_LBT + i * 4) = 1.0f / (1.0f + __expf(l1 - l0)); *(LAS float*)(lds + HG_NGT + i * 4) = a.in[I_HGNG][i]; }
    __syncthreads();
}
__device__ __forceinline__ void hg_prep(HgPrep& P, const float (&z)[16], float lb, int d, int seg, LAS unsigned char* lds) {
    float run = 0.f;
#pragma unroll
    for (int j = 0; j < 16; ++j) { const float sg = sigmoidf_(z[j]); const float f = lb + (1.0f - lb) * sg; run += __logf(f); P.cum[j] = run; P.kh[j] = (1.0f - lb) * (1.0f - sg); }
    LAS float* segs = (LAS float*)(lds + HG_SEG);
    segs[seg * 128 + d] = run;
    __syncthreads();
    float off = 0.f, tot = 0.f;
#pragma unroll
    for (int s = 0; s < 4; ++s) { const float v = segs[s * 128 + d]; tot += v; if (s < seg) off += v; }
#pragma unroll
    for (int j = 0; j < 16; ++j) P.cum[j] += off;
    P.tot = tot;
}
__device__ __forceinline__ void hg_write_vt(const unsigned (&vv)[16], int d, int seg, LAS unsigned char* lds) {
    u32x4 w0, w1;
    w0.x = vv[0] | (vv[1] << 16); w0.y = vv[2] | (vv[3] << 16); w0.z = vv[4] | (vv[5] << 16); w0.w = vv[6] | (vv[7] << 16);
    w1.x = vv[8] | (vv[9] << 16); w1.y = vv[10] | (vv[11] << 16); w1.z = vv[12] | (vv[13] << 16); w1.w = vv[14] | (vv[15] << 16);
    LAS unsigned char* p = lds + HG_VT + d * (HG_LD64 * 2) + seg * 32;
    *(LAS u32x4*)p = w0; *(LAS u32x4*)(p + 16) = w1;
}

__device__ __forceinline__ void hgrn1_unit(const Args& a, int unit, LAS unsigned char* lds, int tid) {
    unsigned char* ws = a.ws;
    const int lane = tid & 63, wave = tid >> 6, d = tid & 127, seg = tid >> 7;
    const int b = unit >> 10, h = (unit >> 7) & 7, n = unit & 127, tok0 = b * SEQ + n * 64;
    float z[16]; unsigned vv[16];
    { const float* AF = (const float*)(ws + WS_AF); const bf16_t* AI = (const bf16_t*)(ws + WS_AI);
#pragma unroll
      for (int j = 0; j < 16; ++j) z[j] = AF[(size_t)(tok0 + seg * 16 + j) * 1024 + h * 128 + d];
#pragma unroll
      for (int j = 0; j < 16; ++j) vv[j] = AI[(size_t)(tok0 + seg * 16 + j) * 1024 + h * 128 + d]; }
    const float lbv = *(const LAS float*)(lds + HG_LBT + (h * 128 + d) * 4);
    HgPrep P;
    hg_prep(P, z, lbv, d, seg, lds);
    { unsigned pk[8];
#pragma unroll
      for (int j = 0; j < 8; ++j) pk[j] = cvt_pk(P.kh[2 * j] * __expf(P.tot - P.cum[2 * j]), P.kh[2 * j + 1] * __expf(P.tot - P.cum[2 * j + 1]));
      LAS unsigned char* p = lds + HG_KD + d * (HG_LD64 * 2) + seg * 32;
      *(LAS u32x4*)p = (u32x4){pk[0], pk[1], pk[2], pk[3]}; *(LAS u32x4*)(p + 16) = (u32x4){pk[4], pk[5], pk[6], pk[7]}; }
    if (seg == 0) ((float*)(ws + WS_DECAY))[(size_t)unit * 128 + d] = __expf(P.tot);
    hg_write_vt(vv, d, seg, lds);
    __syncthreads();
    const int fr = lane & 15, fq = lane >> 4;
    bf16x8 af[2];
#pragma unroll
    for (int ks = 0; ks < 2; ++ks) af[ks] = *(const LAS bf16x8*)(lds + HG_KD + (16 * wave + fr) * (HG_LD64 * 2) + (32 * ks + 8 * fq) * 2);
    float* kvo = (float*)(ws + WS_KV) + (size_t)unit * 16384;
#pragma unroll
    for (int vb = 0; vb < 8; ++vb) {
        f32x4 acc = {0.f, 0.f, 0.f, 0.f};
#pragma unroll
        for (int ks = 0; ks < 2; ++ks) { const bf16x8 bfr = *(const LAS bf16x8*)(lds + HG_VT + (16 * vb + fr) * (HG_LD64 * 2) + (32 * ks + 8 * fq) * 2);
            acc = __builtin_amdgcn_mfma_f32_16x16x32_bf16(af[ks], bfr, acc, 0, 0, 0); }
        *(f32x4*)(kvo + (size_t)(16 * vb + fr) * 128 + 16 * wave + 4 * fq) = acc;
    }
    __syncthreads();
}

__device__ __forceinline__ void hgrn_scan(const Args& a, int tid, int G) {
    unsigned char* ws = a.ws;
    const float* KV = (const float*)(ws + WS_KV); const float* DEC = (const float*)(ws + WS_DECAY); unsigned* ST = (unsigned*)(ws + WS_ST);
    for (int g = blockIdx.x * NTHR + tid; g < 16 * 8192; g += G * NTHR) {
        const int bh = g >> 13, rem = g & 8191, v = rem >> 6, d2 = (rem & 63) * 2;
        float s0 = 0.f, s1 = 0.f;
        for (int n0 = 0; n0 < 128; n0 += 8) {
            f32x2 kv[8], dc[8];
#pragma unroll
            for (int j = 0; j < 8; ++j) { const size_t unit = (size_t)bh * 128 + n0 + j; kv[j] = *(const f32x2*)(KV + unit * 16384 + v * 128 + d2); dc[j] = *(const f32x2*)(DEC + unit * 128 + d2); }
#pragma unroll
            for (int j = 0; j < 8; ++j) { const size_t unit = (size_t)bh * 128 + n0 + j; ST[(unit * 16384 + v * 128 + d2) >> 1] = cvt_pk(s0, s1);
                s0 = dc[j][0] * s0 + kv[j][0]; s1 = dc[j][1] * s1 + kv[j][1]; }
        }
    }
}

__device__ __forceinline__ void hg3_load(const Args& a, int unit, int tid, float (&z)[16], unsigned (&qq)[16], unsigned (&vv)[16], u32x4 (&stp)[4], u32x2 (&gwv)[4]) {
    unsigned char* ws = a.ws; const int d = tid & 127, seg = tid >> 7;
    const int b = unit >> 10, h = (unit >> 7) & 7, n = unit & 127, tok0 = b * SEQ + n * 64;
    const float* AF = (const float*)(ws + WS_AF); const bf16_t* AI = (const bf16_t*)(ws + WS_AI); const bf16_t* AQ = (const bf16_t*)(ws + WS_AQ);
#pragma unroll
    for (int j = 0; j < 16; ++j) z[j] = AF[(size_t)(tok0 + seg * 16 + j) * 1024 + h * 128 + d];
#pragma unroll
    for (int j = 0; j < 16; ++j) qq[j] = AQ[(size_t)(tok0 + seg * 16 + j) * 1024 + h * 128 + d];
#pragma unroll
    for (int j = 0; j < 16; ++j) vv[j] = AI[(size_t)(tok0 + seg * 16 + j) * 1024 + h * 128 + d];
    { const bf16_t* ST = (const bf16_t*)(ws + WS_ST) + (size_t)unit * 16384;
#pragma unroll
      for (int i = 0; i < 4; ++i) stp[i] = *(const u32x4*)(ST + (size_t)(tid + NTHR * i) * 8); }
    { const int lane = tid & 63, wave = tid >> 6, t_ = 16 * (wave & 3) + (lane & 15); const bf16_t* AG = (const bf16_t*)(ws + WS_AG);
#pragma unroll
      for (int vi = 0; vi < 4; ++vi) gwv[vi] = *(const u32x2*)(AG + (size_t)(tok0 + t_) * 1024 + h * 128 + 16 * (4 * (wave >> 2) + vi) + 4 * (lane >> 4)); }
}
__device__ __forceinline__ void hgrn3_unit(const Args& a, int unit, int next_unit, LAS unsigned char* lds, int tid, float (&z)[16], unsigned (&qq)[16], unsigned (&vv)[16], u32x4 (&stp)[4], u32x2 (&gwn)[4]) {
    unsigned char* ws = a.ws;
    const int lane = tid & 63, wave = tid >> 6, d = tid & 127, seg = tid >> 7;
    const int b = unit >> 10, h = (unit >> 7) & 7, n = unit & 127, tok0 = b * SEQ + n * 64;
    const float lbv = *(const LAS float*)(lds + HG_LBT + (h * 128 + d) * 4);
    u32x2 gwv[4];
#pragma unroll
    for (int vi = 0; vi < 4; ++vi) gwv[vi] = gwn[vi];
#ifndef HG3_RA
#define HG3_RA 1
#define HG3_RB 1
#define HG3_RC 1
#endif
    for (int ra = 0; ra < HG3_RA; ++ra) {
    HgPrep P;
    hg_prep(P, z, lbv, d, seg, lds);
    {
#pragma unroll
      for (int j = 0; j < 16; ++j) { const float q = bf2f(qq[j]); const float qs = q * sigmoidf_(q);
          const float qd = qs * __expf(P.cum[j]), kd = P.kh[j] * __expf(-P.cum[j]);
          const int t = seg * 16 + j;
          *(LAS bf16_t*)(lds + HG_QD + (t * HG_LD128 + d) * 2) = (bf16_t)(cvt_pk(qd, 0.f) & 0xffffu);
          *(LAS bf16_t*)(lds + HG_KD + (t * HG_LD128 + d) * 2) = (bf16_t)(cvt_pk(kd, 0.f) & 0xffffu); } }
    hg_write_vt(vv, d, seg, lds);
#pragma unroll
    for (int i = 0; i < 4; ++i) { const int id = tid + NTHR * i; *(LAS u32x4*)(lds + HG_ST + (id >> 4) * (HG_STLD * 2) + (id & 15) * 16) = stp[i]; }
    __syncthreads();
    }
    if (next_unit >= 0) hg3_load(a, next_unit, tid, z, qq, vv, stp, gwn);
    const int fr = lane & 15, fq = lane >> 4;
    for (int rb = 0; rb < HG3_RB; ++rb) {
    { const int tb = wave & 3;
      bf16x8 bq[4];
#pragma unroll
      for (int ks = 0; ks < 4; ++ks) bq[ks] = *(const LAS bf16x8*)(lds + HG_QD + ((16 * tb + fr) * HG_LD128 + 32 * ks + 8 * fq) * 2);
#pragma unroll
      for (int si = 0; si < 2; ++si) { const int sb = 2 * (wave >> 2) + si;
          f32x4 acc = {0.f, 0.f, 0.f, 0.f};
#pragma unroll
          for (int ks = 0; ks < 4; ++ks) { const bf16x8 ak = *(const LAS bf16x8*)(lds + HG_KD + ((16 * sb + fr) * HG_LD128 + 32 * ks + 8 * fq) * 2);
              acc = __builtin_amdgcn_mfma_f32_16x16x32_bf16(ak, bq[ks], acc, 0, 0, 0); }
          const int t = 16 * tb + fr, s0 = 16 * sb + 4 * fq;
          float p[4];
#pragma unroll
          for (int r = 0; r < 4; ++r) p[r] = (s0 + r <= t) ? acc[r] : 0.f;
          *(LAS u32x2*)(lds + HG_P + (t * HG_LD64 + s0) * 2) = (u32x2){cvt_pk(p[0], p[1]), cvt_pk(p[2], p[3])}; } }
    __syncthreads();
    }
    for (int rc = 0; rc < HG3_RC; ++rc) {
    const int tb = wave & 3, t = 16 * tb + fr;
    f32x4 o[4];
    { bf16x8 bp[2], bq[4];
#pragma unroll
      for (int ks = 0; ks < 2; ++ks) bp[ks] = *(const LAS bf16x8*)(lds + HG_P + ((16 * tb + fr) * HG_LD64 + 32 * ks + 8 * fq) * 2);
#pragma unroll
      for (int ks = 0; ks < 4; ++ks) bq[ks] = *(const LAS bf16x8*)(lds + HG_QD + ((16 * tb + fr) * HG_LD128 + 32 * ks + 8 * fq) * 2);
#pragma unroll
      for (int vi = 0; vi < 4; ++vi) { const int vb = 4 * (wave >> 2) + vi;
          f32x4 acc = {0.f, 0.f, 0.f, 0.f};
#pragma unroll
          for (int ks = 0; ks < 2; ++ks) { const bf16x8 av = *(const LAS bf16x8*)(lds + HG_VT + ((16 * vb + fr) * HG_LD64 + 32 * ks + 8 * fq) * 2);
              acc = __builtin_amdgcn_mfma_f32_16x16x32_bf16(av, bp[ks], acc, 0, 0, 0); }
#pragma unroll
          for (int ks = 0; ks < 4; ++ks) { const bf16x8 as = *(const LAS bf16x8*)(lds + HG_ST + ((16 * vb + fr) * HG_STLD + 32 * ks + 8 * fq) * 2);
              acc = __builtin_amdgcn_mfma_f32_16x16x32_bf16(as, bq[ks], acc, 0, 0, 0); }
          o[vi] = acc; } }
    float ss = 0.f;
#pragma unroll
    for (int vi = 0; vi < 4; ++vi) ss += (o[vi][0] * o[vi][0] + o[vi][1] * o[vi][1]) + (o[vi][2] * o[vi][2] + o[vi][3] * o[vi][3]);
    ss += __shfl_xor(ss, 16); ss += __shfl_xor(ss, 32);
    LAS float* red = (LAS float*)(lds + HG_RED);
    if (fq == 0) red[(wave >> 2) * 64 + t] = ss;
    __syncthreads();
    const float tot = red[t] + red[64 + t];
    const float rinv = 1.0f / sqrtf(tot * (1.0f / 128.0f) + RMS_EPS);
    unsigned char* BRA = ws + WS_BRA;
#pragma unroll
    for (int vi = 0; vi < 4; ++vi) { const int v0 = 16 * (4 * (wave >> 2) + vi) + 4 * fq; const size_t off = (size_t)(tok0 + t) * 1024 + h * 128 + v0;
        const u32x2 gw = gwv[vi]; const f32x4 gn = *(const LAS f32x4*)(lds + HG_NGT + (h * 128 + v0) * 4);
        const float g0 = __uint_as_float(gw.x << 16), g1 = __uint_as_float(gw.x & 0xffff0000u), g2 = __uint_as_float(gw.y << 16), g3 = __uint_as_float(gw.y & 0xffff0000u);
        const float r0 = o[vi][0] * rinv * gn[0] * (g0 * sigmoidf_(g0)), r1 = o[vi][1] * rinv * gn[1] * (g1 * sigmoidf_(g1));
        const float r2 = o[vi][2] * rinv * gn[2] * (g2 * sigmoidf_(g2)), r3 = o[vi][3] * rinv * gn[3] * (g3 * sigmoidf_(g3));
        *(unsigned*)(BRA + off) = cvt4_fp8(r0, r1, r2, r3, F8_ASCALE); }
    __syncthreads();
    }
}


constexpr int IX_S = 0, IX_H = 131072, IX_L = 147456, IX_M = 155648, IX_C = 159744;
constexpr int IX_CAP = 512;
__device__ __forceinline__ unsigned ix_sortable(unsigned u) { return (u & 0x80000000u) ? ~u : (u | 0x80000000u); }

__device__ __forceinline__ void ix_radix_fallback(LAS unsigned* S, LAS unsigned* H, unsigned* MASK, int t0, int L, int tid) {
    const int lane = tid & 63, wave = __builtin_amdgcn_readfirstlane(tid >> 6);
    for (int q = 0; q < 4; ++q) for (int i = tid; i < L; i += NTHR) S[q * 8192 + i] = ix_sortable(S[q * 8192 + i]);
    for (int i = tid; i < 2048; i += NTHR) H[i] = 0u;
    __syncthreads();
    const int qs = wave >> 1, half = wave & 1;
    unsigned prefix = 0u; int kth = 256;
    for (int p = 0; p < 4; ++p) {
        const int shift = 24 - 8 * p;
        LAS unsigned* hist = H + (p & 1) * 1024 + qs * 256;
        for (int i = half * 64 + lane; i < L; i += 128) { const unsigned k = S[qs * 8192 + i];
            const bool in = (p == 0) || ((k >> (shift + 8)) == prefix);
            if (in) atomicAdd((unsigned*)(hist + ((k >> shift) & 255u)), 1u); }
        __syncthreads();
        const unsigned c0 = hist[255 - 4 * lane], c1 = hist[254 - 4 * lane], c2 = hist[253 - 4 * lane], c3 = hist[252 - 4 * lane];
        const int tot = (int)(c0 + c1 + c2 + c3);
        int incl = tot;
#pragma unroll
        for (int o = 1; o < 64; o <<= 1) { const int v = __shfl_up(incl, o); if (lane >= o) incl += v; }
        const unsigned long long bal = __ballot(incl >= kth);
        const int fl = __ffsll((long long)bal) - 1;
        const int rem = kth - (incl - tot);
        int dig, nk;
        if (rem <= (int)c0) { dig = 255 - 4 * lane; nk = rem; }
        else if (rem <= (int)(c0 + c1)) { dig = 254 - 4 * lane; nk = rem - (int)c0; }
        else if (rem <= (int)(c0 + c1 + c2)) { dig = 253 - 4 * lane; nk = rem - (int)(c0 + c1); }
        else { dig = 252 - 4 * lane; nk = rem - (int)(c0 + c1 + c2); }
        dig = __shfl(dig, fl); nk = __shfl(nk, fl);
        prefix = (prefix << 8) | (unsigned)dig; kth = nk;
        __syncthreads();
        if (p < 2) for (int i = tid; i < 1024; i += NTHR) H[(p & 1) * 1024 + i] = 0u;
    }
    const unsigned T = prefix;
    const int NG = L / 64;
    int tie_before = 0;
    if (half == 1) for (int g = 0; g < 64 && g < NG; ++g) { const unsigned k = S[qs * 8192 + 64 * g + lane]; tie_before += __popcll(__ballot(k == T)); }
    unsigned mlo = 0u, mhi = 0u;
    const unsigned long long lt = (1ull << lane) - 1ull;
    for (int g = 64 * half; g < NG && g < 64 * half + 64; ++g) {
        const unsigned k = S[qs * 8192 + 64 * g + lane];
        const bool eq = (k == T);
        const unsigned long long eqm = __ballot(eq);
        const int rank = tie_before + __popcll(eqm & lt);
        const bool sel = (k > T) || (eq && rank < kth);
        const unsigned long long m = __ballot(sel);
        if (lane == g - 64 * half) { mlo = (unsigned)m; mhi = (unsigned)(m >> 32); }
        tie_before += __popcll(eqm);
    }
    *(u32x2*)(MASK + (size_t)(t0 + qs) * 256 + 2 * (64 * half + lane)) = (u32x2){mlo, mhi};
    __syncthreads();
}

__device__ __forceinline__ void indexer_unit(const Args& a, int unit, LAS unsigned char* lds, int tid) {
    unsigned char* ws = a.ws;
    const int lane = tid & 63, wave = __builtin_amdgcn_readfirstlane(tid >> 6);
    const int t0 = unit * 4, b = t0 >> 13, qpos0 = t0 & (SEQ - 1), c = qpos0 >> 6, L = 64 * (c + 1);
    unsigned* MASK = (unsigned*)(ws + WS_MASK);
    if (c < 4) {
        const int qi = tid >> 7, w2 = (tid & 127) * 2;
        const unsigned m0 = (w2 * 32 < L) ? 0xffffffffu : 0u, m1 = ((w2 + 1) * 32 < L) ? 0xffffffffu : 0u;
        *(u32x2*)(MASK + (size_t)(t0 + qi) * 256 + w2) = (u32x2){m0, m1};
        return;
    }
    const bf16_t* IQ = (const bf16_t*)(ws + WS_IQ); const bf16_t* IKW = (const bf16_t*)(ws + WS_IKW);
    LAS unsigned* S = (LAS unsigned*)(lds + IX_S); LAS unsigned* H = (LAS unsigned*)(lds + IX_H); LAS unsigned* LST = (LAS unsigned*)(lds + IX_L);
    LAS unsigned* MB = (LAS unsigned*)(lds + IX_M); LAS float* MM = (LAS float*)(lds + IX_C); LAS unsigned* CC = (LAS unsigned*)(lds + IX_C + 256);
    const int r32 = lane & 31, hh = lane >> 5;
    for (int i = tid; i < 4096; i += NTHR) H[i] = 0u;
    for (int i = tid; i < 1024; i += NTHR) MB[i] = 0u;
    if (tid < 8) CC[tid] = 0u;
    bf16x8 af[4];
#pragma unroll
    for (int ks = 0; ks < 4; ++ks) af[ks] = *(const bf16x8*)(IQ + (size_t)(t0 + (r32 >> 3)) * 512 + (r32 & 7) * 64 + 16 * ks + 8 * hh);
    bf16x8 a2[2];
#pragma unroll
    for (int sI = 0; sI < 2; ++sI)
#pragma unroll
        for (int j = 0; j < 8; ++j) { const int qm = 2 * sI + (j >> 2), hm = 4 * hh + (j & 3);
            a2[sI][j] = (r32 == qm) ? (short)IKW[(size_t)(t0 + qm) * 256 + 64 + hm] : (short)0; }
    float mn[4], mx[4];
#pragma unroll
    for (int qi = 0; qi < 4; ++qi) { mn[qi] = 3.0e38f; mx[qi] = -3.0e38f; }
    const int NT32 = L / 32;
    const bf16_t* kbase = (const bf16_t*)(ws + WS_IK2) + (size_t)b * (SEQ / 32) * 2048 + lane * 8;
#define IX_LOADT(dst, kt_) do { const bf16_t* kp_ = kbase + (size_t)(kt_) * 2048; _Pragma("unroll") for (int ks = 0; ks < 4; ++ks) dst[ks] = *(const bf16x8*)(kp_ + 512 * ks); } while (0)
#define IX_MM(acc, bt) do { acc = f32x16{}; _Pragma("unroll") for (int ks = 0; ks < 4; ++ks) acc = __builtin_amdgcn_mfma_f32_32x32x16_bf16(af[ks], bt[ks], acc, 0, 0, 0); } while (0)
#define IX_HS(y_, acc) do { unsigned pk_[8]; _Pragma("unroll") for (int i = 0; i < 8; ++i) { const float x0_ = __builtin_amdgcn_fmed3f(acc[2 * i], 0.0f, 3.0e38f), x1_ = __builtin_amdgcn_fmed3f(acc[2 * i + 1], 0.0f, 3.0e38f); pk_[i] = cvt_pk_to_mfma(x0_, x1_); } \
        const u32x4 f0_ = {pk_[0], pk_[1], pk_[2], pk_[3]}, f1_ = {pk_[4], pk_[5], pk_[6], pk_[7]}; \
        y_ = f32x16{}; y_ = __builtin_amdgcn_mfma_f32_32x32x16_bf16(a2[0], *(const bf16x8*)&f0_, y_, 0, 0, 0); y_ = __builtin_amdgcn_mfma_f32_32x32x16_bf16(a2[1], *(const bf16x8*)&f1_, y_, 0, 0, 0); } while (0)
#define IX_ST(y_, kt_) do { const int key = (kt_) * 32 + r32; \
        if (hh == 0) { _Pragma("unroll") for (int qi = 0; qi < 4; ++qi) { const float s = y_[qi] + 0.0f; mn[qi] = fminf(mn[qi], s); mx[qi] = fmaxf(mx[qi], s); S[qi * 8192 + key] = __float_as_uint(s); } } } while (0)
#ifndef IX_REP_S1
#define IX_REP_S1 1
#endif
    for (int rp1 = 0; rp1 < IX_REP_S1; ++rp1) {
    bf16x8 bA[4], bB[4], bC[4];
    { const int kt = wave; if (kt < NT32) IX_LOADT(bA, kt); if (kt + 8 < NT32) IX_LOADT(bB, kt + 8); if (kt + 16 < NT32) IX_LOADT(bC, kt + 16); }
    for (int kt = wave; kt < NT32; kt += 3 * NWAVES) {
        const int kn = kt + 3 * NWAVES;
        bf16x8 nA[4], nB[4], nC[4];
        if (kn < NT32) IX_LOADT(nA, kn); if (kn + 8 < NT32) IX_LOADT(nB, kn + 8); if (kn + 16 < NT32) IX_LOADT(nC, kn + 16);
        const bool hB = kt + 8 < NT32, hC = kt + 16 < NT32;
#ifndef IX_REP_C
#define IX_REP_C 1
#endif
        for (int rc_ = 0; rc_ < IX_REP_C; ++rc_) {
        f32x16 xA, xB, xC;
        IX_MM(xA, bA); if (hB) IX_MM(xB, bB); if (hC) IX_MM(xC, bC);
        { f32x16 yy; IX_HS(yy, xA); IX_ST(yy, kt); }
        if (hB) { f32x16 yy; IX_HS(yy, xB); IX_ST(yy, kt + 8); }
        if (hC) { f32x16 yy; IX_HS(yy, xC); IX_ST(yy, kt + 16); }
        }
#pragma unroll
        for (int ks = 0; ks < 4; ++ks) { bA[ks] = nA[ks]; bB[ks] = nB[ks]; bC[ks] = nC[ks]; }
    }
    }
#undef IX_LOADT
#undef IX_MM
#undef IX_HS
#undef IX_ST
#pragma unroll
    for (int qi = 0; qi < 4; ++qi) {
#pragma unroll
        for (int o = 1; o < 32; o <<= 1) { mn[qi] = fminf(mn[qi], __shfl_xor(mn[qi], o)); mx[qi] = fmaxf(mx[qi], __shfl_xor(mx[qi], o)); }
        if (lane == 0) { MM[(wave * 4 + qi) * 2] = mn[qi]; MM[(wave * 4 + qi) * 2 + 1] = mx[qi]; } }
    __syncthreads();
    const int qs = wave >> 1, half = wave & 1;
    float mnq = 3.0e38f, mxq = -3.0e38f;
#pragma unroll
    for (int w = 0; w < NWAVES; ++w) { mnq = fminf(mnq, MM[(w * 4 + qs) * 2]); mxq = fmaxf(mxq, MM[(w * 4 + qs) * 2 + 1]); }
    const float scl = (mxq > mnq) ? 1023.0f / (mxq - mnq) : 0.0f;
#define IX_BIN(sbits) min((int)((__uint_as_float(sbits) - mnq) * scl), 1023)
    { LAS unsigned* hist = H + qs * 1024;
      int i = half * 64 + lane;
      for (; i + 384 < L; i += 512) { const unsigned s0 = S[qs * 8192 + i], s1 = S[qs * 8192 + i + 128], s2 = S[qs * 8192 + i + 256], s3 = S[qs * 8192 + i + 384];
          const int b0 = IX_BIN(s0), b1 = IX_BIN(s1), b2 = IX_BIN(s2), b3 = IX_BIN(s3);
          atomicAdd((unsigned*)(hist + b0), 1u); atomicAdd((unsigned*)(hist + b1), 1u); atomicAdd((unsigned*)(hist + b2), 1u); atomicAdd((unsigned*)(hist + b3), 1u); }
      for (; i < L; i += 128) { const int bin = IX_BIN(S[qs * 8192 + i]); atomicAdd((unsigned*)(hist + bin), 1u); } }
    __syncthreads();
    int bstar, rtake, cntb;
    { const LAS u32x4* hp = (const LAS u32x4*)(H + qs * 1024 + 1008 - 16 * lane);
      const u32x4 h0 = hp[0], h1 = hp[1], h2 = hp[2], h3 = hp[3];
      const unsigned cb[16] = {h0.x, h0.y, h0.z, h0.w, h1.x, h1.y, h1.z, h1.w, h2.x, h2.y, h2.z, h2.w, h3.x, h3.y, h3.z, h3.w};
      int tot = 0;
#pragma unroll
      for (int j = 0; j < 16; ++j) tot += (int)cb[j];
      int incl = tot;
#pragma unroll
      for (int o = 1; o < 64; o <<= 1) { const int v = __shfl_up(incl, o); if (lane >= o) incl += v; }
      const unsigned long long bal = __ballot(incl >= 256);
      const int fl = __ffsll((long long)bal) - 1;
      const int rem = 256 - (incl - tot);
      int cum = 0, bs = 0, rt = 0, cn = 0; bool found = false;
#pragma unroll
      for (int j = 15; j >= 0; --j) { const int cj = (int)cb[j]; if (!found && cum + cj >= rem) { bs = 1008 - 16 * lane + j; rt = rem - cum; cn = cj; found = true; } cum += cj; }
      bstar = __shfl(bs, fl); rtake = __shfl(rt, fl); cntb = __shfl(cn, fl); }
    const int NG = L / 64;
    const bool all_eq = (cntb == rtake);
    const unsigned long long lt = (1ull << lane) - 1ull;
    { unsigned mlo = 0u, mhi = 0u;
      const int gh = (NG + 1) >> 1, gbeg = half ? gh : 0, gend = half ? NG : gh;
      const float tge = (float)bstar, tgt = (bstar >= 1023) ? 3.0e38f : (float)(bstar + 1);
      unsigned sv[4] = {0u, 0u, 0u, 0u};
      for (int g = gbeg; g < gend; ++g) {
          const int gi = (g - gbeg) & 3;
          if (gi == 0) {
#pragma unroll
              for (int j = 0; j < 4; ++j) if (g + j < gend) sv[j] = S[qs * 8192 + 64 * (g + j) + lane]; }
          const unsigned sb = (gi == 0) ? sv[0] : (gi == 1) ? sv[1] : (gi == 2) ? sv[2] : sv[3];
          const float tq = (__uint_as_float(sb) - mnq) * scl;
          unsigned long long m = __ballot(tq >= tgt);
          const unsigned long long eqm = __ballot(tq >= tge) & ~m;
          if (all_eq) m |= eqm;
          else if (eqm != 0ull) {
              unsigned base = 0u;
              if (lane == 0) base = atomicAdd((unsigned*)(CC + qs), (unsigned)__popcll(eqm));
              base = __builtin_amdgcn_readfirstlane(base);
              const unsigned pos = base + (unsigned)__popcll(eqm & lt);
              if (((eqm >> lane) & 1ull) && pos < (unsigned)IX_CAP) LST[qs * IX_CAP + pos] = (unsigned)(64 * g + lane); }
          if (lane == g - gbeg) { mlo = (unsigned)m; mhi = (unsigned)(m >> 32); }
      }
      if (lane < gend - gbeg) *(LAS u32x2*)(MB + qs * 256 + 2 * (gbeg + lane)) = (u32x2){mlo, mhi}; }
    __syncthreads();
    if (half == 0 && !all_eq) {
        const int nc = cntb;
        if (nc > IX_CAP) { if (lane == 0) CC[4] = 1u; }
        else {
            unsigned myk[8], myi[8]; int rk[8];
#pragma unroll
            for (int sI = 0; sI < 8; ++sI) { const int j = sI * 64 + lane; rk[sI] = 0; myi[sI] = 0u; myk[sI] = 0u;
                if (sI * 64 < nc && j < nc) { myi[sI] = LST[qs * IX_CAP + j]; myk[sI] = ix_sortable(S[qs * 8192 + myi[sI]]); } }
            for (int t = 0; t < nc; ++t) { const unsigned it = LST[qs * IX_CAP + t]; const unsigned kt_ = ix_sortable(S[qs * 8192 + it]);
#pragma unroll
                for (int sI = 0; sI < 8; ++sI) if (sI * 64 < nc) rk[sI] += (kt_ > myk[sI] || (kt_ == myk[sI] && it < myi[sI])) ? 1 : 0; }
#pragma unroll
            for (int sI = 0; sI < 8; ++sI) { const int j = sI * 64 + lane;
                if (sI * 64 < nc && j < nc && rk[sI] < rtake) atomicOr((unsigned*)(MB + qs * 256 + (myi[sI] >> 5)), 1u << (myi[sI] & 31u)); }
        }
    }
#undef IX_BIN
    __syncthreads();
    if (CC[4] != 0u) { __syncthreads(); ix_radix_fallback(S, H, MASK, t0, L, tid); return; }
    { const int qi = tid >> 7, w2 = (tid & 127) * 2;
      *(u32x2*)(MASK + (size_t)(t0 + qi) * 256 + w2) = *(const LAS u32x2*)(MB + qi * 256 + w2); }
    __syncthreads();
}

constexpr int NA_IDX = 0, NA_LG = 1024, NA_SCAN = 1024 + 8192;
__device__ __forceinline__ void attn_gather_unit(const Args& a, int tok, LAS unsigned char* lds, int tid) {
    unsigned char* ws = a.ws;
    const int lane = tid & 63, wave = __builtin_amdgcn_readfirstlane(tid >> 6);
    const int b = tok >> 13, qpos = tok & (SEQ - 1), c = qpos >> 6, L = 64 * (c + 1), nsel = L < 256 ? L : 256;
    const unsigned* MASK = (const unsigned*)(ws + WS_MASK);
    LAS int* idxs = (LAS int*)(lds + NA_IDX); LAS float* lg = (LAS float*)(lds + NA_LG) + wave * 256; LAS int* wsum = (LAS int*)(lds + NA_SCAN);
    unsigned w = 0u; int cnt = 0;
    if (tid < 256) { w = MASK[(size_t)tok * 256 + tid]; cnt = __popc(w); }
    int incl = cnt;
#pragma unroll
    for (int o = 1; o < 64; o <<= 1) { const int v = __shfl_up(incl, o); if (lane >= o) incl += v; }
    if (lane == 63) wsum[wave] = incl;
    __syncthreads();
    if (tid < 256) { int off = incl - cnt; for (int ww = 0; ww < wave; ++ww) off += wsum[ww];
        while (w) { const int bit = __ffs(w) - 1; w &= w - 1; if (off < 256) idxs[off] = tid * 32 + bit; ++off; } }
    __syncthreads();
    const int h = wave;
    const bf16_t* BQ = (const bf16_t*)(ws + WS_BQ); const bf16_t* BK = (const bf16_t*)(ws + WS_BK); const bf16_t* BV = (const bf16_t*)(ws + WS_BV);
    const float slope = exp2f(-(float)(h + 1));
    float qv[8];
    { const u32x4 qw = *(const u32x4*)(BQ + (size_t)tok * 1024 + h * 128 + 8 * (lane & 15));
      qv[0] = __uint_as_float(qw.x << 16); qv[1] = __uint_as_float(qw.x & 0xffff0000u); qv[2] = __uint_as_float(qw.y << 16); qv[3] = __uint_as_float(qw.y & 0xffff0000u);
      qv[4] = __uint_as_float(qw.z << 16); qv[5] = __uint_as_float(qw.z & 0xffff0000u); qv[6] = __uint_as_float(qw.w << 16); qv[7] = __uint_as_float(qw.w & 0xffff0000u); }
    for (int it = 0; it < nsel / 4; ++it) {
        const int key = idxs[4 * it + (lane >> 4)];
        const u32x4 kw = *(const u32x4*)(BK + (size_t)(b * SEQ + key) * 1024 + h * 128 + 8 * (lane & 15));
        float s = qv[0] * __uint_as_float(kw.x << 16) + qv[1] * __uint_as_float(kw.x & 0xffff0000u) + qv[2] * __uint_as_float(kw.y << 16) + qv[3] * __uint_as_float(kw.y & 0xffff0000u)
                + qv[4] * __uint_as_float(kw.z << 16) + qv[5] * __uint_as_float(kw.z & 0xffff0000u) + qv[6] * __uint_as_float(kw.w << 16) + qv[7] * __uint_as_float(kw.w & 0xffff0000u);
        s += __shfl_xor(s, 1); s += __shfl_xor(s, 2); s += __shfl_xor(s, 4); s += __shfl_xor(s, 8);
        const float dist = fabsf((float)(qpos - key));
        if ((lane & 15) == 0) lg[4 * it + (lane >> 4)] = s * 0.08838834764831845f - slope * dist;
    }
    LDS_WAIT();
    float mx = -3.0e38f;
    for (int k = lane; k < nsel; k += 64) mx = fmaxf(mx, lg[k]);
#pragma unroll
    for (int o = 1; o < 64; o <<= 1) mx = fmaxf(mx, __shfl_xor(mx, o));
    float sm = 0.f;
    for (int k = lane; k < nsel; k += 64) { const float e = __expf(lg[k] - mx); lg[k] = e; sm += e; }
    sm = wave_sum(sm);
    const float rs = 1.0f / sm;
    LDS_WAIT();
    float o0 = 0.f, o1 = 0.f;
    for (int k = 0; k < nsel; k += 4) {
        unsigned vw[4]; float pp[4];
#pragma unroll
        for (int j = 0; j < 4; ++j) { const int key = idxs[k + j]; pp[j] = lg[k + j]; vw[j] = *(const unsigned*)(BV + (size_t)(b * SEQ + key) * 1024 + h * 128 + 2 * lane); }
#pragma unroll
        for (int j = 0; j < 4; ++j) { o0 += pp[j] * __uint_as_float(vw[j] << 16); o1 += pp[j] * __uint_as_float(vw[j] & 0xffff0000u); }
    }
    *(unsigned*)((bf16_t*)(ws + WS_BRB) + (size_t)tok * 1024 + h * 128 + 2 * lane) = cvt_pk(o0 * rs, o1 * rs);
    __syncthreads();
}

constexpr int RT_BLK = 148, RT_BUF = 64 * RT_BLK * 4;
constexpr int RT_SCR = 2 * RT_BUF;
__device__ __forceinline__ void phase8_router_expw(const Args& a, LAS unsigned char* lds, int tid, int G, bool route, bool do_expw) {
    unsigned char* ws = a.ws; const int wave = __builtin_amdgcn_readfirstlane(tid >> 6);
    const int npass = MT / 8;
    if (wave < 4) {
        __syncthreads();
        int cbuf = 0;
        for (int ps = blockIdx.x; ps < npass; ps += G) {
            int lane = tid & 63; asm volatile("" : "+v"(lane));
            f32x4 v[2][8];
#pragma unroll
            for (int r = 0; r < 2; ++r) { const int row = ps * 8 + wave * 2 + r;
                const unsigned ro = (unsigned)row * (unsigned)(DM * 2) + 8u * (unsigned)lane; float s = 0.f;
#pragma unroll
                for (int i = 0; i < 8; ++i) { const u32x2 pw = *(const u32x2*)(ws + (size_t)((unsigned)WS_PRE1 + ro + 512u * i));
                    v[r][i] = (f32x4){__uint_as_float(pw.x << 16), __uint_as_float(pw.x & 0xffff0000u), __uint_as_float(pw.y << 16), __uint_as_float(pw.y & 0xffff0000u)};
                    s += (v[r][i][0] + v[r][i][1]) + (v[r][i][2] + v[r][i][3]); }
                const float mean = wave_sum(s) * (1.0f / DM); float s2 = 0.f;
#pragma unroll
                for (int i = 0; i < 8; ++i) { v[r][i] = v[r][i] - mean; s2 += (v[r][i][0] * v[r][i][0] + v[r][i][1] * v[r][i][1]) + (v[r][i][2] * v[r][i][2] + v[r][i][3] * v[r][i][3]); }
                const float rstd = 1.0f / sqrtf(wave_sum(s2) * (1.0f / DM) + LN_EPS);
#pragma unroll
                for (int i = 0; i < 8; ++i) { const f32x4 gg = *(const f32x4*)(a.in[I_LN1G] + 256 * i + 4 * lane), bb = *(const f32x4*)(a.in[I_LN1B] + 256 * i + 4 * lane);
                    v[r][i] = v[r][i] * rstd * gg + bb;
                    *(u32x2*)(ws + (size_t)((unsigned)WS_H1B + ro + 512u * i)) = (u32x2){cvt_pk(v[r][i][0], v[r][i][1]), cvt_pk(v[r][i][2], v[r][i][3])};
                    *(unsigned*)(ws + (size_t)((unsigned)WS_H1F8 + (ro >> 1) + 256u * i)) = cvt4_fp8_nc(v[r][i][0], v[r][i][1], v[r][i][2], v[r][i][3], F8_ASCALE); } }
            f32x2 acc2[36];
#pragma unroll
            for (int j = 0; j < 36; ++j) acc2[j] = (f32x2){0.f, 0.f};
#pragma unroll
            for (int i = 0; i < 8; ++i) {
                int lq = lane; asm volatile("" : "+v"(lq));
                const LAS float* blk = (const LAS float*)(lds + cbuf * RT_BUF) + lq * RT_BLK;
#pragma unroll
                for (int kk = 0; kk < 4; ++kk) {
                    __builtin_amdgcn_sched_barrier(0);
                    const f32x2 hv = (f32x2){v[0][i][kk], v[1][i][kk]};
#pragma unroll
                    for (int q = 0; q < 9; ++q) { const f32x4 w4 = *(const LAS f32x4*)(blk + kk * 36 + 4 * q);
                        acc2[4 * q + 0] += hv * (f32x2){w4[0], w4[0]}; acc2[4 * q + 1] += hv * (f32x2){w4[1], w4[1]};
                        acc2[4 * q + 2] += hv * (f32x2){w4[2], w4[2]}; acc2[4 * q + 3] += hv * (f32x2){w4[3], w4[3]}; } }
                __syncthreads();
                cbuf ^= 1;
            }
#pragma unroll
            for (int r = 0; r < 2; ++r) {
                const int row = ps * 8 + wave * 2 + r;
                float lgt[36];
#pragma unroll
                for (int j = 0; j < 36; ++j) lgt[j] = wave_sum(r == 0 ? acc2[j][0] : acc2[j][1]);
                float gl[4]; float gm = -3.0e38f; int gt = 0;
#pragma unroll
                for (int j = 0; j < 4; ++j) { gl[j] = lgt[j] + a.in[I_BGRP][j]; if (gl[j] > gm) { gm = gl[j]; gt = j; } }
                float gs = 0.f;
#pragma unroll
                for (int j = 0; j < 4; ++j) gs += __expf(gl[j] - gm);
                const float gp = 1.0f / gs;
                float e1 = -3.0e38f, e2 = -3.0e38f; int i1 = 0, i2 = 0;
#pragma unroll
                for (int j = 0; j < 8; ++j) { float ev = 0.f;
#pragma unroll
                    for (int gq = 0; gq < 4; ++gq) if (gq == gt) ev = lgt[4 + 8 * gq + j] + a.in[I_BRT][8 * gq + j];
                    if (ev > e1) { e2 = e1; i2 = i1; e1 = ev; i1 = j; } else if (ev > e2) { e2 = ev; i2 = j; } }
                const float x2 = __expf(e2 - e1), w1 = gp / (1.0f + x2), w2 = gp * x2 / (1.0f + x2);
                if (lane == 0 && route) {
                    unsigned* ctl = (unsigned*)(ws + WS_CTL);
                    int* rows = (int*)(ws + WS_ROWS); int* slot_e = (int*)(ws + WS_SLOT); int* slot_p = slot_e + 2 * MT; float* slot_w = (float*)(slot_p + 2 * MT);
                    const int ea = gt * 8 + i1, eb = gt * 8 + i2;
                    const int pa = (int)atomicAdd(ctl + CW_CNT + 64 * ea, 1u), pb = (int)atomicAdd(ctl + CW_CNT + 64 * eb, 1u);
                    rows[ea * MT + pa] = row; rows[eb * MT + pb] = row;
                    slot_e[2 * row] = ea; slot_e[2 * row + 1] = eb; slot_p[2 * row] = pa; slot_p[2 * row + 1] = pb; slot_w[2 * row] = w1; slot_w[2 * row + 1] = w2;
                }
            }
        }
    } else {
        const int lane = tid & 63, te = tid - 256;
        const float* wg = a.in[I_WGRP]; const float* wr = a.in[I_WRT];
        LAS float* scr = (LAS float*)(lds + RT_SCR + (wave - 4) * 8704);
        f32x4 sa[9], sb[9];
#define RT_LOADW(dst, chunk) do { const int k_ = (chunk) * 256 + te; dst[0] = *(const f32x4*)(wg + (size_t)k_ * 4); _Pragma("unroll") for (int j_ = 0; j_ < 8; ++j_) dst[1 + j_] = *(const f32x4*)(wr + (size_t)k_ * 32 + 4 * j_); } while (0)
#define RT_WRITEW(src, buf) do { LAS float* p_ = (LAS float*)(buf) + (te >> 2) * RT_BLK + (te & 3) * 36; _Pragma("unroll") for (int j_ = 0; j_ < 9; ++j_) *(LAS f32x4*)(p_ + 4 * j_) = src[j_]; } while (0)
        RT_LOADW(sa, 0); RT_WRITEW(sa, lds); RT_LOADW(sb, 1);
        const int ge = blockIdx.x * 4 + (wave - 4), NGE = G * 4, NIT = do_expw ? NEXP * EW_E : 0;
        int it = ge; f32x4 e0[8], e1[8];
#define EW_LOAD(dst, item) do { if ((item) < NIT) { size_t ldw_; const float* p_ = ew_src(a, (item), lane, ldw_); _Pragma("unroll") for (int i_ = 0; i_ < 8; ++i_) dst[i_] = __builtin_nontemporal_load((const f32x4*)(p_ + (size_t)(8 * i_) * ldw_)); } } while (0)
#define EW_STEPX(cur, fre) do { if (it < NIT) { EW_LOAD(fre, it + NGE); ew_store(a, it, cur, scr, lane); it += NGE; } } while (0)
        EW_LOAD(e0, it);
        __syncthreads();
        int cbuf = 0;
        for (int ps = blockIdx.x; ps < npass; ps += G) {
#pragma unroll
            for (int i = 0; i < 8; ++i) {
                if (i & 1) { RT_LOADW(sb, (i + 2) & 7); RT_WRITEW(sa, lds + (cbuf ^ 1) * RT_BUF); }
                else { RT_LOADW(sa, (i + 2) & 7); RT_WRITEW(sb, lds + (cbuf ^ 1) * RT_BUF); }
                if (i == 0) { EW_STEPX(e0, e1); EW_STEPX(e1, e0); } else if (i == 1) { EW_STEPX(e0, e1); } else if (i == 2) { EW_STEPX(e1, e0); EW_STEPX(e0, e1); } else if (i == 3) { EW_STEPX(e1, e0); }
                else if (i == 4) { EW_STEPX(e0, e1); EW_STEPX(e1, e0); } else if (i == 5) { EW_STEPX(e0, e1); } else if (i == 6) { EW_STEPX(e1, e0); EW_STEPX(e0, e1); } else { EW_STEPX(e1, e0); }
                __syncthreads();
                cbuf ^= 1;
            }
        }
        while (it < NIT) { EW_STEPX(e0, e1); EW_STEPX(e1, e0); }
#undef RT_LOADW
#undef RT_WRITEW
#undef EW_STEPX
#undef EW_LOAD
    }
    __syncthreads();
}

__device__ __forceinline__ void load_tile_base(const Args& a, LAS int* tb, int tid) {
    const unsigned* ctl = (const unsigned*)(a.ws + WS_CTL);
    if (tid == 0) { int acc = 0; for (int e = 0; e < NEXP; ++e) { tb[e] = acc; acc += ((int)ctl[CW_CNT + 64 * e] + 255) >> 8; } tb[NEXP] = acc; }
    __syncthreads();
}

__device__ __forceinline__ void phase_gather(const Args& a, LAS unsigned char* lds, int tid, int G) {
    unsigned char* ws = a.ws; const int lane = tid & 63, wave = tid >> 6;
    LAS int* tb = (LAS int*)lds;
    load_tile_base(a, tb, tid);
    unsigned* ctl = (unsigned*)(ws + WS_CTL);
    const int NT = tb[NEXP];
    if (blockIdx.x == 0) { if (tid == 0) ctl[CW_NT] = (unsigned)NT;
        if (tid < NEXP) for (int t = tb[tid]; t < tb[tid + 1]; ++t) ctl[CW_TILEE + t] = (unsigned)tid;
        if (tid <= NEXP) ctl[CW_TBASE + tid] = (unsigned)tb[tid]; }
    const int* rows = (const int*)(ws + WS_ROWS); const bf16_t* H1B = (const bf16_t*)(ws + WS_H1B); bf16_t* XG = (bf16_t*)(ws + WS_XG);
    for (int r = blockIdx.x * NWAVES + wave; r < NT * 256; r += G * NWAVES) {
        const int tile = r >> 8; int e = 0;
        for (int j = 1; j < NEXP; ++j) if (tb[j] <= tile) e = j;
        const int pos = r - tb[e] * 256; const int cnt = (int)ctl[CW_CNT + 64 * e];
        u32x4 v[4];
        if (pos < cnt) { const int tok = rows[e * MT + pos];
#pragma unroll
            for (int i = 0; i < 4; ++i) v[i] = *(const u32x4*)(H1B + (size_t)tok * DM + 512 * i + 8 * lane); }
        else {
#pragma unroll
            for (int i = 0; i < 4; ++i) v[i] = (u32x4){0u, 0u, 0u, 0u}; }
#pragma unroll
        for (int i = 0; i < 4; ++i) *(u32x4*)(XG + (size_t)r * DM + 512 * i + 8 * lane) = v[i];
    }
}

struct FinSlots { int r0, r1; float w0, w1; };
__device__ __forceinline__ void fin_slots(const Args& a, int row, const LAS int* tb, FinSlots& S) {
    unsigned char* ws = a.ws;
    const int* slot_e = (const int*)(ws + WS_SLOT); const int* slot_p = slot_e + 2 * MT; const float* slot_w = (const float*)(slot_p + 2 * MT);
    const int e0 = slot_e[2 * row], e1 = slot_e[2 * row + 1];
    S.r0 = tb[e0] * 256 + slot_p[2 * row]; S.r1 = tb[e1] * 256 + slot_p[2 * row + 1]; S.w0 = slot_w[2 * row]; S.w1 = slot_w[2 * row + 1];
}
__device__ __forceinline__ void fin_data(const Args& a, int row, int lane, const FinSlots& S, u32x2 (&hw)[8], u32x2 (&ya)[8], u32x2 (&yb)[8]) {
    unsigned char* ws = a.ws;
    const bf16_t* H1B = (const bf16_t*)(ws + WS_H1B) + (size_t)row * DM; const bf16_t* Y = (const bf16_t*)(ws + WS_Y);
#pragma unroll
    for (int i = 0; i < 8; ++i) { hw[i] = *(const u32x2*)(H1B + 256 * i + 4 * lane); ya[i] = *(const u32x2*)(Y + (size_t)S.r0 * DM + 256 * i + 4 * lane); yb[i] = *(const u32x2*)(Y + (size_t)S.r1 * DM + 256 * i + 4 * lane); }
}
__device__ __forceinline__ void fin_compute(const Args& a, int row, int lane, float w0, float w1, const u32x2 (&hw)[8], const u32x2 (&ya)[8], const u32x2 (&yb)[8]) {
    f32x4 v[8]; float s = 0.f;
#pragma unroll
    for (int i = 0; i < 8; ++i) {
        const f32x4 hv = {__uint_as_float(hw[i].x << 16), __uint_as_float(hw[i].x & 0xffff0000u), __uint_as_float(hw[i].y << 16), __uint_as_float(hw[i].y & 0xffff0000u)};
        const f32x4 fa = {__uint_as_float(ya[i].x << 16), __uint_as_float(ya[i].x & 0xffff0000u), __uint_as_float(ya[i].y << 16), __uint_as_float(ya[i].y & 0xffff0000u)};
        const f32x4 fb = {__uint_as_float(yb[i].x << 16), __uint_as_float(yb[i].x & 0xffff0000u), __uint_as_float(yb[i].y << 16), __uint_as_float(yb[i].y & 0xffff0000u)};
        v[i] = hv * DN_ALPHA + fa * w0 + fb * w1; s += (v[i][0] + v[i][1]) + (v[i][2] + v[i][3]); }
    const float mean = wave_sum(s) * (1.0f / DM); float s2 = 0.f;
#pragma unroll
    for (int i = 0; i < 8; ++i) { v[i] = v[i] - mean; s2 += (v[i][0] * v[i][0] + v[i][1] * v[i][1]) + (v[i][2] * v[i][2] + v[i][3] * v[i][3]); }
    const float rstd = 1.0f / sqrtf(wave_sum(s2) * (1.0f / DM) + LN_EPS);
    float* O = a.out + (size_t)row * DM;
#pragma unroll
    for (int i = 0; i < 8; ++i) { const f32x4 g = *(const f32x4*)(a.in[I_LN2G] + 256 * i + 4 * lane), bb = *(const f32x4*)(a.in[I_LN2B] + 256 * i + 4 * lane);
        *(f32x4*)(O + 256 * i + 4 * lane) = v[i] * rstd * g + bb; }
}
__device__ __forceinline__ void phase_final(const Args& a, int tid, int G, const LAS int* tb) {
    const int lane = tid & 63, wave = tid >> 6, gw = blockIdx.x * NWAVES + wave, NGW = G * NWAVES;
    if (gw >= MT) return;
    FinSlots SA, SB; u32x2 hA[8], aA[8], bA[8], hB[8], aB[8], bB[8];
    int row = gw;
    fin_slots(a, row, tb, SA); fin_data(a, row, lane, SA, hA, aA, bA);
    if (row + NGW < MT) fin_slots(a, row + NGW, tb, SB);
    for (;;) {
        const int r1 = row + NGW, r2 = row + 2 * NGW;
        if (r1 < MT) fin_data(a, r1, lane, SB, hB, aB, bB);
        const float w0 = SA.w0, w1 = SA.w1;
        if (r2 < MT) fin_slots(a, r2, tb, SA);
        fin_compute(a, row, lane, w0, w1, hA, aA, bA);
        if (r1 >= MT) break;
        const int r3 = row + 3 * NGW;
        if (r2 < MT) fin_data(a, r2, lane, SA, hA, aA, bA);
        const float x0 = SB.w0, x1 = SB.w1;
        if (r3 < MT) fin_slots(a, r3, tb, SB);
        fin_compute(a, r1, lane, x0, x1, hB, aB, bB);
        if (r2 >= MT) break;
        row = r2;
    }
}

namespace fa {
constexpr int D = 128, NW = 8, QBLK = 32, KVBLK = 64, LDX = 1024;
constexpr float SCALE = 0.088388347648318440f, THR = 8.f;
constexpr size_t SHM_V = KVBLK * D * 2, SHM_K = KVBLK * D * 2, SHM_ATTN = 2 * SHM_V + 2 * SHM_K + NW * 64 * 4;
using s16x4 = __attribute__((ext_vector_type(4))) short;
#define KSWZ(row, colB) ((row) * 256 + ((colB) ^ (((row) & 7) << 4)))
#define SBAR() __builtin_amdgcn_sched_barrier(0)
__device__ __forceinline__ int crow(int r, int hi) { return (r & 3) + 8 * (r >> 2) + 4 * hi; }

__device__ __forceinline__ void partialSM(f32x16& p0, f32x16& p1, float& m_reg, float& mn, float& alpha) {
  constexpr float C = SCALE * 1.4426950408889634f;
  float pmax = p0[0];
#pragma unroll
  for (int r = 1; r < 16; ++r) pmax = fmaxf(pmax, p0[r]);
#pragma unroll
  for (int r = 0; r < 16; ++r) pmax = fmaxf(pmax, p1[r]);
  { auto rr = __builtin_amdgcn_permlane32_swap(__float_as_uint(pmax), __float_as_uint(pmax), false, false);
    pmax = fmaxf(__uint_as_float(rr[0]), __uint_as_float(rr[1])); }
  if (__builtin_expect(__all(pmax - m_reg <= THR / SCALE), 1)) { mn = m_reg; alpha = 1.f; }
  else { mn = fmaxf(m_reg, pmax); alpha = __builtin_amdgcn_exp2f((m_reg - mn) * C); m_reg = mn; }
  float mnC = -mn * C;
#pragma unroll
  for (int r = 0; r < 16; ++r) p0[r] = fmaf(p0[r], C, mnC);
#pragma unroll
  for (int r = 0; r < 16; ++r) p1[r] = fmaf(p1[r], C, mnC);
#pragma unroll
  for (int r = 0; r < 16; ++r) p0[r] = __builtin_amdgcn_exp2f(p0[r]);
}
__device__ __forceinline__ void finishSM(f32x16& p0, f32x16& p1, float alpha, float& l_reg, bf16x8& pa0, bf16x8& pa1, bf16x8& pa2, bf16x8& pa3) {
#pragma unroll
  for (int r = 0; r < 16; ++r) p1[r] = __builtin_amdgcn_exp2f(p1[r]);
  float ps = 0;
#pragma unroll
  for (int r = 0; r < 16; ++r) ps += p0[r];
#pragma unroll
  for (int r = 0; r < 16; ++r) ps += p1[r];
  { auto rr = __builtin_amdgcn_permlane32_swap(__float_as_uint(ps), __float_as_uint(ps), false, false);
    ps = __uint_as_float(rr[0]) + __uint_as_float(rr[1]); }
  l_reg = l_reg * alpha + ps;
#define PK4(P, BASE, OUT) do { unsigned a0 = cvt_pk(P[BASE + 0], P[BASE + 1]), a1 = cvt_pk(P[BASE + 2], P[BASE + 3]);   \
    unsigned b0 = cvt_pk(P[BASE + 4], P[BASE + 5]), b1 = cvt_pk(P[BASE + 6], P[BASE + 7]);                              \
    auto r0 = __builtin_amdgcn_permlane32_swap(a0, b0, false, false); auto r1 = __builtin_amdgcn_permlane32_swap(a1, b1, false, false); \
    u32x4 w = {r0[0], r1[0], r0[1], r1[1]}; OUT = *reinterpret_cast<bf16x8*>(&w); } while (0)
  PK4(p0, 0, pa0); PK4(p0, 8, pa1); PK4(p1, 0, pa2); PK4(p1, 8, pa3);
#undef PK4
}
__device__ __forceinline__ void qkt(f32x16& p0, f32x16& p1, const char* Ks, const bf16x8* qr, int r32, int hi) {
  p0 = f32x16{}; p1 = f32x16{};
#pragma unroll
  for (int d0 = 0; d0 < 8; ++d0) { int cb = (d0 * 16 + hi * 8) * 2;
    bf16x8 b0 = *reinterpret_cast<const bf16x8*>(Ks + KSWZ(r32, cb));
    bf16x8 b1 = *reinterpret_cast<const bf16x8*>(Ks + KSWZ(32 + r32, cb));
    p0 = __builtin_amdgcn_mfma_f32_32x32x16_bf16(b0, qr[d0], p0, 0, 0, 0);
    p1 = __builtin_amdgcn_mfma_f32_32x32x16_bf16(b1, qr[d0], p1, 0, 0, 0); }
}
__device__ __forceinline__ void mask_bias(f32x16& p0, f32x16& p1, u32x2 mw, float dq, float slr, int hi) {
  const unsigned w0 = mw.x >> (4 * hi), w1 = mw.y >> (4 * hi);
  const unsigned NEG = 0xf149f2cau;
#pragma unroll
  for (int r = 0; r < 16; ++r) { const int c = (r & 3) + 8 * (r >> 2);
    const float d0 = dq - (float)c, d1 = dq - (float)(32 + c);
    const float s0 = fmaf(-slr, fabsf(d0), p0[r]), s1 = fmaf(-slr, fabsf(d1), p1[r]);
    const unsigned t0 = (unsigned)(((int)(w0 << (31 - c))) >> 31), t1 = (unsigned)(((int)(w1 << (31 - c))) >> 31);
    p0[r] = __uint_as_float((__float_as_uint(s0) & t0) | (NEG & ~t0));
    p1[r] = __uint_as_float((__float_as_uint(s1) & t1) | (NEG & ~t1)); }
}
__device__ __forceinline__ int v_st(int k, int c) { const int kk = (k & ~0xC) | ((k & 4) << 1) | ((k & 8) >> 1); return ((kk >> 3) * 4 + (c >> 5)) * 512 + ((kk & 7) * 32 + (c & 31)) * 2; }
__device__ __forceinline__ int v_rd_base(int lane) { return ((lane & 3) << 3) | (((lane >> 2) & 3) << 6) | (((lane >> 4) & 1) << 5) | (((lane >> 5) & 1) << 8); }
constexpr int v_rd_off(int d0, int ks, int half) { return d0 * 512 + ks * 4096 + half * 2048; }
template <int OFF> __device__ __forceinline__ s16x4 tr_read(int vb) {
  s16x4 r; asm volatile("ds_read_b64_tr_b16 %0, %1 offset:%2" : "=&v"(r) : "v"(vb), "i"(OFF) : "memory"); return r;
}
template <int D0> __device__ __forceinline__ void pv_one(f32x16& od, int vb, bf16x8 pa0, bf16x8 pa1, bf16x8 pa2, bf16x8 pa3) {
  const s16x4 l0 = tr_read<v_rd_off(D0, 0, 0)>(vb), h0 = tr_read<v_rd_off(D0, 0, 1)>(vb), l1 = tr_read<v_rd_off(D0, 1, 0)>(vb), h1 = tr_read<v_rd_off(D0, 1, 1)>(vb);
  const s16x4 l2 = tr_read<v_rd_off(D0, 2, 0)>(vb), h2 = tr_read<v_rd_off(D0, 2, 1)>(vb), l3 = tr_read<v_rd_off(D0, 3, 0)>(vb), h3 = tr_read<v_rd_off(D0, 3, 1)>(vb);
  asm volatile("s_waitcnt lgkmcnt(0)" ::: "memory"); SBAR();
#define PK(L, H) (bf16x8){L[0], L[1], L[2], L[3], H[0], H[1], H[2], H[3]}
  od = __builtin_amdgcn_mfma_f32_32x32x16_bf16(pa0, PK(l0, h0), od, 0, 0, 0);
  od = __builtin_amdgcn_mfma_f32_32x32x16_bf16(pa1, PK(l1, h1), od, 0, 0, 0);
  od = __builtin_amdgcn_mfma_f32_32x32x16_bf16(pa2, PK(l2, h2), od, 0, 0, 0);
  od = __builtin_amdgcn_mfma_f32_32x32x16_bf16(pa3, PK(l3, h3), od, 0, 0, 0);
#undef PK
}
__device__ __forceinline__ void pv_d0(f32x16* o, int vb, bf16x8 pa0, bf16x8 pa1, bf16x8 pa2, bf16x8 pa3) {
  pv_one<0>(o[0], vb, pa0, pa1, pa2, pa3); pv_one<1>(o[1], vb, pa0, pa1, pa2, pa3); pv_one<2>(o[2], vb, pa0, pa1, pa2, pa3); pv_one<3>(o[3], vb, pa0, pa1, pa2, pa3);
}

#define FA_GAS __attribute__((address_space(1)))
__device__ __forceinline__ void attn_block(const bf16_t* Qb_, const bf16_t* Kh_, const bf16_t* Vh_, const unsigned* maskrow_,
                                           bf16_t* Ob_, int NT, int qpos0, float slr, char* lds) {
  const FA_GAS bf16_t* Qb = (const FA_GAS bf16_t*)Qb_; const FA_GAS bf16_t* Kh = (const FA_GAS bf16_t*)Kh_; const FA_GAS bf16_t* Vh = (const FA_GAS bf16_t*)Vh_;
  const FA_GAS unsigned* maskrow = (const FA_GAS unsigned*)maskrow_; FA_GAS unsigned char* Ob = (FA_GAS unsigned char*)Ob_;
  int tid_ = cur_tid((const LAS unsigned char*)lds); asm volatile("" : "+v"(tid_));
  const int tid = tid_, wid = tid >> 6, lane = tid & 63, r32 = lane & 31, hi = lane >> 5;
  char* V_lds = lds; char* K_lds = lds + 2 * SHM_V;
  float* wsm = (float*)(lds + 2 * SHM_V + 2 * SHM_K) + wid * 64; float* li_l = wsm; float* al_l = wsm + 32;
  float m_reg = -1e30f, l_reg = 0; f32x16 o[4] = {}; bf16x8 qr[8];
  const FA_GAS bf16_t* Qw = Qb + (long)(wid * QBLK + r32) * LDX + hi * 8;
#pragma unroll
  for (int d0 = 0; d0 < 8; ++d0) qr[d0] = *reinterpret_cast<const FA_GAS bf16x8*>(Qw + d0 * 16);
  const unsigned moff = (unsigned)(wid * QBLK + r32) * 256u;
  const float qposf = (float)(qpos0 + wid * QBLK + r32 - 4 * hi);
  const int sr = tid >> 4, sc = (tid & 15) * 8, vst0 = v_st(sr, sc), vst1 = v_st(32 + sr, sc);
  const int vb0 = (int)(uintptr_t)V_lds + v_rd_base(lane);
  constexpr int SDEPTH = 1;
  struct { bf16x8 vs0, vs1, ks0, ks1; } sr_[SDEPTH];
#define KOFF(j) ((NT - 1 - (j)) * KVBLK)
#define SLOAD(i, k0) do { sr_[i].vs0 = *reinterpret_cast<const FA_GAS bf16x8*>(&Vh[(long)((k0) + sr) * LDX + sc]); sr_[i].vs1 = *reinterpret_cast<const FA_GAS bf16x8*>(&Vh[(long)((k0) + 32 + sr) * LDX + sc]); \
    sr_[i].ks0 = *reinterpret_cast<const FA_GAS bf16x8*>(&Kh[(long)((k0) + sr) * LDX + sc]); sr_[i].ks1 = *reinterpret_cast<const FA_GAS bf16x8*>(&Kh[(long)((k0) + 32 + sr) * LDX + sc]); } while (0)
#define SWRITE(b, i) do { *(bf16x8*)(V_lds + (b) * SHM_V + vst0) = sr_[i].vs0;          \
    *(bf16x8*)(V_lds + (b) * SHM_V + vst1) = sr_[i].vs1; int kc = sc * 2;               \
    *(bf16x8*)(K_lds + (b) * SHM_K + KSWZ(sr, kc)) = sr_[i].ks0;                       \
    *(bf16x8*)(K_lds + (b) * SHM_K + KSWZ(32 + sr, kc)) = sr_[i].ks1; } while (0)
#define SWAIT() do { if constexpr (SDEPTH == 2) asm volatile("s_waitcnt vmcnt(4)" ::: "memory"); else asm volatile("s_waitcnt vmcnt(0)" ::: "memory"); } while (0)
#define RESC(a) do { if (__any((a) < 1.f)) { if (hi == 0) al_l[r32] = (a); asm volatile("s_waitcnt lgkmcnt(0)" ::: "memory"); \
    _Pragma("unroll") for (int d = 0; d < 4; ++d) _Pragma("unroll") for (int r = 0; r < 16; ++r) o[d][r] *= al_l[crow(r, hi)]; } } while (0)
#define MASKW(j) (*reinterpret_cast<const FA_GAS u32x2*>(maskrow + (moff + 2u * (unsigned)(NT - 1 - (j)))))
#define MB(P0, P1, j, MW) mask_bias(P0, P1, MW, qposf - (float)KOFF(j), slr, hi)
  f32x16 pA0, pA1, pB0, pB1; float mnA, mnB, alA, alB; bf16x8 pa0, pa1, pa2, pa3;
  constexpr int SE = 0, SO = SDEPTH - 1;
  SLOAD(SE, KOFF(0)); asm volatile("s_waitcnt vmcnt(0)" ::: "memory"); SWRITE(0, SE); __syncthreads();
  { qkt(pA0, pA1, K_lds, qr, r32, hi); MB(pA0, pA1, 0, MASKW(0)); } partialSM(pA0, pA1, m_reg, mnA, alA);
  SLOAD(SO, KOFF(1)); if constexpr (SDEPTH == 2) { if (2 < NT) SLOAD(SE, KOFF(2)); }
  SWAIT(); SWRITE(1, SO); __syncthreads();
  for (int j = 1; j + 1 < NT; j += 2) {
    SBAR(); { qkt(pB0, pB1, K_lds + SHM_K, qr, r32, hi); MB(pB0, pB1, j, MASKW(j)); }
    finishSM(pA0, pA1, alA, l_reg, pa0, pa1, pa2, pa3); SBAR();
    SLOAD(SO, KOFF(j + SDEPTH)); SBAR();
    pv_d0(o, vb0, pa0, pa1, pa2, pa3); partialSM(pB0, pB1, m_reg, mnB, alB);
    __syncthreads(); SWAIT(); SWRITE(0, SE);
    RESC(alB); __syncthreads();
    SBAR(); { qkt(pA0, pA1, K_lds, qr, r32, hi); MB(pA0, pA1, j + 1, MASKW(j + 1)); }
    finishSM(pB0, pB1, alB, l_reg, pa0, pa1, pa2, pa3); SBAR();
    if (SDEPTH == 1 || j + 3 < NT) SLOAD(SE, KOFF(j + 1 + SDEPTH)); SBAR();
    pv_d0(o, vb0 + (int)SHM_V, pa0, pa1, pa2, pa3); partialSM(pA0, pA1, m_reg, mnA, alA);
    __syncthreads(); SWAIT(); SWRITE(1, SO);
    RESC(alA); __syncthreads();
  }
  SBAR(); { qkt(pB0, pB1, K_lds + SHM_K, qr, r32, hi); MB(pB0, pB1, NT - 1, MASKW(NT - 1)); }
  finishSM(pA0, pA1, alA, l_reg, pa0, pa1, pa2, pa3); SBAR();
  pv_d0(o, vb0, pa0, pa1, pa2, pa3); partialSM(pB0, pB1, m_reg, mnB, alB);
  __syncthreads(); RESC(alB);
  finishSM(pB0, pB1, alB, l_reg, pa0, pa1, pa2, pa3); SBAR();
  pv_d0(o, vb0 + (int)SHM_V, pa0, pa1, pa2, pa3);
  if (hi == 0) li_l[r32] = l_reg; asm volatile("s_waitcnt lgkmcnt(0)" ::: "memory");
  float rli[16];
#pragma unroll
  for (int r = 0; r < 16; ++r) rli[r] = __builtin_amdgcn_rcpf(li_l[crow(r, hi)]);
  FA_GAS unsigned char* Ow = Ob + (long)(wid * QBLK) * LDX;
#pragma unroll
  for (int r = 0; r < 16; ++r) { int orow = crow(r, hi);
#pragma unroll
    for (int d0 = 0; d0 < 4; ++d0) Ow[(long)orow * LDX + d0 * 32 + r32] = (unsigned char)cvt1_fp8(o[d0][r] * rli[r], F8_ASCALE); }
  __syncthreads();
#undef KOFF
#undef SLOAD
#undef SWRITE
#undef SWAIT
#undef RESC
#undef MASKW
#undef MB
}
#undef KSWZ
#undef SBAR
}

__device__ __forceinline__ void phase_attention(const Args& a, char* lds, int G, int bid) {
    unsigned char* ws = uni_ptr(a.ws);
    const bf16_t* BQ = (const bf16_t*)(ws + WS_BQ); const bf16_t* BK = (const bf16_t*)(ws + WS_BK); const bf16_t* BV = (const bf16_t*)(ws + WS_BV);
    const unsigned* MASK = (const unsigned*)(ws + WS_MASK); unsigned char* BRB = ws + WS_BRB;
    const int bx = bid; const int vcu = (G % 8 == 0) ? (bx % 8) * (G / 8) + bx / 8 : bx;
    for (int p0 = vcu; p0 < 256; p0 += G) { const int p = __builtin_amdgcn_readfirstlane(p0);
        const int b = p >> 7, h = (p >> 4) & 7, x = p & 15;
        const float slr = uni_f((1.0f / fa::SCALE) / (float)(2 << h));
#pragma unroll 1
        for (int half = 0; half < 2; ++half) { const int qb = half ? 31 - x : x; const size_t row0 = (size_t)b * SEQ + qb * 256;
            fa::attn_block(uni_ptr(BQ + row0 * 1024 + h * 128), uni_ptr(BK + (size_t)b * SEQ * 1024 + h * 128), uni_ptr(BV + (size_t)b * SEQ * 1024 + h * 128),
                           uni_ptr(MASK + row0 * 256), (bf16_t*)uni_ptr(BRB + row0 * 1024 + h * 128), 4 * (qb + 1), qb * 256, slr, lds); }
    }
}


constexpr int NPH = 13;
#ifndef REPS
#define REPS 1,1,1,1,1,1,1,1,1,1,1,1,1,1,1,1
#endif
constexpr int REP[16] = {REPS};
__global__ void __launch_bounds__(NTHR, 2) mk_fwd(Args a) {
    extern __shared__ __attribute__((aligned(16))) unsigned char lds_raw[];
    LAS unsigned char* lds = (LAS unsigned char*)lds_raw;
    cg::grid_group grid = cg::this_grid();
    const int G = gridDim.x;
#define FRESH_TID() int tid = cur_tid(lds); asm volatile("" : "+v"(tid)); const int lane = tid & 63, wave = tid >> 6; (void)lane; (void)wave

    unsigned char* ws = a.ws;
    const int lo = a.ph_lo, hi = a.ph_hi;
#define IN(k) (lo <= (k) && (k) < hi)
    if (lo < 0) grid.sync();
    if (threadIdx.x == 0) { ((volatile LAS unsigned*)(lds + LDS_BARST))[0] = 0u; ((volatile LAS unsigned*)(lds + LDS_BARST))[1] = 0u; }
    if ((threadIdx.x & 63) == 0) ((volatile LAS unsigned char*)(lds + LDS_WTAB))[(unsigned)__builtin_amdgcn_s_getreg((5 << 11) | 4) & 63u] = (unsigned char)(threadIdx.x >> 6);
    __syncthreads();
    (void)xcd_barrier_post((unsigned*)(ws + WS_CTL) + CW_BAR, (volatile LAS unsigned*)(lds + LDS_BARST));
    int bid = blockIdx.x;
    if (lo == 0 && hi == NPH && (G % 8) == 0) {
        if (threadIdx.x == 0) { const unsigned x = xb_xcc_id(); const unsigned r = atomicAdd((unsigned*)(ws + WS_CTL) + CW_TICKET + 64 * x, 1u); ((volatile LAS unsigned*)(lds + LDS_BARST))[2] = r * 8u + (x & 7u); }
    }
#define SEAM(k) do { if (IN(k) && IN((k) + 1)) { { XcdBarrier b_; b_.bar = (unsigned*)(a.ws + WS_CTL) + CW_BAR; b_.x = xb_xcc_id(); b_.st = (volatile LAS unsigned*)(lds + LDS_BARST); xcd_barrier(b_); } } } while (0)

    if (IN(0)) { FRESH_TID(); for (int rp = 0; rp < REP[0]; ++rp) { phase_prologue(a, lds, tid, G); __syncthreads(); } }
    SEAM(0);
    if (lo == 0 && hi == NPH && (G % 8) == 0) {
        const unsigned* bw = (const unsigned*)(ws + WS_CTL) + CW_BAR; bool ok = true;
        for (int j = 0; j < 8; ++j) ok = ok && (__hip_atomic_load(bw + XB_XCNT(j), __ATOMIC_RELAXED, __HIP_MEMORY_SCOPE_AGENT) == (unsigned)(G / 8));
        if (ok) bid = __builtin_amdgcn_readfirstlane((int)((volatile LAS unsigned*)(lds + LDS_BARST))[2]);
    }
    if (IN(1)) { FRESH_TID();
        for (int c8 = tid; c8 < NPROJ_PAD / 2; c8 += NTHR) { const int c = 2 * c8; float b0 = 0.f, b1 = 0.f;
            if (c < 7752) { b0 = a.in[I_BIN][c]; b1 = a.in[I_BIN][c + 1]; } else if (c >= 7936) { b0 = a.in[I_BIN][c - 184]; b1 = a.in[I_BIN][c - 183]; }
            *(LAS unsigned*)(lds + LDS_BIAS + c * 2) = cvt_pk(b0, b1); }
        __syncthreads();
        for (int rp = 0; rp < REP[1]; ++rp) {
            { pg8::Gemm g{(const bf16_t*)(ws + WS_XB), (const bf16_t*)(ws + WS_WIN), MT, 7 * 256, DM}; pg8::StaticOrderT<false, 2> S; S.init(MT, 7 * 256, G, bid);
              pg8::EpiProjT<false> E{ws, lds + LDS_BIAS}; pg8::gemm_phase<pg8::EpiProjT<false>, pg8::StaticOrderT<false, 2>, true, true>(lds, g, S, E); }
            { int k1 = DM / 2; asm volatile("" : "+s"(k1));
              pg8::Gemm g{(const bf16_t*)(ws + WS_X8), (const bf16_t*)(ws + WS_WIN8), MT, 40 * 256, k1}; pg8::StaticOrderT<true, 1> S; S.init(MT, 40 * 256, G, bid);
              pg8::EpiProjT<true> E{ws, lds + LDS_BIAS}; pg8::gemm_phase<pg8::EpiProjT<true>, pg8::StaticOrderT<true, 1>, true, true>(lds, g, S, E); } } }
    SEAM(1);
    if (IN(2)) { FRESH_TID(); hg_fill_lb(a, lds, tid);
        for (int rp = 0; rp < REP[2]; ++rp) for (int u = blockIdx.x; u < 2048; u += G) hgrn1_unit(a, u, lds, tid);
        { int tix = tid; asm volatile("" : "+v"(tix));
        for (int rp = 0; rp < REP[3]; ++rp) for (int k = 0; k * G < MT / 4; ++k) { const int u = k * G + ((k & 1) ? (G - 1 - (int)blockIdx.x) : (int)blockIdx.x); if (u < MT / 4) indexer_unit(a, u, lds, tix); } } }
    SEAM(2);
    if (IN(3)) { FRESH_TID(); for (int rp = 0; rp < REP[4]; ++rp) hgrn_scan(a, tid, G);
        for (int rp = 0; rp < REP[5]; ++rp) phase_attention(a, (char*)lds_raw, G, bid); }
    SEAM(3);
    if (IN(4)) { FRESH_TID(); for (int rp = 0; rp < REP[6]; ++rp) { float z[16]; unsigned qq[16], vv[16]; u32x4 stp[4]; u32x2 gwn[4];
            if ((int)blockIdx.x < 2048) hg3_load(a, blockIdx.x, tid, z, qq, vv, stp, gwn);
            hg_fill_lb(a, lds, tid);
            for (int u = blockIdx.x; u < 2048; u += G) hgrn3_unit(a, u, (u + G < 2048) ? u + G : -1, lds, tid, z, qq, vv, stp, gwn); } }
    SEAM(4);
    if (IN(5)) { FRESH_TID(); for (int rp = 0; rp < REP[7]; ++rp) {
        int kb5 = 512; asm volatile("" : "+s"(kb5));
        { pg8::Gemm g{(const bf16_t*)(ws + WS_BRA), (const bf16_t*)(ws + WS_WA), MT, DM, kb5}; pg8::StaticOrderF8 S; S.init(MT, DM, G, bid);
          pg8::EpiBranch<0> E{(bf16_t*)(ws + WS_MERGED), (const bf16_t*)(ws + WS_GATES), ws + WS_MERGED8};
          pg8::gemm_phase<pg8::EpiBranch<0>, pg8::StaticOrderF8, true, true>(lds, g, S, E); }
        { pg8::Gemm g{(const bf16_t*)(ws + WS_BRB), (const bf16_t*)(ws + WS_WB), MT, DM, kb5}; pg8::StaticOrderF8 S; S.init(MT, DM, G, bid);
          pg8::EpiBranch<1> E{(bf16_t*)(ws + WS_MERGED), (const bf16_t*)(ws + WS_GATES), ws + WS_MERGED8};
          pg8::gemm_phase<pg8::EpiBranch<1>, pg8::StaticOrderF8, true, true>(lds, g, S, E); } } }
    SEAM(6);
    if (IN(7)) { FRESH_TID(); int kb7 = DM / 2; asm volatile("" : "+s"(kb7));
        pg8::Gemm g{(const bf16_t*)(ws + WS_MERGED8), (const bf16_t*)(ws + WS_WOUT), MT, DM, kb7}; pg8::StaticOrderF8 S; S.init(MT, DM, G, bid);
        pg8::EpiResBf16 E{(bf16_t*)(ws + WS_PRE1), a.in[I_X], DN_ALPHA};
        for (int rp = 0; rp < REP[8]; ++rp) pg8::gemm_phase<pg8::EpiResBf16, pg8::StaticOrderF8, true, true>(lds, g, S, E); }
    SEAM(7);
    if (IN(8)) { FRESH_TID(); for (int rp = 0; rp < REP[9]; ++rp) phase8_router_expw(a, lds, tid, G, rp == 0, rp == 0);
        for (int rp = 1; rp < REP[10]; ++rp) phase_expert_weights(a, lds, tid, G); }
    if (IN(8) && IN(10)) { XcdBarrier b_; b_.bar = (unsigned*)(a.ws + WS_CTL) + CW_BAR; b_.x = xb_xcc_id(); b_.st = (volatile LAS unsigned*)(lds + LDS_BARST); xcd_barrier(b_); }
    if (IN(10)) { FRESH_TID(); const unsigned* ctl = (const unsigned*)(ws + WS_CTL);
        LAS int* tb = (LAS int*)(lds + LDS_MOE_TB); LAS unsigned* TE = (LAS unsigned*)(lds + LDS_MOE_TE); LAS unsigned* TOK = (LAS unsigned*)(lds + LDS_MOE_TOK);
        __syncthreads(); load_tile_base(a, tb, tid);
        if (tid < NEXP) for (int t = tb[tid]; t < tb[tid + 1]; ++t) TE[t] = (unsigned)tid;
        __syncthreads();
        const int NT = tb[NEXP];
        pg8::GroupedOrder<true> S; S.init(NT, 8, G, bid, TE, TOK);
        { const int* rows = (const int*)(ws + WS_ROWS);
          for (int i = 0; i < 8; ++i) { pg8::Unit u; if (!S.next(i, u)) break;
              if (tid < 256) { const int e = (int)TE[u.pm], pos = (u.pm - tb[e]) * 256 + tid, cnt = (int)ctl[CW_CNT + 64 * e];
                  TOK[i * 256 + tid] = (pos < cnt) ? (unsigned)rows[e * MT + pos] * (unsigned)DM : 0u; } } }
        __syncthreads();
        pg8::Gemm g{(const bf16_t*)(ws + WS_H1F8), (const bf16_t*)(ws + WS_WGU), NT * 256, 2048, DM / 2};
        pg8::EpiGateUp E{ws + WS_HH};
        for (int rp = 0; rp < REP[12]; ++rp) pg8::gemm_phase<pg8::EpiGateUp, pg8::GroupedOrder<true>, true, true>(lds, g, S, E); }
    SEAM(10);
    if (IN(11)) { FRESH_TID();
        LAS int* tb = (LAS int*)(lds + LDS_MOE_TB); LAS unsigned* TE = (LAS unsigned*)(lds + LDS_MOE_TE);
        __syncthreads(); load_tile_base(a, tb, tid);
        if (tid < NEXP) for (int t = tb[tid]; t < tb[tid + 1]; ++t) TE[t] = (unsigned)tid;
        __syncthreads();
        const int NT = tb[NEXP];
        int kd = DFF / 2; asm volatile("" : "+s"(kd));
        pg8::Gemm g{(const bf16_t*)(ws + WS_HH), (const bf16_t*)(ws + WS_WD), NT * 256, 2048, kd}; pg8::GroupedOrder<false> S; S.init(NT, 8, G, bid, TE, nullptr);
        pg8::EpiStoreBf16 E{(bf16_t*)(ws + WS_Y), DM, uni_f(G > 0 ? F8_UNSCALE : 0.f)};
        for (int rp = 0; rp < REP[13]; ++rp) pg8::gemm_phase<pg8::EpiStoreBf16, pg8::GroupedOrder<false>, true, true>(lds, g, S, E); }
    SEAM(11);
    if (IN(12)) { FRESH_TID(); LAS int* tb = (LAS int*)lds; __syncthreads(); load_tile_base(a, tb, tid);
        for (int rp = 0; rp < REP[14]; ++rp) phase_final(a, tid, G, tb); }
#undef IN
#undef SEAM
}

#ifndef MK_SPLIT
#define MK_SPLIT 0
#endif
extern "C" void kernel_launch(void* const* d_in, const int* in_sizes, int n_in, void* d_out, int out_size, void* d_ws, size_t ws_size, hipStream_t stream) {
    static int grid = 0;
    if (grid == 0) {
        int dev = 0, cus = 0, per_cu = 0;
        if (n_in != 19 || out_size != MT * DM || ws_size < WS_END) { fprintf(stderr, "kernel_launch: unexpected shapes: n_in %d out %d ws %zu (need %zu)\n", n_in, out_size, ws_size, (size_t)WS_END); grid = -1; return; }
        if (hipGetDevice(&dev) != hipSuccess || hipDeviceGetAttribute(&cus, hipDeviceAttributeMultiprocessorCount, dev) != hipSuccess) { grid = -1; return; }
        if (hipFuncSetAttribute((const void*)mk_fwd, hipFuncAttributeMaxDynamicSharedMemorySize, LDS_BYTES) != hipSuccess) { fprintf(stderr, "kernel_launch: hipFuncSetAttribute failed\n"); grid = -1; return; }
        if (hipOccupancyMaxActiveBlocksPerMultiprocessor(&per_cu, (const void*)mk_fwd, NTHR, LDS_BYTES) != hipSuccess || per_cu < 1) { fprintf(stderr, "kernel_launch: occupancy query says %d blocks/CU\n", per_cu); grid = -1; return; }
        grid = cus;
    }
    if (grid < 0) return;
    (void)hipMemsetAsync((char*)d_ws + WS_CTL, 0, 1 * MiB, stream);
    Args a{};
    for (int i = 0; i < 19; ++i) a.in[i] = (const float*)d_in[i];
    a.out = (float*)d_out; a.ws = (unsigned char*)d_ws;
#if MK_SPLIT
#ifndef MK_DUP
#define MK_DUP -1
#endif
    for (int p2 = 0; p2 < NPH + (MK_DUP >= 0 ? 1 : 0); ++p2) { const int p = (MK_DUP >= 0 && p2 > MK_DUP) ? p2 - 1 : p2;
        a.ph_lo = p; a.ph_hi = p + 1; void* args[] = {&a};
        hipError_t e = hipLaunchCooperativeKernel((const void*)mk_fwd, dim3(grid), dim3(NTHR), args, LDS_BYTES, stream);
        if (e != hipSuccess) { fprintf(stderr, "cooperative launch (phase %d) failed: %s (grid %d)\n", p, hipGetErrorString(e), grid); break; } }
#else
    a.ph_lo = 0; a.ph_hi = NPH; void* args[] = {&a};
    hipError_t e = hipLaunchCooperativeKernel((const void*)mk_fwd, dim3(grid), dim3(NTHR), args, LDS_BYTES, stream);
    if (e != hipSuccess) fprintf(stderr, "cooperative launch failed: %s (grid %d)\n", hipGetErrorString(e), grid);
#endif
}
```

```cpp
#include <hip/hip_runtime.h>
#include <hip/hip_cooperative_groups.h>
#include <cstdio>
#include <cstdint>
namespace cg = cooperative_groups;

#define LAS __attribute__((address_space(3)))
typedef unsigned short bf16_t;
typedef short bf16x8 __attribute__((ext_vector_type(8)));
typedef float f32x4 __attribute__((ext_vector_type(4)));
typedef float f32x2 __attribute__((ext_vector_type(2)));
typedef float f32x16 __attribute__((ext_vector_type(16)));
typedef unsigned u32x4 __attribute__((ext_vector_type(4)));
typedef unsigned u32x2 __attribute__((ext_vector_type(2)));

constexpr int MT = 16384, SEQ = 8192, DM = 2048, NHEAD = 8, HD = 128, NPROJ = 11848, NPROJ_PAD = 12032;
constexpr int NEXP = 32, DFF = 1024, MAXROWS = 40960;
constexpr float DN_ALPHA = 1.189207115002721f;
constexpr float LN_EPS = 1e-5f, RMS_EPS = 1e-6f;
constexpr int NWAVES = 8, NTHR = 512;
constexpr int LDS_BYTES = 163840;

constexpr size_t MiB = 1u << 20;
constexpr size_t WS_CTL = 0;
constexpr size_t WS_WIN = 1 * MiB;
constexpr size_t WS_WA = 48 * MiB, WS_WB = 52 * MiB, WS_WOUT = 56 * MiB;
constexpr size_t WS_XB = 64 * MiB;
constexpr size_t WS_MERGED = 64 * MiB;
constexpr size_t WS_AQ = 128 * MiB, WS_AI = 160 * MiB, WS_AG = 192 * MiB, WS_BQ = 224 * MiB, WS_BK = 256 * MiB, WS_BV = 288 * MiB;
constexpr size_t WS_AF = 320 * MiB;
constexpr size_t WS_IQ = 384 * MiB;
constexpr size_t WS_IKW = 400 * MiB;
constexpr size_t WS_GATES = 408 * MiB;
constexpr size_t WS_WGU = 128 * MiB;
constexpr size_t WS_WD = 384 * MiB;
constexpr size_t WS_H1F8 = 256 * MiB;
constexpr size_t WS_MASK = 536 * MiB;
constexpr size_t WS_KV = 552 * MiB;
constexpr size_t WS_PRE1 = 552 * MiB;
constexpr size_t WS_ST = 680 * MiB;
constexpr size_t WS_H1B = 680 * MiB;
constexpr size_t WS_DECAY = 744 * MiB;
constexpr size_t WS_ROWS = 745 * MiB;
constexpr size_t WS_SLOT = 747 * MiB;
constexpr size_t WS_BRA = 750 * MiB, WS_BRB = 782 * MiB;
constexpr size_t WS_MERGED8 = 616 * MiB;
constexpr size_t WS_IK2 = 814 * MiB;
constexpr size_t WS_HH = 750 * MiB;
constexpr size_t WS_XG = 830 * MiB;
constexpr size_t WS_Y = 830 * MiB;
constexpr size_t WS_WIN8 = 830 * MiB;
constexpr size_t WS_X8 = 860 * MiB;
constexpr size_t WS_END = 990 * MiB;
constexpr int CW_CNT = 1024;
constexpr int CW_NT = 4096;
constexpr int CW_TILEE = 4160;
constexpr int CW_TBASE = 4400;
constexpr int CW_BAR = 8192;
constexpr int CW_TICKET = 12288;
constexpr int LDS_BIAS = 131072;
constexpr int LDS_MOE_TB = 131072, LDS_MOE_TE = 131072 + 256, LDS_MOE_TOK = 131072 + 1024;
constexpr int LDS_BARST = LDS_BYTES - 64;
constexpr int LDS_WTAB = LDS_BYTES - 128;

__device__ __forceinline__ float bf2f(unsigned h) { return __uint_as_float(h << 16); }
__device__ __forceinline__ unsigned cvt_pk(float lo, float hi) { unsigned r; asm volatile("v_cvt_pk_bf16_f32 %0, %1, %2" : "=v"(r) : "v"(lo), "v"(hi)); return r; }
__device__ __forceinline__ unsigned cvt_pk_mfma(float lo, float hi) { unsigned r; asm volatile("s_nop 15\n\ts_nop 3\n\tv_cvt_pk_bf16_f32 %0, %1, %2" : "=v"(r) : "v"(lo), "v"(hi)); return r; }
__device__ __forceinline__ unsigned cvt_pk_to_mfma(float lo, float hi) { unsigned r; asm volatile("v_cvt_pk_bf16_f32 %0, %1, %2\n\ts_nop 1" : "=v"(r) : "v"(lo), "v"(hi)); return r; }
__device__ __forceinline__ unsigned cvt4_fp8(float a, float b, float c, float d, float s) {
    a = __builtin_amdgcn_fmed3f(a * s, -448.f, 448.f); b = __builtin_amdgcn_fmed3f(b * s, -448.f, 448.f); c = __builtin_amdgcn_fmed3f(c * s, -448.f, 448.f); d = __builtin_amdgcn_fmed3f(d * s, -448.f, 448.f);
    int w = 0; w = __builtin_amdgcn_cvt_pk_fp8_f32(a, b, w, false); w = __builtin_amdgcn_cvt_pk_fp8_f32(c, d, w, true); return (unsigned)w; }
__device__ __forceinline__ unsigned cvt1_fp8(float a, float s) { a = __builtin_amdgcn_fmed3f(a * s, -448.f, 448.f); return (unsigned)__builtin_amdgcn_cvt_pk_fp8_f32(a, a, 0, false) & 0xffu; }
__device__ __forceinline__ unsigned cvt4_fp8_nc(float a, float b, float c, float d, float s) {
    int w = 0; w = __builtin_amdgcn_cvt_pk_fp8_f32(a * s, b * s, w, false); w = __builtin_amdgcn_cvt_pk_fp8_f32(c * s, d * s, w, true); return (unsigned)w; }
constexpr float F8_WSCALE = 1024.f, F8_ASCALE = 8.f, F8_UNSCALE = 1.0f / 8192.f;
__device__ __forceinline__ float wave_sum(float v) {
#pragma unroll
    for (int o = 1; o < 64; o <<= 1) v += __shfl_xor(v, o);
    return v;
}
template <int CTRL, int RMASK> __device__ __forceinline__ float dpp_get(float v) { return __int_as_float(__builtin_amdgcn_update_dpp(0, __float_as_int(v), CTRL, RMASK, 0xf, false)); }
__device__ __forceinline__ float wave_sum63(float v) {
    v += dpp_get<0xB1, 0xf>(v); v += dpp_get<0x4E, 0xf>(v); v += dpp_get<0x141, 0xf>(v); v += dpp_get<0x140, 0xf>(v); v += dpp_get<0x142, 0xa>(v); v += dpp_get<0x143, 0xc>(v); return v; }
__device__ __forceinline__ float wave_sum_u(float v) { return __int_as_float(__builtin_amdgcn_readlane(__float_as_int(wave_sum63(v)), 63)); }
__device__ __forceinline__ float fast_exp(float x) { return __builtin_amdgcn_exp2f(x * 1.4426950408889634f); }
__device__ __forceinline__ float sigmoidf_(float x) { return __builtin_amdgcn_rcpf(1.0f + __expf(-x)); }
#define LDS_WAIT() asm volatile("s_waitcnt lgkmcnt(0)" ::: "memory")
template <typename T> __device__ __forceinline__ T* uni_ptr(T* p) { const unsigned long long v = (unsigned long long)p; const unsigned lo = __builtin_amdgcn_readfirstlane((unsigned)v), hi = __builtin_amdgcn_readfirstlane((unsigned)(v >> 32)); return (T*)(((unsigned long long)hi << 32) | lo); }
__device__ __forceinline__ int cur_tid(const LAS unsigned char* lds0) {
    const unsigned slot = (unsigned)__builtin_amdgcn_s_getreg((5 << 11) | 4) & 63u;
    const unsigned w = __builtin_amdgcn_readfirstlane((unsigned)((const volatile LAS unsigned char*)(lds0 + LDS_WTAB))[slot]);
    return (int)((w << 6) | __builtin_amdgcn_mbcnt_hi(~0u, __builtin_amdgcn_mbcnt_lo(~0u, 0u)));
}
__device__ __forceinline__ int fresh_lane() { unsigned z = 0u; asm volatile("" : "+v"(z)); return (int)__builtin_amdgcn_mbcnt_hi(~0u, __builtin_amdgcn_mbcnt_lo(~0u, z)); }
__device__ __forceinline__ float uni_f(float x) { return __uint_as_float(__builtin_amdgcn_readfirstlane(__float_as_uint(x))); }

namespace pg8 {
#define PG8_LAS __attribute__((address_space(3)))
typedef unsigned short bf16_t;
typedef short bf16x8 __attribute__((ext_vector_type(8)));
typedef float f32x4 __attribute__((ext_vector_type(4)));
typedef unsigned u32x4 __attribute__((ext_vector_type(4)));
constexpr int BM = 256, BK = 64, HALF = 128, HTB = HALF * BK * 2  , STAGE_BYTES = 8 * HTB, NXCD = 8, WGM = 8;

__host__ __device__ __forceinline__ int lds_byte(int r, int c) { const int st = (r >> 4) * 2 + (c >> 5), rr = r & 15, cc = c & 31, ob = rr * 64 + cc * 2; return st * 1024 + (ob ^ (((ob >> 9) & 1) << 5)); }
__host__ __device__ __forceinline__ void stage_rc(int b, int& R, int& C) { const int st = b / 1024, sb = b % 1024, swz = sb ^ (((sb >> 9) & 1) << 5); R = (st >> 1) * 16 + swz / 64; C = (st & 1) * 32 + (swz % 64) / 2; }
__host__ __device__ __forceinline__ int perm32(int rho) { const int n = rho >> 4, i = rho & 15; return 8 * (i >> 2) + 4 * n + (i & 3); }

typedef int i32x8 __attribute__((ext_vector_type(8)));
typedef int i32x4_ __attribute__((ext_vector_type(4)));
template <bool F8> struct OperandT { typedef bf16x8 T; };
template <> struct OperandT<true> { typedef i32x8 T; };
__device__ __forceinline__ i32x8 ld_f8(const PG8_LAS unsigned char* p) { const i32x4_ lo = *(const PG8_LAS i32x4_*)p, hi = *(const PG8_LAS i32x4_*)(p + 1024); return __builtin_shufflevector(lo, hi, 0, 1, 2, 3, 4, 5, 6, 7); }
__device__ __forceinline__ f32x4 mma_f8(const i32x8 b, const i32x8 a, const f32x4 c) { return __builtin_amdgcn_mfma_scale_f32_16x16x128_f8f6f4(b, a, c, 0, 0, 0, 0, 0, 0); }
__device__ __forceinline__ f32x4 mma_f8(const bf16x8, const bf16x8, const f32x4 c) { return c; }
struct Unit { int pm, pn, pb; };
struct Gemm { const bf16_t* A; const bf16_t* Bt; int M, N, K; };

template <bool F8_, int MAP = 0> struct StaticOrderT {
    static constexpr bool GATHER = false, F8 = F8_; __device__ __forceinline__ unsigned row_off(int, int) const { return 0u; }
    int nM, nN, nwg, G, c;
    __host__ __device__ void init(int M, int N, int G_, int c_) { nM = M / BM; nN = N / BM; nwg = nM * nN; G = G_; c = c_; }
    __host__ __device__ bool next(int i, Unit& u) const {
        const long L = (long)i * G + c; if (L >= nwg) return false;
        int wgid = (int)L; { const int q = nwg / NXCD, r = nwg % NXCD, xcd = wgid % NXCD, off = wgid / NXCD; wgid = (xcd < r ? xcd * (q + 1) : r * (q + 1) + (xcd - r) * q) + off; }
        const int nig = WGM * nN, gid = wgid / nig, fm = gid * WGM, gsz = (nM - fm) < WGM ? (nM - fm) : WGM;
        u.pm = fm + ((wgid % nig) % gsz); u.pn = (wgid % nig) / gsz;
        if (MAP == 1) u.pn = u.pn < 4 ? u.pn : (u.pn < 24 ? u.pn + 4 : u.pn + 7);
        if (MAP == 2) u.pn = u.pn < 4 ? u.pn + 4 : u.pn + 24;
        u.pb = u.pn; return true;
    }
    __device__ __forceinline__ void a_ready(const Unit&) const {}
    __device__ __forceinline__ void done(const Unit&) const {}
};
typedef StaticOrderT<false> StaticOrder;
typedef StaticOrderT<true> StaticOrderF8;


__device__ __forceinline__ unsigned cvt_pk_bf16(float lo, float hi) { unsigned r; asm volatile("v_cvt_pk_bf16_f32 %0, %1, %2" : "=v"(r) : "v"(lo), "v"(hi)); return r; }
__device__ __forceinline__ float sigm(float x) { return __builtin_amdgcn_rcpf(1.0f + __expf(-x)); }

template <bool F8IN> struct EpiProjT {
    static constexpr bool PERM = true, AFTER_DRAIN = false;
    unsigned char* ws; const PG8_LAS unsigned char* lbias;
    __device__ __forceinline__ void operator()(const f32x4 (&acc)[2][2][4][2], const Unit& u, int wr, int wc, int fr, int fq) const {
        const int pn = u.pn, row0 = u.pm * BM + wr * 64 + fr, lc0 = wc * 32 + 8 * fq; constexpr float usc = F8IN ? F8_UNSCALE : 1.0f;
        f32x4 bv[2][2];
#pragma unroll
        for (int bj = 0; bj < 2; ++bj) { const u32x4 bw = *(const PG8_LAS u32x4*)(lbias + (size_t)(pn * 256 + lc0 + bj * HALF) * 2);
            bv[bj][0] = (f32x4){__uint_as_float(bw.x << 16), __uint_as_float(bw.x & 0xffff0000u), __uint_as_float(bw.y << 16), __uint_as_float(bw.y & 0xffff0000u)};
            bv[bj][1] = (f32x4){__uint_as_float(bw.z << 16), __uint_as_float(bw.z & 0xffff0000u), __uint_as_float(bw.w << 16), __uint_as_float(bw.w & 0xffff0000u)}; }
        if (pn >= 4 && pn < 8) {
            float* base = (float*)(ws + WS_AF);
#pragma unroll
            for (int ai = 0; ai < 2; ++ai)
#pragma unroll
                for (int m = 0; m < 4; ++m) { float* rowp = base + (size_t)(row0 + ai * HALF + m * 16) * 1024 + (pn - 4) * 256 + lc0;
#pragma unroll
                    for (int bj = 0; bj < 2; ++bj) { *(f32x4*)(rowp + bj * HALF) = acc[ai][bj][m][0] * usc + bv[bj][0]; *(f32x4*)(rowp + bj * HALF + 4) = acc[ai][bj][m][1] * usc + bv[bj][1]; } }
            return;
        }
        bf16_t* base; int ldc, colt; bool sg = false;
        if (pn < 28) { const int s = pn >> 2, idx = (s == 0) ? 0 : s - 1; base = (bf16_t*)(ws + WS_AQ + (size_t)idx * (32 * MiB)); ldc = 1024; colt = (pn & 3) * 256; }
        else if (pn < 30) { base = (bf16_t*)(ws + WS_IQ); ldc = 512; colt = (pn - 28) * 256; }
        else if (pn == 30) { base = (bf16_t*)(ws + WS_IKW); ldc = 256; colt = 0; }
        else { base = (bf16_t*)(ws + WS_GATES); ldc = 4096; colt = (pn - 31) * 256; sg = true; }
#pragma unroll
        for (int ai = 0; ai < 2; ++ai)
#pragma unroll
            for (int m = 0; m < 4; ++m) { bf16_t* rowp = base + (size_t)(row0 + ai * HALF + m * 16) * ldc + colt + lc0;
#pragma unroll
                for (int bj = 0; bj < 2; ++bj) { f32x4 v0 = acc[ai][bj][m][0] * usc + bv[bj][0], v1 = acc[ai][bj][m][1] * usc + bv[bj][1];
                    if (sg) { v0 = (f32x4){sigm(v0[0]), sigm(v0[1]), sigm(v0[2]), sigm(v0[3])}; v1 = (f32x4){sigm(v1[0]), sigm(v1[1]), sigm(v1[2]), sigm(v1[3])}; }
                    u32x4 w; w.x = cvt_pk_bf16(v0[0], v0[1]); w.y = cvt_pk_bf16(v0[2], v0[3]); w.z = cvt_pk_bf16(v1[0], v1[1]); w.w = cvt_pk_bf16(v1[2], v1[3]);
                    *(u32x4*)(rowp + bj * HALF) = w;
                    if (pn == 30 && bj == 0 && lc0 < 64) {
                        const int tok = row0 + ai * HALF + m * 16;
                        *(u32x4*)((bf16_t*)(ws + WS_IK2) + ((size_t)((tok >> 5) * 4 + (lc0 >> 4)) * 64 + ((lc0 >> 3) & 1) * 32 + (tok & 31)) * 8) = w; } } }
    }
};

typedef EpiProjT<false> EpiProj;
__device__ __forceinline__ f32x4 bf4lo(u32x4 w) { return (f32x4){__uint_as_float(w.x << 16), __uint_as_float(w.x & 0xffff0000u), __uint_as_float(w.y << 16), __uint_as_float(w.y & 0xffff0000u)}; }
__device__ __forceinline__ f32x4 bf4hi(u32x4 w) { return (f32x4){__uint_as_float(w.z << 16), __uint_as_float(w.z & 0xffff0000u), __uint_as_float(w.w << 16), __uint_as_float(w.w & 0xffff0000u)}; }

template <int MODE> struct EpiBranch {
    static constexpr bool PERM = true, AFTER_DRAIN = false;
    bf16_t* merged; const bf16_t* gates; unsigned char* merged8;
    __device__ __forceinline__ void operator()(const f32x4 (&acc)[2][2][4][2], const Unit& u, int wr, int wc, int fr, int fq) const {
        const int row0 = u.pm * BM + wr * 64 + fr, col0 = u.pn * BM + wc * 32 + 8 * fq;
#pragma unroll
        for (int ai = 0; ai < 2; ++ai)
#pragma unroll
            for (int m = 0; m < 4; ++m) { const size_t r = (size_t)(row0 + ai * HALF + m * 16);
#pragma unroll
                for (int bj = 0; bj < 2; ++bj) { const int c = col0 + bj * HALF;
                    const u32x4 gw = *(const u32x4*)(gates + r * 4096 + MODE * 2048 + c);
                    f32x4 v0 = acc[ai][bj][m][0] * (bf4lo(gw) * F8_UNSCALE), v1 = acc[ai][bj][m][1] * (bf4hi(gw) * F8_UNSCALE);
                    if (MODE == 1) { const u32x4 pw = *(const u32x4*)(merged + r * 2048 + c); v0 = v0 + bf4lo(pw); v1 = v1 + bf4hi(pw);
                        *(u32x2*)(merged8 + r * 2048 + c) = (u32x2){cvt4_fp8(v0[0], v0[1], v0[2], v0[3], F8_ASCALE), cvt4_fp8(v1[0], v1[1], v1[2], v1[3], F8_ASCALE)}; }
                    else { u32x4 w; w.x = cvt_pk_bf16(v0[0], v0[1]); w.y = cvt_pk_bf16(v0[2], v0[3]); w.z = cvt_pk_bf16(v1[0], v1[1]); w.w = cvt_pk_bf16(v1[2], v1[3]);
                        *(u32x4*)(merged + r * 2048 + c) = w; } } }
    }
};

struct EpiResBf16 {
    static constexpr bool PERM = true, AFTER_DRAIN = false;
    bf16_t* C; const float* x; float alpha;
    __device__ __forceinline__ void operator()(const f32x4 (&acc)[2][2][4][2], const Unit& u, int wr, int wc, int fr, int fq) const {
        const int row0 = u.pm * BM + wr * 64 + fr, col0 = u.pn * BM + wc * 32 + 8 * fq;
#pragma unroll
        for (int ai = 0; ai < 2; ++ai)
#pragma unroll
            for (int m = 0; m < 4; ++m) { const size_t off = (size_t)(row0 + ai * HALF + m * 16) * 2048 + col0;
#pragma unroll
                for (int bj = 0; bj < 2; ++bj) { const f32x4 x0 = *(const f32x4*)(x + off + bj * HALF), x1 = *(const f32x4*)(x + off + bj * HALF + 4);
                    const f32x4 v0 = x0 * alpha + acc[ai][bj][m][0] * F8_UNSCALE, v1 = x1 * alpha + acc[ai][bj][m][1] * F8_UNSCALE;
                    u32x4 w; w.x = cvt_pk_bf16(v0[0], v0[1]); w.y = cvt_pk_bf16(v0[2], v0[3]); w.z = cvt_pk_bf16(v1[0], v1[1]); w.w = cvt_pk_bf16(v1[2], v1[3]);
                    *(u32x4*)(C + off + bj * HALF) = w; } }
    }
};

struct EpiGateUp {
    static constexpr bool PERM = true, AFTER_DRAIN = false;
    unsigned char* H;
    __device__ __forceinline__ void operator()(const f32x4 (&acc)[2][2][4][2], const Unit& u, int wr, int wc, int fr, int fq) const {
        const int row0 = u.pm * BM + wr * 64 + fr, hc0 = u.pn * 128 + wc * 16 + 4 * fq;
#pragma unroll
        for (int ai = 0; ai < 2; ++ai)
#pragma unroll
            for (int m = 0; m < 4; ++m) { unsigned char* rowp = H + (size_t)(row0 + ai * HALF + m * 16) * 1024 + hc0;
#pragma unroll
                for (int bj = 0; bj < 2; ++bj) { const f32x4 g = acc[ai][bj][m][0], up = acc[ai][bj][m][1];
                    f32x4 h;
#pragma unroll
                    for (int j = 0; j < 4; ++j) { const float gj = g[j] * F8_UNSCALE; h[j] = gj * sigm(gj) * (up[j] * F8_UNSCALE); }
                    *(unsigned*)(rowp + bj * 64) = cvt4_fp8(h[0], h[1], h[2], h[3], F8_ASCALE); } }
    }
};

struct EpiStoreBf16 {
    static constexpr bool PERM = true, AFTER_DRAIN = false;
    bf16_t* O; int ldc; float one;
    __device__ __forceinline__ void operator()(const f32x4 (&acc)[2][2][4][2], const Unit& u, int wr, int wc, int fr, int fq) const {
        const int row0 = u.pm * BM + wr * 64 + fr, col0 = u.pn * BM + wc * 32 + 8 * fq;
#pragma unroll
        for (int ai = 0; ai < 2; ++ai)
#pragma unroll
            for (int m = 0; m < 4; ++m) { bf16_t* rowp = O + (size_t)(row0 + ai * HALF + m * 16) * ldc + col0;
#pragma unroll
                for (int bj = 0; bj < 2; ++bj) { const f32x4 v0 = acc[ai][bj][m][0] * one, v1 = acc[ai][bj][m][1] * one;
                    u32x4 w; w.x = cvt_pk_bf16(v0[0], v0[1]); w.y = cvt_pk_bf16(v0[2], v0[3]); w.z = cvt_pk_bf16(v1[0], v1[1]); w.w = cvt_pk_bf16(v1[2], v1[3]);
                    *(u32x4*)(rowp + bj * HALF) = w; } }
    }
};

template <bool GATH> struct GroupedOrder {
    static constexpr bool GATHER = GATH, F8 = true;
    int nM, nN, nwg, G, c; const PG8_LAS unsigned* tile_e; const PG8_LAS unsigned* tokoff;
    __device__ __forceinline__ void init(int nT, int nN_, int G_, int c_, const PG8_LAS unsigned* te, const PG8_LAS unsigned* to) { nM = nT; nN = nN_; nwg = nM * nN; G = G_; c = c_; tile_e = te; tokoff = to; }
    __device__ __forceinline__ bool next(int i, Unit& u) const {
        const long L = (long)i * G + c; if (L >= nwg) return false;
        int wgid = (int)L; { const int q = nwg / NXCD, r = nwg % NXCD, xcd = wgid % NXCD, off = wgid / NXCD; wgid = (xcd < r ? xcd * (q + 1) : r * (q + 1) + (xcd - r) * q) + off; }
        const int nig = WGM * nN, gid = wgid / nig, fm = gid * WGM, gsz = (nM - fm) < WGM ? (nM - fm) : WGM;
        u.pm = fm + ((wgid % nig) % gsz); u.pn = (wgid % nig) / gsz; u.pb = (int)tile_e[u.pm] * nN + u.pn; return true;
    }
    __device__ __forceinline__ unsigned row_off(int ui, int r) const { return tokoff[ui * 256 + r]; }
    __device__ __forceinline__ void a_ready(const Unit&) const {}
    __device__ __forceinline__ void done(const Unit&) const {}
};

template <class Epi, class Sched, bool ALIGN_EPI = false, bool SP2 = false>
__device__ __forceinline__ void gemm_phase(PG8_LAS unsigned char* lds, const Gemm g, const Sched& S, const Epi& E) {
    int tid_ = cur_tid((const LAS unsigned char*)lds); asm volatile("" : "+v"(tid_));
    const int tid = tid_, wid = __builtin_amdgcn_readfirstlane(tid >> 6), lane = tid & 63, wr = wid >> 2, wc = wid & 3, fr = lane & 15, fq = lane >> 4;
    const int K = g.K, nt = K / BK;
    constexpr bool F8 = Sched::F8;
    constexpr bool GATHER = Sched::GATHER;
    unsigned voffA[2], voffB[2], cAoff[2]; int rA[2];
#pragma unroll
    for (int i = 0; i < 2; ++i) { int R, C; stage_rc(tid * 16 + i * 8192, R, C); const int Rb = Epi::PERM ? ((R & ~31) + perm32(R & 31)) : R;
        voffA[i] = (unsigned)(R * K + C) * 2u; voffB[i] = (unsigned)(Rb * K + C) * 2u; cAoff[i] = (unsigned)C * 2u; rA[i] = R; }
    const size_t kstep = (size_t)(BK * 2);
    const size_t hstep = (size_t)HALF * K * 2;
    const size_t tstep = 2 * hstep;
    const unsigned ldsw = (unsigned)wid * 1024u;
    const int aoff = lds_byte(wr * 64 + fr, fq * 8), boff = lds_byte(wc * 32 + fr, fq * 8);
#define PG8_SA(b, h) (((b) * 2 + (h)) * HTB)
#define PG8_SB(b, h) ((4 + (b) * 2 + (h)) * HTB)
#define PG8_GLDS(gbase, vo, ldsoff) do { if constexpr (F8) asm volatile("s_mov_b32 m0, %2\n\ts_nop 0\n\tglobal_load_lds_dwordx4 %0, %1" :: "v"(vo), "s"((const char*)(gbase)), "s"((unsigned)(uintptr_t)(lds + (ldsoff))) : "memory", "m0"); \
        else __builtin_amdgcn_global_load_lds((const unsigned*)((const char*)(gbase) + (vo)), (PG8_LAS unsigned*)(lds + (ldsoff)), 16, 0, 0); } while (0)
#define PG8_STAGE(bufoff, gbase, voff) do { _Pragma("unroll") for (int _i = 0; _i < 2; ++_i) PG8_GLDS(gbase, (voff)[_i], (bufoff) + ldsw + _i * 8192); } while (0)
#define PG8_STAGE_A(bufoff, gbase, h, nx) do { _Pragma("unroll") for (int _i = 0; _i < 2; ++_i) { const unsigned vo_ = GATHER ? (((nx) && has_next) ? PG8_GOFF(ui + 1, h, _i) : vAc[h][_i]) : voffA[_i]; \
        PG8_GLDS(gbase, vo_, (bufoff) + ldsw + _i * 8192); } } while (0)
#define PG8_LDA(dst, b, h) do { _Pragma("unroll") for (int m = 0; m < 4; ++m) { if constexpr (F8) dst[m][0] = ld_f8(lds + PG8_SA(b, h) + aoff + m * 2048); \
        else { _Pragma("unroll") for (int k = 0; k < 2; ++k) dst[m][k] = *(const PG8_LAS OpT*)(lds + PG8_SA(b, h) + aoff + m * 2048 + k * 1024); } } } while (0)
#define PG8_LDB(dst, b, h) do { _Pragma("unroll") for (int n = 0; n < 2; ++n) { if constexpr (F8) dst[n][0] = ld_f8(lds + PG8_SB(b, h) + boff + n * 2048); \
        else { _Pragma("unroll") for (int k = 0; k < 2; ++k) dst[n][k] = *(const PG8_LAS OpT*)(lds + PG8_SB(b, h) + boff + n * 2048 + k * 1024); } } } while (0)
#define PG8_MMA(ai, bj, At, Bt) do { if constexpr (F8) __builtin_amdgcn_sched_barrier(0); __builtin_amdgcn_s_setprio(1); _Pragma("unroll") for (int m = 0; m < 4; ++m) _Pragma("unroll") for (int n = 0; n < 2; ++n) { \
        if constexpr (F8) acc[ai][bj][m][n] = mma_f8(Bt[n][0], At[m][0], acc[ai][bj][m][n]); \
        else { _Pragma("unroll") for (int k = 0; k < 2; ++k) acc[ai][bj][m][n] = __builtin_amdgcn_mfma_f32_16x16x32_bf16(Bt[n][k], At[m][k], acc[ai][bj][m][n], 0, 0, 0); } } \
        __builtin_amdgcn_s_setprio(0); if constexpr (F8) __builtin_amdgcn_sched_barrier(0); } while (0)
#define PG8_WAIT_V(n) asm volatile("s_waitcnt vmcnt(" #n ")" ::: "memory")
#define PG8_WAIT_L(n) asm volatile("s_waitcnt lgkmcnt(" #n ")" ::: "memory")
#define PG8_BAR __builtin_amdgcn_s_barrier()
#define PG8_SCHED __builtin_amdgcn_sched_barrier(0)
    Unit cur, nxt; int ui = 0;
    if (!S.next(0, cur)) return;
    f32x4 acc[2][2][4][2];
#pragma unroll
    for (int a = 0; a < 2; ++a)
#pragma unroll
        for (int b = 0; b < 2; ++b)
#pragma unroll
            for (int m = 0; m < 4; ++m)
#pragma unroll
                for (int n = 0; n < 2; ++n) acc[a][b][m][n] = (f32x4){0.f, 0.f, 0.f, 0.f};
    using OpT = typename OperandT<F8>::T; constexpr int NK = F8 ? 1 : 2;
    OpT At[4][NK], B0[2][NK], B1[2][NK];
    const size_t hstepA = GATHER ? 0 : hstep;
#define PG8_GOFF(ui_, h, i) (S.row_off((ui_), (h) * HALF + rA[i]) + cAoff[i])
    unsigned vAc[2][2]; bool has_next = false;
#pragma unroll
    for (int h = 0; h < 2; ++h)
#pragma unroll
        for (int i = 0; i < 2; ++i) vAc[h][i] = GATHER ? PG8_GOFF(0, h, i) : 0u;
    const char* cA = (const char*)g.A + (GATHER ? (size_t)0 : (size_t)cur.pm * tstep); const char* cB = (const char*)g.Bt + (size_t)cur.pb * tstep;
    S.a_ready(cur);
    if constexpr (SP2) {
        PG8_STAGE(PG8_SB(0, 0), cB, voffB); PG8_STAGE(PG8_SB(0, 1), cB + hstep, voffB); PG8_STAGE_A(PG8_SA(0, 0), cA, 0, false); PG8_STAGE_A(PG8_SA(0, 1), cA + hstepA, 1, false);
        if (wr == 1) PG8_BAR;
        PG8_WAIT_V(2); PG8_BAR;
        PG8_STAGE(PG8_SB(1, 0), cB + kstep, voffB); PG8_STAGE_A(PG8_SA(1, 0), cA + kstep, 0, false); PG8_STAGE(PG8_SB(1, 1), cB + hstep + kstep, voffB);
        PG8_WAIT_V(6); PG8_BAR;
    } else {
        PG8_STAGE(PG8_SB(0, 0), cB, voffB); PG8_STAGE_A(PG8_SA(0, 0), cA, 0, false); PG8_STAGE(PG8_SB(0, 1), cB + hstep, voffB); PG8_STAGE_A(PG8_SA(0, 1), cA + hstepA, 1, false);
        if (wr == 1) PG8_BAR;
        PG8_WAIT_V(4); PG8_BAR;
        PG8_STAGE(PG8_SB(1, 0), cB + kstep, voffB); PG8_STAGE_A(PG8_SA(1, 0), cA + kstep, 0, false); PG8_STAGE(PG8_SB(1, 1), cB + hstep + kstep, voffB);
        PG8_WAIT_V(6); PG8_BAR;
    }
    for (;;) {
        has_next = S.next(ui + 1, nxt);
        const char* nA = has_next ? (const char*)g.A + (GATHER ? (size_t)0 : (size_t)nxt.pm * tstep) : cA; const char* nB = has_next ? (const char*)g.Bt + (size_t)nxt.pb * tstep : cB;
        for (int t = 0; t < nt; t += 2) {
            const bool last = (t == nt - 2);
            const char* a1 = cA + (size_t)(t + 1) * kstep;
            const char* a2 = last ? nA : cA + (size_t)(t + 2) * kstep; const char* b2 = last ? nB : cB + (size_t)(t + 2) * kstep;
            const char* a3 = a2 + kstep; const char* b3 = b2 + kstep;
            if (last && has_next) S.a_ready(nxt);
            if constexpr (SP2) {
            PG8_LDB(B0, 0, 0); PG8_LDB(B1, 0, 1); PG8_SCHED; PG8_LDA(At, 0, 0); PG8_STAGE_A(PG8_SA(1, 1), a1 + hstepA, 1, false);
            PG8_WAIT_V(8); PG8_WAIT_L(0); PG8_BAR; PG8_MMA(0, 0, At, B0); PG8_MMA(0, 1, At, B1); PG8_BAR; PG8_SCHED;
            PG8_LDA(At, 0, 1); PG8_STAGE(PG8_SB(0, 0), b2, voffB); PG8_STAGE(PG8_SB(0, 1), b2 + hstep, voffB); PG8_STAGE_A(PG8_SA(0, 0), a2, 0, last);
            PG8_WAIT_V(8); PG8_WAIT_L(0); PG8_BAR; PG8_MMA(1, 0, At, B0); PG8_MMA(1, 1, At, B1); PG8_BAR; PG8_SCHED;
            PG8_LDB(B0, 1, 0); PG8_LDB(B1, 1, 1); PG8_SCHED; PG8_LDA(At, 1, 0); PG8_STAGE_A(PG8_SA(0, 1), a2 + hstepA, 1, last);
            PG8_WAIT_V(8); PG8_WAIT_L(0); PG8_BAR; PG8_MMA(0, 0, At, B0); PG8_MMA(0, 1, At, B1); PG8_BAR; PG8_SCHED;
            PG8_LDA(At, 1, 1); PG8_STAGE(PG8_SB(1, 0), b3, voffB); PG8_STAGE(PG8_SB(1, 1), b3 + hstep, voffB); PG8_STAGE_A(PG8_SA(1, 0), a3, 0, last);
            PG8_WAIT_V(8); PG8_WAIT_L(0); PG8_BAR; PG8_MMA(1, 0, At, B0); PG8_MMA(1, 1, At, B1); PG8_BAR; PG8_SCHED;
            } else {
            PG8_LDB(B0, 0, 0); PG8_SCHED; PG8_LDA(At, 0, 0); PG8_STAGE_A(PG8_SA(1, 1), a1 + hstepA, 1, false);
            PG8_WAIT_L(8); PG8_BAR; PG8_WAIT_L(0); PG8_MMA(0, 0, At, B0); PG8_BAR; PG8_SCHED;
            PG8_LDB(B1, 0, 1); PG8_STAGE(PG8_SB(0, 0), b2, voffB);
            PG8_BAR; PG8_WAIT_L(0); PG8_MMA(0, 1, At, B1); PG8_BAR;
            PG8_LDA(At, 0, 1); PG8_STAGE_A(PG8_SA(0, 0), a2, 0, last);
            PG8_BAR; PG8_WAIT_L(0); PG8_MMA(1, 0, At, B0); PG8_BAR; PG8_SCHED;
            PG8_STAGE(PG8_SB(0, 1), b2 + hstep, voffB);
            PG8_WAIT_V(6); PG8_BAR; PG8_MMA(1, 1, At, B1); PG8_BAR;
            PG8_LDB(B0, 1, 0); PG8_SCHED; PG8_LDA(At, 1, 0); PG8_STAGE_A(PG8_SA(0, 1), a2 + hstepA, 1, last);
            PG8_WAIT_L(8); PG8_BAR; PG8_WAIT_L(0); PG8_MMA(0, 0, At, B0); PG8_BAR; PG8_SCHED;
            PG8_LDB(B1, 1, 1); PG8_STAGE(PG8_SB(1, 0), b3, voffB);
            PG8_BAR; PG8_WAIT_L(0); PG8_MMA(0, 1, At, B1); PG8_BAR;
            PG8_LDA(At, 1, 1); PG8_STAGE_A(PG8_SA(1, 0), a3, 0, last);
            PG8_BAR; PG8_WAIT_L(0); PG8_MMA(1, 0, At, B0); PG8_BAR; PG8_SCHED;
            PG8_STAGE(PG8_SB(1, 1), b3 + hstep, voffB);
            PG8_WAIT_V(6); PG8_BAR; PG8_MMA(1, 1, At, B1); PG8_BAR;
            }
        }
        if constexpr (ALIGN_EPI) { if (wr == 0) PG8_BAR; }
        if constexpr (!Epi::AFTER_DRAIN) { int fr_ = fr, fq_ = fq; asm volatile("" : "+v"(fr_), "+v"(fq_));
            E(acc, cur, wr, wc, fr_, fq_); S.done(cur); }
        if (!has_next) break;
#pragma unroll
        for (int a = 0; a < 2; ++a)
#pragma unroll
            for (int b = 0; b < 2; ++b)
#pragma unroll
                for (int m = 0; m < 4; ++m)
#pragma unroll
                    for (int n = 0; n < 2; ++n) acc[a][b][m][n] = (f32x4){0.f, 0.f, 0.f, 0.f};
        cur = nxt; cA = nA; cB = nB; ++ui;
#pragma unroll
        for (int h = 0; h < 2; ++h)
#pragma unroll
            for (int i = 0; i < 2; ++i) if (GATHER) vAc[h][i] = PG8_GOFF(ui, h, i);
        if constexpr (ALIGN_EPI) { if (wr == 1) PG8_BAR; }
    }
    PG8_WAIT_V(0);
    if constexpr (!ALIGN_EPI) { if (wr == 0) PG8_BAR; }
    PG8_BAR;
    if constexpr (Epi::AFTER_DRAIN) { E.fused(acc, cur, wr, wc, fr, fq, lds, wid, lane); S.done(cur); }
#undef PG8_SA
#undef PG8_SB
#undef PG8_STAGE
#undef PG8_STAGE_A
#undef PG8_GOFF
#undef PG8_LDA
#undef PG8_LDB
#undef PG8_MMA
#undef PG8_WAIT_V
#undef PG8_WAIT_L
#undef PG8_BAR
#undef PG8_SCHED
}
}
#define XB_TMO      128
#define XB_XCNT(j)  (256  + 64 * (j))
#define XB_XSUB(j)  (1280 + 64 * (j))
#define XB_XGEN(j)  (2304 + 64 * (j))
#define XB_TOP      3328
#define XB_TOPGEN   3392
#define XCD_BAR_WORDS 3456
#define XB_SPIN_CAP (1u << 18)

__device__ __forceinline__ unsigned xb_ld(unsigned* p)              { return __hip_atomic_load(p, __ATOMIC_RELAXED, __HIP_MEMORY_SCOPE_AGENT); }
__device__ __forceinline__ unsigned xb_add(unsigned* p, unsigned v) { return __hip_atomic_fetch_add(p, v, __ATOMIC_RELAXED, __HIP_MEMORY_SCOPE_AGENT); }
__device__ __forceinline__ unsigned xb_xcc_id() { return (unsigned)__builtin_amdgcn_s_getreg((3 << 11) | 20) & 0xFu; }
#define XB_SPIN(cond, bar) do { unsigned _sp = 0; while (cond) { __builtin_amdgcn_s_sleep(1); \
    if ((++_sp & 255u) == 0u) { if (xb_ld(&(bar)[XB_TMO])) break; if (_sp > XB_SPIN_CAP) { atomicAdd(&(bar)[XB_TMO], 1u); break; } } } } while (0)

struct XcdBarrier {
    unsigned* bar; unsigned x;
    volatile LAS unsigned* st;
};

__device__ __forceinline__ XcdBarrier xcd_barrier_post(unsigned* bar, volatile LAS unsigned* st) {
    XcdBarrier b; b.bar = bar; b.x = xb_xcc_id(); b.st = st;
    if (threadIdx.x == 0) (void)xb_add(&bar[XB_XCNT(b.x)], 1u);
    return b;
}
__device__ __forceinline__ void xcd_barrier_complete(unsigned* bar, unsigned x, unsigned& nloc, unsigned& nx) {
    const unsigned G = gridDim.x * gridDim.y * gridDim.z;
    unsigned sum, cnt, mine, sp = 0u;
    for (;;) {
        sum = 0u; cnt = 0u; mine = 0u;
#pragma unroll
        for (unsigned j = 0; j < 16; ++j) { const unsigned c = xb_ld(&bar[XB_XCNT(j)]); sum += c; cnt += (c > 0u) ? 1u : 0u; mine = (j == x) ? c : mine; }
        if (sum == G) break;
        __builtin_amdgcn_s_sleep(1);
        if ((++sp & 255u) == 0u) { if (xb_ld(&bar[XB_TMO])) break; if (sp > XB_SPIN_CAP) { atomicAdd(&bar[XB_TMO], 1u); break; } }
    }
    nloc = mine > 0u ? mine : 1u; nx = cnt > 0u ? cnt : 1u;
}

__device__ __forceinline__ void xcd_barrier(const XcdBarrier& b) {
    asm volatile("s_waitcnt vmcnt(0)" ::: "memory");
    __syncthreads();
    if (cur_tid((const LAS unsigned char*)b.st - LDS_BARST) == 0) {
        unsigned* bar = b.bar;
        __builtin_amdgcn_s_waitcnt(0);
        unsigned nloc = b.st[0], nx = b.st[1];
        if (nloc == 0u) { xcd_barrier_complete(bar, b.x, nloc, nx); b.st[0] = nloc; b.st[1] = nx; }
        const unsigned old = xb_add(&bar[XB_XSUB(b.x)], 1u);
        const unsigned gen = old / nloc;
        if (old + 1u == (gen + 1u) * nloc) {
            __builtin_amdgcn_fence(__ATOMIC_RELEASE, "agent");
            asm volatile("s_waitcnt vmcnt(0)" ::: "memory");
            const unsigned og = xb_add(&bar[XB_TOP], 1u);
            const unsigned tg = og / nx;
            if (og + 1u == (tg + 1u) * nx) xb_add(&bar[XB_TOPGEN], 1u);
            else XB_SPIN(xb_ld(&bar[XB_TOPGEN]) == tg, bar);
            __builtin_amdgcn_fence(__ATOMIC_ACQUIRE, "agent");
            xb_add(&bar[XB_XGEN(b.x)], 1u);
            asm volatile("s_waitcnt vmcnt(0)" ::: "memory");
        } else {
            XB_SPIN(xb_ld(&bar[XB_XGEN(b.x)]) == gen, bar);
            __builtin_amdgcn_fence(__ATOMIC_ACQUIRE, "agent");
            asm volatile("s_waitcnt vmcnt(0)" ::: "memory");
        }
    }
    __syncthreads();
}

struct Args { const float* in[19]; float* out; unsigned char* ws; int ph_lo, ph_hi; };
enum { I_X = 0, I_WIN, I_BIN, I_LB, I_HGNG, I_WA, I_WB, I_WOUT, I_LN1G, I_LN1B, I_WGRP, I_BGRP, I_WRT, I_BRT, I_WGATE, I_WUP, I_WDOWN, I_LN2G, I_LN2B };

__device__ __forceinline__ void transpose_item(const float* src4, size_t ldw, bf16_t* WT, size_t K, int dest_row0, int k0, LAS float* scr, int lane) {
    f32x4 v[8];
#pragma unroll
    for (int i = 0; i < 8; ++i) v[i] = src4 ? __builtin_nontemporal_load((const f32x4*)(src4 + (size_t)(8 * i) * ldw)) : (f32x4){0.f, 0.f, 0.f, 0.f};
#pragma unroll
    for (int i = 0; i < 8; ++i) { const int k = 8 * i + (lane >> 3), n4 = (lane & 7) * 4;
        scr[k * 33 + n4 + 0] = v[i][0]; scr[k * 33 + n4 + 1] = v[i][1]; scr[k * 33 + n4 + 2] = v[i][2]; scr[k * 33 + n4 + 3] = v[i][3]; }
    LDS_WAIT(); asm volatile("" ::: "memory");
    const int c = lane & 7;
#pragma unroll
    for (int j = 0; j < 4; ++j) { const int n = (lane >> 3) + 8 * j; const LAS float* s = scr + (8 * c) * 33 + n;
        u32x4 o; o.x = cvt_pk(s[0 * 33], s[1 * 33]); o.y = cvt_pk(s[2 * 33], s[3 * 33]); o.z = cvt_pk(s[4 * 33], s[5 * 33]); o.w = cvt_pk(s[6 * 33], s[7 * 33]);
        *(u32x4*)(WT + (size_t)(dest_row0 + n) * K + k0 + 8 * c) = o; }
    LDS_WAIT(); asm volatile("" ::: "memory");
}

__device__ __forceinline__ void transpose_item_f8(const float* src4, size_t ldw, unsigned char* WT, size_t K, int dest_row0, int k0, LAS float* scr, int lane) {
    f32x4 v[8];
#pragma unroll
    for (int i = 0; i < 8; ++i) v[i] = src4 ? __builtin_nontemporal_load((const f32x4*)(src4 + (size_t)(8 * i) * ldw)) : (f32x4){0.f, 0.f, 0.f, 0.f};
#pragma unroll
    for (int i = 0; i < 8; ++i) { const int k = 8 * i + (lane >> 3), n4 = (lane & 7) * 4;
        scr[k * 33 + n4 + 0] = v[i][0]; scr[k * 33 + n4 + 1] = v[i][1]; scr[k * 33 + n4 + 2] = v[i][2]; scr[k * 33 + n4 + 3] = v[i][3]; }
    LDS_WAIT(); asm volatile("" ::: "memory");
    const int c = lane & 3;
#pragma unroll
    for (int j = 0; j < 2; ++j) { const int n = (lane >> 2) + 16 * j; const LAS float* s = scr + (16 * c) * 33 + n;
        u32x4 o;
#pragma unroll
        for (int q = 0; q < 4; ++q) o[q] = cvt4_fp8_nc(s[(4 * q) * 33], s[(4 * q + 1) * 33], s[(4 * q + 2) * 33], s[(4 * q + 3) * 33], F8_WSCALE);
        *(u32x4*)(WT + (size_t)(dest_row0 + n) * K + k0 + 16 * c) = o; }
    LDS_WAIT(); asm volatile("" ::: "memory");
}
__device__ __forceinline__ void phase_prologue(const Args& a, LAS unsigned char* lds, int tid, int G) {
    unsigned char* ws = a.ws;
    { const float* x = a.in[I_X]; bf16_t* xb = (bf16_t*)(ws + WS_XB); const size_t n8 = (size_t)MT * DM / 8;
#pragma unroll 4
      for (size_t i = (size_t)blockIdx.x * NTHR + tid; i < n8; i += (size_t)G * NTHR) {
          const f32x4 p = __builtin_nontemporal_load((const f32x4*)(x + i * 8)), q = __builtin_nontemporal_load((const f32x4*)(x + i * 8 + 4));
          u32x4 o; o.x = cvt_pk(p[0], p[1]); o.y = cvt_pk(p[2], p[3]); o.z = cvt_pk(q[0], q[1]); o.w = cvt_pk(q[2], q[3]);
          *(u32x4*)(xb + i * 8) = o;
          *(u32x2*)(ws + WS_X8 + i * 8) = (u32x2){cvt4_fp8(p[0], p[1], p[2], p[3], F8_ASCALE), cvt4_fp8(q[0], q[1], q[2], q[3], F8_ASCALE)}; } }
    asm volatile("" : "+v"(tid));
    const int lane = tid & 63, wave = tid >> 6;
    LAS float* scr = (LAS float*)(lds + wave * 8704);
    const int gw = blockIdx.x * NWAVES + wave, NGW = G * NWAVES;
    constexpr int IT_IN = (NPROJ_PAD / 32) * (DM / 64);
    constexpr int IT_A = (DM / 32) * (1024 / 64);
    constexpr int IT_OUT = (DM / 32) * (DM / 64);
    constexpr int NIT = IT_IN + 2 * IT_A + IT_OUT;
    for (int it = gw; it < NIT; it += NGW) {
        int r = it;
        if (r < IT_IN) { const int kb = r / (NPROJ_PAD / 32), rb = r % (NPROJ_PAD / 32); const int n = rb * 32 + (lane & 7) * 4;
            int src = -1; if (n < 7752) src = n; else if (n >= 7936) src = n - 184;
            const float* p = (src >= 0) ? a.in[I_WIN] + (size_t)(kb * 64 + (lane >> 3)) * NPROJ + src : nullptr;
            const int pn = rb >> 3;
            if ((pn >= 4 && pn < 8) || (pn >= 28 && pn < 31)) transpose_item(p, NPROJ, (bf16_t*)(ws + WS_WIN), DM, rb * 32, kb * 64, scr, lane);
            else transpose_item_f8(p, NPROJ, ws + WS_WIN8, DM, rb * 32, kb * 64, scr, lane);
            continue; }
        r -= IT_IN;
        if (r < 2 * IT_A) { const int which = r / IT_A; r %= IT_A; const int kb = r / 64, rb = r % 64; const int n = rb * 32 + (lane & 7) * 4;
            const float* pwa = a.in[I_WA]; const float* pwb = a.in[I_WB]; const float* p = (which ? pwb : pwa) + (size_t)(kb * 64 + (lane >> 3)) * DM + n;
            transpose_item_f8(p, DM, ws + (which ? WS_WB : WS_WA), 1024, rb * 32, kb * 64, scr, lane); continue; }
        r -= 2 * IT_A;
        { const int kb = r / 64, rb = r % 64; const int n = rb * 32 + (lane & 7) * 4;
          const float* p = a.in[I_WOUT] + (size_t)(kb * 64 + (lane >> 3)) * DM + n;
          transpose_item_f8(p, DM, ws + WS_WOUT, DM, rb * 32, kb * 64, scr, lane); }
    }
}

constexpr int EW_GU = 64 * 32, EW_D = 64 * 16, EW_E = EW_GU + EW_D;
__device__ __forceinline__ const float* ew_src(const Args& a, int it, int lane, size_t& ldw) {
    const int e = it / EW_E; int r = it % EW_E;
    if (r < EW_GU) { const int kb = r / 64, rb = r % 64; const int n = rb * 32 + (lane & 7) * 4; const int j = n >> 3, up = (n >> 2) & 1; ldw = DFF;
        const float* pg = a.in[I_WGATE]; const float* pu = a.in[I_WUP];
        return (up ? pu : pg) + (size_t)e * DM * DFF + (size_t)(kb * 64 + (lane >> 3)) * DFF + 4 * j; }
    r -= EW_GU; const int kb = r / 64, rb = r % 64; const int n = rb * 32 + (lane & 7) * 4; ldw = DM;
    return a.in[I_WDOWN] + (size_t)e * DFF * DM + (size_t)(kb * 64 + (lane >> 3)) * DM + n;
}
__device__ __forceinline__ void ew_store(const Args& a, int it, const f32x4 (&v)[8], LAS float* scr, int lane) {
    const int e = it / EW_E; int r = it % EW_E; unsigned char* WT; size_t K; int rb, kb;
    if (r < EW_GU) { kb = r / 64; rb = r % 64; WT = a.ws + WS_WGU + (size_t)e * 2048 * 2048; K = 2048; }
    else { r -= EW_GU; kb = r / 64; rb = r % 64; WT = a.ws + WS_WD + (size_t)e * 2048 * 1024; K = 1024; }
#pragma unroll
    for (int i = 0; i < 8; ++i) { const int k = 8 * i + (lane >> 3), n4 = (lane & 7) * 4;
        scr[k * 33 + n4 + 0] = v[i][0]; scr[k * 33 + n4 + 1] = v[i][1]; scr[k * 33 + n4 + 2] = v[i][2]; scr[k * 33 + n4 + 3] = v[i][3]; }
    LDS_WAIT(); asm volatile("" ::: "memory");
    const int c = lane & 3;
#pragma unroll
    for (int j = 0; j < 2; ++j) { const int n = (lane >> 2) + 16 * j; const LAS float* s = scr + (16 * c) * 33 + n;
        u32x4 o;
#pragma unroll
        for (int q = 0; q < 4; ++q) o[q] = cvt4_fp8_nc(s[(4 * q) * 33], s[(4 * q + 1) * 33], s[(4 * q + 2) * 33], s[(4 * q + 3) * 33], F8_WSCALE);
        *(u32x4*)(WT + (size_t)(rb * 32 + n) * K + kb * 64 + 16 * c) = o; __builtin_amdgcn_sched_barrier(0); }
    LDS_WAIT(); asm volatile("" ::: "memory");
}
__device__ __forceinline__ void phase_expert_weights(const Args& a, LAS unsigned char* lds, int tid, int G) {
    const int lane = tid & 63, wave = tid >> 6;
    LAS float* scr = (LAS float*)(lds + wave * 8704);
    const int gw = blockIdx.x * NWAVES + wave, NGW = G * NWAVES, NIT = NEXP * EW_E;
    int it = gw; if (it >= NIT) return;
    f32x4 v[8]; { size_t ldw; const float* p = ew_src(a, it, lane, ldw);
#pragma unroll
        for (int i = 0; i < 8; ++i) v[i] = *(const f32x4*)(p + (size_t)(8 * i) * ldw); }
    for (;;) {
        const int nx = it + NGW; const bool has = nx < NIT;
        f32x4 vn[8];
        if (has) { size_t ldw; const float* p = ew_src(a, nx, lane, ldw);
#pragma unroll
            for (int i = 0; i < 8; ++i) vn[i] = *(const f32x4*)(p + (size_t)(8 * i) * ldw); }
        ew_store(a, it, v, scr, lane);
        if (!has) break;
#pragma unroll
        for (int i = 0; i < 8; ++i) v[i] = vn[i];
        it = nx;
    }
}

constexpr int HG_QD = 0, HG_KD = 17408, HG_P = 34816, HG_VT = 44032, HG_SEG = 62464, HG_RED = 64512;
constexpr int HG_LBT = 66560;
constexpr int HG_NGT = 70656;
constexpr int HG_ST = 74752, HG_STLD = 136;
constexpr int HG_LD128 = 136, HG_LD64 = 72;

struct HgPrep { float cum[16]; float kh[16]; float tot; };
__device__ __forceinline__ void hg_fill_lb(const Args& a, LAS unsigned char* lds, int tid) {
    for (int i = tid; i < 1024; i += NTHR) { const float l0 = a.in[I_LB][i], l1 = a.in[I_LB][1024 + i]; *(LAS float*)(lds + HG_LBT + i * 4) = 1.0f / (1.0f + __expf(l1 - l0)); *(LAS float*)(lds + HG_NGT + i * 4) = a.in[I_HGNG][i]; }
    __syncthreads();
}
__device__ __forceinline__ void hg_prep(HgPrep& P, const float (&z)[16], float lb, int d, int seg, LAS unsigned char* lds) {
    float run = 0.f;
#pragma unroll
    for (int j = 0; j < 16; ++j) { const float sg = sigmoidf_(z[j]); const float f = lb + (1.0f - lb) * sg; run += __logf(f); P.cum[j] = run; P.kh[j] = (1.0f - lb) * (1.0f - sg); }
    LAS float* segs = (LAS float*)(lds + HG_SEG);
    segs[seg * 128 + d] = run;
    __syncthreads();
    float off = 0.f, tot = 0.f;
#pragma unroll
    for (int s = 0; s < 4; ++s) { const float v = segs[s * 128 + d]; tot += v; if (s < seg) off += v; }
#pragma unroll
    for (int j = 0; j < 16; ++j) P.cum[j] += off;
    P.tot = tot;
}
__device__ __forceinline__ void hg_write_vt(const unsigned (&vv)[16], int d, int seg, LAS unsigned char* lds) {
    u32x4 w0, w1;
    w0.x = vv[0] | (vv[1] << 16); w0.y = vv[2] | (vv[3] << 16); w0.z = vv[4] | (vv[5] << 16); w0.w = vv[6] | (vv[7] << 16);
    w1.x = vv[8] | (vv[9] << 16); w1.y = vv[10] | (vv[11] << 16); w1.z = vv[12] | (vv[13] << 16); w1.w = vv[14] | (vv[15] << 16);
    LAS unsigned char* p = lds + HG_VT + d * (HG_LD64 * 2) + seg * 32;
    *(LAS u32x4*)p = w0; *(LAS u32x4*)(p + 16) = w1;
}

__device__ __forceinline__ void hgrn1_unit(const Args& a, int unit, LAS unsigned char* lds, int tid) {
    unsigned char* ws = a.ws;
    const int lane = tid & 63, wave = tid >> 6, d = tid & 127, seg = tid >> 7;
    const int b = unit >> 10, h = (unit >> 7) & 7, n = unit & 127, tok0 = b * SEQ + n * 64;
    float z[16]; unsigned vv[16];
    { const float* AF = (const float*)(ws + WS_AF); const bf16_t* AI = (const bf16_t*)(ws + WS_AI);
#pragma unroll
      for (int j = 0; j < 16; ++j) z[j] = AF[(size_t)(tok0 + seg * 16 + j) * 1024 + h * 128 + d];
#pragma unroll
      for (int j = 0; j < 16; ++j) vv[j] = AI[(size_t)(tok0 + seg * 16 + j) * 1024 + h * 128 + d]; }
    const float lbv = *(const LAS float*)(lds + HG_LBT + (h * 128 + d) * 4);
    HgPrep P;
    hg_prep(P, z, lbv, d, seg, lds);
    { unsigned pk[8];
#pragma unroll
      for (int j = 0; j < 8; ++j) pk[j] = cvt_pk(P.kh[2 * j] * __expf(P.tot - P.cum[2 * j]), P.kh[2 * j + 1] * __expf(P.tot - P.cum[2 * j + 1]));
      LAS unsigned char* p = lds + HG_KD + d * (HG_LD64 * 2) + seg * 32;
      *(LAS u32x4*)p = (u32x4){pk[0], pk[1], pk[2], pk[3]}; *(LAS u32x4*)(p + 16) = (u32x4){pk[4], pk[5], pk[6], pk[7]}; }
    if (seg == 0) ((float*)(ws + WS_DECAY))[(size_t)unit * 128 + d] = __expf(P.tot);
    hg_write_vt(vv, d, seg, lds);
    __syncthreads();
    const int fr = lane & 15, fq = lane >> 4;
    bf16x8 af[2];
#pragma unroll
    for (int ks = 0; ks < 2; ++ks) af[ks] = *(const LAS bf16x8*)(lds + HG_KD + (16 * wave + fr) * (HG_LD64 * 2) + (32 * ks + 8 * fq) * 2);
    float* kvo = (float*)(ws + WS_KV) + (size_t)unit * 16384;
#pragma unroll
    for (int vb = 0; vb < 8; ++vb) {
        f32x4 acc = {0.f, 0.f, 0.f, 0.f};
#pragma unroll
        for (int ks = 0; ks < 2; ++ks) { const bf16x8 bfr = *(const LAS bf16x8*)(lds + HG_VT + (16 * vb + fr) * (HG_LD64 * 2) + (32 * ks + 8 * fq) * 2);
            acc = __builtin_amdgcn_mfma_f32_16x16x32_bf16(af[ks], bfr, acc, 0, 0, 0); }
        *(f32x4*)(kvo + (size_t)(16 * vb + fr) * 128 + 16 * wave + 4 * fq) = acc;
    }
    __syncthreads();
}

__device__ __forceinline__ void hgrn_scan(const Args& a, int tid, int G) {
    unsigned char* ws = a.ws;
    const float* KV = (const float*)(ws + WS_KV); const float* DEC = (const float*)(ws + WS_DECAY); unsigned* ST = (unsigned*)(ws + WS_ST);
    for (int g = blockIdx.x * NTHR + tid; g < 16 * 8192; g += G * NTHR) {
        const int bh = g >> 13, rem = g & 8191, v = rem >> 6, d2 = (rem & 63) * 2;
        float s0 = 0.f, s1 = 0.f;
        for (int n0 = 0; n0 < 128; n0 += 8) {
            f32x2 kv[8], dc[8];
#pragma unroll
            for (int j = 0; j < 8; ++j) { const size_t unit = (size_t)bh * 128 + n0 + j; kv[j] = *(const f32x2*)(KV + unit * 16384 + v * 128 + d2); dc[j] = *(const f32x2*)(DEC + unit * 128 + d2); }
#pragma unroll
            for (int j = 0; j < 8; ++j) { const size_t unit = (size_t)bh * 128 + n0 + j; ST[(unit * 16384 + v * 128 + d2) >> 1] = cvt_pk(s0, s1);
                s0 = dc[j][0] * s0 + kv[j][0]; s1 = dc[j][1] * s1 + kv[j][1]; }
        }
    }
}

__device__ __forceinline__ void hg3_load(const Args& a, int unit, int tid, float (&z)[16], unsigned (&qq)[16], unsigned (&vv)[16], u32x4 (&stp)[4], u32x2 (&gwv)[4]) {
    unsigned char* ws = a.ws; const int d = tid & 127, seg = tid >> 7;
    const int b = unit >> 10, h = (unit >> 7) & 7, n = unit & 127, tok0 = b * SEQ + n * 64;
    const float* AF = (const float*)(ws + WS_AF); const bf16_t* AI = (const bf16_t*)(ws + WS_AI); const bf16_t* AQ = (const bf16_t*)(ws + WS_AQ);
#pragma unroll
    for (int j = 0; j < 16; ++j) z[j] = AF[(size_t)(tok0 + seg * 16 + j) * 1024 + h * 128 + d];
#pragma unroll
    for (int j = 0; j < 16; ++j) qq[j] = AQ[(size_t)(tok0 + seg * 16 + j) * 1024 + h * 128 + d];
#pragma unroll
    for (int j = 0; j < 16; ++j) vv[j] = AI[(size_t)(tok0 + seg * 16 + j) * 1024 + h * 128 + d];
    { const bf16_t* ST = (const bf16_t*)(ws + WS_ST) + (size_t)unit * 16384;
#pragma unroll
      for (int i = 0; i < 4; ++i) stp[i] = *(const u32x4*)(ST + (size_t)(tid + NTHR * i) * 8); }
    { const int lane = tid & 63, wave = tid >> 6, t_ = 16 * (wave & 3) + (lane & 15); const bf16_t* AG = (const bf16_t*)(ws + WS_AG);
#pragma unroll
      for (int vi = 0; vi < 4; ++vi) gwv[vi] = *(const u32x2*)(AG + (size_t)(tok0 + t_) * 1024 + h * 128 + 16 * (4 * (wave >> 2) + vi) + 4 * (lane >> 4)); }
}
__device__ __forceinline__ void hgrn3_unit(const Args& a, int unit, int next_unit, LAS unsigned char* lds, int tid, float (&z)[16], unsigned (&qq)[16], unsigned (&vv)[16], u32x4 (&stp)[4], u32x2 (&gwn)[4]) {
    unsigned char* ws = a.ws;
    const int lane = tid & 63, wave = tid >> 6, d = tid & 127, seg = tid >> 7;
    const int b = unit >> 10, h = (unit >> 7) & 7, n = unit & 127, tok0 = b * SEQ + n * 64;
    const float lbv = *(const LAS float*)(lds + HG_LBT + (h * 128 + d) * 4);
    u32x2 gwv[4];
#pragma unroll
    for (int vi = 0; vi < 4; ++vi) gwv[vi] = gwn[vi];
#ifndef HG3_RA
#define HG3_RA 1
#define HG3_RB 1
#define HG3_RC 1
#endif
    for (int ra = 0; ra < HG3_RA; ++ra) {
    HgPrep P;
    hg_prep(P, z, lbv, d, seg, lds);
    {
#pragma unroll
      for (int j = 0; j < 16; ++j) { const float q = bf2f(qq[j]); const float qs = q * sigmoidf_(q);
          const float qd = qs * __expf(P.cum[j]), kd = P.kh[j] * __expf(-P.cum[j]);
          const int t = seg * 16 + j;
          *(LAS bf16_t*)(lds + HG_QD + (t * HG_LD128 + d) * 2) = (bf16_t)(cvt_pk(qd, 0.f) & 0xffffu);
          *(LAS bf16_t*)(lds + HG_KD + (t * HG_LD128 + d) * 2) = (bf16_t)(cvt_pk(kd, 0.f) & 0xffffu); } }
    hg_write_vt(vv, d, seg, lds);
#pragma unroll
    for (int i = 0; i < 4; ++i) { const int id = tid + NTHR * i; *(LAS u32x4*)(lds + HG_ST + (id >> 4) * (HG_STLD * 2) + (id & 15) * 16) = stp[i]; }
    __syncthreads();
    }
    if (next_unit >= 0) hg3_load(a, next_unit, tid, z, qq, vv, stp, gwn);
    const int fr = lane & 15, fq = lane >> 4;
    for (int rb = 0; rb < HG3_RB; ++rb) {
    { const int tb = wave & 3;
      bf16x8 bq[4];
#pragma unroll
      for (int ks = 0; ks < 4; ++ks) bq[ks] = *(const LAS bf16x8*)(lds + HG_QD + ((16 * tb + fr) * HG_LD128 + 32 * ks + 8 * fq) * 2);
#pragma unroll
      for (int si = 0; si < 2; ++si) { const int sb = 2 * (wave >> 2) + si;
          f32x4 acc = {0.f, 0.f, 0.f, 0.f};
#pragma unroll
          for (int ks = 0; ks < 4; ++ks) { const bf16x8 ak = *(const LAS bf16x8*)(lds + HG_KD + ((16 * sb + fr) * HG_LD128 + 32 * ks + 8 * fq) * 2);
              acc = __builtin_amdgcn_mfma_f32_16x16x32_bf16(ak, bq[ks], acc, 0, 0, 0); }
          const int t = 16 * tb + fr, s0 = 16 * sb + 4 * fq;
          float p[4];
#pragma unroll
          for (int r = 0; r < 4; ++r) p[r] = (s0 + r <= t) ? acc[r] : 0.f;
          *(LAS u32x2*)(lds + HG_P + (t * HG_LD64 + s0) * 2) = (u32x2){cvt_pk(p[0], p[1]), cvt_pk(p[2], p[3])}; } }
    __syncthreads();
    }
    for (int rc = 0; rc < HG3_RC; ++rc) {
    const int tb = wave & 3, t = 16 * tb + fr;
    f32x4 o[4];
    { bf16x8 bp[2], bq[4];
#pragma unroll
      for (int ks = 0; ks < 2; ++ks) bp[ks] = *(const LAS bf16x8*)(lds + HG_P + ((16 * tb + fr) * HG_LD64 + 32 * ks + 8 * fq) * 2);
#pragma unroll
      for (int ks = 0; ks < 4; ++ks) bq[ks] = *(const LAS bf16x8*)(lds + HG_QD + ((16 * tb + fr) * HG_LD128 + 32 * ks + 8 * fq) * 2);
#pragma unroll
      for (int vi = 0; vi < 4; ++vi) { const int vb = 4 * (wave >> 2) + vi;
          f32x4 acc = {0.f, 0.f, 0.f, 0.f};
#pragma unroll
          for (int ks = 0; ks < 2; ++ks) { const bf16x8 av = *(const LAS bf16x8*)(lds + HG_VT + ((16 * vb + fr) * HG_LD64 + 32 * ks + 8 * fq) * 2);
              acc = __builtin_amdgcn_mfma_f32_16x16x32_bf16(av, bp[ks], acc, 0, 0, 0); }
#pragma unroll
          for (int ks = 0; ks < 4; ++ks) { const bf16x8 as = *(const LAS bf16x8*)(lds + HG_ST + ((16 * vb + fr) * HG_STLD + 32 * ks + 8 * fq) * 2);
              acc = __builtin_amdgcn_mfma_f32_16x16x32_bf16(as, bq[ks], acc, 0, 0, 0); }
          o[vi] = acc; } }
    float ss = 0.f;
#pragma unroll
    for (int vi = 0; vi < 4; ++vi) ss += (o[vi][0] * o[vi][0] + o[vi][1] * o[vi][1]) + (o[vi][2] * o[vi][2] + o[vi][3] * o[vi][3]);
    ss += __shfl_xor(ss, 16); ss += __shfl_xor(ss, 32);
    LAS float* red = (LAS float*)(lds + HG_RED);
    if (fq == 0) red[(wave >> 2) * 64 + t] = ss;
    __syncthreads();
    const float tot = red[t] + red[64 + t];
    const float rinv = 1.0f / sqrtf(tot * (1.0f / 128.0f) + RMS_EPS);
    unsigned char* BRA = ws + WS_BRA;
#pragma unroll
    for (int vi = 0; vi < 4; ++vi) { const int v0 = 16 * (4 * (wave >> 2) + vi) + 4 * fq; const size_t off = (size_t)(tok0 + t) * 1024 + h * 128 + v0;
        const u32x2 gw = gwv[vi]; const f32x4 gn = *(const LAS f32x4*)(lds + HG_NGT + (h * 128 + v0) * 4);
        const float g0 = __uint_as_float(gw.x << 16), g1 = __uint_as_float(gw.x & 0xffff0000u), g2 = __uint_as_float(gw.y << 16), g3 = __uint_as_float(gw.y & 0xffff0000u);
        const float r0 = o[vi][0] * rinv * gn[0] * (g0 * sigmoidf_(g0)), r1 = o[vi][1] * rinv * gn[1] * (g1 * sigmoidf_(g1));
        const float r2 = o[vi][2] * rinv * gn[2] * (g2 * sigmoidf_(g2)), r3 = o[vi][3] * rinv * gn[3] * (g3 * sigmoidf_(g3));
        *(unsigned*)(BRA + off) = cvt4_fp8(r0, r1, r2, r3, F8_ASCALE); }
    __syncthreads();
    }
}


constexpr int IX_S = 0, IX_H = 131072, IX_L = 147456, IX_M = 155648, IX_C = 159744;
constexpr int IX_CAP = 512;
__device__ __forceinline__ unsigned ix_sortable(unsigned u) { return (u & 0x80000000u) ? ~u : (u | 0x80000000u); }

__device__ __forceinline__ void ix_radix_fallback(LAS unsigned* S, LAS unsigned* H, unsigned* MASK, int t0, int L, int tid) {
    const int lane = tid & 63, wave = __builtin_amdgcn_readfirstlane(tid >> 6);
    for (int q = 0; q < 4; ++q) for (int i = tid; i < L; i += NTHR) S[q * 8192 + i] = ix_sortable(S[q * 8192 + i]);
    for (int i = tid; i < 2048; i += NTHR) H[i] = 0u;
    __syncthreads();
    const int qs = wave >> 1, half = wave & 1;
    unsigned prefix = 0u; int kth = 256;
    for (int p = 0; p < 4; ++p) {
        const int shift = 24 - 8 * p;
        LAS unsigned* hist = H + (p & 1) * 1024 + qs * 256;
        for (int i = half * 64 + lane; i < L; i += 128) { const unsigned k = S[qs * 8192 + i];
            const bool in = (p == 0) || ((k >> (shift + 8)) == prefix);
            if (in) atomicAdd((unsigned*)(hist + ((k >> shift) & 255u)), 1u); }
        __syncthreads();
        const unsigned c0 = hist[255 - 4 * lane], c1 = hist[254 - 4 * lane], c2 = hist[253 - 4 * lane], c3 = hist[252 - 4 * lane];
        const int tot = (int)(c0 + c1 + c2 + c3);
        int incl = tot;
#pragma unroll
        for (int o = 1; o < 64; o <<= 1) { const int v = __shfl_up(incl, o); if (lane >= o) incl += v; }
        const unsigned long long bal = __ballot(incl >= kth);
        const int fl = __ffsll((long long)bal) - 1;
        const int rem = kth - (incl - tot);
        int dig, nk;
        if (rem <= (int)c0) { dig = 255 - 4 * lane; nk = rem; }
        else if (rem <= (int)(c0 + c1)) { dig = 254 - 4 * lane; nk = rem - (int)c0; }
        else if (rem <= (int)(c0 + c1 + c2)) { dig = 253 - 4 * lane; nk = rem - (int)(c0 + c1); }
        else { dig = 252 - 4 * lane; nk = rem - (int)(c0 + c1 + c2); }
        dig = __shfl(dig, fl); nk = __shfl(nk, fl);
        prefix = (prefix << 8) | (unsigned)dig; kth = nk;
        __syncthreads();
        if (p < 2) for (int i = tid; i < 1024; i += NTHR) H[(p & 1) * 1024 + i] = 0u;
    }
    const unsigned T = prefix;
    const int NG = L / 64;
    int tie_before = 0;
    if (half == 1) for (int g = 0; g < 64 && g < NG; ++g) { const unsigned k = S[qs * 8192 + 64 * g + lane]; tie_before += __popcll(__ballot(k == T)); }
    unsigned mlo = 0u, mhi = 0u;
    const unsigned long long lt = (1ull << lane) - 1ull;
    for (int g = 64 * half; g < NG && g < 64 * half + 64; ++g) {
        const unsigned k = S[qs * 8192 + 64 * g + lane];
        const bool eq = (k == T);
        const unsigned long long eqm = __ballot(eq);
        const int rank = tie_before + __popcll(eqm & lt);
        const bool sel = (k > T) || (eq && rank < kth);
        const unsigned long long m = __ballot(sel);
        if (lane == g - 64 * half) { mlo = (unsigned)m; mhi = (unsigned)(m >> 32); }
        tie_before += __popcll(eqm);
    }
    *(u32x2*)(MASK + (size_t)(t0 + qs) * 256 + 2 * (64 * half + lane)) = (u32x2){mlo, mhi};
    __syncthreads();
}

__device__ __forceinline__ void indexer_unit(const Args& a, int unit, LAS unsigned char* lds, int tid) {
    unsigned char* ws = a.ws;
    const int lane = tid & 63, wave = __builtin_amdgcn_readfirstlane(tid >> 6);
    const int t0 = unit * 4, b = t0 >> 13, qpos0 = t0 & (SEQ - 1), c = qpos0 >> 6, L = 64 * (c + 1);
    unsigned* MASK = (unsigned*)(ws + WS_MASK);
    if (c < 4) {
        const int qi = tid >> 7, w2 = (tid & 127) * 2;
        const unsigned m0 = (w2 * 32 < L) ? 0xffffffffu : 0u, m1 = ((w2 + 1) * 32 < L) ? 0xffffffffu : 0u;
        *(u32x2*)(MASK + (size_t)(t0 + qi) * 256 + w2) = (u32x2){m0, m1};
        return;
    }
    const bf16_t* IQ = (const bf16_t*)(ws + WS_IQ); const bf16_t* IKW = (const bf16_t*)(ws + WS_IKW);
    LAS unsigned* S = (LAS unsigned*)(lds + IX_S); LAS unsigned* H = (LAS unsigned*)(lds + IX_H); LAS unsigned* LST = (LAS unsigned*)(lds + IX_L);
    LAS unsigned* MB = (LAS unsigned*)(lds + IX_M); LAS float* MM = (LAS float*)(lds + IX_C); LAS unsigned* CC = (LAS unsigned*)(lds + IX_C + 256);
    const int r32 = lane & 31, hh = lane >> 5;
    for (int i = tid; i < 4096; i += NTHR) H[i] = 0u;
    for (int i = tid; i < 1024; i += NTHR) MB[i] = 0u;
    if (tid < 8) CC[tid] = 0u;
    bf16x8 af[4];
#pragma unroll
    for (int ks = 0; ks < 4; ++ks) af[ks] = *(const bf16x8*)(IQ + (size_t)(t0 + (r32 >> 3)) * 512 + (r32 & 7) * 64 + 16 * ks + 8 * hh);
    bf16x8 a2[2];
#pragma unroll
    for (int sI = 0; sI < 2; ++sI)
#pragma unroll
        for (int j = 0; j < 8; ++j) { const int qm = 2 * sI + (j >> 2), hm = 4 * hh + (j & 3);
            a2[sI][j] = (r32 == qm) ? (short)IKW[(size_t)(t0 + qm) * 256 + 64 + hm] : (short)0; }
    float mn[4], mx[4];
#pragma unroll
    for (int qi = 0; qi < 4; ++qi) { mn[qi] = 3.0e38f; mx[qi] = -3.0e38f; }
    const int NT32 = L / 32;
    const bf16_t* kbase = (const bf16_t*)(ws + WS_IK2) + (size_t)b * (SEQ / 32) * 2048 + lane * 8;
#define IX_LOADT(dst, kt_) do { const bf16_t* kp_ = kbase + (size_t)(kt_) * 2048; _Pragma("unroll") for (int ks = 0; ks < 4; ++ks) dst[ks] = *(const bf16x8*)(kp_ + 512 * ks); } while (0)
#define IX_MM(acc, bt) do { acc = f32x16{}; _Pragma("unroll") for (int ks = 0; ks < 4; ++ks) acc = __builtin_amdgcn_mfma_f32_32x32x16_bf16(af[ks], bt[ks], acc, 0, 0, 0); } while (0)
#define IX_HS(y_, acc) do { unsigned pk_[8]; _Pragma("unroll") for (int i = 0; i < 8; ++i) { const float x0_ = __builtin_amdgcn_fmed3f(acc[2 * i], 0.0f, 3.0e38f), x1_ = __builtin_amdgcn_fmed3f(acc[2 * i + 1], 0.0f, 3.0e38f); pk_[i] = cvt_pk_to_mfma(x0_, x1_); } \
        const u32x4 f0_ = {pk_[0], pk_[1], pk_[2], pk_[3]}, f1_ = {pk_[4], pk_[5], pk_[6], pk_[7]}; \
        y_ = f32x16{}; y_ = __builtin_amdgcn_mfma_f32_32x32x16_bf16(a2[0], *(const bf16x8*)&f0_, y_, 0, 0, 0); y_ = __builtin_amdgcn_mfma_f32_32x32x16_bf16(a2[1], *(const bf16x8*)&f1_, y_, 0, 0, 0); } while (0)
#define IX_ST(y_, kt_) do { const int key = (kt_) * 32 + r32; \
        if (hh == 0) { _Pragma("unroll") for (int qi = 0; qi < 4; ++qi) { const float s = y_[qi] + 0.0f; mn[qi] = fminf(mn[qi], s); mx[qi] = fmaxf(mx[qi], s); S[qi * 8192 + key] = __float_as_uint(s); } } } while (0)
#ifndef IX_REP_S1
#define IX_REP_S1 1
#endif
    for (int rp1 = 0; rp1 < IX_REP_S1; ++rp1) {
    bf16x8 bA[4], bB[4], bC[4];
    { const int kt = wave; if (kt < NT32) IX_LOADT(bA, kt); if (kt + 8 < NT32) IX_LOADT(bB, kt + 8); if (kt + 16 < NT32) IX_LOADT(bC, kt + 16); }
    for (int kt = wave; kt < NT32; kt += 3 * NWAVES) {
        const int kn = kt + 3 * NWAVES;
        bf16x8 nA[4], nB[4], nC[4];
        if (kn < NT32) IX_LOADT(nA, kn); if (kn + 8 < NT32) IX_LOADT(nB, kn + 8); if (kn + 16 < NT32) IX_LOADT(nC, kn + 16);
        const bool hB = kt + 8 < NT32, hC = kt + 16 < NT32;
#ifndef IX_REP_C
#define IX_REP_C 1
#endif
        for (int rc_ = 0; rc_ < IX_REP_C; ++rc_) {
        f32x16 xA, xB, xC;
        IX_MM(xA, bA); if (hB) IX_MM(xB, bB); if (hC) IX_MM(xC, bC);
        { f32x16 yy; IX_HS(yy, xA); IX_ST(yy, kt); }
        if (hB) { f32x16 yy; IX_HS(yy, xB); IX_ST(yy, kt + 8); }
        if (hC) { f32x16 yy; IX_HS(yy, xC); IX_ST(yy, kt + 16); }
        }
#pragma unroll
        for (int ks = 0; ks < 4; ++ks) { bA[ks] = nA[ks]; bB[ks] = nB[ks]; bC[ks] = nC[ks]; }
    }
    }
#undef IX_LOADT
#undef IX_MM
#undef IX_HS
#undef IX_ST
#pragma unroll
    for (int qi = 0; qi < 4; ++qi) {
#pragma unroll
        for (int o = 1; o < 32; o <<= 1) { mn[qi] = fminf(mn[qi], __shfl_xor(mn[qi], o)); mx[qi] = fmaxf(mx[qi], __shfl_xor(mx[qi], o)); }
        if (lane == 0) { MM[(wave * 4 + qi) * 2] = mn[qi]; MM[(wave * 4 + qi) * 2 + 1] = mx[qi]; } }
    __syncthreads();
    const int qs = wave >> 1, half = wave & 1;
    float mnq = 3.0e38f, mxq = -3.0e38f;
#pragma unroll
    for (int w = 0; w < NWAVES; ++w) { mnq = fminf(mnq, MM[(w * 4 + qs) * 2]); mxq = fmaxf(mxq, MM[(w * 4 + qs) * 2 + 1]); }
    const float scl = (mxq > mnq) ? 1023.0f / (mxq - mnq) : 0.0f;
#define IX_BIN(sbits) min((int)((__uint_as_float(sbits) - mnq) * scl), 1023)
    { LAS unsigned* hist = H + qs * 1024;
      int i = half * 64 + lane;
      for (; i + 384 < L; i += 512) { const unsigned s0 = S[qs * 8192 + i], s1 = S[qs * 8192 + i + 128], s2 = S[qs * 8192 + i + 256], s3 = S[qs * 8192 + i + 384];
          const int b0 = IX_BIN(s0), b1 = IX_BIN(s1), b2 = IX_BIN(s2), b3 = IX_BIN(s3);
          atomicAdd((unsigned*)(hist + b0), 1u); atomicAdd((unsigned*)(hist + b1), 1u); atomicAdd((unsigned*)(hist + b2), 1u); atomicAdd((unsigned*)(hist + b3), 1u); }
      for (; i < L; i += 128) { const int bin = IX_BIN(S[qs * 8192 + i]); atomicAdd((unsigned*)(hist + bin), 1u); } }
    __syncthreads();
    int bstar, rtake, cntb;
    { const LAS u32x4* hp = (const LAS u32x4*)(H + qs * 1024 + 1008 - 16 * lane);
      const u32x4 h0 = hp[0], h1 = hp[1], h2 = hp[2], h3 = hp[3];
      const unsigned cb[16] = {h0.x, h0.y, h0.z, h0.w, h1.x, h1.y, h1.z, h1.w, h2.x, h2.y, h2.z, h2.w, h3.x, h3.y, h3.z, h3.w};
      int tot = 0;
#pragma unroll
      for (int j = 0; j < 16; ++j) tot += (int)cb[j];
      int incl = tot;
#pragma unroll
      for (int o = 1; o < 64; o <<= 1) { const int v = __shfl_up(incl, o); if (lane >= o) incl += v; }
      const unsigned long long bal = __ballot(incl >= 256);
      const int fl = __ffsll((long long)bal) - 1;
      const int rem = 256 - (incl - tot);
      int cum = 0, bs = 0, rt = 0, cn = 0; bool found = false;
#pragma unroll
      for (int j = 15; j >= 0; --j) { const int cj = (int)cb[j]; if (!found && cum + cj >= rem) { bs = 1008 - 16 * lane + j; rt = rem - cum; cn = cj; found = true; } cum += cj; }
      bstar = __shfl(bs, fl); rtake = __shfl(rt, fl); cntb = __shfl(cn, fl); }
    const int NG = L / 64;
    const bool all_eq = (cntb == rtake);
    const unsigned long long lt = (1ull << lane) - 1ull;
    { unsigned mlo = 0u, mhi = 0u;
      const int gh = (NG + 1) >> 1, gbeg = half ? gh : 0, gend = half ? NG : gh;
      const float tge = (float)bstar, tgt = (bstar >= 1023) ? 3.0e38f : (float)(bstar + 1);
      unsigned sv[4] = {0u, 0u, 0u, 0u};
      for (int g = gbeg; g < gend; ++g) {
          const int gi = (g - gbeg) & 3;
          if (gi == 0) {
#pragma unroll
              for (int j = 0; j < 4; ++j) if (g + j < gend) sv[j] = S[qs * 8192 + 64 * (g + j) + lane]; }
          const unsigned sb = (gi == 0) ? sv[0] : (gi == 1) ? sv[1] : (gi == 2) ? sv[2] : sv[3];
          const float tq = (__uint_as_float(sb) - mnq) * scl;
          unsigned long long m = __ballot(tq >= tgt);
          const unsigned long long eqm = __ballot(tq >= tge) & ~m;
          if (all_eq) m |= eqm;
          else if (eqm != 0ull) {
              unsigned base = 0u;
              if (lane == 0) base = atomicAdd((unsigned*)(CC + qs), (unsigned)__popcll(eqm));
              base = __builtin_amdgcn_readfirstlane(base);
              const unsigned pos = base + (unsigned)__popcll(eqm & lt);
              if (((eqm >> lane) & 1ull) && pos < (unsigned)IX_CAP) LST[qs * IX_CAP + pos] = (unsigned)(64 * g + lane); }
          if (lane == g - gbeg) { mlo = (unsigned)m; mhi = (unsigned)(m >> 32); }
      }
      if (lane < gend - gbeg) *(LAS u32x2*)(MB + qs * 256 + 2 * (gbeg + lane)) = (u32x2){mlo, mhi}; }
    __syncthreads();
    if (half == 0 && !all_eq) {
        const int nc = cntb;
        if (nc > IX_CAP) { if (lane == 0) CC[4] = 1u; }
        else {
            unsigned myk[8], myi[8]; int rk[8];
#pragma unroll
            for (int sI = 0; sI < 8; ++sI) { const int j = sI * 64 + lane; rk[sI] = 0; myi[sI] = 0u; myk[sI] = 0u;
                if (sI * 64 < nc && j < nc) { myi[sI] = LST[qs * IX_CAP + j]; myk[sI] = ix_sortable(S[qs * 8192 + myi[sI]]); } }
            for (int t = 0; t < nc; ++t) { const unsigned it = LST[qs * IX_CAP + t]; const unsigned kt_ = ix_sortable(S[qs * 8192 + it]);
#pragma unroll
                for (int sI = 0; sI < 8; ++sI) if (sI * 64 < nc) rk[sI] += (kt_ > myk[sI] || (kt_ == myk[sI] && it < myi[sI])) ? 1 : 0; }
#pragma unroll
            for (int sI = 0; sI < 8; ++sI) { const int j = sI * 64 + lane;
                if (sI * 64 < nc && j < nc && rk[sI] < rtake) atomicOr((unsigned*)(MB + qs * 256 + (myi[sI] >> 5)), 1u << (myi[sI] & 31u)); }
        }
    }
#undef IX_BIN
    __syncthreads();
    if (CC[4] != 0u) { __syncthreads(); ix_radix_fallback(S, H, MASK, t0, L, tid); return; }
    { const int qi = tid >> 7, w2 = (tid & 127) * 2;
      *(u32x2*)(MASK + (size_t)(t0 + qi) * 256 + w2) = *(const LAS u32x2*)(MB + qi * 256 + w2); }
    __syncthreads();
}

constexpr int NA_IDX = 0, NA_LG = 1024, NA_SCAN = 1024 + 8192;
__device__ __forceinline__ void attn_gather_unit(const Args& a, int tok, LAS unsigned char* lds, int tid) {
    unsigned char* ws = a.ws;
    const int lane = tid & 63, wave = __builtin_amdgcn_readfirstlane(tid >> 6);
    const int b = tok >> 13, qpos = tok & (SEQ - 1), c = qpos >> 6, L = 64 * (c + 1), nsel = L < 256 ? L : 256;
    const unsigned* MASK = (const unsigned*)(ws + WS_MASK);
    LAS int* idxs = (LAS int*)(lds + NA_IDX); LAS float* lg = (LAS float*)(lds + NA_LG) + wave * 256; LAS int* wsum = (LAS int*)(lds + NA_SCAN);
    unsigned w = 0u; int cnt = 0;
    if (tid < 256) { w = MASK[(size_t)tok * 256 + tid]; cnt = __popc(w); }
    int incl = cnt;
#pragma unroll
    for (int o = 1; o < 64; o <<= 1) { const int v = __shfl_up(incl, o); if (lane >= o) incl += v; }
    if (lane == 63) wsum[wave] = incl;
    __syncthreads();
    if (tid < 256) { int off = incl - cnt; for (int ww = 0; ww < wave; ++ww) off += wsum[ww];
        while (w) { const int bit = __ffs(w) - 1; w &= w - 1; if (off < 256) idxs[off] = tid * 32 + bit; ++off; } }
    __syncthreads();
    const int h = wave;
    const bf16_t* BQ = (const bf16_t*)(ws + WS_BQ); const bf16_t* BK = (const bf16_t*)(ws + WS_BK); const bf16_t* BV = (const bf16_t*)(ws + WS_BV);
    const float slope = exp2f(-(float)(h + 1));
    float qv[8];
    { const u32x4 qw = *(const u32x4*)(BQ + (size_t)tok * 1024 + h * 128 + 8 * (lane & 15));
      qv[0] = __uint_as_float(qw.x << 16); qv[1] = __uint_as_float(qw.x & 0xffff0000u); qv[2] = __uint_as_float(qw.y << 16); qv[3] = __uint_as_float(qw.y & 0xffff0000u);
      qv[4] = __uint_as_float(qw.z << 16); qv[5] = __uint_as_float(qw.z & 0xffff0000u); qv[6] = __uint_as_float(qw.w << 16); qv[7] = __uint_as_float(qw.w & 0xffff0000u); }
    for (int it = 0; it < nsel / 4; ++it) {
        const int key = idxs[4 * it + (lane >> 4)];
        const u32x4 kw = *(const u32x4*)(BK + (size_t)(b * SEQ + key) * 1024 + h * 128 + 8 * (lane & 15));
        float s = qv[0] * __uint_as_float(kw.x << 16) + qv[1] * __uint_as_float(kw.x & 0xffff0000u) + qv[2] * __uint_as_float(kw.y << 16) + qv[3] * __uint_as_float(kw.y & 0xffff0000u)
                + qv[4] * __uint_as_float(kw.z << 16) + qv[5] * __uint_as_float(kw.z & 0xffff0000u) + qv[6] * __uint_as_float(kw.w << 16) + qv[7] * __uint_as_float(kw.w & 0xffff0000u);
        s += __shfl_xor(s, 1); s += __shfl_xor(s, 2); s += __shfl_xor(s, 4); s += __shfl_xor(s, 8);
        const float dist = fabsf((float)(qpos - key));
        if ((lane & 15) == 0) lg[4 * it + (lane >> 4)] = s * 0.08838834764831845f - slope * dist;
    }
    LDS_WAIT();
    float mx = -3.0e38f;
    for (int k = lane; k < nsel; k += 64) mx = fmaxf(mx, lg[k]);
#pragma unroll
    for (int o = 1; o < 64; o <<= 1) mx = fmaxf(mx, __shfl_xor(mx, o));
    float sm = 0.f;
    for (int k = lane; k < nsel; k += 64) { const float e = __expf(lg[k] - mx); lg[k] = e; sm += e; }
    sm = wave_sum(sm);
    const float rs = 1.0f / sm;
    LDS_WAIT();
    float o0 = 0.f, o1 = 0.f;
    for (int k = 0; k < nsel; k += 4) {
        unsigned vw[4]; float pp[4];
#pragma unroll
        for (int j = 0; j < 4; ++j) { const int key = idxs[k + j]; pp[j] = lg[k + j]; vw[j] = *(const unsigned*)(BV + (size_t)(b * SEQ + key) * 1024 + h * 128 + 2 * lane); }
#pragma unroll
        for (int j = 0; j < 4; ++j) { o0 += pp[j] * __uint_as_float(vw[j] << 16); o1 += pp[j] * __uint_as_float(vw[j] & 0xffff0000u); }
    }
    *(unsigned*)((bf16_t*)(ws + WS_BRB) + (size_t)tok * 1024 + h * 128 + 2 * lane) = cvt_pk(o0 * rs, o1 * rs);
    __syncthreads();
}

constexpr int RT_BLK = 148, RT_BUF = 64 * RT_BLK * 4;
constexpr int RT_SCR = 2 * RT_BUF;
constexpr int RT_LNW = 114688;
#define RT_BAR() do { asm volatile("s_waitcnt lgkmcnt(0)" ::: "memory"); __builtin_amdgcn_s_barrier(); asm volatile("" ::: "memory"); } while (0)
__device__ __forceinline__ void phase8_router_expw(const Args& a, LAS unsigned char* lds, int tid, int G, bool route, bool do_expw) {
    unsigned char* ws = a.ws; const int wave = __builtin_amdgcn_readfirstlane(tid >> 6);
    const int npass = MT / 8;
    if (wave < 4) {
        RT_BAR();
        int cbuf = 0;
        u32x2 pf[2][8];
#define RT_PF(ps_) do { const int l_ = fresh_lane(); _Pragma("unroll") for (int r_ = 0; r_ < 2; ++r_) { const unsigned ro_ = (unsigned)((ps_) * 8 + wave * 2 + r_) * (unsigned)(DM * 2) + 8u * (unsigned)l_; \
            _Pragma("unroll") for (int i_ = 0; i_ < 8; ++i_) pf[r_][i_] = *(const u32x2*)(ws + (size_t)((unsigned)WS_PRE1 + ro_ + 512u * i_)); } } while (0)
        if ((int)blockIdx.x < npass) RT_PF((int)blockIdx.x);
        int p_row = -1, p_ea = 0, p_eb = 0, p_pa = 0, p_pb = 0;
        for (int ps = blockIdx.x; ps < npass; ps += G) {
            int lane = fresh_lane(); asm volatile("" : "+v"(lane));
            f32x4 v[2][8]; float s01[2];
#pragma unroll
            for (int r = 0; r < 2; ++r) { float s = 0.f;
#pragma unroll
                for (int i = 0; i < 8; ++i) { const u32x2 pw = pf[r][i];
                    v[r][i] = (f32x4){__uint_as_float(pw.x << 16), __uint_as_float(pw.x & 0xffff0000u), __uint_as_float(pw.y << 16), __uint_as_float(pw.y & 0xffff0000u)};
                    s += (v[r][i][0] + v[r][i][1]) + (v[r][i][2] + v[r][i][3]); }
                s01[r] = s; }
            if (ps + G < npass) RT_PF(ps + G);
#pragma unroll
            for (int r = 0; r < 2; ++r) { const int row = ps * 8 + wave * 2 + r;
                const unsigned ro = (unsigned)row * (unsigned)(DM * 2) + 8u * (unsigned)lane;
                const float mean = wave_sum_u(s01[r]) * (1.0f / DM); float s2 = 0.f;
#pragma unroll
                for (int i = 0; i < 8; ++i) { v[r][i] = v[r][i] - mean; s2 += (v[r][i][0] * v[r][i][0] + v[r][i][1] * v[r][i][1]) + (v[r][i][2] * v[r][i][2] + v[r][i][3] * v[r][i][3]); }
                const float rstd = 1.0f / sqrtf(wave_sum_u(s2) * (1.0f / DM) + LN_EPS);
#pragma unroll
                for (int i = 0; i < 8; ++i) { const f32x4 gg = *(const LAS f32x4*)(lds + RT_LNW + (256 * i + 4 * lane) * 4), bb = *(const LAS f32x4*)(lds + RT_LNW + 8192 + (256 * i + 4 * lane) * 4);
                    v[r][i] = v[r][i] * rstd * gg + bb;
                    *(u32x2*)(ws + (size_t)((unsigned)WS_H1B + ro + 512u * i)) = (u32x2){cvt_pk(v[r][i][0], v[r][i][1]), cvt_pk(v[r][i][2], v[r][i][3])};
                    *(unsigned*)(ws + (size_t)((unsigned)WS_H1F8 + (ro >> 1) + 256u * i)) = cvt4_fp8_nc(v[r][i][0], v[r][i][1], v[r][i][2], v[r][i][3], F8_ASCALE); } }
            f32x2 acc2[36];
#pragma unroll
            for (int j = 0; j < 36; ++j) acc2[j] = (f32x2){0.f, 0.f};
#pragma unroll
            for (int i = 0; i < 8; ++i) {
                int lq = lane; asm volatile("" : "+v"(lq));
                const LAS float* blk = (const LAS float*)(lds + cbuf * RT_BUF) + lq * RT_BLK;
                f32x4 wA[9], wB[9];
#define RT_RD(dst, kk_) do { _Pragma("unroll") for (int q = 0; q < 9; ++q) dst[q] = *(const LAS f32x4*)(blk + (kk_) * 36 + 4 * q); } while (0)
#define RT_FM(src, kk_) do { const f32x2 hv = (f32x2){v[0][i][kk_], v[1][i][kk_]}; _Pragma("unroll") for (int q = 0; q < 9; ++q) { \
                    acc2[4 * q + 0] += hv * (f32x2){src[q][0], src[q][0]}; acc2[4 * q + 1] += hv * (f32x2){src[q][1], src[q][1]}; \
                    acc2[4 * q + 2] += hv * (f32x2){src[q][2], src[q][2]}; acc2[4 * q + 3] += hv * (f32x2){src[q][3], src[q][3]}; } } while (0)
                RT_RD(wA, 0); __builtin_amdgcn_sched_barrier(0);
                RT_RD(wB, 1); __builtin_amdgcn_sched_barrier(0); RT_FM(wA, 0); __builtin_amdgcn_sched_barrier(0);
                RT_RD(wA, 2); __builtin_amdgcn_sched_barrier(0); RT_FM(wB, 1); __builtin_amdgcn_sched_barrier(0);
                RT_RD(wB, 3); __builtin_amdgcn_sched_barrier(0); RT_FM(wA, 2); __builtin_amdgcn_sched_barrier(0);
                RT_FM(wB, 3);
#undef RT_RD
#undef RT_FM
                RT_BAR();
                cbuf ^= 1;
            }
            const bool odd = (lane & 1) != 0;
            float lgt[36];
#pragma unroll
            for (int j = 0; j < 36; ++j) { const float t0 = wave_sum_u(acc2[j][0]), t1 = wave_sum_u(acc2[j][1]); lgt[j] = odd ? t1 : t0; }
            const int row = ps * 8 + wave * 2 + (lane & 1);
            float gl[4]; float gm = -3.0e38f; int gt = 0;
#pragma unroll
            for (int j = 0; j < 4; ++j) { gl[j] = lgt[j] + a.in[I_BGRP][j]; if (gl[j] > gm) { gm = gl[j]; gt = j; } }
            float gs = 0.f;
#pragma unroll
            for (int j = 0; j < 4; ++j) gs += __expf(gl[j] - gm);
            const float gp = 1.0f / gs;
            float e1 = -3.0e38f, e2 = -3.0e38f; int i1 = 0, i2 = 0;
#pragma unroll
            for (int j = 0; j < 8; ++j) { float ev = 0.f;
#pragma unroll
                for (int gq = 0; gq < 4; ++gq) if (gq == gt) ev = lgt[4 + 8 * gq + j] + a.in[I_BRT][8 * gq + j];
                if (ev > e1) { e2 = e1; i2 = i1; e1 = ev; i1 = j; } else if (ev > e2) { e2 = ev; i2 = j; } }
            const float x2 = __expf(e2 - e1), w1 = gp / (1.0f + x2), w2 = gp * x2 / (1.0f + x2);
            if (lane < 2 && route) {
                unsigned* ctl = (unsigned*)(ws + WS_CTL);
                int* rows = (int*)(ws + WS_ROWS); int* slot_e = (int*)(ws + WS_SLOT); int* slot_p = slot_e + 2 * MT; float* slot_w = (float*)(slot_p + 2 * MT);
                if (p_row >= 0) { rows[p_ea * MT + p_pa] = p_row; rows[p_eb * MT + p_pb] = p_row; slot_p[2 * p_row] = p_pa; slot_p[2 * p_row + 1] = p_pb; }
                const int ea = gt * 8 + i1, eb = gt * 8 + i2;
                p_pa = (int)atomicAdd(ctl + CW_CNT + 64 * ea, 1u); p_pb = (int)atomicAdd(ctl + CW_CNT + 64 * eb, 1u); p_row = row; p_ea = ea; p_eb = eb;
                slot_e[2 * row] = ea; slot_e[2 * row + 1] = eb; slot_w[2 * row] = w1; slot_w[2 * row + 1] = w2;
            }
        }
        if (fresh_lane() < 2 && route && p_row >= 0) {
            int* rows = (int*)(ws + WS_ROWS); int* slot_p = (int*)(ws + WS_SLOT) + 2 * MT;
            rows[p_ea * MT + p_pa] = p_row; rows[p_eb * MT + p_pb] = p_row; slot_p[2 * p_row] = p_pa; slot_p[2 * p_row + 1] = p_pb; }
#undef RT_PF
    } else {
        const int lane = tid & 63, te = tid - 256;
        const float* wg = a.in[I_WGRP]; const float* wr = a.in[I_WRT];
        LAS float* scr = (LAS float*)(lds + RT_SCR + (wave - 4) * 8704);
        f32x4 sa[9];
#define RT_LOADW(dst, chunk) do { const int k_ = (chunk) * 256 + te; dst[0] = *(const f32x4*)(wg + (size_t)k_ * 4); _Pragma("unroll") for (int j_ = 0; j_ < 8; ++j_) dst[1 + j_] = *(const f32x4*)(wr + (size_t)k_ * 32 + 4 * j_); } while (0)
#define RT_WRITEW(src, buf) do { LAS float* p_ = (LAS float*)(buf) + (te >> 2) * RT_BLK + (te & 3) * 36; _Pragma("unroll") for (int j_ = 0; j_ < 9; ++j_) *(LAS f32x4*)(p_ + 4 * j_) = src[j_]; } while (0)
        const float* plg = a.in[I_LN1G]; const float* plb = a.in[I_LN1B];
        for (int c = te; c < 1024; c += 256) { const int wh = c >> 9, idx = (c & 511) * 4; *(LAS f32x4*)(lds + RT_LNW + (wh * 2048 + idx) * 4) = *(const f32x4*)((wh ? plb : plg) + idx); }
        RT_LOADW(sa, 0); RT_WRITEW(sa, lds); RT_LOADW(sa, 1);
        const int ge = blockIdx.x * 4 + (wave - 4), NGE = G * 4, NIT = NEXP * EW_E; (void)do_expw;
        int it = ge; f32x4 e0[8], e1[8], e2[8];
#define EW_LOAD(dst, item) do { const int it_ = (item) < NIT ? (item) : NIT - 1; size_t ldw_; const float* p_ = ew_src(a, it_, lane, ldw_); _Pragma("unroll") for (int i_ = 0; i_ < 8; ++i_) dst[i_] = __builtin_nontemporal_load((const f32x4*)(p_ + (size_t)(8 * i_) * ldw_)); } while (0)
#define EW_STEPX(cur, fre) do { EW_LOAD(fre, it + 2 * NGE); ew_store(a, it < NIT ? it : NIT - 1, cur, scr, lane); it += NGE; } while (0)
        EW_LOAD(e0, it); EW_LOAD(e1, it + NGE);
        RT_BAR();
        int cbuf = 0;
        for (int ps = blockIdx.x; ps < npass; ps += G) {
#pragma unroll
            for (int i = 0; i < 8; ++i) {
                RT_WRITEW(sa, lds + (cbuf ^ 1) * RT_BUF); RT_LOADW(sa, (i + 2) & 7);
                if (i == 0) { EW_STEPX(e0, e2); EW_STEPX(e1, e0); } else if (i == 1) { EW_STEPX(e2, e1); } else if (i == 2) { EW_STEPX(e0, e2); EW_STEPX(e1, e0); } else if (i == 3) { EW_STEPX(e2, e1); }
                else if (i == 4) { EW_STEPX(e0, e2); EW_STEPX(e1, e0); } else if (i == 5) { EW_STEPX(e2, e1); } else if (i == 6) { EW_STEPX(e0, e2); EW_STEPX(e1, e0); } else { EW_STEPX(e2, e1); }
                RT_BAR();
                cbuf ^= 1;
            }
        }
        while (it < NIT) { EW_STEPX(e0, e2); EW_STEPX(e1, e0); EW_STEPX(e2, e1); }
#undef RT_LOADW
#undef RT_WRITEW
#undef EW_STEPX
#undef EW_LOAD
    }
    __syncthreads();
}

__device__ __forceinline__ void load_tile_base(const Args& a, LAS int* tb, int tid) {
    const unsigned* ctl = (const unsigned*)(a.ws + WS_CTL);
    if (tid == 0) { int acc = 0; for (int e = 0; e < NEXP; ++e) { tb[e] = acc; acc += ((int)ctl[CW_CNT + 64 * e] + 255) >> 8; } tb[NEXP] = acc; }
    __syncthreads();
}

__device__ __forceinline__ void phase_gather(const Args& a, LAS unsigned char* lds, int tid, int G) {
    unsigned char* ws = a.ws; const int lane = tid & 63, wave = tid >> 6;
    LAS int* tb = (LAS int*)lds;
    load_tile_base(a, tb, tid);
    unsigned* ctl = (unsigned*)(ws + WS_CTL);
    const int NT = tb[NEXP];
    if (blockIdx.x == 0) { if (tid == 0) ctl[CW_NT] = (unsigned)NT;
        if (tid < NEXP) for (int t = tb[tid]; t < tb[tid + 1]; ++t) ctl[CW_TILEE + t] = (unsigned)tid;
        if (tid <= NEXP) ctl[CW_TBASE + tid] = (unsigned)tb[tid]; }
    const int* rows = (const int*)(ws + WS_ROWS); const bf16_t* H1B = (const bf16_t*)(ws + WS_H1B); bf16_t* XG = (bf16_t*)(ws + WS_XG);
    for (int r = blockIdx.x * NWAVES + wave; r < NT * 256; r += G * NWAVES) {
        const int tile = r >> 8; int e = 0;
        for (int j = 1; j < NEXP; ++j) if (tb[j] <= tile) e = j;
        const int pos = r - tb[e] * 256; const int cnt = (int)ctl[CW_CNT + 64 * e];
        u32x4 v[4];
        if (pos < cnt) { const int tok = rows[e * MT + pos];
#pragma unroll
            for (int i = 0; i < 4; ++i) v[i] = *(const u32x4*)(H1B + (size_t)tok * DM + 512 * i + 8 * lane); }
        else {
#pragma unroll
            for (int i = 0; i < 4; ++i) v[i] = (u32x4){0u, 0u, 0u, 0u}; }
#pragma unroll
        for (int i = 0; i < 4; ++i) *(u32x4*)(XG + (size_t)r * DM + 512 * i + 8 * lane) = v[i];
    }
}

struct FinSlots { int r0, r1; float w0, w1; };
__device__ __forceinline__ void fin_slots(const Args& a, int row, const LAS int* tb, FinSlots& S) {
    unsigned char* ws = a.ws;
    const int* slot_e = (const int*)(ws + WS_SLOT); const int* slot_p = slot_e + 2 * MT; const float* slot_w = (const float*)(slot_p + 2 * MT);
    const int e0 = slot_e[2 * row], e1 = slot_e[2 * row + 1];
    S.r0 = tb[e0] * 256 + slot_p[2 * row]; S.r1 = tb[e1] * 256 + slot_p[2 * row + 1]; S.w0 = slot_w[2 * row]; S.w1 = slot_w[2 * row + 1];
}
__device__ __forceinline__ void fin_data(const Args& a, int row, int lane, const FinSlots& S, u32x2 (&hw)[8], u32x2 (&ya)[8], u32x2 (&yb)[8]) {
    unsigned char* ws = a.ws;
    const bf16_t* H1B = (const bf16_t*)(ws + WS_H1B) + (size_t)row * DM; const bf16_t* Y = (const bf16_t*)(ws + WS_Y);
#pragma unroll
    for (int i = 0; i < 8; ++i) { hw[i] = *(const u32x2*)(H1B + 256 * i + 4 * lane); ya[i] = *(const u32x2*)(Y + (size_t)S.r0 * DM + 256 * i + 4 * lane); yb[i] = *(const u32x2*)(Y + (size_t)S.r1 * DM + 256 * i + 4 * lane); }
}
__device__ __forceinline__ void fin_compute(const Args& a, int row, int lane, float w0, float w1, const u32x2 (&hw)[8], const u32x2 (&ya)[8], const u32x2 (&yb)[8]) {
    f32x4 v[8]; float s = 0.f;
#pragma unroll
    for (int i = 0; i < 8; ++i) {
        const f32x4 hv = {__uint_as_float(hw[i].x << 16), __uint_as_float(hw[i].x & 0xffff0000u), __uint_as_float(hw[i].y << 16), __uint_as_float(hw[i].y & 0xffff0000u)};
        const f32x4 fa = {__uint_as_float(ya[i].x << 16), __uint_as_float(ya[i].x & 0xffff0000u), __uint_as_float(ya[i].y << 16), __uint_as_float(ya[i].y & 0xffff0000u)};
        const f32x4 fb = {__uint_as_float(yb[i].x << 16), __uint_as_float(yb[i].x & 0xffff0000u), __uint_as_float(yb[i].y << 16), __uint_as_float(yb[i].y & 0xffff0000u)};
        v[i] = hv * DN_ALPHA + fa * w0 + fb * w1; s += (v[i][0] + v[i][1]) + (v[i][2] + v[i][3]); }
    const float mean = wave_sum(s) * (1.0f / DM); float s2 = 0.f;
#pragma unroll
    for (int i = 0; i < 8; ++i) { v[i] = v[i] - mean; s2 += (v[i][0] * v[i][0] + v[i][1] * v[i][1]) + (v[i][2] * v[i][2] + v[i][3] * v[i][3]); }
    const float rstd = 1.0f / sqrtf(wave_sum(s2) * (1.0f / DM) + LN_EPS);
    float* O = a.out + (size_t)row * DM;
#pragma unroll
    for (int i = 0; i < 8; ++i) { const f32x4 g = *(const f32x4*)(a.in[I_LN2G] + 256 * i + 4 * lane), bb = *(const f32x4*)(a.in[I_LN2B] + 256 * i + 4 * lane);
        *(f32x4*)(O + 256 * i + 4 * lane) = v[i] * rstd * g + bb; }
}
__device__ __forceinline__ void phase_final(const Args& a, int tid, int G, const LAS int* tb) {
    const int lane = tid & 63, wave = tid >> 6, gw = blockIdx.x * NWAVES + wave, NGW = G * NWAVES;
    if (gw >= MT) return;
    FinSlots SA, SB; u32x2 hA[8], aA[8], bA[8], hB[8], aB[8], bB[8];
    int row = gw;
    fin_slots(a, row, tb, SA); fin_data(a, row, lane, SA, hA, aA, bA);
    if (row + NGW < MT) fin_slots(a, row + NGW, tb, SB);
    for (;;) {
        const int r1 = row + NGW, r2 = row + 2 * NGW;
        if (r1 < MT) fin_data(a, r1, lane, SB, hB, aB, bB);
        const float w0 = SA.w0, w1 = SA.w1;
        if (r2 < MT) fin_slots(a, r2, tb, SA);
        fin_compute(a, row, lane, w0, w1, hA, aA, bA);
        if (r1 >= MT) break;
        const int r3 = row + 3 * NGW;
        if (r2 < MT) fin_data(a, r2, lane, SA, hA, aA, bA);
        const float x0 = SB.w0, x1 = SB.w1;
        if (r3 < MT) fin_slots(a, r3, tb, SB);
        fin_compute(a, r1, lane, x0, x1, hB, aB, bB);
        if (r2 >= MT) break;
        row = r2;
    }
}

namespace fa {
constexpr int D = 128, NW = 8, QBLK = 32, KVBLK = 64, LDX = 1024;
constexpr float SCALE = 0.088388347648318440f, THR = 8.f;
constexpr size_t SHM_V = KVBLK * D * 2, SHM_K = KVBLK * D * 2, SHM_ATTN = 2 * SHM_V + 2 * SHM_K + NW * 64 * 4;
using s16x4 = __attribute__((ext_vector_type(4))) short;
#define KSWZ(row, colB) ((row) * 256 + ((colB) ^ (((row) & 7) << 4)))
#define SBAR() __builtin_amdgcn_sched_barrier(0)
__device__ __forceinline__ int crow(int r, int hi) { return (r & 3) + 8 * (r >> 2) + 4 * hi; }

__device__ __forceinline__ void partialSM(f32x16& p0, f32x16& p1, float& m_reg, float& mn, float& alpha) {
  constexpr float C = SCALE * 1.4426950408889634f;
  float pmax = p0[0];
#pragma unroll
  for (int r = 1; r < 16; ++r) pmax = fmaxf(pmax, p0[r]);
#pragma unroll
  for (int r = 0; r < 16; ++r) pmax = fmaxf(pmax, p1[r]);
  { auto rr = __builtin_amdgcn_permlane32_swap(__float_as_uint(pmax), __float_as_uint(pmax), false, false);
    pmax = fmaxf(__uint_as_float(rr[0]), __uint_as_float(rr[1])); }
  if (__builtin_expect(__all(pmax - m_reg <= THR / SCALE), 1)) { mn = m_reg; alpha = 1.f; }
  else { mn = fmaxf(m_reg, pmax); alpha = __builtin_amdgcn_exp2f((m_reg - mn) * C); m_reg = mn; }
  float mnC = -mn * C;
#pragma unroll
  for (int r = 0; r < 16; ++r) p0[r] = fmaf(p0[r], C, mnC);
#pragma unroll
  for (int r = 0; r < 16; ++r) p1[r] = fmaf(p1[r], C, mnC);
#pragma unroll
  for (int r = 0; r < 16; ++r) p0[r] = __builtin_amdgcn_exp2f(p0[r]);
}
__device__ __forceinline__ void finishSM(f32x16& p0, f32x16& p1, float alpha, float& l_reg, bf16x8& pa0, bf16x8& pa1, bf16x8& pa2, bf16x8& pa3) {
#pragma unroll
  for (int r = 0; r < 16; ++r) p1[r] = __builtin_amdgcn_exp2f(p1[r]);
  float ps = 0;
#pragma unroll
  for (int r = 0; r < 16; ++r) ps += p0[r];
#pragma unroll
  for (int r = 0; r < 16; ++r) ps += p1[r];
  { auto rr = __builtin_amdgcn_permlane32_swap(__float_as_uint(ps), __float_as_uint(ps), false, false);
    ps = __uint_as_float(rr[0]) + __uint_as_float(rr[1]); }
  l_reg = l_reg * alpha + ps;
#define PK4(P, BASE, OUT) do { unsigned a0 = cvt_pk(P[BASE + 0], P[BASE + 1]), a1 = cvt_pk(P[BASE + 2], P[BASE + 3]);   \
    unsigned b0 = cvt_pk(P[BASE + 4], P[BASE + 5]), b1 = cvt_pk(P[BASE + 6], P[BASE + 7]);                              \
    auto r0 = __builtin_amdgcn_permlane32_swap(a0, b0, false, false); auto r1 = __builtin_amdgcn_permlane32_swap(a1, b1, false, false); \
    u32x4 w = {r0[0], r1[0], r0[1], r1[1]}; OUT = *reinterpret_cast<bf16x8*>(&w); } while (0)
  PK4(p0, 0, pa0); PK4(p0, 8, pa1); PK4(p1, 0, pa2); PK4(p1, 8, pa3);
#undef PK4
}
__device__ __forceinline__ void qkt(f32x16& p0, f32x16& p1, const char* Ks, const bf16x8* qr, int r32, int hi) {
  p0 = f32x16{}; p1 = f32x16{};
#pragma unroll
  for (int d0 = 0; d0 < 8; ++d0) { int cb = (d0 * 16 + hi * 8) * 2;
    bf16x8 b0 = *reinterpret_cast<const bf16x8*>(Ks + KSWZ(r32, cb));
    bf16x8 b1 = *reinterpret_cast<const bf16x8*>(Ks + KSWZ(32 + r32, cb));
    p0 = __builtin_amdgcn_mfma_f32_32x32x16_bf16(b0, qr[d0], p0, 0, 0, 0);
    p1 = __builtin_amdgcn_mfma_f32_32x32x16_bf16(b1, qr[d0], p1, 0, 0, 0); }
}
__device__ __forceinline__ void mask_bias(f32x16& p0, f32x16& p1, u32x2 mw, float dq, float slr, int hi) {
  const unsigned w0 = mw.x >> (4 * hi), w1 = mw.y >> (4 * hi);
  const unsigned NEG = 0xf149f2cau;
#pragma unroll
  for (int r = 0; r < 16; ++r) { const int c = (r & 3) + 8 * (r >> 2);
    const float d0 = dq - (float)c, d1 = dq - (float)(32 + c);
    const float s0 = fmaf(-slr, fabsf(d0), p0[r]), s1 = fmaf(-slr, fabsf(d1), p1[r]);
    const unsigned t0 = (unsigned)(((int)(w0 << (31 - c))) >> 31), t1 = (unsigned)(((int)(w1 << (31 - c))) >> 31);
    p0[r] = __uint_as_float((__float_as_uint(s0) & t0) | (NEG & ~t0));
    p1[r] = __uint_as_float((__float_as_uint(s1) & t1) | (NEG & ~t1)); }
}
__device__ __forceinline__ int v_st(int k, int c) { const int kk = (k & ~0xC) | ((k & 4) << 1) | ((k & 8) >> 1); return ((kk >> 3) * 4 + (c >> 5)) * 512 + ((kk & 7) * 32 + (c & 31)) * 2; }
__device__ __forceinline__ int v_rd_base(int lane) { return ((lane & 3) << 3) | (((lane >> 2) & 3) << 6) | (((lane >> 4) & 1) << 5) | (((lane >> 5) & 1) << 8); }
constexpr int v_rd_off(int d0, int ks, int half) { return d0 * 512 + ks * 4096 + half * 2048; }
template <int OFF> __device__ __forceinline__ s16x4 tr_read(int vb) {
  s16x4 r; asm volatile("ds_read_b64_tr_b16 %0, %1 offset:%2" : "=&v"(r) : "v"(vb), "i"(OFF) : "memory"); return r;
}
template <int D0> __device__ __forceinline__ void pv_one(f32x16& od, int vb, bf16x8 pa0, bf16x8 pa1, bf16x8 pa2, bf16x8 pa3) {
  const s16x4 l0 = tr_read<v_rd_off(D0, 0, 0)>(vb), h0 = tr_read<v_rd_off(D0, 0, 1)>(vb), l1 = tr_read<v_rd_off(D0, 1, 0)>(vb), h1 = tr_read<v_rd_off(D0, 1, 1)>(vb);
  const s16x4 l2 = tr_read<v_rd_off(D0, 2, 0)>(vb), h2 = tr_read<v_rd_off(D0, 2, 1)>(vb), l3 = tr_read<v_rd_off(D0, 3, 0)>(vb), h3 = tr_read<v_rd_off(D0, 3, 1)>(vb);
  asm volatile("s_waitcnt lgkmcnt(0)" ::: "memory"); SBAR();
#define PK(L, H) (bf16x8){L[0], L[1], L[2], L[3], H[0], H[1], H[2], H[3]}
  od = __builtin_amdgcn_mfma_f32_32x32x16_bf16(pa0, PK(l0, h0), od, 0, 0, 0);
  od = __builtin_amdgcn_mfma_f32_32x32x16_bf16(pa1, PK(l1, h1), od, 0, 0, 0);
  od = __builtin_amdgcn_mfma_f32_32x32x16_bf16(pa2, PK(l2, h2), od, 0, 0, 0);
  od = __builtin_amdgcn_mfma_f32_32x32x16_bf16(pa3, PK(l3, h3), od, 0, 0, 0);
#undef PK
}
__device__ __forceinline__ void pv_d0(f32x16* o, int vb, bf16x8 pa0, bf16x8 pa1, bf16x8 pa2, bf16x8 pa3) {
  pv_one<0>(o[0], vb, pa0, pa1, pa2, pa3); pv_one<1>(o[1], vb, pa0, pa1, pa2, pa3); pv_one<2>(o[2], vb, pa0, pa1, pa2, pa3); pv_one<3>(o[3], vb, pa0, pa1, pa2, pa3);
}

#define FA_GAS __attribute__((address_space(1)))
__device__ __forceinline__ void attn_block(const bf16_t* Qb_, const bf16_t* Kh_, const bf16_t* Vh_, const unsigned* maskrow_,
                                           bf16_t* Ob_, int NT, int qpos0, float slr, char* lds) {
  const FA_GAS bf16_t* Qb = (const FA_GAS bf16_t*)Qb_; const FA_GAS bf16_t* Kh = (const FA_GAS bf16_t*)Kh_; const FA_GAS bf16_t* Vh = (const FA_GAS bf16_t*)Vh_;
  const FA_GAS unsigned* maskrow = (const FA_GAS unsigned*)maskrow_; FA_GAS unsigned char* Ob = (FA_GAS unsigned char*)Ob_;
  int tid_ = cur_tid((const LAS unsigned char*)lds); asm volatile("" : "+v"(tid_));
  const int tid = tid_, wid = tid >> 6, lane = tid & 63, r32 = lane & 31, hi = lane >> 5;
  char* V_lds = lds; char* K_lds = lds + 2 * SHM_V;
  float* wsm = (float*)(lds + 2 * SHM_V + 2 * SHM_K) + wid * 64; float* li_l = wsm; float* al_l = wsm + 32;
  float m_reg = -1e30f, l_reg = 0; f32x16 o[4] = {}; bf16x8 qr[8];
  const FA_GAS bf16_t* Qw = Qb + (long)(wid * QBLK + r32) * LDX + hi * 8;
#pragma unroll
  for (int d0 = 0; d0 < 8; ++d0) qr[d0] = *reinterpret_cast<const FA_GAS bf16x8*>(Qw + d0 * 16);
  const unsigned moff = (unsigned)(wid * QBLK + r32) * 256u;
  const float qposf = (float)(qpos0 + wid * QBLK + r32 - 4 * hi);
  const int sr = tid >> 4, sc = (tid & 15) * 8, vst0 = v_st(sr, sc), vst1 = v_st(32 + sr, sc);
  const int vb0 = (int)(uintptr_t)V_lds + v_rd_base(lane);
  constexpr int SDEPTH = 1;
  struct { bf16x8 vs0, vs1, ks0, ks1; } sr_[SDEPTH];
#define KOFF(j) ((NT - 1 - (j)) * KVBLK)
#define SLOAD(i, k0) do { sr_[i].vs0 = *reinterpret_cast<const FA_GAS bf16x8*>(&Vh[(long)((k0) + sr) * LDX + sc]); sr_[i].vs1 = *reinterpret_cast<const FA_GAS bf16x8*>(&Vh[(long)((k0) + 32 + sr) * LDX + sc]); \
    sr_[i].ks0 = *reinterpret_cast<const FA_GAS bf16x8*>(&Kh[(long)((k0) + sr) * LDX + sc]); sr_[i].ks1 = *reinterpret_cast<const FA_GAS bf16x8*>(&Kh[(long)((k0) + 32 + sr) * LDX + sc]); } while (0)
#define SWRITE(b, i) do { *(bf16x8*)(V_lds + (b) * SHM_V + vst0) = sr_[i].vs0;          \
    *(bf16x8*)(V_lds + (b) * SHM_V + vst1) = sr_[i].vs1; int kc = sc * 2;               \
    *(bf16x8*)(K_lds + (b) * SHM_K + KSWZ(sr, kc)) = sr_[i].ks0;                       \
    *(bf16x8*)(K_lds + (b) * SHM_K + KSWZ(32 + sr, kc)) = sr_[i].ks1; } while (0)
#define SWAIT() do { if constexpr (SDEPTH == 2) asm volatile("s_waitcnt vmcnt(4)" ::: "memory"); else asm volatile("s_waitcnt vmcnt(0)" ::: "memory"); } while (0)
#define RESC(a) do { if (__any((a) < 1.f)) { if (hi == 0) al_l[r32] = (a); asm volatile("s_waitcnt lgkmcnt(0)" ::: "memory"); \
    _Pragma("unroll") for (int d = 0; d < 4; ++d) _Pragma("unroll") for (int r = 0; r < 16; ++r) o[d][r] *= al_l[crow(r, hi)]; } } while (0)
#define MASKW(j) (*reinterpret_cast<const FA_GAS u32x2*>(maskrow + (moff + 2u * (unsigned)(NT - 1 - (j)))))
#define MB(P0, P1, j, MW) mask_bias(P0, P1, MW, qposf - (float)KOFF(j), slr, hi)
  f32x16 pA0, pA1, pB0, pB1; float mnA, mnB, alA, alB; bf16x8 pa0, pa1, pa2, pa3;
  constexpr int SE = 0, SO = SDEPTH - 1;
  SLOAD(SE, KOFF(0)); asm volatile("s_waitcnt vmcnt(0)" ::: "memory"); SWRITE(0, SE); __syncthreads();
  { qkt(pA0, pA1, K_lds, qr, r32, hi); MB(pA0, pA1, 0, MASKW(0)); } partialSM(pA0, pA1, m_reg, mnA, alA);
  SLOAD(SO, KOFF(1)); if constexpr (SDEPTH == 2) { if (2 < NT) SLOAD(SE, KOFF(2)); }
  SWAIT(); SWRITE(1, SO); __syncthreads();
  for (int j = 1; j + 1 < NT; j += 2) {
    SBAR(); { qkt(pB0, pB1, K_lds + SHM_K, qr, r32, hi); MB(pB0, pB1, j, MASKW(j)); }
    finishSM(pA0, pA1, alA, l_reg, pa0, pa1, pa2, pa3); SBAR();
    SLOAD(SO, KOFF(j + SDEPTH)); SBAR();
    pv_d0(o, vb0, pa0, pa1, pa2, pa3); partialSM(pB0, pB1, m_reg, mnB, alB);
    __syncthreads(); SWAIT(); SWRITE(0, SE);
    RESC(alB); __syncthreads();
    SBAR(); { qkt(pA0, pA1, K_lds, qr, r32, hi); MB(pA0, pA1, j + 1, MASKW(j + 1)); }
    finishSM(pB0, pB1, alB, l_reg, pa0, pa1, pa2, pa3); SBAR();
    if (SDEPTH == 1 || j + 3 < NT) SLOAD(SE, KOFF(j + 1 + SDEPTH)); SBAR();
    pv_d0(o, vb0 + (int)SHM_V, pa0, pa1, pa2, pa3); partialSM(pA0, pA1, m_reg, mnA, alA);
    __syncthreads(); SWAIT(); SWRITE(1, SO);
    RESC(alA); __syncthreads();
  }
  SBAR(); { qkt(pB0, pB1, K_lds + SHM_K, qr, r32, hi); MB(pB0, pB1, NT - 1, MASKW(NT - 1)); }
  finishSM(pA0, pA1, alA, l_reg, pa0, pa1, pa2, pa3); SBAR();
  pv_d0(o, vb0, pa0, pa1, pa2, pa3); partialSM(pB0, pB1, m_reg, mnB, alB);
  __syncthreads(); RESC(alB);
  finishSM(pB0, pB1, alB, l_reg, pa0, pa1, pa2, pa3); SBAR();
  pv_d0(o, vb0 + (int)SHM_V, pa0, pa1, pa2, pa3);
  if (hi == 0) li_l[r32] = l_reg; asm volatile("s_waitcnt lgkmcnt(0)" ::: "memory");
  float rli[16];
#pragma unroll
  for (int r = 0; r < 16; ++r) rli[r] = __builtin_amdgcn_rcpf(li_l[crow(r, hi)]);
  FA_GAS unsigned char* Ow = Ob + (long)(wid * QBLK) * LDX;
#pragma unroll
  for (int r = 0; r < 16; ++r) { int orow = crow(r, hi);
#pragma unroll
    for (int d0 = 0; d0 < 4; ++d0) Ow[(long)orow * LDX + d0 * 32 + r32] = (unsigned char)cvt1_fp8(o[d0][r] * rli[r], F8_ASCALE); }
  __syncthreads();
#undef KOFF
#undef SLOAD
#undef SWRITE
#undef SWAIT
#undef RESC
#undef MASKW
#undef MB
}
#undef KSWZ
#undef SBAR
}

__device__ __forceinline__ void phase_attention(const Args& a, char* lds, int G, int bid) {
    unsigned char* ws = uni_ptr(a.ws);
    const bf16_t* BQ = (const bf16_t*)(ws + WS_BQ); const bf16_t* BK = (const bf16_t*)(ws + WS_BK); const bf16_t* BV = (const bf16_t*)(ws + WS_BV);
    const unsigned* MASK = (const unsigned*)(ws + WS_MASK); unsigned char* BRB = ws + WS_BRB;
    const int bx = bid; const int vcu = (G % 8 == 0) ? (bx % 8) * (G / 8) + bx / 8 : bx;
    for (int p0 = vcu; p0 < 256; p0 += G) { const int p = __builtin_amdgcn_readfirstlane(p0);
        const int b = p >> 7, h = (p >> 4) & 7, x = p & 15;
        const float slr = uni_f((1.0f / fa::SCALE) / (float)(2 << h));
#pragma unroll 1
        for (int half = 0; half < 2; ++half) { const int qb = half ? 31 - x : x; const size_t row0 = (size_t)b * SEQ + qb * 256;
            fa::attn_block(uni_ptr(BQ + row0 * 1024 + h * 128), uni_ptr(BK + (size_t)b * SEQ * 1024 + h * 128), uni_ptr(BV + (size_t)b * SEQ * 1024 + h * 128),
                           uni_ptr(MASK + row0 * 256), (bf16_t*)uni_ptr(BRB + row0 * 1024 + h * 128), 4 * (qb + 1), qb * 256, slr, lds); }
    }
}


constexpr int NPH = 13;
#ifndef REPS
#define REPS 1,1,1,1,1,1,1,1,1,1,1,1,1,1,1,1
#endif
constexpr int REP[16] = {REPS};
__global__ void __launch_bounds__(NTHR, 2) mk_fwd(Args a) {
    extern __shared__ __attribute__((aligned(16))) unsigned char lds_raw[];
    LAS unsigned char* lds = (LAS unsigned char*)lds_raw;
    cg::grid_group grid = cg::this_grid();
    const int G = gridDim.x;
#define FRESH_TID() int tid = cur_tid(lds); asm volatile("" : "+v"(tid)); const int lane = tid & 63, wave = tid >> 6; (void)lane; (void)wave

    unsigned char* ws = a.ws;
    const int lo = a.ph_lo, hi = a.ph_hi;
#define IN(k) (lo <= (k) && (k) < hi)
    if (lo < 0) grid.sync();
    if (threadIdx.x == 0) { ((volatile LAS unsigned*)(lds + LDS_BARST))[0] = 0u; ((volatile LAS unsigned*)(lds + LDS_BARST))[1] = 0u; }
    if ((threadIdx.x & 63) == 0) ((volatile LAS unsigned char*)(lds + LDS_WTAB))[(unsigned)__builtin_amdgcn_s_getreg((5 << 11) | 4) & 63u] = (unsigned char)(threadIdx.x >> 6);
    __syncthreads();
    (void)xcd_barrier_post((unsigned*)(ws + WS_CTL) + CW_BAR, (volatile LAS unsigned*)(lds + LDS_BARST));
    int bid = blockIdx.x;
    if (lo == 0 && hi == NPH && (G % 8) == 0) {
        if (threadIdx.x == 0) { const unsigned x = xb_xcc_id(); const unsigned r = atomicAdd((unsigned*)(ws + WS_CTL) + CW_TICKET + 64 * x, 1u); ((volatile LAS unsigned*)(lds + LDS_BARST))[2] = r * 8u + (x & 7u); }
    }
#define SEAM(k) do { if (IN(k) && IN((k) + 1)) { { XcdBarrier b_; b_.bar = (unsigned*)(a.ws + WS_CTL) + CW_BAR; b_.x = xb_xcc_id(); b_.st = (volatile LAS unsigned*)(lds + LDS_BARST); xcd_barrier(b_); } } } while (0)

    if (IN(0)) { FRESH_TID(); for (int rp = 0; rp < REP[0]; ++rp) { phase_prologue(a, lds, tid, G); __syncthreads(); } }
    SEAM(0);
    if (lo == 0 && hi == NPH && (G % 8) == 0) {
        const unsigned* bw = (const unsigned*)(ws + WS_CTL) + CW_BAR; bool ok = true;
        for (int j = 0; j < 8; ++j) ok = ok && (__hip_atomic_load(bw + XB_XCNT(j), __ATOMIC_RELAXED, __HIP_MEMORY_SCOPE_AGENT) == (unsigned)(G / 8));
        if (ok) bid = __builtin_amdgcn_readfirstlane((int)((volatile LAS unsigned*)(lds + LDS_BARST))[2]);
    }
    if (IN(1)) { FRESH_TID();
        for (int c8 = tid; c8 < NPROJ_PAD / 2; c8 += NTHR) { const int c = 2 * c8; float b0 = 0.f, b1 = 0.f;
            if (c < 7752) { b0 = a.in[I_BIN][c]; b1 = a.in[I_BIN][c + 1]; } else if (c >= 7936) { b0 = a.in[I_BIN][c - 184]; b1 = a.in[I_BIN][c - 183]; }
            *(LAS unsigned*)(lds + LDS_BIAS + c * 2) = cvt_pk(b0, b1); }
        __syncthreads();
        for (int rp = 0; rp < REP[1]; ++rp) {
            { pg8::Gemm g{(const bf16_t*)(ws + WS_XB), (const bf16_t*)(ws + WS_WIN), MT, 7 * 256, DM}; pg8::StaticOrderT<false, 2> S; S.init(MT, 7 * 256, G, bid);
              pg8::EpiProjT<false> E{ws, lds + LDS_BIAS}; pg8::gemm_phase<pg8::EpiProjT<false>, pg8::StaticOrderT<false, 2>, true, true>(lds, g, S, E); }
            { int k1 = DM / 2; asm volatile("" : "+s"(k1));
              pg8::Gemm g{(const bf16_t*)(ws + WS_X8), (const bf16_t*)(ws + WS_WIN8), MT, 40 * 256, k1}; pg8::StaticOrderT<true, 1> S; S.init(MT, 40 * 256, G, bid);
              pg8::EpiProjT<true> E{ws, lds + LDS_BIAS}; pg8::gemm_phase<pg8::EpiProjT<true>, pg8::StaticOrderT<true, 1>, true, true>(lds, g, S, E); } } }
    SEAM(1);
    if (IN(2)) { FRESH_TID(); hg_fill_lb(a, lds, tid);
        for (int rp = 0; rp < REP[2]; ++rp) for (int u = blockIdx.x; u < 2048; u += G) hgrn1_unit(a, u, lds, tid);
        { int tix = tid; asm volatile("" : "+v"(tix));
        for (int rp = 0; rp < REP[3]; ++rp) for (int k = 0; k * G < MT / 4; ++k) { const int u = k * G + ((k & 1) ? (G - 1 - (int)blockIdx.x) : (int)blockIdx.x); if (u < MT / 4) indexer_unit(a, u, lds, tix); } } }
    SEAM(2);
    if (IN(3)) { FRESH_TID(); for (int rp = 0; rp < REP[4]; ++rp) hgrn_scan(a, tid, G);
        for (int rp = 0; rp < REP[5]; ++rp) phase_attention(a, (char*)lds_raw, G, bid); }
    SEAM(3);
    if (IN(4)) { FRESH_TID(); for (int rp = 0; rp < REP[6]; ++rp) { float z[16]; unsigned qq[16], vv[16]; u32x4 stp[4]; u32x2 gwn[4];
            if ((int)blockIdx.x < 2048) hg3_load(a, blockIdx.x, tid, z, qq, vv, stp, gwn);
            hg_fill_lb(a, lds, tid);
            for (int u = blockIdx.x; u < 2048; u += G) hgrn3_unit(a, u, (u + G < 2048) ? u + G : -1, lds, tid, z, qq, vv, stp, gwn); } }
    SEAM(4);
    if (IN(5)) { FRESH_TID(); for (int rp = 0; rp < REP[7]; ++rp) {
        int kb5 = 512; asm volatile("" : "+s"(kb5));
        { pg8::Gemm g{(const bf16_t*)(ws + WS_BRA), (const bf16_t*)(ws + WS_WA), MT, DM, kb5}; pg8::StaticOrderF8 S; S.init(MT, DM, G, bid);
          pg8::EpiBranch<0> E{(bf16_t*)(ws + WS_MERGED), (const bf16_t*)(ws + WS_GATES), ws + WS_MERGED8};
          pg8::gemm_phase<pg8::EpiBranch<0>, pg8::StaticOrderF8, true, true>(lds, g, S, E); }
        { pg8::Gemm g{(const bf16_t*)(ws + WS_BRB), (const bf16_t*)(ws + WS_WB), MT, DM, kb5}; pg8::StaticOrderF8 S; S.init(MT, DM, G, bid);
          pg8::EpiBranch<1> E{(bf16_t*)(ws + WS_MERGED), (const bf16_t*)(ws + WS_GATES), ws + WS_MERGED8};
          pg8::gemm_phase<pg8::EpiBranch<1>, pg8::StaticOrderF8, true, true>(lds, g, S, E); } } }
    SEAM(6);
    if (IN(7)) { FRESH_TID(); int kb7 = DM / 2; asm volatile("" : "+s"(kb7));
        pg8::Gemm g{(const bf16_t*)(ws + WS_MERGED8), (const bf16_t*)(ws + WS_WOUT), MT, DM, kb7}; pg8::StaticOrderF8 S; S.init(MT, DM, G, bid);
        pg8::EpiResBf16 E{(bf16_t*)(ws + WS_PRE1), a.in[I_X], DN_ALPHA};
        for (int rp = 0; rp < REP[8]; ++rp) pg8::gemm_phase<pg8::EpiResBf16, pg8::StaticOrderF8, true, true>(lds, g, S, E); }
    SEAM(7);
    if (IN(8)) { FRESH_TID(); for (int rp = 0; rp < REP[9]; ++rp) phase8_router_expw(a, lds, tid, G, rp == 0, rp == 0);
        for (int rp = 1; rp < REP[10]; ++rp) phase_expert_weights(a, lds, tid, G); }
    if (IN(8) && IN(10)) { XcdBarrier b_; b_.bar = (unsigned*)(a.ws + WS_CTL) + CW_BAR; b_.x = xb_xcc_id(); b_.st = (volatile LAS unsigned*)(lds + LDS_BARST); xcd_barrier(b_); }
    if (IN(10)) { FRESH_TID(); const unsigned* ctl = (const unsigned*)(ws + WS_CTL);
        LAS int* tb = (LAS int*)(lds + LDS_MOE_TB); LAS unsigned* TE = (LAS unsigned*)(lds + LDS_MOE_TE); LAS unsigned* TOK = (LAS unsigned*)(lds + LDS_MOE_TOK);
        __syncthreads(); load_tile_base(a, tb, tid);
        if (tid < NEXP) for (int t = tb[tid]; t < tb[tid + 1]; ++t) TE[t] = (unsigned)tid;
        __syncthreads();
        const int NT = tb[NEXP];
        pg8::GroupedOrder<true> S; S.init(NT, 8, G, bid, TE, TOK);
        { const int* rows = (const int*)(ws + WS_ROWS);
          for (int i = 0; i < 8; ++i) { pg8::Unit u; if (!S.next(i, u)) break;
              if (tid < 256) { const int e = (int)TE[u.pm], pos = (u.pm - tb[e]) * 256 + tid, cnt = (int)ctl[CW_CNT + 64 * e];
                  TOK[i * 256 + tid] = (pos < cnt) ? (unsigned)rows[e * MT + pos] * (unsigned)DM : 0u; } } }
        __syncthreads();
        pg8::Gemm g{(const bf16_t*)(ws + WS_H1F8), (const bf16_t*)(ws + WS_WGU), NT * 256, 2048, DM / 2};
        pg8::EpiGateUp E{ws + WS_HH};
        for (int rp = 0; rp < REP[12]; ++rp) pg8::gemm_phase<pg8::EpiGateUp, pg8::GroupedOrder<true>, true, true>(lds, g, S, E); }
    SEAM(10);
    if (IN(11)) { FRESH_TID();
        LAS int* tb = (LAS int*)(lds + LDS_MOE_TB); LAS unsigned* TE = (LAS unsigned*)(lds + LDS_MOE_TE);
        __syncthreads(); load_tile_base(a, tb, tid);
        if (tid < NEXP) for (int t = tb[tid]; t < tb[tid + 1]; ++t) TE[t] = (unsigned)tid;
        __syncthreads();
        const int NT = tb[NEXP];
        int kd = DFF / 2; asm volatile("" : "+s"(kd));
        pg8::Gemm g{(const bf16_t*)(ws + WS_HH), (const bf16_t*)(ws + WS_WD), NT * 256, 2048, kd}; pg8::GroupedOrder<false> S; S.init(NT, 8, G, bid, TE, nullptr);
        pg8::EpiStoreBf16 E{(bf16_t*)(ws + WS_Y), DM, uni_f(G > 0 ? F8_UNSCALE : 0.f)};
        for (int rp = 0; rp < REP[13]; ++rp) pg8::gemm_phase<pg8::EpiStoreBf16, pg8::GroupedOrder<false>, true, true>(lds, g, S, E); }
    SEAM(11);
    if (IN(12)) { FRESH_TID(); LAS int* tb = (LAS int*)lds; __syncthreads(); load_tile_base(a, tb, tid);
        for (int rp = 0; rp < REP[14]; ++rp) phase_final(a, tid, G, tb); }
#undef IN
#undef SEAM
}

#ifndef MK_SPLIT
#define MK_SPLIT 0
#endif
extern "C" void kernel_launch(void* const* d_in, const int* in_sizes, int n_in, void* d_out, int out_size, void* d_ws, size_t ws_size, hipStream_t stream) {
    static int grid = 0;
    if (grid == 0) {
        int dev = 0, cus = 0, per_cu = 0;
        if (n_in != 19 || out_size != MT * DM || ws_size < WS_END) { fprintf(stderr, "kernel_launch: unexpected shapes: n_in %d out %d ws %zu (need %zu)\n", n_in, out_size, ws_size, (size_t)WS_END); grid = -1; return; }
        if (hipGetDevice(&dev) != hipSuccess || hipDeviceGetAttribute(&cus, hipDeviceAttributeMultiprocessorCount, dev) != hipSuccess) { grid = -1; return; }
        if (hipFuncSetAttribute((const void*)mk_fwd, hipFuncAttributeMaxDynamicSharedMemorySize, LDS_BYTES) != hipSuccess) { fprintf(stderr, "kernel_launch: hipFuncSetAttribute failed\n"); grid = -1; return; }
        if (hipOccupancyMaxActiveBlocksPerMultiprocessor(&per_cu, (const void*)mk_fwd, NTHR, LDS_BYTES) != hipSuccess || per_cu < 1) { fprintf(stderr, "kernel_launch: occupancy query says %d blocks/CU\n", per_cu); grid = -1; return; }
        grid = cus;
    }
    if (grid < 0) return;
    (void)hipMemsetAsync((char*)d_ws + WS_CTL, 0, 1 * MiB, stream);
    Args a{};
    for (int i = 0; i < 19; ++i) a.in[i] = (const float*)d_in[i];
    a.out = (float*)d_out; a.ws = (unsigned char*)d_ws;
#if MK_SPLIT
#ifndef MK_DUP
#define MK_DUP -1
#endif
    for (int p2 = 0; p2 < NPH + (MK_DUP >= 0 ? 1 : 0); ++p2) { const int p = (MK_DUP >= 0 && p2 > MK_DUP) ? p2 - 1 : p2;
        a.ph_lo = p; a.ph_hi = p + 1; void* args[] = {&a};
        hipError_t e = hipLaunchCooperativeKernel((const void*)mk_fwd, dim3(grid), dim3(NTHR), args, LDS_BYTES, stream);
        if (e != hipSuccess) { fprintf(stderr, "cooperative launch (phase %d) failed: %s (grid %d)\n", p, hipGetErrorString(e), grid); break; } }
#else
    a.ph_lo = 0; a.ph_hi = NPH; void* args[] = {&a};
    hipError_t e = hipLaunchCooperativeKernel((const void*)mk_fwd, dim3(grid), dim3(NTHR), args, LDS_BYTES, stream);
    if (e != hipSuccess) fprintf(stderr, "cooperative launch failed: %s (grid %d)\n", hipGetErrorString(e), grid);
#endif
}
```

```cpp
#include <hip/hip_runtime.h>
#include <hip/hip_cooperative_groups.h>
#include <cstdio>
#include <cstdint>
namespace cg = cooperative_groups;

#define LAS __attribute__((address_space(3)))
typedef unsigned short bf16_t;
typedef short bf16x8 __attribute__((ext_vector_type(8)));
typedef float f32x4 __attribute__((ext_vector_type(4)));
typedef float f32x2 __attribute__((ext_vector_type(2)));
typedef float f32x16 __attribute__((ext_vector_type(16)));
typedef unsigned u32x4 __attribute__((ext_vector_type(4)));
typedef unsigned u32x2 __attribute__((ext_vector_type(2)));

constexpr int MT = 16384, SEQ = 8192, DM = 2048, NHEAD = 8, HD = 128, NPROJ = 11848, NPROJ_PAD = 12032;
constexpr int NEXP = 32, DFF = 1024, MAXROWS = 40960;
constexpr float DN_ALPHA = 1.189207115002721f;
constexpr float LN_EPS = 1e-5f, RMS_EPS = 1e-6f;
constexpr int NWAVES = 8, NTHR = 512;
constexpr int LDS_BYTES = 163840;

constexpr size_t MiB = 1u << 20;
constexpr size_t WS_CTL = 0;
constexpr size_t WS_WIN = 1 * MiB;
constexpr size_t WS_WA = 48 * MiB, WS_WB = 52 * MiB, WS_WOUT = 56 * MiB;
constexpr size_t WS_WR2 = 60 * MiB;
constexpr size_t WS_LGP = 448 * MiB;
constexpr size_t WS_XB = 64 * MiB;
constexpr size_t WS_MERGED = 128 * MiB;
constexpr size_t WS_AQ = 128 * MiB, WS_AI = 160 * MiB, WS_AG = 192 * MiB, WS_BQ = 224 * MiB, WS_BK = 256 * MiB, WS_BV = 288 * MiB;
constexpr size_t WS_AF = 320 * MiB;
constexpr size_t WS_IQ = 384 * MiB;
constexpr size_t WS_IKW = 400 * MiB;
constexpr size_t WS_GATES = 472 * MiB;
constexpr size_t WS_WGU = 830 * MiB;
constexpr size_t WS_WD = 384 * MiB;
constexpr size_t WS_H1F8 = 256 * MiB;
constexpr size_t WS_MASK = 536 * MiB;
constexpr size_t WS_KV = 552 * MiB;
constexpr size_t WS_PRE1 = 552 * MiB;
constexpr size_t WS_ST = 680 * MiB;
constexpr size_t WS_H1B = 680 * MiB;
constexpr size_t WS_DECAY = 744 * MiB;
constexpr size_t WS_ROWS = 745 * MiB;
constexpr size_t WS_SLOT = 747 * MiB;
constexpr size_t WS_BRA = 750 * MiB, WS_BRB = 782 * MiB;
constexpr size_t WS_MERGED8 = 616 * MiB;
constexpr size_t WS_IK2 = 814 * MiB;
constexpr size_t WS_HH = 750 * MiB;
constexpr size_t WS_XG = 830 * MiB;
constexpr size_t WS_Y = 830 * MiB;
constexpr size_t WS_WIN8 = 830 * MiB;
constexpr size_t WS_X8 = 860 * MiB;
constexpr size_t WS_END = 990 * MiB;
constexpr int CW_CNT = 1024;
constexpr int CW_NT = 4096;
constexpr int CW_TILEE = 4160;
constexpr int CW_TBASE = 4400;
constexpr int CW_BAR = 8192;
constexpr int CW_TICKET = 12288;
constexpr int LDS_BIAS = 131072;
constexpr int LDS_MOE_TB = 131072, LDS_MOE_TE = 131072 + 256, LDS_MOE_TOK = 131072 + 1024;
constexpr int LDS_BARST = LDS_BYTES - 64;
constexpr int LDS_WTAB = LDS_BYTES - 128;

__device__ __forceinline__ float bf2f(unsigned h) { return __uint_as_float(h << 16); }
__device__ __forceinline__ unsigned cvt_pk(float lo, float hi) { unsigned r; asm volatile("v_cvt_pk_bf16_f32 %0, %1, %2" : "=v"(r) : "v"(lo), "v"(hi)); return r; }
__device__ __forceinline__ unsigned cvt_pk_mfma(float lo, float hi) { unsigned r; asm volatile("s_nop 15\n\ts_nop 3\n\tv_cvt_pk_bf16_f32 %0, %1, %2" : "=v"(r) : "v"(lo), "v"(hi)); return r; }
__device__ __forceinline__ unsigned cvt_pk_to_mfma(float lo, float hi) { unsigned r; asm volatile("v_cvt_pk_bf16_f32 %0, %1, %2\n\ts_nop 1" : "=v"(r) : "v"(lo), "v"(hi)); return r; }
__device__ __forceinline__ unsigned cvt4_fp8(float a, float b, float c, float d, float s) {
    a = __builtin_amdgcn_fmed3f(a * s, -448.f, 448.f); b = __builtin_amdgcn_fmed3f(b * s, -448.f, 448.f); c = __builtin_amdgcn_fmed3f(c * s, -448.f, 448.f); d = __builtin_amdgcn_fmed3f(d * s, -448.f, 448.f);
    int w = 0; w = __builtin_amdgcn_cvt_pk_fp8_f32(a, b, w, false); w = __builtin_amdgcn_cvt_pk_fp8_f32(c, d, w, true); return (unsigned)w; }
__device__ __forceinline__ unsigned cvt1_fp8(float a, float s) { a = __builtin_amdgcn_fmed3f(a * s, -448.f, 448.f); return (unsigned)__builtin_amdgcn_cvt_pk_fp8_f32(a, a, 0, false) & 0xffu; }
__device__ __forceinline__ unsigned cvt4_fp8_nc(float a, float b, float c, float d, float s) {
    int w = 0; w = __builtin_amdgcn_cvt_pk_fp8_f32(a * s, b * s, w, false); w = __builtin_amdgcn_cvt_pk_fp8_f32(c * s, d * s, w, true); return (unsigned)w; }
__device__ __forceinline__ f32x4 fp8x4_f32(unsigned w) { const f32x2 lo = __builtin_amdgcn_cvt_pk_f32_fp8((int)w, false), hi = __builtin_amdgcn_cvt_pk_f32_fp8((int)w, true); return (f32x4){lo[0], lo[1], hi[0], hi[1]}; }
__device__ __forceinline__ unsigned fp8b_bf16(unsigned byte) { const float f = __builtin_amdgcn_cvt_f32_fp8((int)byte, 0) * 0.125f; return __float_as_uint(f) >> 16; }
constexpr float F8_YSCALE = 16.f;
constexpr float F8_GSCALE = 128.f;
constexpr float F8_WSCALE = 1024.f, F8_ASCALE = 8.f, F8_UNSCALE = 1.0f / 8192.f;
__device__ __forceinline__ float wave_sum(float v) {
#pragma unroll
    for (int o = 1; o < 64; o <<= 1) v += __shfl_xor(v, o);
    return v;
}
template <int CTRL, int RMASK> __device__ __forceinline__ float dpp_get(float v) { return __int_as_float(__builtin_amdgcn_update_dpp(0, __float_as_int(v), CTRL, RMASK, 0xf, false)); }
__device__ __forceinline__ float wave_sum63(float v) {
    v += dpp_get<0xB1, 0xf>(v); v += dpp_get<0x4E, 0xf>(v); v += dpp_get<0x141, 0xf>(v); v += dpp_get<0x140, 0xf>(v); v += dpp_get<0x142, 0xa>(v); v += dpp_get<0x143, 0xc>(v); return v; }
__device__ __forceinline__ float wave_sum_u(float v) { return __int_as_float(__builtin_amdgcn_readlane(__float_as_int(wave_sum63(v)), 63)); }
__device__ __forceinline__ float fast_exp(float x) { return __builtin_amdgcn_exp2f(x * 1.4426950408889634f); }
__device__ __forceinline__ float sigmoidf_(float x) { return __builtin_amdgcn_rcpf(1.0f + __expf(-x)); }
#define LDS_WAIT() asm volatile("s_waitcnt lgkmcnt(0)" ::: "memory")
template <typename T> __device__ __forceinline__ T* uni_ptr(T* p) { const unsigned long long v = (unsigned long long)p; const unsigned lo = __builtin_amdgcn_readfirstlane((unsigned)v), hi = __builtin_amdgcn_readfirstlane((unsigned)(v >> 32)); return (T*)(((unsigned long long)hi << 32) | lo); }
__device__ __forceinline__ int cur_tid(const LAS unsigned char* lds0) {
    const unsigned slot = (unsigned)__builtin_amdgcn_s_getreg((5 << 11) | 4) & 63u;
    const unsigned w = __builtin_amdgcn_readfirstlane((unsigned)((const volatile LAS unsigned char*)(lds0 + LDS_WTAB))[slot]);
    return (int)((w << 6) | __builtin_amdgcn_mbcnt_hi(~0u, __builtin_amdgcn_mbcnt_lo(~0u, 0u)));
}
__device__ __forceinline__ int fresh_lane() { unsigned z = 0u; asm volatile("" : "+v"(z)); return (int)__builtin_amdgcn_mbcnt_hi(~0u, __builtin_amdgcn_mbcnt_lo(~0u, z)); }
__device__ __forceinline__ float uni_f(float x) { return __uint_as_float(__builtin_amdgcn_readfirstlane(__float_as_uint(x))); }

namespace pg8 {
#define PG8_LAS __attribute__((address_space(3)))
typedef unsigned short bf16_t;
typedef short bf16x8 __attribute__((ext_vector_type(8)));
typedef float f32x4 __attribute__((ext_vector_type(4)));
typedef unsigned u32x4 __attribute__((ext_vector_type(4)));
constexpr int BM = 256, BK = 64, HALF = 128, HTB = HALF * BK * 2  , STAGE_BYTES = 8 * HTB, NXCD = 8, WGM = 8;

__host__ __device__ __forceinline__ int lds_byte(int r, int c) { const int st = (r >> 4) * 2 + (c >> 5), rr = r & 15, cc = c & 31, ob = rr * 64 + cc * 2; return st * 1024 + (ob ^ (((ob >> 9) & 1) << 5)); }
__host__ __device__ __forceinline__ void stage_rc(int b, int& R, int& C) { const int st = b / 1024, sb = b % 1024, swz = sb ^ (((sb >> 9) & 1) << 5); R = (st >> 1) * 16 + swz / 64; C = (st & 1) * 32 + (swz % 64) / 2; }
__host__ __device__ __forceinline__ int perm32(int rho) { const int n = rho >> 4, i = rho & 15; return 8 * (i >> 2) + 4 * n + (i & 3); }

typedef int i32x8 __attribute__((ext_vector_type(8)));
typedef int i32x4_ __attribute__((ext_vector_type(4)));
template <bool F8> struct OperandT { typedef bf16x8 T; };
template <> struct OperandT<true> { typedef i32x8 T; };
__device__ __forceinline__ i32x8 ld_f8(const PG8_LAS unsigned char* p) { const i32x4_ lo = *(const PG8_LAS i32x4_*)p, hi = *(const PG8_LAS i32x4_*)(p + 1024); return __builtin_shufflevector(lo, hi, 0, 1, 2, 3, 4, 5, 6, 7); }
__device__ __forceinline__ f32x4 mma_f8(const i32x8 b, const i32x8 a, const f32x4 c) { return __builtin_amdgcn_mfma_scale_f32_16x16x128_f8f6f4(b, a, c, 0, 0, 0, 0, 0, 0); }
__device__ __forceinline__ f32x4 mma_f8(const bf16x8, const bf16x8, const f32x4 c) { return c; }
struct Unit { int pm, pn, pb, ph; };
struct Gemm { const bf16_t* A; const bf16_t* Bt; int M, N, K; };

template <bool F8_, int MAP = 0> struct StaticOrderT {
    static constexpr bool GATHER = false, F8 = F8_; static constexpr int KC = 0; static constexpr bool CHAIN = false; __device__ __forceinline__ unsigned row_off(int, int) const { return 0u; } __device__ __forceinline__ size_t aoff(const Unit&) const { return 0; } __device__ __forceinline__ size_t boff(const Unit&) const { return 0; }
    int nM, nN, nwg, G, c;
    __host__ __device__ void init(int M, int N, int G_, int c_) { nM = M / BM; nN = N / BM; nwg = nM * nN; G = G_; c = c_; }
    __host__ __device__ bool next(int i, Unit& u) const {
        const long L = (long)i * G + c; if (L >= nwg) return false;
        int wgid = (int)L; { const int q = nwg / NXCD, r = nwg % NXCD, xcd = wgid % NXCD, off = wgid / NXCD; wgid = (xcd < r ? xcd * (q + 1) : r * (q + 1) + (xcd - r) * q) + off; }
        const int nig = WGM * nN, gid = wgid / nig, fm = gid * WGM, gsz = (nM - fm) < WGM ? (nM - fm) : WGM;
        u.pm = fm + ((wgid % nig) % gsz); u.pn = (wgid % nig) / gsz;
        if (MAP == 1) u.pn = u.pn < 28 ? u.pn : u.pn + 3;
        if (MAP == 2) u.pn = u.pn + 28;
        u.pb = u.pn; return true;
    }
    __device__ __forceinline__ void a_ready(const Unit&) const {}
    __device__ __forceinline__ void done(const Unit&) const {}
};
typedef StaticOrderT<false> StaticOrder;
typedef StaticOrderT<true> StaticOrderF8;


__device__ __forceinline__ unsigned cvt_pk_bf16(float lo, float hi) { unsigned r; asm volatile("v_cvt_pk_bf16_f32 %0, %1, %2" : "=v"(r) : "v"(lo), "v"(hi)); return r; }
__device__ __forceinline__ float sigm(float x) { return __builtin_amdgcn_rcpf(1.0f + __expf(-x)); }

template <bool F8IN> struct EpiProjT {
    static constexpr bool PERM = true, AFTER_DRAIN = false;
    unsigned char* ws; const PG8_LAS unsigned char* lbias;
    __device__ __forceinline__ void operator()(const f32x4 (&acc)[2][2][4][2], const Unit& u, int wr, int wc, int fr, int fq) const {
        const int pn = u.pn, row0 = u.pm * BM + wr * 64 + fr, lc0 = wc * 32 + 8 * fq; constexpr float usc = F8IN ? F8_UNSCALE : 1.0f;
        f32x4 bv[2][2];
#pragma unroll
        for (int bj = 0; bj < 2; ++bj) { const u32x4 bw = *(const PG8_LAS u32x4*)(lbias + (size_t)(pn * 256 + lc0 + bj * HALF) * 2);
            bv[bj][0] = (f32x4){__uint_as_float(bw.x << 16), __uint_as_float(bw.x & 0xffff0000u), __uint_as_float(bw.y << 16), __uint_as_float(bw.y & 0xffff0000u)};
            bv[bj][1] = (f32x4){__uint_as_float(bw.z << 16), __uint_as_float(bw.z & 0xffff0000u), __uint_as_float(bw.w << 16), __uint_as_float(bw.w & 0xffff0000u)}; }
        if (pn < 16 && (pn < 4 || pn >= 8)) {
            const int sgm = pn >> 2, idx = (sgm == 0) ? 0 : sgm - 1;
            unsigned char* hb = ws + WS_AQ + (size_t)idx * (32 * MiB) + (pn & 3) * 256 + lc0;
#pragma unroll
            for (int ai = 0; ai < 2; ++ai)
#pragma unroll
                for (int m = 0; m < 4; ++m) { unsigned char* rowp = hb + (size_t)(row0 + ai * HALF + m * 16) * 1024;
#pragma unroll
                    for (int bj = 0; bj < 2; ++bj) { const f32x4 v0 = acc[ai][bj][m][0] * usc + bv[bj][0], v1 = acc[ai][bj][m][1] * usc + bv[bj][1];
                        *(u32x2*)(rowp + bj * HALF) = (u32x2){cvt4_fp8_nc(v0[0], v0[1], v0[2], v0[3], F8_ASCALE), cvt4_fp8_nc(v1[0], v1[1], v1[2], v1[3], F8_ASCALE)}; } }
            return;
        }
        if (pn >= 31) {
            unsigned char* gbase = ws + WS_GATES + (size_t)(pn - 31) * 256 + lc0;
#pragma unroll
            for (int ai = 0; ai < 2; ++ai)
#pragma unroll
                for (int m = 0; m < 4; ++m) { unsigned char* rowp = gbase + (size_t)(row0 + ai * HALF + m * 16) * 4096;
#pragma unroll
                    for (int bj = 0; bj < 2; ++bj) { const f32x4 v0 = acc[ai][bj][m][0] * usc + bv[bj][0], v1 = acc[ai][bj][m][1] * usc + bv[bj][1];
                        *(u32x2*)(rowp + bj * HALF) = (u32x2){cvt4_fp8_nc(sigm(v0[0]), sigm(v0[1]), sigm(v0[2]), sigm(v0[3]), F8_GSCALE), cvt4_fp8_nc(sigm(v1[0]), sigm(v1[1]), sigm(v1[2]), sigm(v1[3]), F8_GSCALE)}; } }
            return;
        }
        bf16_t* base; int ldc, colt; bool sg = false;
        if (pn >= 4 && pn < 8) { base = (bf16_t*)(ws + WS_AF); ldc = 1024; colt = (pn & 3) * 256; }
        else if (pn < 28) { const int s = pn >> 2, idx = (s == 0) ? 0 : s - 1; base = (bf16_t*)(ws + WS_AQ + (size_t)idx * (32 * MiB)); ldc = 1024; colt = (pn & 3) * 256; }
        else if (pn < 30) { base = (bf16_t*)(ws + WS_IQ); ldc = 512; colt = (pn - 28) * 256; }
        else if (pn == 30) { base = (bf16_t*)(ws + WS_IKW); ldc = 256; colt = 0; }
        else { base = (bf16_t*)(ws + WS_GATES); ldc = 4096; colt = (pn - 31) * 256; sg = true; }
#pragma unroll
        for (int ai = 0; ai < 2; ++ai)
#pragma unroll
            for (int m = 0; m < 4; ++m) { bf16_t* rowp = base + (size_t)(row0 + ai * HALF + m * 16) * ldc + colt + lc0;
#pragma unroll
                for (int bj = 0; bj < 2; ++bj) { f32x4 v0 = acc[ai][bj][m][0] * usc + bv[bj][0], v1 = acc[ai][bj][m][1] * usc + bv[bj][1];
                    if (sg) { v0 = (f32x4){sigm(v0[0]), sigm(v0[1]), sigm(v0[2]), sigm(v0[3])}; v1 = (f32x4){sigm(v1[0]), sigm(v1[1]), sigm(v1[2]), sigm(v1[3])}; }
                    u32x4 w; w.x = cvt_pk_bf16(v0[0], v0[1]); w.y = cvt_pk_bf16(v0[2], v0[3]); w.z = cvt_pk_bf16(v1[0], v1[1]); w.w = cvt_pk_bf16(v1[2], v1[3]);
                    *(u32x4*)(rowp + bj * HALF) = w;
                    if (pn == 30 && bj == 0 && lc0 < 64) {
                        const int tok = row0 + ai * HALF + m * 16;
                        *(u32x4*)((bf16_t*)(ws + WS_IK2) + ((size_t)((tok >> 5) * 4 + (lc0 >> 4)) * 64 + ((lc0 >> 3) & 1) * 32 + (tok & 31)) * 8) = w; } } }
    }
};

typedef EpiProjT<false> EpiProj;
__device__ __forceinline__ f32x4 bf4lo(u32x4 w) { return (f32x4){__uint_as_float(w.x << 16), __uint_as_float(w.x & 0xffff0000u), __uint_as_float(w.y << 16), __uint_as_float(w.y & 0xffff0000u)}; }
__device__ __forceinline__ f32x4 bf4hi(u32x4 w) { return (f32x4){__uint_as_float(w.z << 16), __uint_as_float(w.z & 0xffff0000u), __uint_as_float(w.w << 16), __uint_as_float(w.w & 0xffff0000u)}; }

template <int MODE> struct EpiBranch {
    static constexpr bool PERM = true, AFTER_DRAIN = false;
    bf16_t* merged; const bf16_t* gates; unsigned char* merged8;
    __device__ __forceinline__ void operator()(const f32x4 (&acc)[2][2][4][2], const Unit& u, int wr, int wc, int fr, int fq) const {
        const int row0 = u.pm * BM + wr * 64 + fr, col0 = u.pn * BM + wc * 32 + 8 * fq;
#pragma unroll
        for (int ai = 0; ai < 2; ++ai)
#pragma unroll
            for (int m = 0; m < 4; ++m) { const size_t r = (size_t)(row0 + ai * HALF + m * 16);
#pragma unroll
                for (int bj = 0; bj < 2; ++bj) { const int c = col0 + bj * HALF;
                    const u32x4 gw = *(const u32x4*)(gates + r * 4096 + MODE * 2048 + c);
                    f32x4 v0 = acc[ai][bj][m][0] * (bf4lo(gw) * F8_UNSCALE), v1 = acc[ai][bj][m][1] * (bf4hi(gw) * F8_UNSCALE);
                    if (MODE == 1) { const u32x4 pw = *(const u32x4*)(merged + r * 2048 + c); v0 = v0 + bf4lo(pw); v1 = v1 + bf4hi(pw);
                        *(u32x2*)(merged8 + r * 2048 + c) = (u32x2){cvt4_fp8(v0[0], v0[1], v0[2], v0[3], F8_ASCALE), cvt4_fp8(v1[0], v1[1], v1[2], v1[3], F8_ASCALE)}; }
                    else { u32x4 w; w.x = cvt_pk_bf16(v0[0], v0[1]); w.y = cvt_pk_bf16(v0[2], v0[3]); w.z = cvt_pk_bf16(v1[0], v1[1]); w.w = cvt_pk_bf16(v1[2], v1[3]);
                        *(u32x4*)(merged + r * 2048 + c) = w; } } }
    }
};

struct EpiBranchChain {
    static constexpr bool PERM = true, AFTER_DRAIN = false;
    const unsigned char* gates; unsigned char* merged8;
    __device__ __forceinline__ void mid(f32x4 (&acc)[2][2][4][2], const Unit& u, int wr, int wc, int fr, int fq) const {
        const int row0 = u.pm * BM + wr * 64 + fr, col0 = u.pn * BM + wc * 32 + 8 * fq;
#pragma unroll
        for (int ai = 0; ai < 2; ++ai)
#pragma unroll
            for (int m = 0; m < 4; ++m) { const size_t r = (size_t)(row0 + ai * HALF + m * 16);
#pragma unroll
                for (int bj = 0; bj < 2; ++bj) { const int c = col0 + bj * HALF;
                    const u32x2 ga = *(const u32x2*)(gates + r * 4096 + c), gb = *(const u32x2*)(gates + r * 4096 + 2048 + c);
                    const f32x4 a0 = fp8x4_f32(ga.x), a1 = fp8x4_f32(ga.y), b0 = fp8x4_f32(gb.x), b1 = fp8x4_f32(gb.y); f32x4 q0, q1;
#pragma unroll
                    for (int j = 0; j < 4; ++j) { q0[j] = a0[j] * __builtin_amdgcn_rcpf(fmaxf(b0[j], 1e-30f)); q1[j] = a1[j] * __builtin_amdgcn_rcpf(fmaxf(b1[j], 1e-30f)); }
                    acc[ai][bj][m][0] = acc[ai][bj][m][0] * q0; acc[ai][bj][m][1] = acc[ai][bj][m][1] * q1; } }
    }
    __device__ __forceinline__ void operator()(const f32x4 (&acc)[2][2][4][2], const Unit& u, int wr, int wc, int fr, int fq) const {
        const int row0 = u.pm * BM + wr * 64 + fr, col0 = u.pn * BM + wc * 32 + 8 * fq;
#pragma unroll
        for (int ai = 0; ai < 2; ++ai)
#pragma unroll
            for (int m = 0; m < 4; ++m) { const size_t r = (size_t)(row0 + ai * HALF + m * 16);
#pragma unroll
                for (int bj = 0; bj < 2; ++bj) { const int c = col0 + bj * HALF;
                    const u32x2 gb = *(const u32x2*)(gates + r * 4096 + 2048 + c); f32x4 b0 = fp8x4_f32(gb.x), b1 = fp8x4_f32(gb.y);
#pragma unroll
                    for (int j = 0; j < 4; ++j) { b0[j] = fmaxf(b0[j], 1e-30f) * (F8_UNSCALE / F8_GSCALE); b1[j] = fmaxf(b1[j], 1e-30f) * (F8_UNSCALE / F8_GSCALE); }
                    const f32x4 v0 = acc[ai][bj][m][0] * b0, v1 = acc[ai][bj][m][1] * b1;
                    *(u32x2*)(merged8 + r * 2048 + c) = (u32x2){cvt4_fp8(v0[0], v0[1], v0[2], v0[3], F8_ASCALE), cvt4_fp8(v1[0], v1[1], v1[2], v1[3], F8_ASCALE)}; } }
    }
};
struct ChainOrder {
    static constexpr bool GATHER = false, F8 = true, CHAIN = true; static constexpr int KC = 0; __device__ __forceinline__ unsigned row_off(int, int) const { return 0u; }
    StaticOrderF8 so; size_t a1, b1;
    __device__ __forceinline__ bool next(int i, Unit& u) const { if (!so.next(i >> 1, u)) return false; u.ph = i & 1; return true; }
    __device__ __forceinline__ size_t aoff(const Unit& u) const { return u.ph ? a1 : 0; }
    __device__ __forceinline__ size_t boff(const Unit& u) const { return u.ph ? b1 : 0; }
    __device__ __forceinline__ void a_ready(const Unit&) const {}
    __device__ __forceinline__ void done(const Unit&) const {}
};

struct EpiResBf16 {
    static constexpr bool PERM = true, AFTER_DRAIN = false;
    bf16_t* C; const bf16_t* x; float alpha;
    __device__ __forceinline__ void operator()(const f32x4 (&acc)[2][2][4][2], const Unit& u, int wr, int wc, int fr, int fq) const {
        const int row0 = u.pm * BM + wr * 64 + fr, col0 = u.pn * BM + wc * 32 + 8 * fq;
#pragma unroll
        for (int ai = 0; ai < 2; ++ai)
#pragma unroll
            for (int m = 0; m < 4; ++m) { const size_t off = (size_t)(row0 + ai * HALF + m * 16) * 2048 + col0;
#pragma unroll
                for (int bj = 0; bj < 2; ++bj) { const u32x4 xw = *(const u32x4*)(x + off + bj * HALF); const f32x4 x0 = bf4lo(xw), x1 = bf4hi(xw);
                    const f32x4 v0 = x0 * alpha + acc[ai][bj][m][0] * F8_UNSCALE, v1 = x1 * alpha + acc[ai][bj][m][1] * F8_UNSCALE;
                    u32x4 w; w.x = cvt_pk_bf16(v0[0], v0[1]); w.y = cvt_pk_bf16(v0[2], v0[3]); w.z = cvt_pk_bf16(v1[0], v1[1]); w.w = cvt_pk_bf16(v1[2], v1[3]);
                    *(u32x4*)(C + off + bj * HALF) = w; } }
    }
};

struct EpiGateUp {
    static constexpr bool PERM = true, AFTER_DRAIN = false;
    unsigned char* H;
    __device__ __forceinline__ void operator()(const f32x4 (&acc)[2][2][4][2], const Unit& u, int wr, int wc, int fr, int fq) const {
        const int row0 = u.pm * BM + wr * 64 + fr, hc0 = u.pn * 128 + wc * 16 + 4 * fq;
#pragma unroll
        for (int ai = 0; ai < 2; ++ai)
#pragma unroll
            for (int m = 0; m < 4; ++m) { unsigned char* rowp = H + (size_t)(row0 + ai * HALF + m * 16) * 1024 + hc0;
#pragma unroll
                for (int bj = 0; bj < 2; ++bj) { const f32x4 g = acc[ai][bj][m][0], up = acc[ai][bj][m][1];
                    f32x4 h;
#pragma unroll
                    for (int j = 0; j < 4; ++j) { const float gj = g[j] * F8_UNSCALE; h[j] = gj * sigm(gj) * (up[j] * F8_UNSCALE); }
                    *(unsigned*)(rowp + bj * 64) = cvt4_fp8(h[0], h[1], h[2], h[3], F8_ASCALE); } }
    }
};

struct EpiStoreBf16 {
    static constexpr bool PERM = true, AFTER_DRAIN = false;
    bf16_t* O; int ldc; float one;
    __device__ __forceinline__ void operator()(const f32x4 (&acc)[2][2][4][2], const Unit& u, int wr, int wc, int fr, int fq) const {
        const int row0 = u.pm * BM + wr * 64 + fr, col0 = u.pn * BM + wc * 32 + 8 * fq;
#pragma unroll
        for (int ai = 0; ai < 2; ++ai)
#pragma unroll
            for (int m = 0; m < 4; ++m) { bf16_t* rowp = O + (size_t)(row0 + ai * HALF + m * 16) * ldc + col0;
#pragma unroll
                for (int bj = 0; bj < 2; ++bj) { const f32x4 v0 = acc[ai][bj][m][0] * one, v1 = acc[ai][bj][m][1] * one;
                    u32x4 w; w.x = cvt_pk_bf16(v0[0], v0[1]); w.y = cvt_pk_bf16(v0[2], v0[3]); w.z = cvt_pk_bf16(v1[0], v1[1]); w.w = cvt_pk_bf16(v1[2], v1[3]);
                    *(u32x4*)(rowp + bj * HALF) = w; } }
    }
};

struct EpiStoreF8 {
    static constexpr bool PERM = true, AFTER_DRAIN = false;
    unsigned char* O; int ldc; float sc;
    __device__ __forceinline__ void operator()(const f32x4 (&acc)[2][2][4][2], const Unit& u, int wr, int wc, int fr, int fq) const {
        const int row0 = u.pm * BM + wr * 64 + fr, col0 = u.pn * BM + wc * 32 + 8 * fq;
#pragma unroll
        for (int ai = 0; ai < 2; ++ai)
#pragma unroll
            for (int m = 0; m < 4; ++m) { unsigned char* rowp = O + (size_t)(row0 + ai * HALF + m * 16) * ldc + col0;
#pragma unroll
                for (int bj = 0; bj < 2; ++bj) { const f32x4 v0 = acc[ai][bj][m][0], v1 = acc[ai][bj][m][1];
                    *(u32x2*)(rowp + bj * HALF) = (u32x2){cvt4_fp8_nc(v0[0], v0[1], v0[2], v0[3], sc), cvt4_fp8_nc(v1[0], v1[1], v1[2], v1[3], sc)}; } }
    }
};
struct EpiRouter {
    static constexpr bool PERM = true, AFTER_DRAIN = false;
    float* LGP;
    __device__ __forceinline__ void operator()(const f32x4 (&acc)[2][2][4][2], const Unit& u, int wr, int wc, int fr, int fq) const {
        const int col0 = wc * 32 + 8 * fq;
        if (col0 < 72) { float* base = LGP + ((size_t)u.pn * MT + (size_t)u.pm * BM + wr * 64 + fr) * 72 + col0;
#pragma unroll
            for (int ai = 0; ai < 2; ++ai)
#pragma unroll
                for (int m = 0; m < 4; ++m) { float* p = base + (size_t)(ai * HALF + m * 16) * 72; *(f32x4*)p = acc[ai][0][m][0]; *(f32x4*)(p + 4) = acc[ai][0][m][1]; } }
    }
};
struct RouterOrder {
    static constexpr bool GATHER = false, F8 = false; static constexpr int KC = 512; __device__ __forceinline__ unsigned row_off(int, int) const { return 0u; }
    int G, c;
    __device__ __forceinline__ bool next(int i, Unit& u) const { const int L = i * G + c; if (L >= (MT / BM) * 4) return false; u.pm = L >> 2; u.pn = L & 3; u.pb = 0; return true; }
    static constexpr bool CHAIN = false;
    __device__ __forceinline__ size_t aoff(const Unit& u) const { return (size_t)u.pn * (KC * 2); }
    __device__ __forceinline__ size_t boff(const Unit& u) const { return (size_t)u.pn * (KC * 2); }
    __device__ __forceinline__ void a_ready(const Unit&) const {}
    __device__ __forceinline__ void done(const Unit&) const {}
};

template <bool GATH> struct GroupedOrder {
    static constexpr bool GATHER = GATH, F8 = true;
    static constexpr int KC = 0; static constexpr bool CHAIN = false; __device__ __forceinline__ size_t aoff(const Unit&) const { return 0; } __device__ __forceinline__ size_t boff(const Unit&) const { return 0; }
    int nM, nN, nwg, G, c; const PG8_LAS unsigned* tile_e; const PG8_LAS unsigned* tokoff;
    __device__ __forceinline__ void init(int nT, int nN_, int G_, int c_, const PG8_LAS unsigned* te, const PG8_LAS unsigned* to) { nM = nT; nN = nN_; nwg = nM * nN; G = G_; c = c_; tile_e = te; tokoff = to; }
    __device__ __forceinline__ bool next(int i, Unit& u) const {
        const long L = (long)i * G + c; if (L >= nwg) return false;
        int wgid = (int)L; { const int q = nwg / NXCD, r = nwg % NXCD, xcd = wgid % NXCD, off = wgid / NXCD; wgid = (xcd < r ? xcd * (q + 1) : r * (q + 1) + (xcd - r) * q) + off; }
        const int nig = WGM * nN, gid = wgid / nig, fm = gid * WGM, gsz = (nM - fm) < WGM ? (nM - fm) : WGM;
        u.pm = fm + ((wgid % nig) % gsz); u.pn = (wgid % nig) / gsz; u.pb = (int)tile_e[u.pm] * nN + u.pn; return true;
    }
    __device__ __forceinline__ unsigned row_off(int ui, int r) const { return tokoff[ui * 256 + r]; }
    __device__ __forceinline__ void a_ready(const Unit&) const {}
    __device__ __forceinline__ void done(const Unit&) const {}
};

template <class Epi, class Sched, bool ALIGN_EPI = false, bool SP2 = false>
__device__ __forceinline__ void gemm_phase(PG8_LAS unsigned char* lds, const Gemm g, const Sched& S, const Epi& E) {
    int tid_ = cur_tid((const LAS unsigned char*)lds); asm volatile("" : "+v"(tid_));
    const int tid = tid_, wid = __builtin_amdgcn_readfirstlane(tid >> 6), lane = tid & 63, wr = wid >> 2, wc = wid & 3, fr = lane & 15, fq = lane >> 4;
    const int K = g.K, nt = (Sched::KC > 0 ? Sched::KC : K) / BK;
    constexpr bool F8 = Sched::F8;
    constexpr bool GATHER = Sched::GATHER;
    unsigned voffA[2], voffB[2], cAoff[2]; int rA[2];
#pragma unroll
    for (int i = 0; i < 2; ++i) { int R, C; stage_rc(tid * 16 + i * 8192, R, C); const int Rb = Epi::PERM ? ((R & ~31) + perm32(R & 31)) : R;
        voffA[i] = (unsigned)(R * K + C) * 2u; voffB[i] = (unsigned)(Rb * K + C) * 2u; cAoff[i] = (unsigned)C * 2u; rA[i] = R; }
    const size_t kstep = (size_t)(BK * 2);
    const size_t hstep = (size_t)HALF * K * 2;
    const size_t tstep = 2 * hstep;
    const unsigned ldsw = (unsigned)wid * 1024u;
    const int aoff = lds_byte(wr * 64 + fr, fq * 8), boff = lds_byte(wc * 32 + fr, fq * 8);
#define PG8_SA(b, h) (((b) * 2 + (h)) * HTB)
#define PG8_SB(b, h) ((4 + (b) * 2 + (h)) * HTB)
#define PG8_GLDS(gbase, vo, ldsoff) do { if constexpr (F8) asm volatile("s_mov_b32 m0, %2\n\ts_nop 0\n\tglobal_load_lds_dwordx4 %0, %1" :: "v"(vo), "s"((const char*)(gbase)), "s"((unsigned)(uintptr_t)(lds + (ldsoff))) : "memory", "m0"); \
        else __builtin_amdgcn_global_load_lds((const unsigned*)((const char*)(gbase) + (vo)), (PG8_LAS unsigned*)(lds + (ldsoff)), 16, 0, 0); } while (0)
#define PG8_STAGE(bufoff, gbase, voff) do { _Pragma("unroll") for (int _i = 0; _i < 2; ++_i) PG8_GLDS(gbase, (voff)[_i], (bufoff) + ldsw + _i * 8192); } while (0)
#define PG8_STAGE_A(bufoff, gbase, h, nx) do { _Pragma("unroll") for (int _i = 0; _i < 2; ++_i) { const unsigned vo_ = GATHER ? (((nx) && has_next) ? PG8_GOFF(ui + 1, h, _i) : vAc[h][_i]) : voffA[_i]; \
        PG8_GLDS(gbase, vo_, (bufoff) + ldsw + _i * 8192); } } while (0)
#define PG8_LDA(dst, b, h) do { _Pragma("unroll") for (int m = 0; m < 4; ++m) { if constexpr (F8) dst[m][0] = ld_f8(lds + PG8_SA(b, h) + aoff + m * 2048); \
        else { _Pragma("unroll") for (int k = 0; k < 2; ++k) dst[m][k] = *(const PG8_LAS OpT*)(lds + PG8_SA(b, h) + aoff + m * 2048 + k * 1024); } } } while (0)
#define PG8_LDB(dst, b, h) do { _Pragma("unroll") for (int n = 0; n < 2; ++n) { if constexpr (F8) dst[n][0] = ld_f8(lds + PG8_SB(b, h) + boff + n * 2048); \
        else { _Pragma("unroll") for (int k = 0; k < 2; ++k) dst[n][k] = *(const PG8_LAS OpT*)(lds + PG8_SB(b, h) + boff + n * 2048 + k * 1024); } } } while (0)
#define PG8_MMA(ai, bj, At, Bt) do { if constexpr (F8) __builtin_amdgcn_sched_barrier(0); __builtin_amdgcn_s_setprio(1); _Pragma("unroll") for (int m = 0; m < 4; ++m) _Pragma("unroll") for (int n = 0; n < 2; ++n) { \
        if constexpr (F8) acc[ai][bj][m][n] = mma_f8(Bt[n][0], At[m][0], acc[ai][bj][m][n]); \
        else { _Pragma("unroll") for (int k = 0; k < 2; ++k) acc[ai][bj][m][n] = __builtin_amdgcn_mfma_f32_16x16x32_bf16(Bt[n][k], At[m][k], acc[ai][bj][m][n], 0, 0, 0); } } \
        __builtin_amdgcn_s_setprio(0); if constexpr (F8) __builtin_amdgcn_sched_barrier(0); } while (0)
#define PG8_WAIT_V(n) asm volatile("s_waitcnt vmcnt(" #n ")" ::: "memory")
#define PG8_WAIT_L(n) asm volatile("s_waitcnt lgkmcnt(" #n ")" ::: "memory")
#define PG8_BAR __builtin_amdgcn_s_barrier()
#define PG8_SCHED __builtin_amdgcn_sched_barrier(0)
    Unit cur, nxt; int ui = 0;
    if (!S.next(0, cur)) return;
    f32x4 acc[2][2][4][2];
#pragma unroll
    for (int a = 0; a < 2; ++a)
#pragma unroll
        for (int b = 0; b < 2; ++b)
#pragma unroll
            for (int m = 0; m < 4; ++m)
#pragma unroll
                for (int n = 0; n < 2; ++n) acc[a][b][m][n] = (f32x4){0.f, 0.f, 0.f, 0.f};
    using OpT = typename OperandT<F8>::T; constexpr int NK = F8 ? 1 : 2;
    OpT At[4][NK], B0[2][NK], B1[2][NK];
    const size_t hstepA = GATHER ? 0 : hstep;
#define PG8_GOFF(ui_, h, i) (S.row_off((ui_), (h) * HALF + rA[i]) + cAoff[i])
    unsigned vAc[2][2]; bool has_next = false;
#pragma unroll
    for (int h = 0; h < 2; ++h)
#pragma unroll
        for (int i = 0; i < 2; ++i) vAc[h][i] = GATHER ? PG8_GOFF(0, h, i) : 0u;
    const char* cA = (const char*)g.A + (GATHER ? (size_t)0 : (size_t)cur.pm * tstep) + S.aoff(cur); const char* cB = (const char*)g.Bt + (size_t)cur.pb * tstep + S.boff(cur);
    S.a_ready(cur);
    if constexpr (SP2) {
        PG8_STAGE(PG8_SB(0, 0), cB, voffB); PG8_STAGE(PG8_SB(0, 1), cB + hstep, voffB); PG8_STAGE_A(PG8_SA(0, 0), cA, 0, false); PG8_STAGE_A(PG8_SA(0, 1), cA + hstepA, 1, false);
        if (wr == 1) PG8_BAR;
        PG8_WAIT_V(2); PG8_BAR;
        PG8_STAGE(PG8_SB(1, 0), cB + kstep, voffB); PG8_STAGE_A(PG8_SA(1, 0), cA + kstep, 0, false); PG8_STAGE(PG8_SB(1, 1), cB + hstep + kstep, voffB);
        PG8_WAIT_V(6); PG8_BAR;
    } else {
        PG8_STAGE(PG8_SB(0, 0), cB, voffB); PG8_STAGE_A(PG8_SA(0, 0), cA, 0, false); PG8_STAGE(PG8_SB(0, 1), cB + hstep, voffB); PG8_STAGE_A(PG8_SA(0, 1), cA + hstepA, 1, false);
        if (wr == 1) PG8_BAR;
        PG8_WAIT_V(4); PG8_BAR;
        PG8_STAGE(PG8_SB(1, 0), cB + kstep, voffB); PG8_STAGE_A(PG8_SA(1, 0), cA + kstep, 0, false); PG8_STAGE(PG8_SB(1, 1), cB + hstep + kstep, voffB);
        PG8_WAIT_V(6); PG8_BAR;
    }
    for (;;) {
        has_next = S.next(ui + 1, nxt);
        const char* nA = has_next ? (const char*)g.A + (GATHER ? (size_t)0 : (size_t)nxt.pm * tstep) + S.aoff(nxt) : cA; const char* nB = has_next ? (const char*)g.Bt + (size_t)nxt.pb * tstep + S.boff(nxt) : cB;
        for (int t = 0; t < nt; t += 2) {
            const bool last = (t == nt - 2);
            const char* a1 = cA + (size_t)(t + 1) * kstep;
            const char* a2 = last ? nA : cA + (size_t)(t + 2) * kstep; const char* b2 = last ? nB : cB + (size_t)(t + 2) * kstep;
            const char* a3 = a2 + kstep; const char* b3 = b2 + kstep;
            if (last && has_next) S.a_ready(nxt);
            if constexpr (SP2) {
            PG8_LDB(B0, 0, 0); PG8_LDB(B1, 0, 1); PG8_SCHED; PG8_LDA(At, 0, 0); PG8_STAGE_A(PG8_SA(1, 1), a1 + hstepA, 1, false);
            PG8_WAIT_V(8); PG8_WAIT_L(0); PG8_BAR; PG8_MMA(0, 0, At, B0); PG8_MMA(0, 1, At, B1); PG8_BAR; PG8_SCHED;
            PG8_LDA(At, 0, 1); PG8_STAGE(PG8_SB(0, 0), b2, voffB); PG8_STAGE(PG8_SB(0, 1), b2 + hstep, voffB); PG8_STAGE_A(PG8_SA(0, 0), a2, 0, last);
            PG8_WAIT_V(8); PG8_WAIT_L(0); PG8_BAR; PG8_MMA(1, 0, At, B0); PG8_MMA(1, 1, At, B1); PG8_BAR; PG8_SCHED;
            PG8_LDB(B0, 1, 0); PG8_LDB(B1, 1, 1); PG8_SCHED; PG8_LDA(At, 1, 0); PG8_STAGE_A(PG8_SA(0, 1), a2 + hstepA, 1, last);
            PG8_WAIT_V(8); PG8_WAIT_L(0); PG8_BAR; PG8_MMA(0, 0, At, B0); PG8_MMA(0, 1, At, B1); PG8_BAR; PG8_SCHED;
            PG8_LDA(At, 1, 1); PG8_STAGE(PG8_SB(1, 0), b3, voffB); PG8_STAGE(PG8_SB(1, 1), b3 + hstep, voffB); PG8_STAGE_A(PG8_SA(1, 0), a3, 0, last);
            PG8_WAIT_V(8); PG8_WAIT_L(0); PG8_BAR; PG8_MMA(1, 0, At, B0); PG8_MMA(1, 1, At, B1); PG8_BAR; PG8_SCHED;
            } else {
            PG8_LDB(B0, 0, 0); PG8_SCHED; PG8_LDA(At, 0, 0); PG8_STAGE_A(PG8_SA(1, 1), a1 + hstepA, 1, false);
            PG8_WAIT_L(8); PG8_BAR; PG8_WAIT_L(0); PG8_MMA(0, 0, At, B0); PG8_BAR; PG8_SCHED;
            PG8_LDB(B1, 0, 1); PG8_STAGE(PG8_SB(0, 0), b2, voffB);
            PG8_BAR; PG8_WAIT_L(0); PG8_MMA(0, 1, At, B1); PG8_BAR;
            PG8_LDA(At, 0, 1); PG8_STAGE_A(PG8_SA(0, 0), a2, 0, last);
            PG8_BAR; PG8_WAIT_L(0); PG8_MMA(1, 0, At, B0); PG8_BAR; PG8_SCHED;
            PG8_STAGE(PG8_SB(0, 1), b2 + hstep, voffB);
            PG8_WAIT_V(6); PG8_BAR; PG8_MMA(1, 1, At, B1); PG8_BAR;
            PG8_LDB(B0, 1, 0); PG8_SCHED; PG8_LDA(At, 1, 0); PG8_STAGE_A(PG8_SA(0, 1), a2 + hstepA, 1, last);
            PG8_WAIT_L(8); PG8_BAR; PG8_WAIT_L(0); PG8_MMA(0, 0, At, B0); PG8_BAR; PG8_SCHED;
            PG8_LDB(B1, 1, 1); PG8_STAGE(PG8_SB(1, 0), b3, voffB);
            PG8_BAR; PG8_WAIT_L(0); PG8_MMA(0, 1, At, B1); PG8_BAR;
            PG8_LDA(At, 1, 1); PG8_STAGE_A(PG8_SA(1, 0), a3, 0, last);
            PG8_BAR; PG8_WAIT_L(0); PG8_MMA(1, 0, At, B0); PG8_BAR; PG8_SCHED;
            PG8_STAGE(PG8_SB(1, 1), b3 + hstep, voffB);
            PG8_WAIT_V(6); PG8_BAR; PG8_MMA(1, 1, At, B1); PG8_BAR;
            }
        }
        if constexpr (ALIGN_EPI) { if (wr == 0) PG8_BAR; }
        if constexpr (!Epi::AFTER_DRAIN) { int fr_ = fr, fq_ = fq; asm volatile("" : "+v"(fr_), "+v"(fq_));
            if constexpr (Sched::CHAIN) { if (cur.ph == 0) E.mid(acc, cur, wr, wc, fr_, fq_); else E(acc, cur, wr, wc, fr_, fq_); }
            else E(acc, cur, wr, wc, fr_, fq_);
            S.done(cur); }
        if (!has_next) break;
        if (!(Sched::CHAIN && cur.ph == 0))
#pragma unroll
        for (int a = 0; a < 2; ++a)
#pragma unroll
            for (int b = 0; b < 2; ++b)
#pragma unroll
                for (int m = 0; m < 4; ++m)
#pragma unroll
                    for (int n = 0; n < 2; ++n) acc[a][b][m][n] = (f32x4){0.f, 0.f, 0.f, 0.f};
        cur = nxt; cA = nA; cB = nB; ++ui;
#pragma unroll
        for (int h = 0; h < 2; ++h)
#pragma unroll
            for (int i = 0; i < 2; ++i) if (GATHER) vAc[h][i] = PG8_GOFF(ui, h, i);
        if constexpr (ALIGN_EPI) { if (wr == 1) PG8_BAR; }
    }
    PG8_WAIT_V(0);
    if constexpr (!ALIGN_EPI) { if (wr == 0) PG8_BAR; }
    PG8_BAR;
    if constexpr (Epi::AFTER_DRAIN) { E.fused(acc, cur, wr, wc, fr, fq, lds, wid, lane); S.done(cur); }
#undef PG8_SA
#undef PG8_SB
#undef PG8_STAGE
#undef PG8_STAGE_A
#undef PG8_GOFF
#undef PG8_LDA
#undef PG8_LDB
#undef PG8_MMA
#undef PG8_WAIT_V
#undef PG8_WAIT_L
#undef PG8_BAR
#undef PG8_SCHED
}
}
#define XB_TMO      128
#define XB_XCNT(j)  (256  + 64 * (j))
#define XB_XSUB(j)  (1280 + 64 * (j))
#define XB_XGEN(j)  (2304 + 64 * (j))
#define XB_TOP      3328
#define XB_TOPGEN   3392
#define XCD_BAR_WORDS 3456
#define XB_SPIN_CAP (1u << 18)

__device__ __forceinline__ unsigned xb_ld(unsigned* p)              { return __hip_atomic_load(p, __ATOMIC_RELAXED, __HIP_MEMORY_SCOPE_AGENT); }
__device__ __forceinline__ unsigned xb_add(unsigned* p, unsigned v) { return __hip_atomic_fetch_add(p, v, __ATOMIC_RELAXED, __HIP_MEMORY_SCOPE_AGENT); }
__device__ __forceinline__ unsigned xb_xcc_id() { return (unsigned)__builtin_amdgcn_s_getreg((3 << 11) | 20) & 0xFu; }
#define XB_SPIN(cond, bar) do { unsigned _sp = 0; while (cond) { __builtin_amdgcn_s_sleep(1); \
    if ((++_sp & 255u) == 0u) { if (xb_ld(&(bar)[XB_TMO])) break; if (_sp > XB_SPIN_CAP) { atomicAdd(&(bar)[XB_TMO], 1u); break; } } } } while (0)

struct XcdBarrier {
    unsigned* bar; unsigned x;
    volatile LAS unsigned* st;
};

__device__ __forceinline__ XcdBarrier xcd_barrier_post(unsigned* bar, volatile LAS unsigned* st) {
    XcdBarrier b; b.bar = bar; b.x = xb_xcc_id(); b.st = st;
    if (threadIdx.x == 0) (void)xb_add(&bar[XB_XCNT(b.x)], 1u);
    return b;
}
__device__ __forceinline__ void xcd_barrier_complete(unsigned* bar, unsigned x, unsigned& nloc, unsigned& nx) {
    const unsigned G = gridDim.x * gridDim.y * gridDim.z;
    unsigned sum, cnt, mine, sp = 0u;
    for (;;) {
        sum = 0u; cnt = 0u; mine = 0u;
#pragma unroll
        for (unsigned j = 0; j < 16; ++j) { const unsigned c = xb_ld(&bar[XB_XCNT(j)]); sum += c; cnt += (c > 0u) ? 1u : 0u; mine = (j == x) ? c : mine; }
        if (sum == G) break;
        __builtin_amdgcn_s_sleep(1);
        if ((++sp & 255u) == 0u) { if (xb_ld(&bar[XB_TMO])) break; if (sp > XB_SPIN_CAP) { atomicAdd(&bar[XB_TMO], 1u); break; } }
    }
    nloc = mine > 0u ? mine : 1u; nx = cnt > 0u ? cnt : 1u;
}

__device__ __forceinline__ void xcd_barrier(const XcdBarrier& b) {
    asm volatile("s_waitcnt vmcnt(0)" ::: "memory");
    __syncthreads();
    if (cur_tid((const LAS unsigned char*)b.st - LDS_BARST) == 0) {
        unsigned* bar = b.bar;
        __builtin_amdgcn_s_waitcnt(0);
        unsigned nloc = b.st[0], nx = b.st[1];
        if (nloc == 0u) { xcd_barrier_complete(bar, b.x, nloc, nx); b.st[0] = nloc; b.st[1] = nx; }
        const unsigned old = xb_add(&bar[XB_XSUB(b.x)], 1u);
        const unsigned gen = old / nloc;
        if (old + 1u == (gen + 1u) * nloc) {
            __builtin_amdgcn_fence(__ATOMIC_RELEASE, "agent");
            asm volatile("s_waitcnt vmcnt(0)" ::: "memory");
            const unsigned og = xb_add(&bar[XB_TOP], 1u);
            const unsigned tg = og / nx;
            if (og + 1u == (tg + 1u) * nx) xb_add(&bar[XB_TOPGEN], 1u);
            else XB_SPIN(xb_ld(&bar[XB_TOPGEN]) == tg, bar);
            __builtin_amdgcn_fence(__ATOMIC_ACQUIRE, "agent");
            xb_add(&bar[XB_XGEN(b.x)], 1u);
            asm volatile("s_waitcnt vmcnt(0)" ::: "memory");
        } else {
            XB_SPIN(xb_ld(&bar[XB_XGEN(b.x)]) == gen, bar);
            __builtin_amdgcn_fence(__ATOMIC_ACQUIRE, "agent");
            asm volatile("s_waitcnt vmcnt(0)" ::: "memory");
        }
    }
    __syncthreads();
}

struct Args { const float* in[19]; float* out; unsigned char* ws; int ph_lo, ph_hi; };
enum { I_X = 0, I_WIN, I_BIN, I_LB, I_HGNG, I_WA, I_WB, I_WOUT, I_LN1G, I_LN1B, I_WGRP, I_BGRP, I_WRT, I_BRT, I_WGATE, I_WUP, I_WDOWN, I_LN2G, I_LN2B };

__device__ __forceinline__ void transpose_item(const float* src4, size_t ldw, bf16_t* WT, size_t K, int dest_row0, int k0, LAS float* scr, int lane) {
    f32x4 v[8];
#pragma unroll
    for (int i = 0; i < 8; ++i) v[i] = src4 ? __builtin_nontemporal_load((const f32x4*)(src4 + (size_t)(8 * i) * ldw)) : (f32x4){0.f, 0.f, 0.f, 0.f};
#pragma unroll
    for (int i = 0; i < 8; ++i) { const int k = 8 * i + (lane >> 3), n4 = (lane & 7) * 4;
        scr[k * 33 + n4 + 0] = v[i][0]; scr[k * 33 + n4 + 1] = v[i][1]; scr[k * 33 + n4 + 2] = v[i][2]; scr[k * 33 + n4 + 3] = v[i][3]; }
    LDS_WAIT(); asm volatile("" ::: "memory");
    const int c = lane & 7;
#pragma unroll
    for (int j = 0; j < 4; ++j) { const int n = (lane >> 3) + 8 * j; const LAS float* s = scr + (8 * c) * 33 + n;
        u32x4 o; o.x = cvt_pk(s[0 * 33], s[1 * 33]); o.y = cvt_pk(s[2 * 33], s[3 * 33]); o.z = cvt_pk(s[4 * 33], s[5 * 33]); o.w = cvt_pk(s[6 * 33], s[7 * 33]);
        *(u32x4*)(WT + (size_t)(dest_row0 + n) * K + k0 + 8 * c) = o; }
    LDS_WAIT(); asm volatile("" ::: "memory");
}

template <bool PERMK = false>
__device__ __forceinline__ void transpose_item_f8(const float* src4, size_t ldw, unsigned char* WT, size_t K, int dest_row0, int k0, LAS float* scr, int lane) {
    f32x4 v[8];
#pragma unroll
    for (int i = 0; i < 8; ++i) { if (PERMK) { const int k = k0 + 8 * i + (lane >> 3), pp = k & 127; v[i] = __builtin_nontemporal_load((const f32x4*)(src4 + (size_t)((k & ~127) + 32 * (pp & 3) + (pp >> 2)) * ldw)); }
        else v[i] = src4 ? __builtin_nontemporal_load((const f32x4*)(src4 + (size_t)(8 * i) * ldw)) : (f32x4){0.f, 0.f, 0.f, 0.f}; }
#pragma unroll
    for (int i = 0; i < 8; ++i) { const int k = 8 * i + (lane >> 3), n4 = (lane & 7) * 4;
        scr[k * 33 + n4 + 0] = v[i][0]; scr[k * 33 + n4 + 1] = v[i][1]; scr[k * 33 + n4 + 2] = v[i][2]; scr[k * 33 + n4 + 3] = v[i][3]; }
    LDS_WAIT(); asm volatile("" ::: "memory");
    const int c = lane & 3;
#pragma unroll
    for (int j = 0; j < 2; ++j) { const int n = (lane >> 2) + 16 * j; const LAS float* s = scr + (16 * c) * 33 + n;
        u32x4 o;
#pragma unroll
        for (int q = 0; q < 4; ++q) o[q] = cvt4_fp8_nc(s[(4 * q) * 33], s[(4 * q + 1) * 33], s[(4 * q + 2) * 33], s[(4 * q + 3) * 33], F8_WSCALE);
        *(u32x4*)(WT + (size_t)(dest_row0 + n) * K + k0 + 16 * c) = o; }
    LDS_WAIT(); asm volatile("" ::: "memory");
}
__device__ __forceinline__ void phase_prologue(const Args& a, LAS unsigned char* lds, int tid, int G) {
    unsigned char* ws = a.ws;
    { const float* x = a.in[I_X]; bf16_t* xb = (bf16_t*)(ws + WS_XB); const size_t n8 = (size_t)MT * DM / 8;
#pragma unroll 4
      for (size_t i = (size_t)blockIdx.x * NTHR + tid; i < n8; i += (size_t)G * NTHR) {
          const f32x4 p = __builtin_nontemporal_load((const f32x4*)(x + i * 8)), q = __builtin_nontemporal_load((const f32x4*)(x + i * 8 + 4));
          u32x4 o; o.x = cvt_pk(p[0], p[1]); o.y = cvt_pk(p[2], p[3]); o.z = cvt_pk(q[0], q[1]); o.w = cvt_pk(q[2], q[3]);
          *(u32x4*)(xb + i * 8) = o;
          *(u32x2*)(ws + WS_X8 + i * 8) = (u32x2){cvt4_fp8(p[0], p[1], p[2], p[3], F8_ASCALE), cvt4_fp8(q[0], q[1], q[2], q[3], F8_ASCALE)}; } }
    asm volatile("" : "+v"(tid));
    const int lane = tid & 63, wave = tid >> 6;
    LAS float* scr = (LAS float*)(lds + wave * 8704);
    const int gw = blockIdx.x * NWAVES + wave, NGW = G * NWAVES;
    constexpr int IT_IN = (NPROJ_PAD / 32) * (DM / 64);
    for (int it = gw; it < IT_IN; it += NGW) {
        int r = it;
        { const int kb = r / (NPROJ_PAD / 32), rb = r % (NPROJ_PAD / 32); const int n = rb * 32 + (lane & 7) * 4;
            int src = -1; if (n < 7752) src = n; else if (n >= 7936) src = n - 184;
            const float* p = (src >= 0) ? a.in[I_WIN] + (size_t)(kb * 64 + (lane >> 3)) * NPROJ + src : nullptr;
            const int pn = rb >> 3;
            if (pn >= 28 && pn < 31) transpose_item(p, NPROJ, (bf16_t*)(ws + WS_WIN), DM, rb * 32, kb * 64, scr, lane);
            else transpose_item_f8(p, NPROJ, ws + WS_WIN8, DM, rb * 32, kb * 64, scr, lane); }
    }
}

__device__ __forceinline__ void small_weights(const Args& a, LAS unsigned char* lds, int tid, int zb, int nz) {
    unsigned char* ws = a.ws;
    { bf16_t* WR2 = (bf16_t*)(ws + WS_WR2); const float* wgp = a.in[I_WGRP]; const float* wrp = a.in[I_WRT];
      for (int idx = zb * NTHR + tid; idx < 36 * DM; idx += nz * NTHR) { const int c = idx / DM, k = idx - c * DM;
          const float w = c < 4 ? wgp[k * 4 + c] : wrp[k * 32 + (c - 4)]; const unsigned hi = cvt_pk(w, 0.f) & 0xffffu; const float lo = w - __uint_as_float(hi << 16);
          WR2[(size_t)c * DM + k] = (bf16_t)hi; WR2[(size_t)(36 + c) * DM + k] = (bf16_t)(cvt_pk(lo, 0.f) & 0xffffu); } }
    const int lane = tid & 63, wave = tid >> 6;
    LAS float* scr = (LAS float*)(lds + wave * 8704);
    constexpr int IT_A = (DM / 32) * (1024 / 64);
    constexpr int IT_OUT = (DM / 32) * (DM / 64);
    for (int it = zb * NWAVES + wave; it < 2 * IT_A + IT_OUT; it += nz * NWAVES) {
        int r = it;
        if (r < 2 * IT_A) { const int which = r / IT_A; r %= IT_A; const int kb = r / 64, rb = r % 64; const int n = rb * 32 + (lane & 7) * 4;
            const float* pwa = a.in[I_WA]; const float* pwb = a.in[I_WB];
            if (which) transpose_item_f8<true>(pwb + n, DM, ws + WS_WB, 1024, rb * 32, kb * 64, scr, lane);
            else transpose_item_f8(pwa + (size_t)(kb * 64 + (lane >> 3)) * DM + n, DM, ws + WS_WA, 1024, rb * 32, kb * 64, scr, lane);
            continue; }
        r -= 2 * IT_A;
        { const int kb = r / 64, rb = r % 64; const int n = rb * 32 + (lane & 7) * 4;
          const float* p = a.in[I_WOUT] + (size_t)(kb * 64 + (lane >> 3)) * DM + n;
          transpose_item_f8(p, DM, ws + WS_WOUT, DM, rb * 32, kb * 64, scr, lane); }
    }
}

constexpr int EW_GU = 64 * 32, EW_D = 64 * 16, EW_E = EW_GU + EW_D;
__device__ __forceinline__ const float* ew_src(const Args& a, int it, int lane, size_t& ldw) {
    const int e = it / EW_E; int r = it % EW_E;
    if (r < EW_GU) { const int kb = r / 64, rb = r % 64; const int n = rb * 32 + (lane & 7) * 4; const int j = n >> 3, up = (n >> 2) & 1; ldw = DFF;
        const float* pg = a.in[I_WGATE]; const float* pu = a.in[I_WUP];
        return (up ? pu : pg) + (size_t)e * DM * DFF + (size_t)(kb * 64 + (lane >> 3)) * DFF + 4 * j; }
    r -= EW_GU; const int kb = r / 64, rb = r % 64; const int n = rb * 32 + (lane & 7) * 4; ldw = DM;
    return a.in[I_WDOWN] + (size_t)e * DFF * DM + (size_t)(kb * 64 + (lane >> 3)) * DM + n;
}
__device__ __forceinline__ void ew_store(const Args& a, int it, const f32x4 (&v)[8], LAS float* scr, int lane) {
    const int e = it / EW_E; int r = it % EW_E; unsigned char* WT; size_t K; int rb, kb;
    if (r < EW_GU) { kb = r / 64; rb = r % 64; WT = a.ws + WS_WGU + (size_t)e * 2048 * 2048; K = 2048; }
    else { r -= EW_GU; kb = r / 64; rb = r % 64; WT = a.ws + WS_WD + (size_t)e * 2048 * 1024; K = 1024; }
#pragma unroll
    for (int i = 0; i < 8; ++i) { const int k = 8 * i + (lane >> 3), n4 = (lane & 7) * 4;
        scr[k * 33 + n4 + 0] = v[i][0]; scr[k * 33 + n4 + 1] = v[i][1]; scr[k * 33 + n4 + 2] = v[i][2]; scr[k * 33 + n4 + 3] = v[i][3]; }
    LDS_WAIT(); asm volatile("" ::: "memory");
    const int c = lane & 3;
#pragma unroll
    for (int j = 0; j < 2; ++j) { const int n = (lane >> 2) + 16 * j; const LAS float* s = scr + (16 * c) * 33 + n;
        u32x4 o;
#pragma unroll
        for (int q = 0; q < 4; ++q) o[q] = cvt4_fp8_nc(s[(4 * q) * 33], s[(4 * q + 1) * 33], s[(4 * q + 2) * 33], s[(4 * q + 3) * 33], F8_WSCALE);
        *(u32x4*)(WT + (size_t)(rb * 32 + n) * K + kb * 64 + 16 * c) = o; __builtin_amdgcn_sched_barrier(0); }
    LDS_WAIT(); asm volatile("" ::: "memory");
}
__device__ __forceinline__ void expert_stream(const Args& a, LAS unsigned char* lds, int tid, int first, int stride, int end) {
    const int lane = tid & 63, wave = tid >> 6;
    LAS float* scr = (LAS float*)(lds + wave * 8704);
    int it = __builtin_amdgcn_readfirstlane(first); if (it >= end) return;
    f32x4 v[8]; { size_t ldw; const float* p = ew_src(a, it, lane, ldw);
#pragma unroll
        for (int i = 0; i < 8; ++i) v[i] = __builtin_nontemporal_load((const f32x4*)(p + (size_t)(8 * i) * ldw)); }
    for (;;) {
        const int nx = it + stride; const bool has = nx < end;
        f32x4 vn[8];
        if (has) { size_t ldw; const float* p = ew_src(a, nx, lane, ldw);
#pragma unroll
            for (int i = 0; i < 8; ++i) vn[i] = __builtin_nontemporal_load((const f32x4*)(p + (size_t)(8 * i) * ldw)); }
        ew_store(a, it, v, scr, lane);
        if (!has) break;
#pragma unroll
        for (int i = 0; i < 8; ++i) v[i] = vn[i];
        it = nx;
    }
}
constexpr int EW2_UNITS = 6144;
struct Ew2 { const float* src0; const float* src1; size_t ldw; unsigned char* dst; int kpitch; };
__device__ __forceinline__ void ew2_decode(const Args& a, int unit, int s, int lane, const float*& src, size_t& ldw, unsigned char*& dst, int& kpitch) {
    const int l = lane & 31, rr = lane >> 5;
    if (unit < 4096) { const int e = unit >> 7, r = unit & 127, cb = r >> 3, k0 = ((r & 7) * 16 + s) * 16;
        const float* pg = a.in[I_WGATE]; const float* pu = a.in[I_WUP];
        src = (l < 16 ? pg : pu) + (size_t)e * DM * DFF + (size_t)(k0 + rr) * DFF + 64 * cb + 4 * (l & 15); ldw = DFF;
        dst = a.ws + WS_WGU + (size_t)e * 2048 * 2048 + (size_t)(128 * cb) * 2048 + k0; kpitch = 2048; }
    else { const int u2 = unit - 4096, e = u2 >> 6, r = u2 & 63, cb = r >> 2, k0 = ((r & 3) * 16 + s) * 16;
        src = a.in[I_WDOWN] + (size_t)e * DFF * DM + (size_t)(k0 + rr) * DM + 128 * cb + 4 * l; ldw = DM;
        dst = a.ws + WS_WD + (size_t)e * 2048 * 1024 + (size_t)(128 * cb) * 1024 + k0; kpitch = 1024; }
}
__device__ __forceinline__ void ew2_store(unsigned char* dst, int kpitch, bool gu, const f32x4 (&v)[8], LAS float* scr, int lane) {
    const int l = lane & 31, rr = lane >> 5;
    const int nb = gu ? (8 * (l & 15) + (l < 16 ? 0 : 4)) : 4 * l;
#pragma unroll
    for (int i = 0; i < 8; ++i) { LAS float* p = scr + (2 * i + rr) * 129 + nb; p[0] = v[i][0]; p[1] = v[i][1]; p[2] = v[i][2]; p[3] = v[i][3]; }
    LDS_WAIT(); asm volatile("" ::: "memory");
#pragma unroll
    for (int jj = 0; jj < 2; ++jj) { const int n = lane + 64 * jj; const LAS float* q = scr + n;
        u32x4 o;
#pragma unroll
        for (int w = 0; w < 4; ++w) o[w] = cvt4_fp8_nc(q[(4 * w) * 129], q[(4 * w + 1) * 129], q[(4 * w + 2) * 129], q[(4 * w + 3) * 129], F8_WSCALE);
        *(u32x4*)(dst + (size_t)n * kpitch) = o; __builtin_amdgcn_sched_barrier(0); }
    LDS_WAIT(); asm volatile("" ::: "memory");
}
__device__ __forceinline__ void expert_stream2(const Args& a, LAS unsigned char* lds, int tid, int gw_, int ngw) {
    const int lane = tid & 63, wave = tid >> 6;
    LAS float* scr = (LAS float*)(lds + wave * 8704);
    const int gw = __builtin_amdgcn_readfirstlane(gw_);
    const int nun = (EW2_UNITS - gw + ngw - 1) / ngw, nq = gw < EW2_UNITS ? nun * 16 : 0;
    if (nq == 0) return;
    f32x4 e0[8], e1[8], e2[8];
#define E2_LOAD(dst_, q_) do { const int qq_ = (q_) < nq ? (q_) : nq - 1; const float* sp_; size_t lw_; unsigned char* dd_; int kp_; ew2_decode(a, gw + ngw * (qq_ >> 4), qq_ & 15, lane, sp_, lw_, dd_, kp_); \
        _Pragma("unroll") for (int i_ = 0; i_ < 8; ++i_) dst_[i_] = __builtin_nontemporal_load((const f32x4*)(sp_ + (size_t)(2 * i_) * lw_)); } while (0)
#define E2_STORE(src_, q_) do { const float* sp_; size_t lw_; unsigned char* dd_; int kp_; const int un_ = gw + ngw * ((q_) >> 4); ew2_decode(a, un_, (q_) & 15, lane, sp_, lw_, dd_, kp_); ew2_store(dd_, kp_, un_ < 4096, src_, scr, lane); } while (0)
    int q = 0;
    E2_LOAD(e0, 0); E2_LOAD(e1, 1);
    while (q + 2 < nq) {
        E2_LOAD(e2, q + 2); E2_STORE(e0, q); ++q;
        E2_LOAD(e0, q + 2); E2_STORE(e1, q); ++q;
        E2_LOAD(e1, q + 2); E2_STORE(e2, q); ++q;
    }
    if (q < nq) { E2_STORE(e0, q); ++q; }
    if (q < nq) { E2_STORE(e1, q); }
#undef E2_LOAD
#undef E2_STORE
}
constexpr int EW3_GU = 16 * 64, EW3_D = 8 * 64, EW3_E = EW3_GU + EW3_D;
__device__ __forceinline__ const float* ew3_src(const Args& a, int it, int lane, size_t& ldw) {
    const int e = it / EW3_E; int r = it % EW3_E;
    if (r < EW3_GU) { const int kb = r / 64, rb = r % 64; ldw = DFF;
        const float* pg = a.in[I_WGATE]; const float* pu = a.in[I_WUP];
        return ((rb >> 5) ? pu : pg) + (size_t)e * DM * DFF + (size_t)(kb * 128 + (lane >> 3)) * DFF + 32 * (rb & 31) + (lane & 7) * 4; }
    r -= EW3_GU; const int kb = r / 64, rb = r % 64; const int n = rb * 32 + (lane & 7) * 4; ldw = DM;
    return a.in[I_WDOWN] + (size_t)e * DFF * DM + (size_t)(kb * 128 + (lane >> 3)) * DM + n;
}
__device__ __forceinline__ void ew3_store(const Args& a, int it, const f32x4 (&v)[16], LAS float* scr, int lane) {
    const int e = it / EW3_E; int r = it % EW3_E; unsigned char* WT; size_t K; int rb, kb; const bool gu = r < EW3_GU;
    if (r < EW3_GU) { kb = r / 64; rb = r % 64; WT = a.ws + WS_WGU + (size_t)e * 2048 * 2048; K = 2048; }
    else { r -= EW3_GU; kb = r / 64; rb = r % 64; WT = a.ws + WS_WD + (size_t)e * 2048 * 1024; K = 1024; }
#pragma unroll
    for (int i = 0; i < 16; ++i) { const int k = 8 * i + (lane >> 3), n4 = (lane & 7) * 4;
        scr[k * 33 + n4 + 0] = v[i][0]; scr[k * 33 + n4 + 1] = v[i][1]; scr[k * 33 + n4 + 2] = v[i][2]; scr[k * 33 + n4 + 3] = v[i][3]; }
    LDS_WAIT(); asm volatile("" ::: "memory");
    const int c = lane & 7;
#pragma unroll
    for (int j = 0; j < 4; ++j) { const int n = (lane >> 3) + 8 * j; const LAS float* q = scr + (16 * c) * 33 + n;
        u32x4 o;
#pragma unroll
        for (int w = 0; w < 4; ++w) o[w] = cvt4_fp8_nc(q[(4 * w) * 33], q[(4 * w + 1) * 33], q[(4 * w + 2) * 33], q[(4 * w + 3) * 33], F8_WSCALE);
        const int drow = gu ? 64 * (rb & 31) + 8 * (n >> 2) + 4 * (rb >> 5) + (n & 3) : rb * 32 + n;
        *(u32x4*)(WT + (size_t)drow * K + kb * 128 + 16 * c) = o; __builtin_amdgcn_sched_barrier(0); }
    LDS_WAIT(); asm volatile("" ::: "memory");
}
__device__ __forceinline__ void expert_stream3(const Args& a, LAS unsigned char* lds, int tid, int first, int stride) {
    const int lane = tid & 63, wave = tid >> 6; const int end = NEXP * EW3_E, last = end - 1;
    LAS float* scr = (LAS float*)(lds + wave * 16896);
    int it = __builtin_amdgcn_readfirstlane(first); if (it >= end) return;
    f32x4 e0[16], e1[16];
#define E3_LOAD(dst_, item) do { const int it_ = (item) < last ? (item) : last; size_t ldw_; const float* p_ = ew3_src(a, it_, lane, ldw_); _Pragma("unroll") for (int i_ = 0; i_ < 16; ++i_) dst_[i_] = *(const f32x4*)(p_ + (size_t)(8 * i_) * ldw_); } while (0)
    E3_LOAD(e0, it);
    while (it + stride < end) {
        E3_LOAD(e1, it + stride); ew3_store(a, it, e0, scr, lane); it += stride;
        E3_LOAD(e0, it + stride); ew3_store(a, it, e1, scr, lane); it += stride;
    }
    if (it < end) ew3_store(a, it, e0, scr, lane);
#undef E3_LOAD
}
__device__ __forceinline__ void phase_expert_weights(const Args& a, LAS unsigned char* lds, int tid, int G) { expert_stream(a, lds, tid, blockIdx.x * NWAVES + (tid >> 6), G * NWAVES, NEXP * EW_E); }

constexpr int HG_QD = 0, HG_KD = 17408, HG_P = 34816, HG_VT = 44032, HG_SEG = 62464, HG_RED = 64512;
constexpr int HG_LBT = 66560;
constexpr int HG_NGT = 70656;
constexpr int HG_ST = 74752, HG_STLD = 136;
constexpr int HG_LD128 = 136, HG_LD64 = 72;

struct HgPrep { float cum[16]; float kh[16]; float tot; };
__device__ __forceinline__ void hg_fill_lb(const Args& a, LAS unsigned char* lds, int tid) {
    for (int i = tid; i < 1024; i += NTHR) { const float l0 = a.in[I_LB][i], l1 = a.in[I_LB][1024 + i]; *(LAS float*)(lds + HG_LBT + i * 4) = 1.0f / (1.0f + __expf(l1 - l0)); *(LAS float*)(lds + HG_NGT + i * 4) = a.in[I_HGNG][i]; }
    __syncthreads();
}
__device__ __forceinline__ void hg_prep(HgPrep& P, const float (&z)[16], float lb, int d, int seg, LAS unsigned char* lds) {
    float run = 0.f;
#pragma unroll
    for (int j = 0; j < 16; ++j) { const float sg = sigmoidf_(z[j]); const float f = lb + (1.0f - lb) * sg; run += __logf(f); P.cum[j] = run; P.kh[j] = (1.0f - lb) * (1.0f - sg); }
    LAS float* segs = (LAS float*)(lds + HG_SEG);
    segs[seg * 128 + d] = run;
    __syncthreads();
    float off = 0.f, tot = 0.f;
#pragma unroll
    for (int s = 0; s < 4; ++s) { const float v = segs[s * 128 + d]; tot += v; if (s < seg) off += v; }
#pragma unroll
    for (int j = 0; j < 16; ++j) P.cum[j] += off;
    P.tot = tot;
}
__device__ __forceinline__ void hg_write_vt(const unsigned (&vv)[16], int d, int seg, LAS unsigned char* lds) {
    u32x4 w0, w1;
    w0.x = vv[0] | (vv[1] << 16); w0.y = vv[2] | (vv[3] << 16); w0.z = vv[4] | (vv[5] << 16); w0.w = vv[6] | (vv[7] << 16);
    w1.x = vv[8] | (vv[9] << 16); w1.y = vv[10] | (vv[11] << 16); w1.z = vv[12] | (vv[13] << 16); w1.w = vv[14] | (vv[15] << 16);
    LAS unsigned char* p = lds + HG_VT + d * (HG_LD64 * 2) + seg * 32;
    *(LAS u32x4*)p = w0; *(LAS u32x4*)(p + 16) = w1;
}

__device__ __forceinline__ void hgrn1_unit(const Args& a, int unit, LAS unsigned char* lds, int tid) {
    unsigned char* ws = a.ws;
    const int lane = tid & 63, wave = tid >> 6, d = tid & 127, seg = tid >> 7;
    const int b = unit >> 10, h = (unit >> 7) & 7, n = unit & 127, tok0 = b * SEQ + n * 64;
    float z[16]; unsigned vv[16];
    { const bf16_t* AF = (const bf16_t*)(ws + WS_AF); const unsigned char* AI = ws + WS_AI;
#pragma unroll
      for (int j = 0; j < 16; ++j) z[j] = bf2f(AF[(size_t)(tok0 + seg * 16 + j) * 1024 + h * 128 + d]);
#pragma unroll
      for (int j = 0; j < 16; ++j) vv[j] = fp8b_bf16(AI[(size_t)(tok0 + seg * 16 + j) * 1024 + h * 128 + d]); }
    const float lbv = *(const LAS float*)(lds + HG_LBT + (h * 128 + d) * 4);
    HgPrep P;
    hg_prep(P, z, lbv, d, seg, lds);
    { unsigned pk[8];
#pragma unroll
      for (int j = 0; j < 8; ++j) pk[j] = cvt_pk(P.kh[2 * j] * __expf(P.tot - P.cum[2 * j]), P.kh[2 * j + 1] * __expf(P.tot - P.cum[2 * j + 1]));
      LAS unsigned char* p = lds + HG_KD + d * (HG_LD64 * 2) + seg * 32;
      *(LAS u32x4*)p = (u32x4){pk[0], pk[1], pk[2], pk[3]}; *(LAS u32x4*)(p + 16) = (u32x4){pk[4], pk[5], pk[6], pk[7]}; }
    if (seg == 0) ((float*)(ws + WS_DECAY))[(size_t)unit * 128 + d] = __expf(P.tot);
    hg_write_vt(vv, d, seg, lds);
    __syncthreads();
    const int fr = lane & 15, fq = lane >> 4;
    bf16x8 af[2];
#pragma unroll
    for (int ks = 0; ks < 2; ++ks) af[ks] = *(const LAS bf16x8*)(lds + HG_KD + (16 * wave + fr) * (HG_LD64 * 2) + (32 * ks + 8 * fq) * 2);
    unsigned char* kvo = ws + WS_KV + (size_t)unit * 16384;
#pragma unroll
    for (int vb = 0; vb < 8; ++vb) {
        f32x4 acc = {0.f, 0.f, 0.f, 0.f};
#pragma unroll
        for (int ks = 0; ks < 2; ++ks) { const bf16x8 bfr = *(const LAS bf16x8*)(lds + HG_VT + (16 * vb + fr) * (HG_LD64 * 2) + (32 * ks + 8 * fq) * 2);
            acc = __builtin_amdgcn_mfma_f32_16x16x32_bf16(af[ks], bfr, acc, 0, 0, 0); }
        *(unsigned*)(kvo + (size_t)(16 * vb + fr) * 128 + 16 * wave + 4 * fq) = cvt4_fp8(acc[0], acc[1], acc[2], acc[3], 1.0f);
    }
    __syncthreads();
}

__device__ __forceinline__ void hgrn_scan(const Args& a, int tid, int G) {
    unsigned char* ws = a.ws;
    const unsigned char* KV = ws + WS_KV; const float* DEC = (const float*)(ws + WS_DECAY); unsigned char* ST = ws + WS_ST;
    for (int g = blockIdx.x * NTHR + tid; g < 16 * 8192; g += G * NTHR) {
        const int bh = g >> 13, rem = g & 8191, v = rem >> 6, d2 = (rem & 63) * 2;
        float s0 = 0.f, s1 = 0.f;
        for (int n0 = 0; n0 < 128; n0 += 8) {
            unsigned kv[8]; f32x2 dc[8];
#pragma unroll
            for (int j = 0; j < 8; ++j) { const size_t unit = (size_t)bh * 128 + n0 + j; kv[j] = *(const unsigned short*)(KV + unit * 16384 + v * 128 + d2); dc[j] = *(const f32x2*)(DEC + unit * 128 + d2); }
#pragma unroll
            for (int j = 0; j < 8; ++j) { const size_t unit = (size_t)bh * 128 + n0 + j; *(unsigned short*)(ST + unit * 16384 + v * 128 + d2) = (unsigned short)(__builtin_amdgcn_cvt_pk_fp8_f32(__builtin_amdgcn_fmed3f(s0, -448.f, 448.f), __builtin_amdgcn_fmed3f(s1, -448.f, 448.f), 0, false) & 0xffff);
                const f32x2 kf = __builtin_amdgcn_cvt_pk_f32_fp8((int)kv[j], false); s0 = dc[j][0] * s0 + kf[0]; s1 = dc[j][1] * s1 + kf[1]; }
        }
    }
}

__device__ __forceinline__ void hg3_load(const Args& a, int unit, int tid, float (&z)[16], unsigned (&qq)[16], unsigned (&vv)[16], u32x4 (&stp)[4], u32x2 (&gwv)[4]) {
    unsigned char* ws = a.ws; const int d = tid & 127, seg = tid >> 7;
    const int b = unit >> 10, h = (unit >> 7) & 7, n = unit & 127, tok0 = b * SEQ + n * 64;
    const bf16_t* AF = (const bf16_t*)(ws + WS_AF); const unsigned char* AI = ws + WS_AI; const unsigned char* AQ = ws + WS_AQ;
#pragma unroll
    for (int j = 0; j < 16; ++j) z[j] = bf2f(AF[(size_t)(tok0 + seg * 16 + j) * 1024 + h * 128 + d]);
#pragma unroll
    for (int j = 0; j < 16; ++j) qq[j] = fp8b_bf16(AQ[(size_t)(tok0 + seg * 16 + j) * 1024 + h * 128 + d]);
#pragma unroll
    for (int j = 0; j < 16; ++j) vv[j] = fp8b_bf16(AI[(size_t)(tok0 + seg * 16 + j) * 1024 + h * 128 + d]);
    { const unsigned char* ST = ws + WS_ST + (size_t)unit * 16384;
#pragma unroll
      for (int i = 0; i < 4; ++i) { const u32x2 w8 = *(const u32x2*)(ST + (size_t)(tid + NTHR * i) * 8); stp[i] = (u32x4){w8.x, w8.y, 0u, 0u}; } }
    { const int lane = tid & 63, wave = tid >> 6, t_ = 16 * (wave & 3) + (lane & 15); const unsigned char* AG = ws + WS_AG;
#pragma unroll
      for (int vi = 0; vi < 4; ++vi) { const unsigned w8 = *(const unsigned*)(AG + (size_t)(tok0 + t_) * 1024 + h * 128 + 16 * (4 * (wave >> 2) + vi) + 4 * (lane >> 4));
          gwv[vi] = (u32x2){fp8b_bf16(w8 & 0xffu) | (fp8b_bf16((w8 >> 8) & 0xffu) << 16), fp8b_bf16((w8 >> 16) & 0xffu) | (fp8b_bf16(w8 >> 24) << 16)}; } }
}
__device__ __forceinline__ void hgrn3_unit(const Args& a, int unit, int next_unit, LAS unsigned char* lds, int tid, float (&z)[16], unsigned (&qq)[16], unsigned (&vv)[16], u32x4 (&stp)[4], u32x2 (&gwn)[4]) {
    unsigned char* ws = a.ws;
    const int lane = tid & 63, wave = tid >> 6, d = tid & 127, seg = tid >> 7;
    const int b = unit >> 10, h = (unit >> 7) & 7, n = unit & 127, tok0 = b * SEQ + n * 64;
    const float lbv = *(const LAS float*)(lds + HG_LBT + (h * 128 + d) * 4);
    u32x2 gwv[4];
#pragma unroll
    for (int vi = 0; vi < 4; ++vi) gwv[vi] = gwn[vi];
#ifndef HG3_RA
#define HG3_RA 1
#define HG3_RB 1
#define HG3_RC 1
#endif
    for (int ra = 0; ra < HG3_RA; ++ra) {
    HgPrep P;
    hg_prep(P, z, lbv, d, seg, lds);
    {
#pragma unroll
      for (int j = 0; j < 16; ++j) { const float q = bf2f(qq[j]); const float qs = q * sigmoidf_(q);
          const float qd = qs * __expf(P.cum[j]), kd = P.kh[j] * __expf(-P.cum[j]);
          const int t = seg * 16 + j;
          *(LAS bf16_t*)(lds + HG_QD + (t * HG_LD128 + d) * 2) = (bf16_t)(cvt_pk(qd, 0.f) & 0xffffu);
          *(LAS bf16_t*)(lds + HG_KD + (t * HG_LD128 + d) * 2) = (bf16_t)(cvt_pk(kd, 0.f) & 0xffffu); } }
    hg_write_vt(vv, d, seg, lds);
#pragma unroll
    for (int i = 0; i < 4; ++i) { const int id = tid + NTHR * i;
        const f32x2 a0 = __builtin_amdgcn_cvt_pk_f32_fp8((int)stp[i].x, false), a1 = __builtin_amdgcn_cvt_pk_f32_fp8((int)stp[i].x, true), a2 = __builtin_amdgcn_cvt_pk_f32_fp8((int)stp[i].y, false), a3 = __builtin_amdgcn_cvt_pk_f32_fp8((int)stp[i].y, true);
        const u32x4 o = {(__float_as_uint(a0[0]) >> 16) | (__float_as_uint(a0[1]) & 0xffff0000u), (__float_as_uint(a1[0]) >> 16) | (__float_as_uint(a1[1]) & 0xffff0000u),
                         (__float_as_uint(a2[0]) >> 16) | (__float_as_uint(a2[1]) & 0xffff0000u), (__float_as_uint(a3[0]) >> 16) | (__float_as_uint(a3[1]) & 0xffff0000u)};
        *(LAS u32x4*)(lds + HG_ST + (id >> 4) * (HG_STLD * 2) + (id & 15) * 16) = o; }
    __syncthreads();
    }
    if (next_unit >= 0) hg3_load(a, next_unit, tid, z, qq, vv, stp, gwn);
    const int fr = lane & 15, fq = lane >> 4;
    for (int rb = 0; rb < HG3_RB; ++rb) {
    { const int tb = wave & 3;
      bf16x8 bq[4];
#pragma unroll
      for (int ks = 0; ks < 4; ++ks) bq[ks] = *(const LAS bf16x8*)(lds + HG_QD + ((16 * tb + fr) * HG_LD128 + 32 * ks + 8 * fq) * 2);
#pragma unroll
      for (int si = 0; si < 2; ++si) { const int sb = 2 * (wave >> 2) + si;
          f32x4 acc = {0.f, 0.f, 0.f, 0.f};
#pragma unroll
          for (int ks = 0; ks < 4; ++ks) { const bf16x8 ak = *(const LAS bf16x8*)(lds + HG_KD + ((16 * sb + fr) * HG_LD128 + 32 * ks + 8 * fq) * 2);
              acc = __builtin_amdgcn_mfma_f32_16x16x32_bf16(ak, bq[ks], acc, 0, 0, 0); }
          const int t = 16 * tb + fr, s0 = 16 * sb + 4 * fq;
          float p[4];
#pragma unroll
          for (int r = 0; r < 4; ++r) p[r] = (s0 + r <= t) ? acc[r] : 0.f;
          *(LAS u32x2*)(lds + HG_P + (t * HG_LD64 + s0) * 2) = (u32x2){cvt_pk(p[0], p[1]), cvt_pk(p[2], p[3])}; } }
    __syncthreads();
    }
    for (int rc = 0; rc < HG3_RC; ++rc) {
    const int tb = wave & 3, t = 16 * tb + fr;
    f32x4 o[4];
    { bf16x8 bp[2], bq[4];
#pragma unroll
      for (int ks = 0; ks < 2; ++ks) bp[ks] = *(const LAS bf16x8*)(lds + HG_P + ((16 * tb + fr) * HG_LD64 + 32 * ks + 8 * fq) * 2);
#pragma unroll
      for (int ks = 0; ks < 4; ++ks) bq[ks] = *(const LAS bf16x8*)(lds + HG_QD + ((16 * tb + fr) * HG_LD128 + 32 * ks + 8 * fq) * 2);
#pragma unroll
      for (int vi = 0; vi < 4; ++vi) { const int vb = 4 * (wave >> 2) + vi;
          f32x4 acc = {0.f, 0.f, 0.f, 0.f};
#pragma unroll
          for (int ks = 0; ks < 2; ++ks) { const bf16x8 av = *(const LAS bf16x8*)(lds + HG_VT + ((16 * vb + fr) * HG_LD64 + 32 * ks + 8 * fq) * 2);
              acc = __builtin_amdgcn_mfma_f32_16x16x32_bf16(av, bp[ks], acc, 0, 0, 0); }
#pragma unroll
          for (int ks = 0; ks < 4; ++ks) { const bf16x8 as = *(const LAS bf16x8*)(lds + HG_ST + ((16 * vb + fr) * HG_STLD + 32 * ks + 8 * fq) * 2);
              acc = __builtin_amdgcn_mfma_f32_16x16x32_bf16(as, bq[ks], acc, 0, 0, 0); }
          o[vi] = acc; } }
    float ss = 0.f;
#pragma unroll
    for (int vi = 0; vi < 4; ++vi) ss += (o[vi][0] * o[vi][0] + o[vi][1] * o[vi][1]) + (o[vi][2] * o[vi][2] + o[vi][3] * o[vi][3]);
    ss += __shfl_xor(ss, 16); ss += __shfl_xor(ss, 32);
    LAS float* red = (LAS float*)(lds + HG_RED);
    if (fq == 0) red[(wave >> 2) * 64 + t] = ss;
    __syncthreads();
    const float tot = red[t] + red[64 + t];
    const float rinv = 1.0f / sqrtf(tot * (1.0f / 128.0f) + RMS_EPS);
    unsigned char* BRA = ws + WS_BRA;
#pragma unroll
    for (int vi = 0; vi < 4; ++vi) { const int v0 = 16 * (4 * (wave >> 2) + vi) + 4 * fq; const size_t off = (size_t)(tok0 + t) * 1024 + h * 128 + v0;
        const u32x2 gw = gwv[vi]; const f32x4 gn = *(const LAS f32x4*)(lds + HG_NGT + (h * 128 + v0) * 4);
        const float g0 = __uint_as_float(gw.x << 16), g1 = __uint_as_float(gw.x & 0xffff0000u), g2 = __uint_as_float(gw.y << 16), g3 = __uint_as_float(gw.y & 0xffff0000u);
        const float r0 = o[vi][0] * rinv * gn[0] * (g0 * sigmoidf_(g0)), r1 = o[vi][1] * rinv * gn[1] * (g1 * sigmoidf_(g1));
        const float r2 = o[vi][2] * rinv * gn[2] * (g2 * sigmoidf_(g2)), r3 = o[vi][3] * rinv * gn[3] * (g3 * sigmoidf_(g3));
        *(unsigned*)(BRA + off) = cvt4_fp8(r0, r1, r2, r3, F8_ASCALE); }
    __syncthreads();
    }
}


constexpr int IX_S = 0, IX_H = 131072, IX_L = 147456, IX_M = 155648, IX_C = 159744;
constexpr int IX_CAP = 512;
__device__ __forceinline__ unsigned ix_sortable(unsigned u) { return (u & 0x80000000u) ? ~u : (u | 0x80000000u); }

__device__ __forceinline__ void ix_radix_fallback(LAS unsigned* S, LAS unsigned* H, unsigned* MASK, int t0, int L, int tid) {
    const int lane = tid & 63, wave = __builtin_amdgcn_readfirstlane(tid >> 6);
    for (int q = 0; q < 4; ++q) for (int i = tid; i < L; i += NTHR) S[q * 8192 + i] = ix_sortable(S[q * 8192 + i]);
    for (int i = tid; i < 2048; i += NTHR) H[i] = 0u;
    __syncthreads();
    const int qs = wave >> 1, half = wave & 1;
    unsigned prefix = 0u; int kth = 256;
    for (int p = 0; p < 4; ++p) {
        const int shift = 24 - 8 * p;
        LAS unsigned* hist = H + (p & 1) * 1024 + qs * 256;
        for (int i = half * 64 + lane; i < L; i += 128) { const unsigned k = S[qs * 8192 + i];
            const bool in = (p == 0) || ((k >> (shift + 8)) == prefix);
            if (in) atomicAdd((unsigned*)(hist + ((k >> shift) & 255u)), 1u); }
        __syncthreads();
        const unsigned c0 = hist[255 - 4 * lane], c1 = hist[254 - 4 * lane], c2 = hist[253 - 4 * lane], c3 = hist[252 - 4 * lane];
        const int tot = (int)(c0 + c1 + c2 + c3);
        int incl = tot;
#pragma unroll
        for (int o = 1; o < 64; o <<= 1) { const int v = __shfl_up(incl, o); if (lane >= o) incl += v; }
        const unsigned long long bal = __ballot(incl >= kth);
        const int fl = __ffsll((long long)bal) - 1;
        const int rem = kth - (incl - tot);
        int dig, nk;
        if (rem <= (int)c0) { dig = 255 - 4 * lane; nk = rem; }
        else if (rem <= (int)(c0 + c1)) { dig = 254 - 4 * lane; nk = rem - (int)c0; }
        else if (rem <= (int)(c0 + c1 + c2)) { dig = 253 - 4 * lane; nk = rem - (int)(c0 + c1); }
        else { dig = 252 - 4 * lane; nk = rem - (int)(c0 + c1 + c2); }
        dig = __shfl(dig, fl); nk = __shfl(nk, fl);
        prefix = (prefix << 8) | (unsigned)dig; kth = nk;
        __syncthreads();
        if (p < 2) for (int i = tid; i < 1024; i += NTHR) H[(p & 1) * 1024 + i] = 0u;
    }
    const unsigned T = prefix;
    const int NG = L / 64;
    int tie_before = 0;
    if (half == 1) for (int g = 0; g < 64 && g < NG; ++g) { const unsigned k = S[qs * 8192 + 64 * g + lane]; tie_before += __popcll(__ballot(k == T)); }
    unsigned mlo = 0u, mhi = 0u;
    const unsigned long long lt = (1ull << lane) - 1ull;
    for (int g = 64 * half; g < NG && g < 64 * half + 64; ++g) {
        const unsigned k = S[qs * 8192 + 64 * g + lane];
        const bool eq = (k == T);
        const unsigned long long eqm = __ballot(eq);
        const int rank = tie_before + __popcll(eqm & lt);
        const bool sel = (k > T) || (eq && rank < kth);
        const unsigned long long m = __ballot(sel);
        if (lane == g - 64 * half) { mlo = (unsigned)m; mhi = (unsigned)(m >> 32); }
        tie_before += __popcll(eqm);
    }
    *(u32x2*)(MASK + (size_t)(t0 + qs) * 256 + 2 * (64 * half + lane)) = (u32x2){mlo, mhi};
    __syncthreads();
}

__device__ __forceinline__ void indexer_unit(const Args& a, int unit, LAS unsigned char* lds, int tid) {
    unsigned char* ws = a.ws;
    const int lane = tid & 63, wave = __builtin_amdgcn_readfirstlane(tid >> 6);
    const int t0 = unit * 4, b = t0 >> 13, qpos0 = t0 & (SEQ - 1), c = qpos0 >> 6, L = 64 * (c + 1);
    unsigned* MASK = (unsigned*)(ws + WS_MASK);
    if (c < 4) {
        const int qi = tid >> 7, w2 = (tid & 127) * 2;
        const unsigned m0 = (w2 * 32 < L) ? 0xffffffffu : 0u, m1 = ((w2 + 1) * 32 < L) ? 0xffffffffu : 0u;
        *(u32x2*)(MASK + (size_t)(t0 + qi) * 256 + w2) = (u32x2){m0, m1};
        return;
    }
    const bf16_t* IQ = (const bf16_t*)(ws + WS_IQ); const bf16_t* IKW = (const bf16_t*)(ws + WS_IKW);
    LAS unsigned* S = (LAS unsigned*)(lds + IX_S); LAS unsigned* H = (LAS unsigned*)(lds + IX_H); LAS unsigned* LST = (LAS unsigned*)(lds + IX_L);
    LAS unsigned* MB = (LAS unsigned*)(lds + IX_M); LAS float* MM = (LAS float*)(lds + IX_C); LAS unsigned* CC = (LAS unsigned*)(lds + IX_C + 256);
    const int r32 = lane & 31, hh = lane >> 5;
    for (int i = tid; i < 4096; i += NTHR) H[i] = 0u;
    for (int i = tid; i < 1024; i += NTHR) MB[i] = 0u;
    if (tid < 8) CC[tid] = 0u;
    bf16x8 af[4];
#pragma unroll
    for (int ks = 0; ks < 4; ++ks) af[ks] = *(const bf16x8*)(IQ + (size_t)(t0 + (r32 >> 3)) * 512 + (r32 & 7) * 64 + 16 * ks + 8 * hh);
    bf16x8 a2[2];
#pragma unroll
    for (int sI = 0; sI < 2; ++sI)
#pragma unroll
        for (int j = 0; j < 8; ++j) { const int qm = 2 * sI + (j >> 2), hm = 4 * hh + (j & 3);
            a2[sI][j] = (r32 == qm) ? (short)IKW[(size_t)(t0 + qm) * 256 + 64 + hm] : (short)0; }
    float mn[4], mx[4];
#pragma unroll
    for (int qi = 0; qi < 4; ++qi) { mn[qi] = 3.0e38f; mx[qi] = -3.0e38f; }
    const int NT32 = L / 32;
    const bf16_t* kbase = (const bf16_t*)(ws + WS_IK2) + (size_t)b * (SEQ / 32) * 2048 + lane * 8;
#define IX_LOADT(dst, kt_) do { const bf16_t* kp_ = kbase + (size_t)(kt_) * 2048; _Pragma("unroll") for (int ks = 0; ks < 4; ++ks) dst[ks] = *(const bf16x8*)(kp_ + 512 * ks); } while (0)
#define IX_MM(acc, bt) do { acc = f32x16{}; _Pragma("unroll") for (int ks = 0; ks < 4; ++ks) acc = __builtin_amdgcn_mfma_f32_32x32x16_bf16(af[ks], bt[ks], acc, 0, 0, 0); } while (0)
#define IX_HS(y_, acc) do { unsigned pk_[8]; _Pragma("unroll") for (int i = 0; i < 8; ++i) { const float x0_ = __builtin_amdgcn_fmed3f(acc[2 * i], 0.0f, 3.0e38f), x1_ = __builtin_amdgcn_fmed3f(acc[2 * i + 1], 0.0f, 3.0e38f); pk_[i] = cvt_pk_to_mfma(x0_, x1_); } \
        const u32x4 f0_ = {pk_[0], pk_[1], pk_[2], pk_[3]}, f1_ = {pk_[4], pk_[5], pk_[6], pk_[7]}; \
        y_ = f32x16{}; y_ = __builtin_amdgcn_mfma_f32_32x32x16_bf16(a2[0], *(const bf16x8*)&f0_, y_, 0, 0, 0); y_ = __builtin_amdgcn_mfma_f32_32x32x16_bf16(a2[1], *(const bf16x8*)&f1_, y_, 0, 0, 0); } while (0)
#define IX_ST(y_, kt_) do { const int key = (kt_) * 32 + r32; \
        if (hh == 0) { _Pragma("unroll") for (int qi = 0; qi < 4; ++qi) { const float s = y_[qi] + 0.0f; mn[qi] = fminf(mn[qi], s); mx[qi] = fmaxf(mx[qi], s); S[qi * 8192 + key] = __float_as_uint(s); } } } while (0)
#ifndef IX_REP_S1
#define IX_REP_S1 1
#endif
    for (int rp1 = 0; rp1 < IX_REP_S1; ++rp1) {
    bf16x8 bA[4], bB[4], bC[4];
    { const int kt = wave; if (kt < NT32) IX_LOADT(bA, kt); if (kt + 8 < NT32) IX_LOADT(bB, kt + 8); if (kt + 16 < NT32) IX_LOADT(bC, kt + 16); }
    for (int kt = wave; kt < NT32; kt += 3 * NWAVES) {
        const int kn = kt + 3 * NWAVES;
        bf16x8 nA[4], nB[4], nC[4];
        if (kn < NT32) IX_LOADT(nA, kn); if (kn + 8 < NT32) IX_LOADT(nB, kn + 8); if (kn + 16 < NT32) IX_LOADT(nC, kn + 16);
        const bool hB = kt + 8 < NT32, hC = kt + 16 < NT32;
#ifndef IX_REP_C
#define IX_REP_C 1
#endif
        for (int rc_ = 0; rc_ < IX_REP_C; ++rc_) {
        f32x16 xA, xB, xC;
        IX_MM(xA, bA); if (hB) IX_MM(xB, bB); if (hC) IX_MM(xC, bC);
        { f32x16 yy; IX_HS(yy, xA); IX_ST(yy, kt); }
        if (hB) { f32x16 yy; IX_HS(yy, xB); IX_ST(yy, kt + 8); }
        if (hC) { f32x16 yy; IX_HS(yy, xC); IX_ST(yy, kt + 16); }
        }
#pragma unroll
        for (int ks = 0; ks < 4; ++ks) { bA[ks] = nA[ks]; bB[ks] = nB[ks]; bC[ks] = nC[ks]; }
    }
    }
#undef IX_LOADT
#undef IX_MM
#undef IX_HS
#undef IX_ST
#pragma unroll
    for (int qi = 0; qi < 4; ++qi) {
#pragma unroll
        for (int o = 1; o < 32; o <<= 1) { mn[qi] = fminf(mn[qi], __shfl_xor(mn[qi], o)); mx[qi] = fmaxf(mx[qi], __shfl_xor(mx[qi], o)); }
        if (lane == 0) { MM[(wave * 4 + qi) * 2] = mn[qi]; MM[(wave * 4 + qi) * 2 + 1] = mx[qi]; } }
    __syncthreads();
    const int qs = wave >> 1, half = wave & 1;
    float mnq = 3.0e38f, mxq = -3.0e38f;
#pragma unroll
    for (int w = 0; w < NWAVES; ++w) { mnq = fminf(mnq, MM[(w * 4 + qs) * 2]); mxq = fmaxf(mxq, MM[(w * 4 + qs) * 2 + 1]); }
    const float scl = (mxq > mnq) ? 1023.0f / (mxq - mnq) : 0.0f;
#define IX_BIN(sbits) min((int)((__uint_as_float(sbits) - mnq) * scl), 1023)
    { LAS unsigned* hist = H + qs * 1024;
      int i = half * 64 + lane;
      for (; i + 384 < L; i += 512) { const unsigned s0 = S[qs * 8192 + i], s1 = S[qs * 8192 + i + 128], s2 = S[qs * 8192 + i + 256], s3 = S[qs * 8192 + i + 384];
          const int b0 = IX_BIN(s0), b1 = IX_BIN(s1), b2 = IX_BIN(s2), b3 = IX_BIN(s3);
          atomicAdd((unsigned*)(hist + b0), 1u); atomicAdd((unsigned*)(hist + b1), 1u); atomicAdd((unsigned*)(hist + b2), 1u); atomicAdd((unsigned*)(hist + b3), 1u); }
      for (; i < L; i += 128) { const int bin = IX_BIN(S[qs * 8192 + i]); atomicAdd((unsigned*)(hist + bin), 1u); } }
    __syncthreads();
    int bstar, rtake, cntb;
    { const LAS u32x4* hp = (const LAS u32x4*)(H + qs * 1024 + 1008 - 16 * lane);
      const u32x4 h0 = hp[0], h1 = hp[1], h2 = hp[2], h3 = hp[3];
      const unsigned cb[16] = {h0.x, h0.y, h0.z, h0.w, h1.x, h1.y, h1.z, h1.w, h2.x, h2.y, h2.z, h2.w, h3.x, h3.y, h3.z, h3.w};
      int tot = 0;
#pragma unroll
      for (int j = 0; j < 16; ++j) tot += (int)cb[j];
      int incl = tot;
#pragma unroll
      for (int o = 1; o < 64; o <<= 1) { const int v = __shfl_up(incl, o); if (lane >= o) incl += v; }
      const unsigned long long bal = __ballot(incl >= 256);
      const int fl = __ffsll((long long)bal) - 1;
      const int rem = 256 - (incl - tot);
      int cum = 0, bs = 0, rt = 0, cn = 0; bool found = false;
#pragma unroll
      for (int j = 15; j >= 0; --j) { const int cj = (int)cb[j]; if (!found && cum + cj >= rem) { bs = 1008 - 16 * lane + j; rt = rem - cum; cn = cj; found = true; } cum += cj; }
      bstar = __shfl(bs, fl); rtake = __shfl(rt, fl); cntb = __shfl(cn, fl); }
    const int NG = L / 64;
    const bool all_eq = (cntb == rtake);
    const unsigned long long lt = (1ull << lane) - 1ull;
    { unsigned mlo = 0u, mhi = 0u;
      const int gh = (NG + 1) >> 1, gbeg = half ? gh : 0, gend = half ? NG : gh;
      const float tge = (float)bstar, tgt = (bstar >= 1023) ? 3.0e38f : (float)(bstar + 1);
      unsigned sv[4] = {0u, 0u, 0u, 0u};
      for (int g = gbeg; g < gend; ++g) {
          const int gi = (g - gbeg) & 3;
          if (gi == 0) {
#pragma unroll
              for (int j = 0; j < 4; ++j) if (g + j < gend) sv[j] = S[qs * 8192 + 64 * (g + j) + lane]; }
          const unsigned sb = (gi == 0) ? sv[0] : (gi == 1) ? sv[1] : (gi == 2) ? sv[2] : sv[3];
          const float tq = (__uint_as_float(sb) - mnq) * scl;
          unsigned long long m = __ballot(tq >= tgt);
          const unsigned long long eqm = __ballot(tq >= tge) & ~m;
          if (all_eq) m |= eqm;
          else if (eqm != 0ull) {
              unsigned base = 0u;
              if (lane == 0) base = atomicAdd((unsigned*)(CC + qs), (unsigned)__popcll(eqm));
              base = __builtin_amdgcn_readfirstlane(base);
              const unsigned pos = base + (unsigned)__popcll(eqm & lt);
              if (((eqm >> lane) & 1ull) && pos < (unsigned)IX_CAP) LST[qs * IX_CAP + pos] = (unsigned)(64 * g + lane); }
          if (lane == g - gbeg) { mlo = (unsigned)m; mhi = (unsigned)(m >> 32); }
      }
      if (lane < gend - gbeg) *(LAS u32x2*)(MB + qs * 256 + 2 * (gbeg + lane)) = (u32x2){mlo, mhi}; }
    __syncthreads();
    if (half == 0 && !all_eq) {
        const int nc = cntb;
        if (nc > IX_CAP) { if (lane == 0) CC[4] = 1u; }
        else {
            unsigned myk[8], myi[8]; int rk[8];
#pragma unroll
            for (int sI = 0; sI < 8; ++sI) { const int j = sI * 64 + lane; rk[sI] = 0; myi[sI] = 0u; myk[sI] = 0u;
                if (sI * 64 < nc && j < nc) { myi[sI] = LST[qs * IX_CAP + j]; myk[sI] = ix_sortable(S[qs * 8192 + myi[sI]]); } }
            for (int t = 0; t < nc; ++t) { const unsigned it = LST[qs * IX_CAP + t]; const unsigned kt_ = ix_sortable(S[qs * 8192 + it]);
#pragma unroll
                for (int sI = 0; sI < 8; ++sI) if (sI * 64 < nc) rk[sI] += (kt_ > myk[sI] || (kt_ == myk[sI] && it < myi[sI])) ? 1 : 0; }
#pragma unroll
            for (int sI = 0; sI < 8; ++sI) { const int j = sI * 64 + lane;
                if (sI * 64 < nc && j < nc && rk[sI] < rtake) atomicOr((unsigned*)(MB + qs * 256 + (myi[sI] >> 5)), 1u << (myi[sI] & 31u)); }
        }
    }
#undef IX_BIN
    __syncthreads();
    if (CC[4] != 0u) { __syncthreads(); ix_radix_fallback(S, H, MASK, t0, L, tid); return; }
    { const int qi = tid >> 7, w2 = (tid & 127) * 2;
      *(u32x2*)(MASK + (size_t)(t0 + qi) * 256 + w2) = *(const LAS u32x2*)(MB + qi * 256 + w2); }
    __syncthreads();
}

constexpr int NA_IDX = 0, NA_LG = 1024, NA_SCAN = 1024 + 8192;
__device__ __forceinline__ void attn_gather_unit(const Args& a, int tok, LAS unsigned char* lds, int tid) {
    unsigned char* ws = a.ws;
    const int lane = tid & 63, wave = __builtin_amdgcn_readfirstlane(tid >> 6);
    const int b = tok >> 13, qpos = tok & (SEQ - 1), c = qpos >> 6, L = 64 * (c + 1), nsel = L < 256 ? L : 256;
    const unsigned* MASK = (const unsigned*)(ws + WS_MASK);
    LAS int* idxs = (LAS int*)(lds + NA_IDX); LAS float* lg = (LAS float*)(lds + NA_LG) + wave * 256; LAS int* wsum = (LAS int*)(lds + NA_SCAN);
    unsigned w = 0u; int cnt = 0;
    if (tid < 256) { w = MASK[(size_t)tok * 256 + tid]; cnt = __popc(w); }
    int incl = cnt;
#pragma unroll
    for (int o = 1; o < 64; o <<= 1) { const int v = __shfl_up(incl, o); if (lane >= o) incl += v; }
    if (lane == 63) wsum[wave] = incl;
    __syncthreads();
    if (tid < 256) { int off = incl - cnt; for (int ww = 0; ww < wave; ++ww) off += wsum[ww];
        while (w) { const int bit = __ffs(w) - 1; w &= w - 1; if (off < 256) idxs[off] = tid * 32 + bit; ++off; } }
    __syncthreads();
    const int h = wave;
    const bf16_t* BQ = (const bf16_t*)(ws + WS_BQ); const bf16_t* BK = (const bf16_t*)(ws + WS_BK); const bf16_t* BV = (const bf16_t*)(ws + WS_BV);
    const float slope = exp2f(-(float)(h + 1));
    float qv[8];
    { const u32x4 qw = *(const u32x4*)(BQ + (size_t)tok * 1024 + h * 128 + 8 * (lane & 15));
      qv[0] = __uint_as_float(qw.x << 16); qv[1] = __uint_as_float(qw.x & 0xffff0000u); qv[2] = __uint_as_float(qw.y << 16); qv[3] = __uint_as_float(qw.y & 0xffff0000u);
      qv[4] = __uint_as_float(qw.z << 16); qv[5] = __uint_as_float(qw.z & 0xffff0000u); qv[6] = __uint_as_float(qw.w << 16); qv[7] = __uint_as_float(qw.w & 0xffff0000u); }
    for (int it = 0; it < nsel / 4; ++it) {
        const int key = idxs[4 * it + (lane >> 4)];
        const u32x4 kw = *(const u32x4*)(BK + (size_t)(b * SEQ + key) * 1024 + h * 128 + 8 * (lane & 15));
        float s = qv[0] * __uint_as_float(kw.x << 16) + qv[1] * __uint_as_float(kw.x & 0xffff0000u) + qv[2] * __uint_as_float(kw.y << 16) + qv[3] * __uint_as_float(kw.y & 0xffff0000u)
                + qv[4] * __uint_as_float(kw.z << 16) + qv[5] * __uint_as_float(kw.z & 0xffff0000u) + qv[6] * __uint_as_float(kw.w << 16) + qv[7] * __uint_as_float(kw.w & 0xffff0000u);
        s += __shfl_xor(s, 1); s += __shfl_xor(s, 2); s += __shfl_xor(s, 4); s += __shfl_xor(s, 8);
        const float dist = fabsf((float)(qpos - key));
        if ((lane & 15) == 0) lg[4 * it + (lane >> 4)] = s * 0.08838834764831845f - slope * dist;
    }
    LDS_WAIT();
    float mx = -3.0e38f;
    for (int k = lane; k < nsel; k += 64) mx = fmaxf(mx, lg[k]);
#pragma unroll
    for (int o = 1; o < 64; o <<= 1) mx = fmaxf(mx, __shfl_xor(mx, o));
    float sm = 0.f;
    for (int k = lane; k < nsel; k += 64) { const float e = __expf(lg[k] - mx); lg[k] = e; sm += e; }
    sm = wave_sum(sm);
    const float rs = 1.0f / sm;
    LDS_WAIT();
    float o0 = 0.f, o1 = 0.f;
    for (int k = 0; k < nsel; k += 4) {
        unsigned vw[4]; float pp[4];
#pragma unroll
        for (int j = 0; j < 4; ++j) { const int key = idxs[k + j]; pp[j] = lg[k + j]; vw[j] = *(const unsigned*)(BV + (size_t)(b * SEQ + key) * 1024 + h * 128 + 2 * lane); }
#pragma unroll
        for (int j = 0; j < 4; ++j) { o0 += pp[j] * __uint_as_float(vw[j] << 16); o1 += pp[j] * __uint_as_float(vw[j] & 0xffff0000u); }
    }
    *(unsigned*)((bf16_t*)(ws + WS_BRB) + (size_t)tok * 1024 + h * 128 + 2 * lane) = cvt_pk(o0 * rs, o1 * rs);
    __syncthreads();
}

constexpr int RT_BLK = 148, RT_BUF = 64 * RT_BLK * 4;
constexpr int RT_SCR = 2 * RT_BUF;
constexpr int RT_LNW = 114688;
#define RT_BAR() do { asm volatile("s_waitcnt lgkmcnt(0)" ::: "memory"); __builtin_amdgcn_s_barrier(); asm volatile("" ::: "memory"); } while (0)
__device__ __forceinline__ void phase8_router_expw(const Args& a, LAS unsigned char* lds, int tid, int G, bool route, bool do_expw) {
    unsigned char* ws = a.ws; const int wave = __builtin_amdgcn_readfirstlane(tid >> 6);
    const int npass = MT / 8;
    if (wave < 4) {
        RT_BAR();
        int cbuf = 0;
        u32x2 pf[2][8];
#define RT_PF(ps_) do { const int l_ = fresh_lane(); _Pragma("unroll") for (int r_ = 0; r_ < 2; ++r_) { const unsigned ro_ = (unsigned)((ps_) * 8 + wave * 2 + r_) * (unsigned)(DM * 2) + 8u * (unsigned)l_; \
            _Pragma("unroll") for (int i_ = 0; i_ < 8; ++i_) pf[r_][i_] = *(const u32x2*)(ws + (size_t)((unsigned)WS_PRE1 + ro_ + 512u * i_)); } } while (0)
        if ((int)blockIdx.x < npass) RT_PF((int)blockIdx.x);
        int p_row = -1, p_ea = 0, p_eb = 0, p_pa = 0, p_pb = 0;
        for (int ps = blockIdx.x; ps < npass; ps += G) {
            int lane = fresh_lane(); asm volatile("" : "+v"(lane));
            f32x4 v[2][8]; float s01[2];
#pragma unroll
            for (int r = 0; r < 2; ++r) { float s = 0.f;
#pragma unroll
                for (int i = 0; i < 8; ++i) { const u32x2 pw = pf[r][i];
                    v[r][i] = (f32x4){__uint_as_float(pw.x << 16), __uint_as_float(pw.x & 0xffff0000u), __uint_as_float(pw.y << 16), __uint_as_float(pw.y & 0xffff0000u)};
                    s += (v[r][i][0] + v[r][i][1]) + (v[r][i][2] + v[r][i][3]); }
                s01[r] = s; }
            if (ps + G < npass) RT_PF(ps + G);
#pragma unroll
            for (int r = 0; r < 2; ++r) { const int row = ps * 8 + wave * 2 + r;
                const unsigned ro = (unsigned)row * (unsigned)(DM * 2) + 8u * (unsigned)lane;
                const float mean = wave_sum_u(s01[r]) * (1.0f / DM); float s2 = 0.f;
#pragma unroll
                for (int i = 0; i < 8; ++i) { v[r][i] = v[r][i] - mean; s2 += (v[r][i][0] * v[r][i][0] + v[r][i][1] * v[r][i][1]) + (v[r][i][2] * v[r][i][2] + v[r][i][3] * v[r][i][3]); }
                const float rstd = 1.0f / sqrtf(wave_sum_u(s2) * (1.0f / DM) + LN_EPS);
#pragma unroll
                for (int i = 0; i < 8; ++i) { const f32x4 gg = *(const LAS f32x4*)(lds + RT_LNW + (256 * i + 4 * lane) * 4), bb = *(const LAS f32x4*)(lds + RT_LNW + 8192 + (256 * i + 4 * lane) * 4);
                    v[r][i] = v[r][i] * rstd * gg + bb;
                    *(u32x2*)(ws + (size_t)((unsigned)WS_H1B + ro + 512u * i)) = (u32x2){cvt_pk(v[r][i][0], v[r][i][1]), cvt_pk(v[r][i][2], v[r][i][3])};
                    *(unsigned*)(ws + (size_t)((unsigned)WS_H1F8 + (ro >> 1) + 256u * i)) = cvt4_fp8_nc(v[r][i][0], v[r][i][1], v[r][i][2], v[r][i][3], F8_ASCALE); } }
            f32x2 acc2[36];
#pragma unroll
            for (int j = 0; j < 36; ++j) acc2[j] = (f32x2){0.f, 0.f};
#pragma unroll
            for (int i = 0; i < 8; ++i) {
                int lq = lane; asm volatile("" : "+v"(lq));
                const LAS float* blk = (const LAS float*)(lds + cbuf * RT_BUF) + lq * RT_BLK;
                f32x4 wA[9], wB[9];
#define RT_RD(dst, kk_) do { _Pragma("unroll") for (int q = 0; q < 9; ++q) dst[q] = *(const LAS f32x4*)(blk + (kk_) * 36 + 4 * q); } while (0)
#define RT_FM(src, kk_) do { const f32x2 hv = (f32x2){v[0][i][kk_], v[1][i][kk_]}; _Pragma("unroll") for (int q = 0; q < 9; ++q) { \
                    acc2[4 * q + 0] += hv * (f32x2){src[q][0], src[q][0]}; acc2[4 * q + 1] += hv * (f32x2){src[q][1], src[q][1]}; \
                    acc2[4 * q + 2] += hv * (f32x2){src[q][2], src[q][2]}; acc2[4 * q + 3] += hv * (f32x2){src[q][3], src[q][3]}; } } while (0)
                RT_RD(wA, 0); __builtin_amdgcn_sched_barrier(0);
                RT_RD(wB, 1); __builtin_amdgcn_sched_barrier(0); RT_FM(wA, 0); __builtin_amdgcn_sched_barrier(0);
                RT_RD(wA, 2); __builtin_amdgcn_sched_barrier(0); RT_FM(wB, 1); __builtin_amdgcn_sched_barrier(0);
                RT_RD(wB, 3); __builtin_amdgcn_sched_barrier(0); RT_FM(wA, 2); __builtin_amdgcn_sched_barrier(0);
                RT_FM(wB, 3);
#undef RT_RD
#undef RT_FM
                RT_BAR();
                cbuf ^= 1;
            }
            const bool odd = (lane & 1) != 0;
            float lgt[36];
#pragma unroll
            for (int j = 0; j < 36; ++j) { const float t0 = wave_sum_u(acc2[j][0]), t1 = wave_sum_u(acc2[j][1]); lgt[j] = odd ? t1 : t0; }
            const int row = ps * 8 + wave * 2 + (lane & 1);
            float gl[4]; float gm = -3.0e38f; int gt = 0;
#pragma unroll
            for (int j = 0; j < 4; ++j) { gl[j] = lgt[j] + a.in[I_BGRP][j]; if (gl[j] > gm) { gm = gl[j]; gt = j; } }
            float gs = 0.f;
#pragma unroll
            for (int j = 0; j < 4; ++j) gs += __expf(gl[j] - gm);
            const float gp = 1.0f / gs;
            float e1 = -3.0e38f, e2 = -3.0e38f; int i1 = 0, i2 = 0;
#pragma unroll
            for (int j = 0; j < 8; ++j) { float ev = 0.f;
#pragma unroll
                for (int gq = 0; gq < 4; ++gq) if (gq == gt) ev = lgt[4 + 8 * gq + j] + a.in[I_BRT][8 * gq + j];
                if (ev > e1) { e2 = e1; i2 = i1; e1 = ev; i1 = j; } else if (ev > e2) { e2 = ev; i2 = j; } }
            const float x2 = __expf(e2 - e1), w1 = gp / (1.0f + x2), w2 = gp * x2 / (1.0f + x2);
            if (lane < 2 && route) {
                unsigned* ctl = (unsigned*)(ws + WS_CTL);
                int* rows = (int*)(ws + WS_ROWS); int* slot_e = (int*)(ws + WS_SLOT); int* slot_p = slot_e + 2 * MT; float* slot_w = (float*)(slot_p + 2 * MT);
                if (p_row >= 0) { rows[p_ea * MT + p_pa] = p_row; rows[p_eb * MT + p_pb] = p_row; slot_p[2 * p_row] = p_pa; slot_p[2 * p_row + 1] = p_pb; }
                const int ea = gt * 8 + i1, eb = gt * 8 + i2;
                p_pa = (int)atomicAdd(ctl + CW_CNT + 64 * ea, 1u); p_pb = (int)atomicAdd(ctl + CW_CNT + 64 * eb, 1u); p_row = row; p_ea = ea; p_eb = eb;
                slot_e[2 * row] = ea; slot_e[2 * row + 1] = eb; slot_w[2 * row] = w1; slot_w[2 * row + 1] = w2;
            }
        }
        if (fresh_lane() < 2 && route && p_row >= 0) {
            int* rows = (int*)(ws + WS_ROWS); int* slot_p = (int*)(ws + WS_SLOT) + 2 * MT;
            rows[p_ea * MT + p_pa] = p_row; rows[p_eb * MT + p_pb] = p_row; slot_p[2 * p_row] = p_pa; slot_p[2 * p_row + 1] = p_pb; }
#undef RT_PF
    } else {
        const int lane = tid & 63, te = tid - 256;
        const float* wg = a.in[I_WGRP]; const float* wr = a.in[I_WRT];
        LAS float* scr = (LAS float*)(lds + RT_SCR + (wave - 4) * 8704);
        f32x4 sa[9];
#define RT_LOADW(dst, chunk) do { const int k_ = (chunk) * 256 + te; dst[0] = *(const f32x4*)(wg + (size_t)k_ * 4); _Pragma("unroll") for (int j_ = 0; j_ < 8; ++j_) dst[1 + j_] = *(const f32x4*)(wr + (size_t)k_ * 32 + 4 * j_); } while (0)
#define RT_WRITEW(src, buf) do { LAS float* p_ = (LAS float*)(buf) + (te >> 2) * RT_BLK + (te & 3) * 36; _Pragma("unroll") for (int j_ = 0; j_ < 9; ++j_) *(LAS f32x4*)(p_ + 4 * j_) = src[j_]; } while (0)
        const float* plg = a.in[I_LN1G]; const float* plb = a.in[I_LN1B];
        for (int c = te; c < 1024; c += 256) { const int wh = c >> 9, idx = (c & 511) * 4; *(LAS f32x4*)(lds + RT_LNW + (wh * 2048 + idx) * 4) = *(const f32x4*)((wh ? plb : plg) + idx); }
        RT_LOADW(sa, 0); RT_WRITEW(sa, lds); RT_LOADW(sa, 1);
        const int ge = blockIdx.x * 4 + (wave - 4), NGE = G * 4, NIT = NEXP * EW_E; (void)do_expw;
        int it = ge; f32x4 e0[8], e1[8], e2[8];
#define EW_LOAD(dst, item) do { const int it_ = (item) < NIT ? (item) : NIT - 1; size_t ldw_; const float* p_ = ew_src(a, it_, lane, ldw_); _Pragma("unroll") for (int i_ = 0; i_ < 8; ++i_) dst[i_] = __builtin_nontemporal_load((const f32x4*)(p_ + (size_t)(8 * i_) * ldw_)); } while (0)
#define EW_STEPX(cur, fre) do { EW_LOAD(fre, it + 2 * NGE); ew_store(a, it < NIT ? it : NIT - 1, cur, scr, lane); it += NGE; } while (0)
        EW_LOAD(e0, it); EW_LOAD(e1, it + NGE);
        RT_BAR();
        int cbuf = 0;
        for (int ps = blockIdx.x; ps < npass; ps += G) {
#pragma unroll
            for (int i = 0; i < 8; ++i) {
                RT_WRITEW(sa, lds + (cbuf ^ 1) * RT_BUF); RT_LOADW(sa, (i + 2) & 7);
                if (i == 0) { EW_STEPX(e0, e2); EW_STEPX(e1, e0); } else if (i == 1) { EW_STEPX(e2, e1); } else if (i == 2) { EW_STEPX(e0, e2); EW_STEPX(e1, e0); } else if (i == 3) { EW_STEPX(e2, e1); }
                else if (i == 4) { EW_STEPX(e0, e2); EW_STEPX(e1, e0); } else if (i == 5) { EW_STEPX(e2, e1); } else if (i == 6) { EW_STEPX(e0, e2); EW_STEPX(e1, e0); } else { EW_STEPX(e2, e1); }
                RT_BAR();
                cbuf ^= 1;
            }
        }
        while (it < NIT) { EW_STEPX(e0, e2); EW_STEPX(e1, e0); EW_STEPX(e2, e1); }
#undef RT_LOADW
#undef RT_WRITEW
#undef EW_STEPX
#undef EW_LOAD
    }
    __syncthreads();
}

template <int NT> __device__ __forceinline__ void ln1_rows(const Args& a, int tid, int row0) {
    unsigned char* ws = a.ws; const int lane = tid & 63, wave = tid >> 6;
    f32x4 gg[8], bb[8];
#pragma unroll
    for (int i = 0; i < 8; ++i) { gg[i] = *(const f32x4*)(a.in[I_LN1G] + 256 * i + 4 * lane); bb[i] = *(const f32x4*)(a.in[I_LN1B] + 256 * i + 4 * lane); }
    const unsigned rbase = (unsigned)(row0 + wave * (2 * NT)) * (unsigned)(DM * 2) + 8u * (unsigned)lane;
    u32x2 pf[2][8];
#define RB_PF(t_) do { _Pragma("unroll") for (int r_ = 0; r_ < 2; ++r_) _Pragma("unroll") for (int i_ = 0; i_ < 8; ++i_) pf[r_][i_] = *(const u32x2*)(ws + (size_t)((unsigned)WS_PRE1 + rbase + (unsigned)(2 * (t_) + r_) * (unsigned)(DM * 2) + 512u * i_)); } while (0)
    RB_PF(0);
#pragma unroll 1
    for (int t = 0; t < NT; ++t) {
        f32x4 v[2][8]; float s01[2];
#pragma unroll
        for (int r = 0; r < 2; ++r) { float s = 0.f;
#pragma unroll
            for (int i = 0; i < 8; ++i) { const u32x2 pw = pf[r][i];
                v[r][i] = (f32x4){__uint_as_float(pw.x << 16), __uint_as_float(pw.x & 0xffff0000u), __uint_as_float(pw.y << 16), __uint_as_float(pw.y & 0xffff0000u)};
                s += (v[r][i][0] + v[r][i][1]) + (v[r][i][2] + v[r][i][3]); }
            s01[r] = s; }
        if (t + 1 < NT) RB_PF(t + 1);
#pragma unroll
        for (int r = 0; r < 2; ++r) { const unsigned ro = rbase + (unsigned)(2 * t + r) * (unsigned)(DM * 2);
            const float mean = wave_sum_u(s01[r]) * (1.0f / DM); float s2 = 0.f;
#pragma unroll
            for (int i = 0; i < 8; ++i) { v[r][i] = v[r][i] - mean; s2 += (v[r][i][0] * v[r][i][0] + v[r][i][1] * v[r][i][1]) + (v[r][i][2] * v[r][i][2] + v[r][i][3] * v[r][i][3]); }
            const float rstd = 1.0f / sqrtf(wave_sum_u(s2) * (1.0f / DM) + LN_EPS);
#pragma unroll
            for (int i = 0; i < 8; ++i) { const f32x4 h = v[r][i] * rstd * gg[i] + bb[i];
                *(u32x2*)(ws + (size_t)((unsigned)WS_H1B + ro + 512u * i)) = (u32x2){cvt_pk(h[0], h[1]), cvt_pk(h[2], h[3])};
                *(unsigned*)(ws + (size_t)((unsigned)WS_H1F8 + (ro >> 1) + 256u * i)) = cvt4_fp8_nc(h[0], h[1], h[2], h[3], F8_ASCALE); } } }
#undef RB_PF
}
__device__ __forceinline__ void router_choose(const Args& a, LAS unsigned char* lds, int tid, int row0) {
    unsigned char* ws = a.ws;
    LAS unsigned* lcnt = (LAS unsigned*)lds; LAS unsigned* lbase = lcnt + 32;
    __syncthreads();
    if (tid < 32) lcnt[tid] = 0u;
    __syncthreads();
    int ea = 0, eb = 0, la = 0, lb = 0; float w1 = 0.f, w2 = 0.f;
    if (tid < 64) { const int row = row0 + tid; const float* LGP = (const float*)(ws + WS_LGP);
        float lgt[36];
#pragma unroll
        for (int j = 0; j < 36; ++j) lgt[j] = 0.f;
#pragma unroll 1
        for (int ks = 0; ks < 4; ++ks) { const float* L = LGP + ((size_t)ks * MT + row) * 72;
#pragma unroll
            for (int q = 0; q < 9; ++q) { const f32x4 hi = *(const f32x4*)(L + 4 * q), lo = *(const f32x4*)(L + 36 + 4 * q);
                lgt[4 * q] += hi[0] + lo[0]; lgt[4 * q + 1] += hi[1] + lo[1]; lgt[4 * q + 2] += hi[2] + lo[2]; lgt[4 * q + 3] += hi[3] + lo[3]; } }
        float gl[4]; float gm = -3.0e38f; int gt = 0;
#pragma unroll
        for (int j = 0; j < 4; ++j) { gl[j] = lgt[j] + a.in[I_BGRP][j]; if (gl[j] > gm) { gm = gl[j]; gt = j; } }
        float gs = 0.f;
#pragma unroll
        for (int j = 0; j < 4; ++j) gs += __expf(gl[j] - gm);
        const float gp = 1.0f / gs;
        float e1 = -3.0e38f, e2 = -3.0e38f; int i1 = 0, i2 = 0;
#pragma unroll
        for (int j = 0; j < 8; ++j) { float ev = 0.f;
#pragma unroll
            for (int gq = 0; gq < 4; ++gq) if (gq == gt) ev = lgt[4 + 8 * gq + j] + a.in[I_BRT][8 * gq + j];
            if (ev > e1) { e2 = e1; i2 = i1; e1 = ev; i1 = j; } else if (ev > e2) { e2 = ev; i2 = j; } }
        const float x2 = __expf(e2 - e1); w1 = gp / (1.0f + x2); w2 = gp * x2 / (1.0f + x2);
        ea = gt * 8 + i1; eb = gt * 8 + i2;
        la = (int)__hip_atomic_fetch_add(lcnt + ea, 1u, __ATOMIC_RELAXED, __HIP_MEMORY_SCOPE_WORKGROUP); lb = (int)__hip_atomic_fetch_add(lcnt + eb, 1u, __ATOMIC_RELAXED, __HIP_MEMORY_SCOPE_WORKGROUP);
    }
    __syncthreads();
    if (tid < 32) { const unsigned n = lcnt[tid]; lbase[tid] = n ? atomicAdd((unsigned*)(ws + WS_CTL) + CW_CNT + 64 * tid, n) : 0u; }
    __syncthreads();
    if (tid < 64) { const int row = row0 + tid;
        int* rows = (int*)(ws + WS_ROWS); int* slot_e = (int*)(ws + WS_SLOT); int* slot_p = slot_e + 2 * MT; float* slot_w = (float*)(slot_p + 2 * MT);
        const int pa = (int)lbase[ea] + la, pb = (int)lbase[eb] + lb;
        rows[ea * MT + pa] = row; rows[eb * MT + pb] = row;
        slot_e[2 * row] = ea; slot_e[2 * row + 1] = eb; slot_p[2 * row] = pa; slot_p[2 * row + 1] = pb; slot_w[2 * row] = w1; slot_w[2 * row + 1] = w2;
    }
    __syncthreads();
}

__device__ __forceinline__ void load_tile_base(const Args& a, LAS int* tb, int tid) {
    const unsigned* ctl = (const unsigned*)(a.ws + WS_CTL);
    if (tid == 0) { int acc = 0; for (int e = 0; e < NEXP; ++e) { tb[e] = acc; acc += ((int)ctl[CW_CNT + 64 * e] + 255) >> 8; } tb[NEXP] = acc; }
    __syncthreads();
}

__device__ __forceinline__ void phase_gather(const Args& a, LAS unsigned char* lds, int tid, int G) {
    unsigned char* ws = a.ws; const int lane = tid & 63, wave = tid >> 6;
    LAS int* tb = (LAS int*)lds;
    load_tile_base(a, tb, tid);
    unsigned* ctl = (unsigned*)(ws + WS_CTL);
    const int NT = tb[NEXP];
    if (blockIdx.x == 0) { if (tid == 0) ctl[CW_NT] = (unsigned)NT;
        if (tid < NEXP) for (int t = tb[tid]; t < tb[tid + 1]; ++t) ctl[CW_TILEE + t] = (unsigned)tid;
        if (tid <= NEXP) ctl[CW_TBASE + tid] = (unsigned)tb[tid]; }
    const int* rows = (const int*)(ws + WS_ROWS); const bf16_t* H1B = (const bf16_t*)(ws + WS_H1B); bf16_t* XG = (bf16_t*)(ws + WS_XG);
    for (int r = blockIdx.x * NWAVES + wave; r < NT * 256; r += G * NWAVES) {
        const int tile = r >> 8; int e = 0;
        for (int j = 1; j < NEXP; ++j) if (tb[j] <= tile) e = j;
        const int pos = r - tb[e] * 256; const int cnt = (int)ctl[CW_CNT + 64 * e];
        u32x4 v[4];
        if (pos < cnt) { const int tok = rows[e * MT + pos];
#pragma unroll
            for (int i = 0; i < 4; ++i) v[i] = *(const u32x4*)(H1B + (size_t)tok * DM + 512 * i + 8 * lane); }
        else {
#pragma unroll
            for (int i = 0; i < 4; ++i) v[i] = (u32x4){0u, 0u, 0u, 0u}; }
#pragma unroll
        for (int i = 0; i < 4; ++i) *(u32x4*)(XG + (size_t)r * DM + 512 * i + 8 * lane) = v[i];
    }
}

struct FinSlots { int r0, r1; float w0, w1; };
__device__ __forceinline__ void fin_slots(const Args& a, int row, const LAS int* tb, FinSlots& S) {
    unsigned char* ws = a.ws;
    const int* slot_e = (const int*)(ws + WS_SLOT); const int* slot_p = slot_e + 2 * MT; const float* slot_w = (const float*)(slot_p + 2 * MT);
    const int e0 = slot_e[2 * row], e1 = slot_e[2 * row + 1];
    S.r0 = tb[e0] * 256 + slot_p[2 * row]; S.r1 = tb[e1] * 256 + slot_p[2 * row + 1]; S.w0 = slot_w[2 * row]; S.w1 = slot_w[2 * row + 1];
}
__device__ __forceinline__ void fin_data(const Args& a, int row, int lane, const FinSlots& S, u32x2 (&hw)[8], unsigned (&ya)[8], unsigned (&yb)[8]) {
    unsigned char* ws = a.ws;
    const bf16_t* H1B = (const bf16_t*)(ws + WS_H1B) + (size_t)row * DM; const unsigned char* Y = ws + WS_Y;
#pragma unroll
    for (int i = 0; i < 8; ++i) { hw[i] = *(const u32x2*)(H1B + 256 * i + 4 * lane); ya[i] = *(const unsigned*)(Y + (size_t)S.r0 * DM + 256 * i + 4 * lane); yb[i] = *(const unsigned*)(Y + (size_t)S.r1 * DM + 256 * i + 4 * lane); }
}
__device__ __forceinline__ void fin_compute(const Args& a, int row, int lane, float w0_, float w1_, const u32x2 (&hw)[8], const unsigned (&ya)[8], const unsigned (&yb)[8]) {
    const float w0 = w0_ * (1.0f / F8_YSCALE), w1 = w1_ * (1.0f / F8_YSCALE);
    f32x4 v[8]; float s = 0.f;
#pragma unroll
    for (int i = 0; i < 8; ++i) {
        const f32x4 hv = {__uint_as_float(hw[i].x << 16), __uint_as_float(hw[i].x & 0xffff0000u), __uint_as_float(hw[i].y << 16), __uint_as_float(hw[i].y & 0xffff0000u)};
        const f32x4 fa = fp8x4_f32(ya[i]), fb = fp8x4_f32(yb[i]);
        v[i] = hv * DN_ALPHA + fa * w0 + fb * w1; s += (v[i][0] + v[i][1]) + (v[i][2] + v[i][3]); }
    const float mean = wave_sum(s) * (1.0f / DM); float s2 = 0.f;
#pragma unroll
    for (int i = 0; i < 8; ++i) { v[i] = v[i] - mean; s2 += (v[i][0] * v[i][0] + v[i][1] * v[i][1]) + (v[i][2] * v[i][2] + v[i][3] * v[i][3]); }
    const float rstd = 1.0f / sqrtf(wave_sum(s2) * (1.0f / DM) + LN_EPS);
    float* O = a.out + (size_t)row * DM;
#pragma unroll
    for (int i = 0; i < 8; ++i) { const f32x4 g = *(const f32x4*)(a.in[I_LN2G] + 256 * i + 4 * lane), bb = *(const f32x4*)(a.in[I_LN2B] + 256 * i + 4 * lane);
        *(f32x4*)(O + 256 * i + 4 * lane) = v[i] * rstd * g + bb; }
}
__device__ __forceinline__ void phase_final(const Args& a, int tid, int G, const LAS int* tb) {
    const int lane = tid & 63, wave = tid >> 6, gw = blockIdx.x * NWAVES + wave, NGW = G * NWAVES;
    if (gw >= MT) return;
    FinSlots SA, SB; u32x2 hA[8], hB[8]; unsigned aA[8], bA[8], aB[8], bB[8];
    int row = gw;
    fin_slots(a, row, tb, SA); fin_data(a, row, lane, SA, hA, aA, bA);
    if (row + NGW < MT) fin_slots(a, row + NGW, tb, SB);
    for (;;) {
        const int r1 = row + NGW, r2 = row + 2 * NGW;
        if (r1 < MT) fin_data(a, r1, lane, SB, hB, aB, bB);
        const float w0 = SA.w0, w1 = SA.w1;
        if (r2 < MT) fin_slots(a, r2, tb, SA);
        fin_compute(a, row, lane, w0, w1, hA, aA, bA);
        if (r1 >= MT) break;
        const int r3 = row + 3 * NGW;
        if (r2 < MT) fin_data(a, r2, lane, SA, hA, aA, bA);
        const float x0 = SB.w0, x1 = SB.w1;
        if (r3 < MT) fin_slots(a, r3, tb, SB);
        fin_compute(a, r1, lane, x0, x1, hB, aB, bB);
        if (r2 >= MT) break;
        row = r2;
    }
}

namespace fa {
constexpr int D = 128, NW = 8, QBLK = 32, KVBLK = 64, LDX = 1024;
constexpr float SCALE = 0.088388347648318440f, THR = 8.f;
constexpr size_t SHM_V = KVBLK * D * 2, SHM_K = KVBLK * D * 2, SHM_ATTN = 2 * SHM_V + 2 * SHM_K + NW * 64 * 4;
using s16x4 = __attribute__((ext_vector_type(4))) short;
#define KSWZ(row, colB) ((row) * 256 + ((colB) ^ (((row) & 7) << 4)))
#define SBAR() __builtin_amdgcn_sched_barrier(0)
__device__ __forceinline__ int crow(int r, int hi) { return (r & 3) + 8 * (r >> 2) + 4 * hi; }

__device__ __forceinline__ void partialSM(f32x16& p0, f32x16& p1, float& m_reg, float& mn, float& alpha, float tsub) {
  constexpr float C = SCALE * 1.4426950408889634f;
  float pmax = p0[0];
#pragma unroll
  for (int r = 1; r < 16; ++r) pmax = fmaxf(pmax, p0[r]);
#pragma unroll
  for (int r = 0; r < 16; ++r) pmax = fmaxf(pmax, p1[r]);
  pmax -= tsub;
  { auto rr = __builtin_amdgcn_permlane32_swap(__float_as_uint(pmax), __float_as_uint(pmax), false, false);
    pmax = fmaxf(__uint_as_float(rr[0]), __uint_as_float(rr[1])); }
  if (__builtin_expect(__all(pmax - m_reg <= THR / SCALE), 1)) { mn = m_reg; alpha = 1.f; }
  else { mn = fmaxf(m_reg, pmax); alpha = __builtin_amdgcn_exp2f((m_reg - mn) * C); m_reg = mn; }
  float mnC = -(mn + tsub) * C;
#pragma unroll
  for (int r = 0; r < 16; ++r) p0[r] = fmaf(p0[r], C, mnC);
#pragma unroll
  for (int r = 0; r < 16; ++r) p1[r] = fmaf(p1[r], C, mnC);
#pragma unroll
  for (int r = 0; r < 16; ++r) p0[r] = __builtin_amdgcn_exp2f(p0[r]);
}
__device__ __forceinline__ void finishSM(f32x16& p0, f32x16& p1, float alpha, float& l_reg, bf16x8& pa0, bf16x8& pa1, bf16x8& pa2, bf16x8& pa3) {
#pragma unroll
  for (int r = 0; r < 16; ++r) p1[r] = __builtin_amdgcn_exp2f(p1[r]);
  float ps = 0;
#pragma unroll
  for (int r = 0; r < 16; ++r) ps += p0[r];
#pragma unroll
  for (int r = 0; r < 16; ++r) ps += p1[r];
  { auto rr = __builtin_amdgcn_permlane32_swap(__float_as_uint(ps), __float_as_uint(ps), false, false);
    ps = __uint_as_float(rr[0]) + __uint_as_float(rr[1]); }
  l_reg = l_reg * alpha + ps;
#define PK4(P, BASE, OUT) do { unsigned a0 = cvt_pk(P[BASE + 0], P[BASE + 1]), a1 = cvt_pk(P[BASE + 2], P[BASE + 3]);   \
    unsigned b0 = cvt_pk(P[BASE + 4], P[BASE + 5]), b1 = cvt_pk(P[BASE + 6], P[BASE + 7]);                              \
    auto r0 = __builtin_amdgcn_permlane32_swap(a0, b0, false, false); auto r1 = __builtin_amdgcn_permlane32_swap(a1, b1, false, false); \
    u32x4 w = {r0[0], r1[0], r0[1], r1[1]}; OUT = *reinterpret_cast<bf16x8*>(&w); } while (0)
  PK4(p0, 0, pa0); PK4(p0, 8, pa1); PK4(p1, 0, pa2); PK4(p1, 8, pa3);
#undef PK4
}
__device__ __forceinline__ void qkt(f32x16& p0, f32x16& p1, const char* Ks, const bf16x8* qr, int r32, int hi) {
  p0 = f32x16{}; p1 = f32x16{};
#pragma unroll
  for (int d0 = 0; d0 < 8; ++d0) { int cb = (d0 * 16 + hi * 8) * 2;
    bf16x8 b0 = *reinterpret_cast<const bf16x8*>(Ks + KSWZ(r32, cb));
    bf16x8 b1 = *reinterpret_cast<const bf16x8*>(Ks + KSWZ(32 + r32, cb));
    p0 = __builtin_amdgcn_mfma_f32_32x32x16_bf16(b0, qr[d0], p0, 0, 0, 0);
    p1 = __builtin_amdgcn_mfma_f32_32x32x16_bf16(b1, qr[d0], p1, 0, 0, 0); }
}
__device__ __forceinline__ float bfi_f(int t, float s, unsigned neg) { unsigned o; asm("v_bfi_b32 %0, %1, %2, %3" : "=v"(o) : "v"(t), "v"(s), "s"(neg)); return __uint_as_float(o); }
__device__ __forceinline__ void mask_bias(f32x16& p0, f32x16& p1, u32x2 mw, float dq, float slr, int hi) {
  const int w0 = (int)(mw.x >> (4 * hi)), w1 = (int)(mw.y >> (4 * hi));
  const unsigned NEG = 0xf149f2cau;
#pragma unroll
  for (int r = 0; r < 16; ++r) { const int c = (r & 3) + 8 * (r >> 2);
    const float d0 = dq - (float)c, d1 = dq - (float)(32 + c);
    const float s0 = fmaf(-slr, fabsf(d0), p0[r]), s1 = fmaf(-slr, fabsf(d1), p1[r]);
    p0[r] = bfi_f(__builtin_amdgcn_sbfe(w0, c, 1), s0, NEG); p1[r] = bfi_f(__builtin_amdgcn_sbfe(w1, c, 1), s1, NEG); }
}
__device__ __forceinline__ void mask_bias_fast(f32x16& p0, f32x16& p1, u32x2 mw, float slr, int hi) {
  const int w0 = (int)(mw.x >> (4 * hi)), w1 = (int)(mw.y >> (4 * hi));
  const unsigned NEG = 0xf149f2cau;
#pragma unroll
  for (int r = 0; r < 16; ++r) { const int c = (r & 3) + 8 * (r >> 2);
    const float s0 = fmaf(slr, (float)c, p0[r]), s1 = fmaf(slr, (float)(32 + c), p1[r]);
    p0[r] = bfi_f(__builtin_amdgcn_sbfe(w0, c, 1), s0, NEG); p1[r] = bfi_f(__builtin_amdgcn_sbfe(w1, c, 1), s1, NEG); }
}
__device__ __forceinline__ int v_st(int k, int c) { const int kk = (k & ~0xC) | ((k & 4) << 1) | ((k & 8) >> 1); return ((kk >> 3) * 4 + (c >> 5)) * 512 + ((kk & 7) * 32 + (c & 31)) * 2; }
__device__ __forceinline__ int v_rd_base(int lane) { return ((lane & 3) << 3) | (((lane >> 2) & 3) << 6) | (((lane >> 4) & 1) << 5) | (((lane >> 5) & 1) << 8); }
constexpr int v_rd_off(int d0, int ks, int half) { return d0 * 512 + ks * 4096 + half * 2048; }
template <int OFF> __device__ __forceinline__ s16x4 tr_read(int vb) {
  s16x4 r; asm volatile("ds_read_b64_tr_b16 %0, %1 offset:%2" : "=&v"(r) : "v"(vb), "i"(OFF) : "memory"); return r;
}
template <int D0> __device__ __forceinline__ void pv_one(f32x16& od, int vb, bf16x8 pa0, bf16x8 pa1, bf16x8 pa2, bf16x8 pa3) {
  const s16x4 l0 = tr_read<v_rd_off(D0, 0, 0)>(vb), h0 = tr_read<v_rd_off(D0, 0, 1)>(vb), l1 = tr_read<v_rd_off(D0, 1, 0)>(vb), h1 = tr_read<v_rd_off(D0, 1, 1)>(vb);
  const s16x4 l2 = tr_read<v_rd_off(D0, 2, 0)>(vb), h2 = tr_read<v_rd_off(D0, 2, 1)>(vb), l3 = tr_read<v_rd_off(D0, 3, 0)>(vb), h3 = tr_read<v_rd_off(D0, 3, 1)>(vb);
  asm volatile("s_waitcnt lgkmcnt(0)" ::: "memory"); SBAR();
#define PK(L, H) (bf16x8){L[0], L[1], L[2], L[3], H[0], H[1], H[2], H[3]}
  od = __builtin_amdgcn_mfma_f32_32x32x16_bf16(pa0, PK(l0, h0), od, 0, 0, 0);
  od = __builtin_amdgcn_mfma_f32_32x32x16_bf16(pa1, PK(l1, h1), od, 0, 0, 0);
  od = __builtin_amdgcn_mfma_f32_32x32x16_bf16(pa2, PK(l2, h2), od, 0, 0, 0);
  od = __builtin_amdgcn_mfma_f32_32x32x16_bf16(pa3, PK(l3, h3), od, 0, 0, 0);
#undef PK
}
__device__ __forceinline__ void pv_d0(f32x16* o, int vb, bf16x8 pa0, bf16x8 pa1, bf16x8 pa2, bf16x8 pa3) {
  pv_one<0>(o[0], vb, pa0, pa1, pa2, pa3); pv_one<1>(o[1], vb, pa0, pa1, pa2, pa3); pv_one<2>(o[2], vb, pa0, pa1, pa2, pa3); pv_one<3>(o[3], vb, pa0, pa1, pa2, pa3);
}

#define FA_GAS __attribute__((address_space(1)))
__device__ __forceinline__ void attn_block(const bf16_t* Qb_, const bf16_t* Kh_, const bf16_t* Vh_, const unsigned* maskrow_,
                                           bf16_t* Ob_, int NT, int qpos0, float slr, char* lds) {
  const FA_GAS bf16_t* Qb = (const FA_GAS bf16_t*)Qb_; const FA_GAS bf16_t* Kh = (const FA_GAS bf16_t*)Kh_; const FA_GAS bf16_t* Vh = (const FA_GAS bf16_t*)Vh_;
  const FA_GAS unsigned* maskrow = (const FA_GAS unsigned*)maskrow_; FA_GAS unsigned char* Ob = (FA_GAS unsigned char*)Ob_;
  int tid_ = cur_tid((const LAS unsigned char*)lds); asm volatile("" : "+v"(tid_));
  const int tid = tid_, wid = tid >> 6, lane = tid & 63, r32 = lane & 31, hi = lane >> 5;
  char* V_lds = lds; char* K_lds = lds + 2 * SHM_V;
  float* wsm = (float*)(lds + 2 * SHM_V + 2 * SHM_K) + wid * 64; float* li_l = wsm; float* al_l = wsm + 32;
  float m_reg = -1e30f, l_reg = 0; f32x16 o[4] = {}; bf16x8 qr[8];
  const FA_GAS bf16_t* Qw = Qb + (long)(wid * QBLK + r32) * LDX + hi * 8;
#pragma unroll
  for (int d0 = 0; d0 < 8; ++d0) qr[d0] = *reinterpret_cast<const FA_GAS bf16x8*>(Qw + d0 * 16);
  const unsigned moff = (unsigned)(wid * QBLK + r32) * 256u;
  const float qposf = (float)(qpos0 + wid * QBLK + r32 - 4 * hi);
  const int sr = tid >> 4, sc = (tid & 15) * 8, vst0 = v_st(sr, sc), vst1 = v_st(32 + sr, sc);
  const int vb0 = (int)(uintptr_t)V_lds + v_rd_base(lane);
  constexpr int SDEPTH = 1;
  struct { bf16x8 vs0, vs1, ks0, ks1; } sr_[SDEPTH];
#define KOFF(j) ((NT - 1 - (j)) * KVBLK)
#define SLOAD(i, k0) do { sr_[i].vs0 = *reinterpret_cast<const FA_GAS bf16x8*>(&Vh[(long)((k0) + sr) * LDX + sc]); sr_[i].vs1 = *reinterpret_cast<const FA_GAS bf16x8*>(&Vh[(long)((k0) + 32 + sr) * LDX + sc]); \
    sr_[i].ks0 = *reinterpret_cast<const FA_GAS bf16x8*>(&Kh[(long)((k0) + sr) * LDX + sc]); sr_[i].ks1 = *reinterpret_cast<const FA_GAS bf16x8*>(&Kh[(long)((k0) + 32 + sr) * LDX + sc]); } while (0)
#define SWRITE(b, i) do { *(bf16x8*)(V_lds + (b) * SHM_V + vst0) = sr_[i].vs0;          \
    *(bf16x8*)(V_lds + (b) * SHM_V + vst1) = sr_[i].vs1; int kc = sc * 2;               \
    *(bf16x8*)(K_lds + (b) * SHM_K + KSWZ(sr, kc)) = sr_[i].ks0;                       \
    *(bf16x8*)(K_lds + (b) * SHM_K + KSWZ(32 + sr, kc)) = sr_[i].ks1; } while (0)
#define SWAIT() do { if constexpr (SDEPTH == 2) asm volatile("s_waitcnt vmcnt(4)" ::: "memory"); else asm volatile("s_waitcnt vmcnt(0)" ::: "memory"); } while (0)
#define RESC(a) do { if (__any((a) < 1.f)) { if (hi == 0) al_l[r32] = (a); asm volatile("s_waitcnt lgkmcnt(0)" ::: "memory"); \
    _Pragma("unroll") for (int d = 0; d < 4; ++d) _Pragma("unroll") for (int r = 0; r < 16; ++r) o[d][r] *= al_l[crow(r, hi)]; } } while (0)
#define MASKW(j) (*reinterpret_cast<const FA_GAS u32x2*>(maskrow + (moff + 2u * (unsigned)(NT - 1 - (j)))))
#define MB(P0, P1, j, MW) mask_bias(P0, P1, MW, qposf - (float)KOFF(j), slr, hi)
#define TS(j) 0.f
  f32x16 pA0, pA1, pB0, pB1; float mnA, mnB, alA, alB; bf16x8 pa0, pa1, pa2, pa3;
  constexpr int SE = 0, SO = SDEPTH - 1;
  SLOAD(SE, KOFF(0)); asm volatile("s_waitcnt vmcnt(0)" ::: "memory"); SWRITE(0, SE); __syncthreads();
  { qkt(pA0, pA1, K_lds, qr, r32, hi); MB(pA0, pA1, 0, MASKW(0)); } partialSM(pA0, pA1, m_reg, mnA, alA, TS(0));
  SLOAD(SO, KOFF(1)); if constexpr (SDEPTH == 2) { if (2 < NT) SLOAD(SE, KOFF(2)); }
  SWAIT(); SWRITE(1, SO); __syncthreads();
  for (int j = 1; j + 1 < NT; j += 2) {
    SBAR(); { qkt(pB0, pB1, K_lds + SHM_K, qr, r32, hi); MB(pB0, pB1, j, MASKW(j)); }
    finishSM(pA0, pA1, alA, l_reg, pa0, pa1, pa2, pa3); SBAR();
    SLOAD(SO, KOFF(j + SDEPTH)); SBAR();
    pv_d0(o, vb0, pa0, pa1, pa2, pa3); partialSM(pB0, pB1, m_reg, mnB, alB, TS(j));
    __syncthreads(); SWAIT(); SWRITE(0, SE);
    RESC(alB); __syncthreads();
    SBAR(); { qkt(pA0, pA1, K_lds, qr, r32, hi); MB(pA0, pA1, j + 1, MASKW(j + 1)); }
    finishSM(pB0, pB1, alB, l_reg, pa0, pa1, pa2, pa3); SBAR();
    if (SDEPTH == 1 || j + 3 < NT) SLOAD(SE, KOFF(j + 1 + SDEPTH)); SBAR();
    pv_d0(o, vb0 + (int)SHM_V, pa0, pa1, pa2, pa3); partialSM(pA0, pA1, m_reg, mnA, alA, TS(j + 1));
    __syncthreads(); SWAIT(); SWRITE(1, SO);
    RESC(alA); __syncthreads();
  }
  SBAR(); { qkt(pB0, pB1, K_lds + SHM_K, qr, r32, hi); MB(pB0, pB1, NT - 1, MASKW(NT - 1)); }
  finishSM(pA0, pA1, alA, l_reg, pa0, pa1, pa2, pa3); SBAR();
  pv_d0(o, vb0, pa0, pa1, pa2, pa3); partialSM(pB0, pB1, m_reg, mnB, alB, TS(NT - 1));
  __syncthreads(); RESC(alB);
  finishSM(pB0, pB1, alB, l_reg, pa0, pa1, pa2, pa3); SBAR();
  pv_d0(o, vb0 + (int)SHM_V, pa0, pa1, pa2, pa3);
  if (hi == 0) li_l[r32] = l_reg; asm volatile("s_waitcnt lgkmcnt(0)" ::: "memory");
  float rli[16];
#pragma unroll
  for (int r = 0; r < 16; ++r) rli[r] = __builtin_amdgcn_rcpf(li_l[crow(r, hi)]);
  FA_GAS unsigned char* Ow = Ob + (long)(wid * QBLK) * LDX;
#pragma unroll
  for (int r = 0; r < 16; ++r) { int orow = crow(r, hi);
    *(FA_GAS unsigned*)(Ow + (long)orow * LDX + 4 * r32) = cvt4_fp8(o[0][r] * rli[r], o[1][r] * rli[r], o[2][r] * rli[r], o[3][r] * rli[r], F8_ASCALE); }
  __syncthreads();
#undef KOFF
#undef SLOAD
#undef SWRITE
#undef SWAIT
#undef RESC
#undef MASKW
#undef MB
#undef TS
}
#undef KSWZ
#undef SBAR
}

__device__ __forceinline__ void phase_attention(const Args& a, char* lds, int G, int bid, int h_lo, int h_hi) {
    unsigned char* ws = uni_ptr(a.ws);
    const bf16_t* BQ = (const bf16_t*)(ws + WS_BQ); const bf16_t* BK = (const bf16_t*)(ws + WS_BK); const bf16_t* BV = (const bf16_t*)(ws + WS_BV);
    const unsigned* MASK = (const unsigned*)(ws + WS_MASK); unsigned char* BRB = ws + WS_BRB;
    const int bx = bid; const int vcu = (G % 8 == 0) ? (bx % 8) * (G / 8) + bx / 8 : bx;
    for (int p0 = vcu; p0 < 256; p0 += G) { const int p = __builtin_amdgcn_readfirstlane(p0);
        const int b = p >> 7, h = (p >> 4) & 7, x = p & 15;
        const float slr = uni_f((1.0f / fa::SCALE) / (float)(2 << h));
#pragma unroll 1
        for (int half = h_lo; half < h_hi; ++half) { const int qb = half ? 31 - x : x; const size_t row0 = (size_t)b * SEQ + qb * 256;
            fa::attn_block(uni_ptr(BQ + row0 * 1024 + h * 128), uni_ptr(BK + (size_t)b * SEQ * 1024 + h * 128), uni_ptr(BV + (size_t)b * SEQ * 1024 + h * 128),
                           uni_ptr(MASK + row0 * 256), (bf16_t*)uni_ptr(BRB + row0 * 1024 + h * 128), 4 * (qb + 1), qb * 256, slr, lds); }
    }
}


constexpr int NPH = 13;
#ifndef REPS
#define REPS 1,1,1,1,1,1,1,1,1,1,1,1,1,1,1,1
#endif
constexpr int REP[16] = {REPS};
__global__ void __launch_bounds__(NTHR, 2) mk_fwd(Args a) {
    extern __shared__ __attribute__((aligned(16))) unsigned char lds_raw[];
    LAS unsigned char* lds = (LAS unsigned char*)lds_raw;
    cg::grid_group grid = cg::this_grid();
    const int G = gridDim.x;
#define FRESH_TID() int tid = cur_tid(lds); asm volatile("" : "+v"(tid)); const int lane = tid & 63, wave = tid >> 6; (void)lane; (void)wave

    unsigned char* ws = a.ws;
    const int lo = a.ph_lo, hi = a.ph_hi;
#define IN(k) (lo <= (k) && (k) < hi)
    if (lo < 0) grid.sync();
    if (threadIdx.x == 0) { ((volatile LAS unsigned*)(lds + LDS_BARST))[0] = 0u; ((volatile LAS unsigned*)(lds + LDS_BARST))[1] = 0u; }
    if ((threadIdx.x & 63) == 0) ((volatile LAS unsigned char*)(lds + LDS_WTAB))[(unsigned)__builtin_amdgcn_s_getreg((5 << 11) | 4) & 63u] = (unsigned char)(threadIdx.x >> 6);
    __syncthreads();
    (void)xcd_barrier_post((unsigned*)(ws + WS_CTL) + CW_BAR, (volatile LAS unsigned*)(lds + LDS_BARST));
    int bid = blockIdx.x;
    if (lo == 0 && hi == NPH && (G % 8) == 0) {
        if (threadIdx.x == 0) { const unsigned x = xb_xcc_id(); const unsigned r = atomicAdd((unsigned*)(ws + WS_CTL) + CW_TICKET + 64 * x, 1u); ((volatile LAS unsigned*)(lds + LDS_BARST))[2] = r * 8u + (x & 7u); }
    }
#define SEAM(k) do { if (IN(k) && IN((k) + 1)) { { XcdBarrier b_; b_.bar = (unsigned*)(a.ws + WS_CTL) + CW_BAR; b_.x = xb_xcc_id(); b_.st = (volatile LAS unsigned*)(lds + LDS_BARST); xcd_barrier(b_); } } } while (0)

    if (IN(0)) { FRESH_TID(); for (int rp = 0; rp < REP[0]; ++rp) { phase_prologue(a, lds, tid, G); __syncthreads(); } }
    SEAM(0);
    if (lo == 0 && hi == NPH && (G % 8) == 0) {
        const unsigned* bw = (const unsigned*)(ws + WS_CTL) + CW_BAR; bool ok = true;
        for (int j = 0; j < 8; ++j) ok = ok && (__hip_atomic_load(bw + XB_XCNT(j), __ATOMIC_RELAXED, __HIP_MEMORY_SCOPE_AGENT) == (unsigned)(G / 8));
        if (ok) bid = __builtin_amdgcn_readfirstlane((int)((volatile LAS unsigned*)(lds + LDS_BARST))[2]);
    }
    if (IN(1)) { FRESH_TID();
        for (int c8 = tid; c8 < NPROJ_PAD / 2; c8 += NTHR) { const int c = 2 * c8; float b0 = 0.f, b1 = 0.f;
            if (c < 7752) { b0 = a.in[I_BIN][c]; b1 = a.in[I_BIN][c + 1]; } else if (c >= 7936) { b0 = a.in[I_BIN][c - 184]; b1 = a.in[I_BIN][c - 183]; }
            *(LAS unsigned*)(lds + LDS_BIAS + c * 2) = cvt_pk(b0, b1); }
        __syncthreads();
        { const int ZB = (G > 192) ? 192 : 0; if (bid >= ZB) { small_weights(a, lds, tid, bid - ZB, G - ZB); __syncthreads(); } }
        for (int rp = 0; rp < REP[1]; ++rp) {
            { pg8::Gemm g{(const bf16_t*)(ws + WS_XB), (const bf16_t*)(ws + WS_WIN), MT, 3 * 256, DM}; pg8::StaticOrderT<false, 2> S; S.init(MT, 3 * 256, G, bid);
              pg8::EpiProjT<false> E{ws, lds + LDS_BIAS}; pg8::gemm_phase<pg8::EpiProjT<false>, pg8::StaticOrderT<false, 2>, true, true>(lds, g, S, E); }
            { int k1 = DM / 2; asm volatile("" : "+s"(k1));
              pg8::Gemm g{(const bf16_t*)(ws + WS_X8), (const bf16_t*)(ws + WS_WIN8), MT, 44 * 256, k1}; pg8::StaticOrderT<true, 1> S; S.init(MT, 44 * 256, G, bid);
              pg8::EpiProjT<true> E{ws, lds + LDS_BIAS}; pg8::gemm_phase<pg8::EpiProjT<true>, pg8::StaticOrderT<true, 1>, true, true>(lds, g, S, E); } }
}

    SEAM(1);
    if (IN(2)) { FRESH_TID(); hg_fill_lb(a, lds, tid);
        for (int rp = 0; rp < REP[2]; ++rp) for (int u = blockIdx.x; u < 2048; u += G) hgrn1_unit(a, u, lds, tid);
        { int tix = tid; asm volatile("" : "+v"(tix));
        for (int rp = 0; rp < REP[3]; ++rp) for (int k = 0; k * G < MT / 4; ++k) { const int u = k * G + ((k & 1) ? (G - 1 - (int)blockIdx.x) : (int)blockIdx.x); if (u < MT / 4) indexer_unit(a, u, lds, tix); } } }
    SEAM(2);
    if (IN(3)) { { FRESH_TID(); hgrn_scan(a, tid, G); }
        const int sg = (bid >> 3) & 3;
#define P3_STREAM() do { FRESH_TID(); __syncthreads(); expert_stream3(a, lds, tid, (int)blockIdx.x * NWAVES + wave, G * NWAVES); __syncthreads(); } while (0)
        if (sg == 0) { P3_STREAM(); phase_attention(a, (char*)lds_raw, G, bid, 0, 2); }
        else if (sg == 3) { phase_attention(a, (char*)lds_raw, G, bid, 0, 2); P3_STREAM(); }
        else { phase_attention(a, (char*)lds_raw, G, bid, 0, 1); P3_STREAM(); phase_attention(a, (char*)lds_raw, G, bid, 1, 2); } }
    SEAM(3);
    if (IN(4)) { FRESH_TID(); for (int rp = 0; rp < REP[6]; ++rp) { float z[16]; unsigned qq[16], vv[16]; u32x4 stp[4]; u32x2 gwn[4];
            if ((int)blockIdx.x < 2048) hg3_load(a, blockIdx.x, tid, z, qq, vv, stp, gwn);
            hg_fill_lb(a, lds, tid);
            for (int u = blockIdx.x; u < 2048; u += G) hgrn3_unit(a, u, (u + G < 2048) ? u + G : -1, lds, tid, z, qq, vv, stp, gwn); } }
    SEAM(4);
    if (IN(5)) { FRESH_TID(); for (int rp = 0; rp < REP[7]; ++rp) {
        int kb5 = 512; asm volatile("" : "+s"(kb5));
        { pg8::Gemm g{(const bf16_t*)(ws + WS_BRA), (const bf16_t*)(ws + WS_WA), MT, DM, kb5}; pg8::ChainOrder S; S.so.init(MT, DM, G, bid); S.a1 = WS_BRB - WS_BRA; S.b1 = WS_WB - WS_WA;
          pg8::EpiBranchChain E{ws + WS_GATES, ws + WS_MERGED8};
          pg8::gemm_phase<pg8::EpiBranchChain, pg8::ChainOrder, true, true>(lds, g, S, E); } } }
    SEAM(6);
    if (IN(7)) { FRESH_TID(); int kb7 = DM / 2; asm volatile("" : "+s"(kb7));
        pg8::Gemm g{(const bf16_t*)(ws + WS_MERGED8), (const bf16_t*)(ws + WS_WOUT), MT, DM, kb7}; pg8::StaticOrderF8 S; S.init(MT, DM, G, bid);
        pg8::EpiResBf16 E{(bf16_t*)(ws + WS_PRE1), (const bf16_t*)(ws + WS_XB), DN_ALPHA};
        for (int rp = 0; rp < REP[8]; ++rp) pg8::gemm_phase<pg8::EpiResBf16, pg8::StaticOrderF8, true, true>(lds, g, S, E); }
    SEAM(7);
#define P8_SYNC() do { XcdBarrier b_; b_.bar = (unsigned*)(a.ws + WS_CTL) + CW_BAR; b_.x = xb_xcc_id(); b_.st = (volatile LAS unsigned*)(lds + LDS_BARST); xcd_barrier(b_); } while (0)
    if (IN(8)) {
        { FRESH_TID(); for (int r0 = bid * 64; r0 < MT; r0 += G * 64) ln1_rows<4>(a, tid, r0); }
        P8_SYNC();
        { FRESH_TID(); (void)tid; pg8::Gemm g{(const bf16_t*)(ws + WS_H1B), (const bf16_t*)(ws + WS_WR2), MT, 256, DM}; pg8::RouterOrder S; S.G = G; S.c = bid; pg8::EpiRouter E{(float*)(ws + WS_LGP)};
          pg8::gemm_phase<pg8::EpiRouter, pg8::RouterOrder, true, true>(lds, g, S, E); }
        P8_SYNC();
        { FRESH_TID(); for (int r0 = bid * 64; r0 < MT; r0 += G * 64) router_choose(a, lds, tid, r0); }
 }
    if (IN(8) && IN(10)) { XcdBarrier b_; b_.bar = (unsigned*)(a.ws + WS_CTL) + CW_BAR; b_.x = xb_xcc_id(); b_.st = (volatile LAS unsigned*)(lds + LDS_BARST); xcd_barrier(b_); }
    if (IN(10)) { FRESH_TID(); const unsigned* ctl = (const unsigned*)(ws + WS_CTL);
        LAS int* tb = (LAS int*)(lds + LDS_MOE_TB); LAS unsigned* TE = (LAS unsigned*)(lds + LDS_MOE_TE); LAS unsigned* TOK = (LAS unsigned*)(lds + LDS_MOE_TOK);
        __syncthreads(); load_tile_base(a, tb, tid);
        if (tid < NEXP) for (int t = tb[tid]; t < tb[tid + 1]; ++t) TE[t] = (unsigned)tid;
        __syncthreads();
        const int NT = tb[NEXP];
        pg8::GroupedOrder<true> S; S.init(NT, 8, G, bid, TE, TOK);
        { const int* rows = (const int*)(ws + WS_ROWS);
          for (int i = 0; i < 8; ++i) { pg8::Unit u; if (!S.next(i, u)) break;
              if (tid < 256) { const int e = (int)TE[u.pm], pos = (u.pm - tb[e]) * 256 + tid, cnt = (int)ctl[CW_CNT + 64 * e];
                  TOK[i * 256 + tid] = (pos < cnt) ? (unsigned)rows[e * MT + pos] * (unsigned)DM : 0u; } } }
        __syncthreads();
        pg8::Gemm g{(const bf16_t*)(ws + WS_H1F8), (const bf16_t*)(ws + WS_WGU), NT * 256, 2048, DM / 2};
        pg8::EpiGateUp E{ws + WS_HH};
        for (int rp = 0; rp < REP[12]; ++rp) pg8::gemm_phase<pg8::EpiGateUp, pg8::GroupedOrder<true>, true, true>(lds, g, S, E); }
    SEAM(10);
    if (IN(11)) { FRESH_TID();
        LAS int* tb = (LAS int*)(lds + LDS_MOE_TB); LAS unsigned* TE = (LAS unsigned*)(lds + LDS_MOE_TE);
        __syncthreads(); load_tile_base(a, tb, tid);
        if (tid < NEXP) for (int t = tb[tid]; t < tb[tid + 1]; ++t) TE[t] = (unsigned)tid;
        __syncthreads();
        const int NT = tb[NEXP];
        int kd = DFF / 2; asm volatile("" : "+s"(kd));
        pg8::Gemm g{(const bf16_t*)(ws + WS_HH), (const bf16_t*)(ws + WS_WD), NT * 256, 2048, kd}; pg8::GroupedOrder<false> S; S.init(NT, 8, G, bid, TE, nullptr);
        pg8::EpiStoreF8 E{ws + WS_Y, DM, uni_f(G > 0 ? F8_UNSCALE * F8_YSCALE : 0.f)};
        for (int rp = 0; rp < REP[13]; ++rp) pg8::gemm_phase<pg8::EpiStoreF8, pg8::GroupedOrder<false>, true, true>(lds, g, S, E); }
    SEAM(11);
    if (IN(12)) { FRESH_TID(); LAS int* tb = (LAS int*)lds; __syncthreads(); load_tile_base(a, tb, tid);
        for (int rp = 0; rp < REP[14]; ++rp) phase_final(a, tid, G, tb); }
#undef IN
#undef SEAM
}

#ifndef MK_SPLIT
#define MK_SPLIT 0
#endif
extern "C" void kernel_launch(void* const* d_in, const int* in_sizes, int n_in, void* d_out, int out_size, void* d_ws, size_t ws_size, hipStream_t stream) {
    static int grid = 0;
    if (grid == 0) {
        int dev = 0, cus = 0, per_cu = 0;
        if (n_in != 19 || out_size != MT * DM || ws_size < WS_END) { fprintf(stderr, "kernel_launch: unexpected shapes: n_in %d out %d ws %zu (need %zu)\n", n_in, out_size, ws_size, (size_t)WS_END); grid = -1; return; }
        if (hipGetDevice(&dev) != hipSuccess || hipDeviceGetAttribute(&cus, hipDeviceAttributeMultiprocessorCount, dev) != hipSuccess) { grid = -1; return; }
        if (hipFuncSetAttribute((const void*)mk_fwd, hipFuncAttributeMaxDynamicSharedMemorySize, LDS_BYTES) != hipSuccess) { fprintf(stderr, "kernel_launch: hipFuncSetAttribute failed\n"); grid = -1; return; }
        if (hipOccupancyMaxActiveBlocksPerMultiprocessor(&per_cu, (const void*)mk_fwd, NTHR, LDS_BYTES) != hipSuccess || per_cu < 1) { fprintf(stderr, "kernel_launch: occupancy query says %d blocks/CU\n", per_cu); grid = -1; return; }
        grid = cus;
    }
    if (grid < 0) return;
    (void)hipMemsetAsync((char*)d_ws + WS_CTL, 0, 1 * MiB, stream);
    Args a{};
    for (int i = 0; i < 19; ++i) a.in[i] = (const float*)d_in[i];
    a.out = (float*)d_out; a.ws = (unsigned char*)d_ws;
#if MK_SPLIT
#ifndef MK_DUP
#define MK_DUP -1
#endif
    for (int p2 = 0; p2 < NPH + (MK_DUP >= 0 ? 1 : 0); ++p2) { const int p = (MK_DUP >= 0 && p2 > MK_DUP) ? p2 - 1 : p2;
        a.ph_lo = p; a.ph_hi = p + 1; void* args[] = {&a};
        hipError_t e = hipLaunchCooperativeKernel((const void*)mk_fwd, dim3(grid), dim3(NTHR), args, LDS_BYTES, stream);
        if (e != hipSuccess) { fprintf(stderr, "cooperative launch (phase %d) failed: %s (grid %d)\n", p, hipGetErrorString(e), grid); break; } }
#else
    a.ph_lo = 0; a.ph_hi = NPH; void* args[] = {&a};
    hipError_t e = hipLaunchCooperativeKernel((const void*)mk_fwd, dim3(grid), dim3(NTHR), args, LDS_BYTES, stream);
    if (e != hipSuccess) fprintf(stderr, "cooperative launch failed: %s (grid %d)\n", hipGetErrorString(e), grid);
#endif
}
```
